# Optimizing an MI355X kernel written in HIP

```python
import jax, jax.numpy as jnp
from jax import lax
import numpy as np

D_MODEL = 2048
BATCH = 8
SEQ = 2048
DEPTH = 1

MEM_LEN = 256
EPS = 1e-6
ATTN_HEADS = 8
HEAD_DIM = 128
ATTN_WIDTH = ATTN_HEADS * HEAD_DIM
ROPE_DIM = HEAD_DIM // 4
ROPE_THETA = 500000.0
MOBA_BLOCK = 256
MOBA_TOPK = 3
MOBA_Q_BLOCK = 64
SSM_WIDTH = D_MODEL
SSM_HEAD_DIM = 64
SSM_HEADS = SSM_WIDTH // SSM_HEAD_DIM
SSM_GROUPS = 4
SSM_STATE = 128
SSM_CONV = 4
SSM_CHUNK = 128
SSM_CONV_DIM = SSM_WIDTH + 2 * SSM_GROUPS * SSM_STATE
MIX_WIDTH = ATTN_WIDTH + SSM_WIDTH
IN_PROJ_WIDTH = 3 * ATTN_WIDTH + SSM_WIDTH + SSM_CONV_DIM + SSM_HEADS
IN_PROJ_SPLITS = (ATTN_WIDTH, 2 * ATTN_WIDTH, 3 * ATTN_WIDTH,
                  3 * ATTN_WIDTH + SSM_WIDTH,
                  3 * ATTN_WIDTH + SSM_WIDTH + SSM_CONV_DIM)
CROSS_HEADS = 4
CROSS_HEAD_DIM = 128
CROSS_WIDTH = CROSS_HEADS * CROSS_HEAD_DIM
N_EXPERT_GROUPS = 4
EXPERTS_PER_GROUP = 8
N_EXPERTS = N_EXPERT_GROUPS * EXPERTS_PER_GROUP
TOP_K_IN_GROUP = 2
D_EXPERT = 1024
MOE_ROW_BLOCK = 256

kernel_name = "hymba_moba_ssd_hmoe_block"


def rmsnorm(x, w):
    xf = x.astype(jnp.float32)
    var = jnp.mean(xf * xf, axis=-1, keepdims=True)
    return (xf * lax.rsqrt(var + EPS)).astype(x.dtype) * w.astype(x.dtype)


def partial_rope(x, pos):
    half = ROPE_DIM // 2
    inv_freq = jnp.power(ROPE_THETA, -jnp.arange(0, ROPE_DIM, 2, dtype=jnp.float32) / ROPE_DIM)
    ang = pos.astype(jnp.float32)[:, None] * inv_freq[None, :]
    cos = jnp.cos(ang)[None, :, None, :]
    sin = jnp.sin(ang)[None, :, None, :]
    xf = x.astype(jnp.float32)
    x1, x2, rest = xf[..., :half], xf[..., half:ROPE_DIM], xf[..., ROPE_DIM:]
    out = jnp.concatenate([x1 * cos - x2 * sin, x2 * cos + x1 * sin, rest], axis=-1)
    return out.astype(x.dtype)


def moba_attention(q, k, v):
    b, s, h, d = q.shape
    nb = -(-s // MOBA_BLOCK)
    s_pad = nb * MOBA_BLOCK
    pad = [(0, 0), (0, s_pad - s), (0, 0), (0, 0)]
    q, k, v = jnp.pad(q, pad), jnp.pad(k, pad), jnp.pad(v, pad)
    scale = d ** -0.5
    kb = k.reshape(b, nb, MOBA_BLOCK, h, d).transpose(0, 3, 1, 2, 4)
    vb = v.reshape(b, nb, MOBA_BLOCK, h, d).transpose(0, 3, 1, 2, 4)
    k_mean = jnp.mean(kb.astype(jnp.float32), axis=3)
    q_blk = jnp.arange(s_pad) // MOBA_BLOCK
    gate = jnp.einsum('bshd,bhnd->bhsn', q.astype(jnp.float32), k_mean)
    fully_past = jnp.arange(nb)[None, :] < q_blk[:, None]
    gate = jnp.where(fully_past, gate, -jnp.inf)
    top_k = min(MOBA_TOPK, nb)
    _, sel = lax.top_k(gate, top_k)
    valid = sel < q_blk[None, None, :, None]
    nq = s_pad // MOBA_Q_BLOCK
    q_c = q.reshape(b, nq, MOBA_Q_BLOCK, h, d)
    sel_c = sel.transpose(0, 2, 1, 3).reshape(b, nq, MOBA_Q_BLOCK, h, top_k)
    valid_c = valid.transpose(0, 2, 1, 3).reshape(b, nq, MOBA_Q_BLOCK, h, top_k)
    chunk_ids = jnp.arange(nq)
    head_idx = jnp.arange(h)[None, :, None]
    n_sel = top_k * MOBA_BLOCK

    def per_batch(args):
        q_b, sel_b, valid_b, kb_b, vb_b = args

        def per_chunk(cargs):
            qc, selc, validc, ci = cargs
            k_sel = kb_b[head_idx, selc]
            v_sel = vb_b[head_idx, selc]
            s_sel = jnp.einsum('qhd,qhktd->qhkt', qc, k_sel).astype(jnp.float32) * scale
            s_sel = jnp.where(validc[..., None], s_sel, -jnp.inf).reshape(MOBA_Q_BLOCK, h, n_sel)
            blk = (ci * MOBA_Q_BLOCK) // MOBA_BLOCK
            k_own = lax.dynamic_index_in_dim(kb_b, blk, axis=1, keepdims=False)
            v_own = lax.dynamic_index_in_dim(vb_b, blk, axis=1, keepdims=False)
            s_own = jnp.einsum('qhd,htd->qht', qc, k_own).astype(jnp.float32) * scale
            q_pos = ci * MOBA_Q_BLOCK + jnp.arange(MOBA_Q_BLOCK)
            k_pos = blk * MOBA_BLOCK + jnp.arange(MOBA_BLOCK)
            causal = (k_pos[None, :] <= q_pos[:, None])[:, None, :]
            s_own = jnp.where(causal, s_own, -jnp.inf)
            p = jax.nn.softmax(jnp.concatenate([s_sel, s_own], axis=-1), axis=-1).astype(v_sel.dtype)
            p_sel = p[..., :n_sel].reshape(MOBA_Q_BLOCK, h, top_k, MOBA_BLOCK)
            p_own = p[..., n_sel:]
            return (jnp.einsum('qhkt,qhktd->qhd', p_sel, v_sel)
                    + jnp.einsum('qht,htd->qhd', p_own, v_own))

        return lax.map(per_chunk, (q_b, sel_b, valid_b, chunk_ids))

    out = lax.map(per_batch, (q_c, sel_c, valid_c, kb, vb))
    return out.reshape(b, s_pad, h, d)[:, :s]


def causal_depthwise_conv(x, w, bias):
    out = lax.conv_general_dilated(
        x, w[:, None, :].astype(x.dtype), window_strides=(1,), padding=[(SSM_CONV - 1, 0)],
        dimension_numbers=('NWC', 'WIO', 'NWC'), feature_group_count=x.shape[-1])
    return out + bias.astype(x.dtype)


def ssd_chunked_scan(x, dt, a, bm, cm):
    b, s, h, p = x.shape
    g, n = bm.shape[2], bm.shape[3]
    e = h // g
    l = SSM_CHUNK
    c = s // l
    xdt = (x.astype(jnp.float32) * dt[..., None]).reshape(b, c, l, g, e, p)
    a_dt = (dt * a).reshape(b, c, l, g, e).transpose(0, 3, 4, 1, 2)
    bmf = bm.astype(jnp.float32).reshape(b, c, l, g, n)
    cmf = cm.astype(jnp.float32).reshape(b, c, l, g, n)
    a_cs = jnp.cumsum(a_dt, axis=-1)
    causal = jnp.tril(jnp.ones((l, l), dtype=bool))
    seg = a_cs[..., :, None] - a_cs[..., None, :]
    decay = jnp.exp(jnp.where(causal, seg, -jnp.inf))
    cb = jnp.einsum('bclgn,bcsgn->bcgls', cmf, bmf)
    y_diag = jnp.einsum('bcgls,bgecls,bcsgep->bclgep', cb, decay, xdt)
    decay_to_end = jnp.exp(a_cs[..., -1:] - a_cs)
    states = jnp.einsum('bcsgn,bgecs,bcsgep->bcgepn', bmf, decay_to_end, xdt)
    chunk_decay = jnp.exp(a_cs[..., -1])

    def step(carry, inp):
        st, dec = inp
        return carry * dec[..., None, None] + st, carry

    init = jnp.zeros((b, g, e, p, n), jnp.float32)
    _, prev_states = lax.scan(step, init, (states.transpose(1, 0, 2, 3, 4, 5),
                                           chunk_decay.transpose(3, 0, 1, 2)))
    prev_states = prev_states.transpose(1, 0, 2, 3, 4, 5)
    y_off = jnp.einsum('bclgn,bcgepn,bgecl->bclgep', cmf, prev_states, jnp.exp(a_cs))
    return (y_diag + y_off).reshape(b, s, h, p)


def ssd_mixer(z, xbc, dt_raw, conv_w, conv_b, dt_bias, a_log, d_skip, ssm_norm_w):
    b, s, _ = z.shape
    xbc = jax.nn.silu(causal_depthwise_conv(xbc, conv_w, conv_b))
    xs = xbc[..., :SSM_WIDTH].reshape(b, s, SSM_HEADS, SSM_HEAD_DIM)
    bm = xbc[..., SSM_WIDTH:SSM_WIDTH + SSM_GROUPS * SSM_STATE].reshape(b, s, SSM_GROUPS, SSM_STATE)
    cm = xbc[..., SSM_WIDTH + SSM_GROUPS * SSM_STATE:].reshape(b, s, SSM_GROUPS, SSM_STATE)
    dt = jax.nn.softplus(dt_raw.astype(jnp.float32) + dt_bias.astype(jnp.float32))
    a = -jnp.exp(a_log.astype(jnp.float32))
    y = ssd_chunked_scan(xs, dt, a, bm, cm)
    y = y + xs.astype(jnp.float32) * d_skip.astype(jnp.float32)[:, None]
    yg = y.reshape(b, s, SSM_WIDTH) * jax.nn.silu(z.astype(jnp.float32))
    yg = yg.reshape(b, s, SSM_GROUPS, SSM_WIDTH // SSM_GROUPS)
    yg = yg * lax.rsqrt(jnp.mean(yg * yg, axis=-1, keepdims=True) + EPS)
    return yg.reshape(b, s, SSM_WIDTH).astype(z.dtype) * ssm_norm_w.astype(z.dtype)


def memory_cross_attention(u, mem, mem_norm_w, w_cq, w_ck, w_cv, w_co):
    b, s, _ = u.shape
    m = mem.shape[1]
    mn = rmsnorm(mem, mem_norm_w)
    q = (u @ w_cq).reshape(b, s, CROSS_HEADS, CROSS_HEAD_DIM)
    k = (mn @ w_ck).reshape(b, m, CROSS_HEADS, CROSS_HEAD_DIM)
    v = (mn @ w_cv).reshape(b, m, CROSS_HEADS, CROSS_HEAD_DIM)
    logits = jnp.einsum('bshd,bmhd->bhsm', q, k).astype(jnp.float32) * CROSS_HEAD_DIM ** -0.5
    p = jax.nn.softmax(logits, axis=-1).astype(v.dtype)
    o = jnp.einsum('bhsm,bmhd->bshd', p, v).reshape(b, s, CROSS_WIDTH)
    return o @ w_co


def hierarchical_moe(u, w_rg, b_rg, w_re, b_re, w_gate, w_up, w_down):
    b, s, d = u.shape
    t = u.reshape(-1, d)
    nt = t.shape[0]
    g_prob = jax.nn.softmax((t @ w_rg).astype(jnp.float32) + b_rg.astype(jnp.float32), axis=-1)
    g_w, g_idx = lax.top_k(g_prob, 1)
    e_logits = ((t @ w_re).astype(jnp.float32) + b_re.astype(jnp.float32)).reshape(
        nt, N_EXPERT_GROUPS, EXPERTS_PER_GROUP)
    e_logits_g = jnp.take_along_axis(e_logits, g_idx[:, :, None], axis=1)[:, 0]
    e_top, e_loc = lax.top_k(e_logits_g, TOP_K_IN_GROUP)
    weights = g_w * jax.nn.softmax(e_top, axis=-1)
    expert = g_idx * EXPERTS_PER_GROUP + e_loc
    n_assign = nt * TOP_K_IN_GROUP
    flat_e = expert.reshape(-1)
    flat_t = jnp.repeat(jnp.arange(nt), TOP_K_IN_GROUP)
    flat_w = weights.reshape(-1)
    order = jnp.argsort(flat_e)
    e_sorted, t_sorted, w_sorted = flat_e[order], flat_t[order], flat_w[order]
    counts = jnp.zeros((N_EXPERTS,), jnp.int32).at[flat_e].add(1)
    start = jnp.cumsum(counts) - counts
    padded = (counts + MOE_ROW_BLOCK - 1) // MOE_ROW_BLOCK * MOE_ROW_BLOCK
    pad_end = jnp.cumsum(padded)
    pad_start = pad_end - padded
    dest = pad_start[e_sorted] + (jnp.arange(n_assign) - start[e_sorted])
    n_blocks = -(-n_assign // MOE_ROW_BLOCK) + N_EXPERTS
    rows = jnp.zeros((n_blocks * MOE_ROW_BLOCK, d), t.dtype).at[dest].set(t[t_sorted])
    block_expert = jnp.minimum(
        jnp.searchsorted(pad_end, jnp.arange(n_blocks) * MOE_ROW_BLOCK, side='right'), N_EXPERTS - 1)

    def expert_block(args):
        xb, ei = args
        return (jax.nn.silu(xb @ w_gate[ei]) * (xb @ w_up[ei])) @ w_down[ei]

    y_rows = lax.map(expert_block, (rows.reshape(n_blocks, MOE_ROW_BLOCK, d), block_expert))
    y_assign = y_rows.reshape(-1, d)[dest] * w_sorted[:, None].astype(t.dtype)
    out = jax.ops.segment_sum(y_assign, t_sorted, num_segments=nt)
    return out.reshape(b, s, d)


def setup_inputs(seed: int = 0) -> dict:
    key = jax.random.key(seed)
    ks = jax.random.split(key, 32)
    f32 = jnp.float32
    L = DEPTH

    def nrm(k, shape, fan_in):
        return jax.random.normal(k, shape, f32) * fan_in ** -0.5

    def gain(k, shape):
        return 1.0 + 0.02 * jax.random.normal(k, shape, f32)

    dt0 = jnp.exp(jax.random.uniform(ks[6], (L, SSM_HEADS), f32, np.log(1e-3), np.log(1e-1)))
    return {
        "x": jax.random.normal(ks[0], (BATCH, SEQ, D_MODEL), f32),
        "mem": jax.random.normal(ks[1], (BATCH, MEM_LEN, D_MODEL), f32),
        "norm_mix_w": gain(ks[2], (L, D_MODEL)),
        "w_in": nrm(ks[3], (L, D_MODEL, IN_PROJ_WIDTH), D_MODEL),
        "conv_w": nrm(ks[4], (L, SSM_CONV, SSM_CONV_DIM), SSM_CONV),
        "conv_b": 0.02 * jax.random.normal(ks[5], (L, SSM_CONV_DIM), f32),
        "dt_bias": dt0 + jnp.log(-jnp.expm1(-dt0)),
        "a_log": jnp.log(jax.random.uniform(ks[7], (L, SSM_HEADS), f32, 1.0, 16.0)),
        "d_skip": 1.0 + 0.1 * jax.random.normal(ks[8], (L, SSM_HEADS), f32),
        "attn_norm_w": gain(ks[9], (L, ATTN_WIDTH)),
        "ssm_norm_w": gain(ks[10], (L, SSM_WIDTH)),
        "w_out": nrm(ks[11], (L, MIX_WIDTH, D_MODEL), MIX_WIDTH),
        "norm_cross_w": gain(ks[12], (L, D_MODEL)),
        "mem_norm_w": gain(ks[13], (L, D_MODEL)),
        "w_cq": nrm(ks[14], (L, D_MODEL, CROSS_WIDTH), D_MODEL),
        "w_ck": nrm(ks[15], (L, D_MODEL, CROSS_WIDTH), D_MODEL),
        "w_cv": nrm(ks[16], (L, D_MODEL, CROSS_WIDTH), D_MODEL),
        "w_co": nrm(ks[17], (L, CROSS_WIDTH, D_MODEL), CROSS_WIDTH),
        "norm_ffn_w": gain(ks[18], (L, D_MODEL)),
        "w_router_group": nrm(ks[19], (L, D_MODEL, N_EXPERT_GROUPS), D_MODEL),
        "b_router_group": 0.01 * jax.random.normal(ks[20], (L, N_EXPERT_GROUPS), f32),
        "w_router_expert": nrm(ks[21], (L, D_MODEL, N_EXPERTS), D_MODEL),
        "b_router_expert": 0.01 * jax.random.normal(ks[22], (L, N_EXPERTS), f32),
        "w_gate": nrm(ks[23], (L, N_EXPERTS, D_MODEL, D_EXPERT), D_MODEL),
        "w_up": nrm(ks[24], (L, N_EXPERTS, D_MODEL, D_EXPERT), D_MODEL),
        "w_down": nrm(ks[25], (L, N_EXPERTS, D_EXPERT, D_MODEL), D_EXPERT),
        "final_norm_w": gain(ks[26], (D_MODEL,)),
    }


def reference(x, mem, norm_mix_w, w_in, conv_w, conv_b, dt_bias, a_log, d_skip, attn_norm_w,
              ssm_norm_w, w_out, norm_cross_w, mem_norm_w, w_cq, w_ck, w_cv, w_co, norm_ffn_w,
              w_router_group, b_router_group, w_router_expert, b_router_expert, w_gate, w_up,
              w_down, final_norm_w):
    b, s, _ = x.shape
    pos = jnp.arange(s)
    h = x
    for i in range(DEPTH):
        u = rmsnorm(h, norm_mix_w[i])
        proj = u @ w_in[i]
        q, k, v, z, xbc, dt_raw = jnp.split(proj, IN_PROJ_SPLITS, axis=-1)
        q = partial_rope(q.reshape(b, s, ATTN_HEADS, HEAD_DIM), pos)
        k = partial_rope(k.reshape(b, s, ATTN_HEADS, HEAD_DIM), pos)
        v = v.reshape(b, s, ATTN_HEADS, HEAD_DIM)
        attn = moba_attention(q, k, v)
        attn = rmsnorm(attn, attn_norm_w[i].reshape(ATTN_HEADS, HEAD_DIM)).reshape(b, s, ATTN_WIDTH)
        ssm = ssd_mixer(z, xbc, dt_raw, conv_w[i], conv_b[i], dt_bias[i], a_log[i], d_skip[i],
                        ssm_norm_w[i])
        h = h + jnp.concatenate([attn, ssm], axis=-1) @ w_out[i]
        h = h + memory_cross_attention(rmsnorm(h, norm_cross_w[i]), mem, mem_norm_w[i],
                                       w_cq[i], w_ck[i], w_cv[i], w_co[i])
        h = h + hierarchical_moe(rmsnorm(h, norm_ffn_w[i]), w_router_group[i], b_router_group[i],
                                 w_router_expert[i], b_router_expert[i], w_gate[i], w_up[i],
                                 w_down[i])
    return rmsnorm(h, final_norm_w)
```

```cpp
#include <hip/hip_runtime.h>
#include <stdint.h>
#include <math.h>

namespace {
constexpr int DM = 2048, BATCH = 8, SEQ = 2048, M = BATCH * SEQ, MEM = 256, MROWS = BATCH * MEM;
constexpr float EPS = 1e-6f;
constexpr int AH = 8, HD = 128, AW = 1024, ROPE = 32;
constexpr int MB = 256, NB = SEQ / MB;
constexpr int SW = 2048, SHD = 64, SH = 32, SG = 4, SN = 128, SCONV = 4, CONVD = 3072;
constexpr int MIXW = 3072, INW = 8224;
constexpr int C_Q = 0, C_K = 1024, C_V = 2048, C_Z = 3072, C_XBC = 5120, C_DT = 8192;
constexpr int CH = 4, CHD = 128, CW = 512;
constexpr int NG = 4, EPG = 8, NE = 32, DE = 1024;
constexpr int NASSIGN = M * 2;

__device__ __forceinline__ float wave_sum(float v) {
#pragma unroll
  for (int o = 1; o < 64; o <<= 1) v += __shfl_xor(v, o);
  return v;
}
__device__ __forceinline__ float wave_max(float v) {
#pragma unroll
  for (int o = 1; o < 64; o <<= 1) v = fmaxf(v, __shfl_xor(v, o));
  return v;
}
__device__ __forceinline__ float silu_f(float x) { return x / (1.f + __expf(-x)); }

__global__ __launch_bounds__(256) void k_rmsnorm(const float* __restrict__ x, const float* __restrict__ w, float* __restrict__ out) {
  __shared__ float red[4];
  const size_t row = blockIdx.x; const int tid = threadIdx.x;
  const float4* xr = (const float4*)(x + row * DM);
  float4 a = xr[tid], b = xr[tid + 256];
  float s = a.x * a.x + a.y * a.y + a.z * a.z + a.w * a.w + b.x * b.x + b.y * b.y + b.z * b.z + b.w * b.w;
  s = wave_sum(s);
  if ((tid & 63) == 0) red[tid >> 6] = s;
  __syncthreads();
  const float tot = red[0] + red[1] + red[2] + red[3];
  const float rs = rsqrtf(tot * (1.f / DM) + EPS);
  const float4 wa = ((const float4*)w)[tid], wb = ((const float4*)w)[tid + 256];
  float4* o = (float4*)(out + row * DM);
  o[tid] = make_float4(a.x * rs * wa.x, a.y * rs * wa.y, a.z * rs * wa.z, a.w * rs * wa.w);
  o[tid + 256] = make_float4(b.x * rs * wb.x, b.y * rs * wb.y, b.z * rs * wb.z, b.w * rs * wb.w);
}

__global__ __launch_bounds__(256) void k_gemm(const float* __restrict__ A, int lda, const float* __restrict__ B, int ldb, float* C, int ldc,
                                              const float* R, int ldr, int N, int K) {
  __shared__ float As[16][68];
  __shared__ float Bs[16][68];
  const int tid = threadIdx.x, tx = tid & 15, ty = tid >> 4;
  const int m0 = blockIdx.y * 64, n0 = blockIdx.x * 64;
  float acc[4][4];
#pragma unroll
  for (int i = 0; i < 4; ++i)
#pragma unroll
    for (int j = 0; j < 4; ++j) acc[i][j] = 0.f;
  const int arow = tid >> 2, akq = (tid & 3) * 4;
  const int bk = tid >> 4, bn = (tid & 15) * 4;
  for (int k0 = 0; k0 < K; k0 += 16) {
    const float4 av = *(const float4*)(A + (size_t)(m0 + arow) * lda + k0 + akq);
    float4 bv = make_float4(0.f, 0.f, 0.f, 0.f);
    if (n0 + bn < N) bv = *(const float4*)(B + (size_t)(k0 + bk) * ldb + n0 + bn);
    As[akq + 0][arow] = av.x; As[akq + 1][arow] = av.y; As[akq + 2][arow] = av.z; As[akq + 3][arow] = av.w;
    *(float4*)&Bs[bk][bn] = bv;
    __syncthreads();
#pragma unroll
    for (int kk = 0; kk < 16; ++kk) {
      const float4 a4 = *(const float4*)&As[kk][ty * 4];
      const float4 b4 = *(const float4*)&Bs[kk][tx * 4];
      const float a[4] = {a4.x, a4.y, a4.z, a4.w}, b[4] = {b4.x, b4.y, b4.z, b4.w};
#pragma unroll
      for (int i = 0; i < 4; ++i)
#pragma unroll
        for (int j = 0; j < 4; ++j) acc[i][j] = fmaf(a[i], b[j], acc[i][j]);
    }
    __syncthreads();
  }
  if (n0 + tx * 4 < N) {
#pragma unroll
    for (int i = 0; i < 4; ++i) {
      const size_t r = (size_t)(m0 + ty * 4 + i);
      float4 o = make_float4(acc[i][0], acc[i][1], acc[i][2], acc[i][3]);
      if (R) { const float4 rv = *(const float4*)(R + r * ldr + n0 + tx * 4); o.x += rv.x; o.y += rv.y; o.z += rv.z; o.w += rv.w; }
      *(float4*)(C + r * ldc + n0 + tx * 4) = o;
    }
  }
}

struct RopeFreq { float f[16]; };
__global__ __launch_bounds__(256) void k_rope(float* proj, RopeFreq rf) {
  const size_t gid = (size_t)blockIdx.x * 256 + threadIdx.x;
  const int i = gid & 15; const int head = (gid >> 4) & 7; const int qk = (gid >> 7) & 1; const size_t tok = gid >> 8;
  if (tok >= (size_t)M) return;
  const int pos = (int)(tok % SEQ);
  const float ang = (float)pos * rf.f[i];
  double r = (double)ang * 0.15915494309189533577; r -= rint(r);
  const float th = (float)(r * 6.283185307179586477);
  const float c = cosf(th), s = sinf(th);
  float* p = proj + tok * INW + (qk ? C_K : C_Q) + head * HD;
  const float x1 = p[i], x2 = p[16 + i];
  p[i] = x1 * c - x2 * s; p[16 + i] = x2 * c + x1 * s;
}

__global__ __launch_bounds__(256) void k_kmean(const float* __restrict__ proj, float* __restrict__ kmean) {
  const int gid = blockIdx.x * 256 + threadIdx.x;
  const int col = gid & 1023; const int bb = gid >> 10;
  const float* p = proj + (size_t)bb * MB * INW + C_K + col;
  float s = 0.f;
  for (int t = 0; t < MB; ++t) s += p[(size_t)t * INW];
  kmean[gid] = s * (1.f / MB);
}

__global__ __launch_bounds__(256) void k_moba(const float* __restrict__ proj, const float* __restrict__ kmean, const float* __restrict__ anw, float* __restrict__ mix) {
  __shared__ float qs_all[4][128];
  __shared__ float sc_all[4][1024];
  const int wid = threadIdx.x >> 6, lane = threadIdx.x & 63;
  const int gw = blockIdx.x * 4 + wid;
  const int h = gw & 7; const int tok = gw >> 3; const int b = tok / SEQ, s = tok % SEQ;
  float* qs = qs_all[wid]; float* sc = sc_all[wid];
  const float* qp = proj + (size_t)tok * INW + C_Q + h * HD;
  const float q0 = qp[lane], q1 = qp[lane + 64];
  qs[lane] = q0; qs[lane + 64] = q1;
  const int j = s / MB;
  float gate[NB];
#pragma unroll
  for (int kb = 0; kb < NB; ++kb) {
    float g = -INFINITY;
    if (kb < j) { const float* km = kmean + (size_t)(b * NB + kb) * 1024 + h * HD; g = wave_sum(q0 * km[lane] + q1 * km[lane + 64]); }
    gate[kb] = g;
  }
  unsigned selmask = 0;
#pragma unroll
  for (int r = 0; r < 3; ++r) {
    float best = -INFINITY; int bi = -1;
#pragma unroll
    for (int kb = 0; kb < NB; ++kb) { const bool ok = (kb < j) && !((selmask >> kb) & 1u) && (gate[kb] > best || bi < 0); if (ok) { best = gate[kb]; bi = kb; } }
    if (bi >= 0) selmask |= 1u << bi;
  }
  __syncthreads();
  const float scale = 0.08838834764831845f;
  int nslot = 0; float mx = -INFINITY;
  for (int kb = 0; kb <= j; ++kb) {
    const bool own = (kb == j);
    if (!own && !((selmask >> kb) & 1u)) continue;
#pragma unroll
    for (int i = 0; i < 4; ++i) {
      const int kl = lane + 64 * i; const int key = kb * MB + kl;
      const float* kp = proj + (size_t)(b * SEQ + key) * INW + C_K + h * HD;
      float d = 0.f;
      for (int dd = 0; dd < 128; dd += 4) { const float4 kv = *(const float4*)(kp + dd); d += qs[dd] * kv.x + qs[dd + 1] * kv.y + qs[dd + 2] * kv.z + qs[dd + 3] * kv.w; }
      d *= scale;
      if (own && key > s) d = -INFINITY;
      sc[nslot * 256 + kl] = d; mx = fmaxf(mx, d);
    }
    ++nslot;
  }
  mx = wave_max(mx);
  float sum = 0.f;
  for (int i = lane; i < nslot * 256; i += 64) { const float e = __expf(sc[i] - mx); sc[i] = e; sum += e; }
  sum = wave_sum(sum);
  __syncthreads();
  float o0 = 0.f, o1 = 0.f; int slot = 0;
  for (int kb = 0; kb <= j; ++kb) {
    const bool own = (kb == j);
    if (!own && !((selmask >> kb) & 1u)) continue;
    const float* vp = proj + (size_t)(b * SEQ + kb * MB) * INW + C_V + h * HD;
    const int lim = own ? (s - kb * MB + 1) : MB;
    for (int kl = 0; kl < lim; ++kl) { const float p = sc[slot * 256 + kl]; o0 += p * vp[(size_t)kl * INW + lane]; o1 += p * vp[(size_t)kl * INW + lane + 64]; }
    ++slot;
  }
  const float inv = 1.f / sum; o0 *= inv; o1 *= inv;
  const float ss = wave_sum(o0 * o0 + o1 * o1);
  const float rs = rsqrtf(ss * (1.f / HD) + EPS);
  float* mp = mix + (size_t)tok * MIXW + h * HD;
  mp[lane] = o0 * rs * anw[h * HD + lane]; mp[lane + 64] = o1 * rs * anw[h * HD + lane + 64];
}

__global__ __launch_bounds__(256) void k_ssd(const float* __restrict__ proj, const float* __restrict__ conv_w, const float* __restrict__ conv_b,
                                             const float* __restrict__ dt_bias, const float* __restrict__ a_log, const float* __restrict__ d_skip,
                                             float* __restrict__ yg) {
  constexpr int T = 16;
  __shared__ float xs[T][64], Bs[T][128], Cs[T][128], dts[T];
  const int b = blockIdx.x / SH, h = blockIdx.x % SH, g = h / (SH / SG);
  const int tid = threadIdx.x, p = tid >> 2, nq = tid & 3;
  const float a = -__expf(a_log[h]), dtb = dt_bias[h], Dh = d_skip[h];
  float st[32];
#pragma unroll
  for (int i = 0; i < 32; ++i) st[i] = 0.f;
  for (int t0 = 0; t0 < SEQ; t0 += T) {
    __syncthreads();
    for (int idx = tid; idx < T * 320; idx += 256) {
      const int tt = idx / 320, c = idx % 320; const int t = t0 + tt;
      int ch; if (c < 64) ch = h * 64 + c; else if (c < 192) ch = 2048 + g * 128 + (c - 64); else ch = 2560 + g * 128 + (c - 192);
      float v = conv_b[ch];
#pragma unroll
      for (int i = 0; i < SCONV; ++i) { const int ts = t - 3 + i; if (ts >= 0) v += conv_w[i * CONVD + ch] * proj[(size_t)(b * SEQ + ts) * INW + C_XBC + ch]; }
      v = silu_f(v);
      if (c < 64) xs[tt][c] = v; else if (c < 192) Bs[tt][c - 64] = v; else Cs[tt][c - 192] = v;
    }
    if (tid < T) { const float r = proj[(size_t)(b * SEQ + t0 + tid) * INW + C_DT + h] + dtb; dts[tid] = fmaxf(r, 0.f) + log1pf(__expf(-fabsf(r))); }
    __syncthreads();
    for (int tt = 0; tt < T; ++tt) {
      const float dt = dts[tt], dA = __expf(dt * a), xv = xs[tt][p], xdt = xv * dt;
      float y = 0.f;
      const float4* B4 = (const float4*)&Bs[tt][nq * 32]; const float4* C4 = (const float4*)&Cs[tt][nq * 32];
#pragma unroll
      for (int i = 0; i < 8; ++i) { const float4 bv = B4[i], cv = C4[i];
        st[4 * i + 0] = st[4 * i + 0] * dA + xdt * bv.x; y += cv.x * st[4 * i + 0];
        st[4 * i + 1] = st[4 * i + 1] * dA + xdt * bv.y; y += cv.y * st[4 * i + 1];
        st[4 * i + 2] = st[4 * i + 2] * dA + xdt * bv.z; y += cv.z * st[4 * i + 2];
        st[4 * i + 3] = st[4 * i + 3] * dA + xdt * bv.w; y += cv.w * st[4 * i + 3]; }
      y += __shfl_xor(y, 1); y += __shfl_xor(y, 2);
      if (nq == 0) {
        const size_t tok = (size_t)(b * SEQ + t0 + tt);
        const float z = proj[tok * INW + C_Z + h * 64 + p];
        yg[tok * SW + h * 64 + p] = (y + xv * Dh) * silu_f(z);
      }
    }
  }
}

__global__ __launch_bounds__(256) void k_gnorm(const float* __restrict__ yg, const float* __restrict__ w, float* __restrict__ mix) {
  const int gw = blockIdx.x * 4 + (threadIdx.x >> 6), lane = threadIdx.x & 63;
  const int g = gw & 3; const size_t tok = gw >> 2;
  const float* p = yg + tok * SW + g * 512;
  float v[8]; float s = 0.f;
#pragma unroll
  for (int i = 0; i < 8; ++i) { v[i] = p[lane + 64 * i]; s += v[i] * v[i]; }
  s = wave_sum(s);
  const float rs = rsqrtf(s * (1.f / 512.f) + EPS);
  float* o = mix + tok * MIXW + AW + g * 512;
#pragma unroll
  for (int i = 0; i < 8; ++i) o[lane + 64 * i] = v[i] * rs * w[g * 512 + lane + 64 * i];
}

__global__ __launch_bounds__(256) void k_xattn(const float* __restrict__ qc, const float* __restrict__ kc, const float* __restrict__ vc, float* __restrict__ oc) {
  __shared__ float qs_all[4][128];
  __shared__ float sc_all[4][256];
  const int wid = threadIdx.x >> 6, lane = threadIdx.x & 63;
  const int gw = blockIdx.x * 4 + wid; const int h = gw & 3; const int tok = gw >> 2; const int b = tok / SEQ;
  float* qs = qs_all[wid]; float* sc = sc_all[wid];
  const float* qp = qc + (size_t)tok * CW + h * CHD;
  qs[lane] = qp[lane]; qs[lane + 64] = qp[lane + 64];
  __syncthreads();
  const float scale = 0.08838834764831845f;
  float mx = -INFINITY;
#pragma unroll
  for (int i = 0; i < 4; ++i) {
    const int m = lane + 64 * i; const float* kp = kc + (size_t)(b * MEM + m) * CW + h * CHD;
    float d = 0.f;
    for (int dd = 0; dd < 128; dd += 4) { const float4 kv = *(const float4*)(kp + dd); d += qs[dd] * kv.x + qs[dd + 1] * kv.y + qs[dd + 2] * kv.z + qs[dd + 3] * kv.w; }
    d *= scale; sc[m] = d; mx = fmaxf(mx, d);
  }
  mx = wave_max(mx);
  float sum = 0.f;
#pragma unroll
  for (int i = 0; i < 4; ++i) { const int m = lane + 64 * i; const float e = __expf(sc[m] - mx); sc[m] = e; sum += e; }
  sum = wave_sum(sum);
  __syncthreads();
  float o0 = 0.f, o1 = 0.f;
  const float* vp = vc + (size_t)(b * MEM) * CW + h * CHD;
  for (int m = 0; m < MEM; ++m) { const float p = sc[m]; o0 += p * vp[(size_t)m * CW + lane]; o1 += p * vp[(size_t)m * CW + lane + 64]; }
  const float inv = 1.f / sum;
  float* op = oc + (size_t)tok * CW + h * CHD;
  op[lane] = o0 * inv; op[lane + 64] = o1 * inv;
}

__global__ __launch_bounds__(256) void k_route(const float* __restrict__ logits, const float* __restrict__ b_rg, const float* __restrict__ b_re,
                                               int* cnt, int* list, int* tok_e, int* tok_pos, float* tok_w) {
  const int t = blockIdx.x * 256 + threadIdx.x; if (t >= M) return;
  const float* lg = logits + (size_t)t * 36;
  float g[4]; float gm = -INFINITY; int gi = 0;
#pragma unroll
  for (int i = 0; i < 4; ++i) { g[i] = lg[i] + b_rg[i]; if (g[i] > gm) { gm = g[i]; gi = i; } }
  float gs = 0.f;
#pragma unroll
  for (int i = 0; i < 4; ++i) gs += __expf(g[i] - gm);
  const float gw = 1.f / gs;
  float e1 = -INFINITY, e2 = -INFINITY; int i1 = 0, i2 = 0;
#pragma unroll
  for (int i = 0; i < 8; ++i) { const float v = lg[4 + gi * 8 + i] + b_re[gi * 8 + i]; if (v > e1) { e2 = e1; i2 = i1; e1 = v; i1 = i; } else if (v > e2) { e2 = v; i2 = i; } }
  const float p2 = 1.f / (1.f + __expf(e1 - e2)), p1 = 1.f - p2;
  const int ea = gi * 8 + i1, eb = gi * 8 + i2;
  const int pa = atomicAdd(&cnt[ea], 1), pb = atomicAdd(&cnt[eb], 1);
  list[ea * M + pa] = t; list[eb * M + pb] = t;
  tok_e[t * 2] = ea; tok_e[t * 2 + 1] = eb; tok_pos[t * 2] = pa; tok_pos[t * 2 + 1] = pb; tok_w[t * 2] = gw * p1; tok_w[t * 2 + 1] = gw * p2;
}
__global__ void k_offsets(const int* cnt, int* off) { if (threadIdx.x == 0) { int s = 0; for (int e = 0; e < NE; ++e) { off[e] = s; s += cnt[e]; } off[NE] = s; } }

__global__ __launch_bounds__(256) void k_moe_gu(const float* __restrict__ T, const int* __restrict__ list, const int* __restrict__ cnt, const int* __restrict__ off,
                                                const float* __restrict__ Wg, const float* __restrict__ Wu, float* __restrict__ Hact) {
  __shared__ float As[16][68];
  __shared__ float Bg[16][68];
  __shared__ float Bu[16][68];
  const int e = blockIdx.z, c = cnt[e], m0 = blockIdx.y * 64; if (m0 >= c) return;
  const int tid = threadIdx.x, tx = tid & 15, ty = tid >> 4, n0 = blockIdx.x * 64;
  const int arow = tid >> 2, akq = (tid & 3) * 4, bk = tid >> 4, bn = (tid & 15) * 4;
  const int r = m0 + arow; const int tok = list[e * M + (r < c ? r : 0)];
  const float* wg = Wg + (size_t)e * DM * DE; const float* wu = Wu + (size_t)e * DM * DE;
  float ag[4][4], au[4][4];
#pragma unroll
  for (int i = 0; i < 4; ++i)
#pragma unroll
    for (int j = 0; j < 4; ++j) { ag[i][j] = 0.f; au[i][j] = 0.f; }
  for (int k0 = 0; k0 < DM; k0 += 16) {
    const float4 av = *(const float4*)(T + (size_t)tok * DM + k0 + akq);
    As[akq + 0][arow] = av.x; As[akq + 1][arow] = av.y; As[akq + 2][arow] = av.z; As[akq + 3][arow] = av.w;
    *(float4*)&Bg[bk][bn] = *(const float4*)(wg + (size_t)(k0 + bk) * DE + n0 + bn);
    *(float4*)&Bu[bk][bn] = *(const float4*)(wu + (size_t)(k0 + bk) * DE + n0 + bn);
    __syncthreads();
#pragma unroll
    for (int kk = 0; kk < 16; ++kk) {
      const float4 a4 = *(const float4*)&As[kk][ty * 4];
      const float4 g4 = *(const float4*)&Bg[kk][tx * 4];
      const float4 u4 = *(const float4*)&Bu[kk][tx * 4];
      const float a[4] = {a4.x, a4.y, a4.z, a4.w}, gg[4] = {g4.x, g4.y, g4.z, g4.w}, uu[4] = {u4.x, u4.y, u4.z, u4.w};
#pragma unroll
      for (int i = 0; i < 4; ++i)
#pragma unroll
        for (int j = 0; j < 4; ++j) { ag[i][j] = fmaf(a[i], gg[j], ag[i][j]); au[i][j] = fmaf(a[i], uu[j], au[i][j]); }
    }
    __syncthreads();
  }
#pragma unroll
  for (int i = 0; i < 4; ++i) {
    const int rr = m0 + ty * 4 + i; if (rr >= c) continue;
    float4 o = make_float4(silu_f(ag[i][0]) * au[i][0], silu_f(ag[i][1]) * au[i][1], silu_f(ag[i][2]) * au[i][2], silu_f(ag[i][3]) * au[i][3]);
    *(float4*)(Hact + (size_t)(off[e] + rr) * DE + n0 + tx * 4) = o;
  }
}
__global__ __launch_bounds__(256) void k_moe_down(const float* __restrict__ Hact, const int* __restrict__ cnt, const int* __restrict__ off,
                                                  const float* __restrict__ Wd, float* __restrict__ Y) {
  __shared__ float As[16][68];
  __shared__ float Bs[16][68];
  const int e = blockIdx.z, c = cnt[e], m0 = blockIdx.y * 64; if (m0 >= c) return;
  const int tid = threadIdx.x, tx = tid & 15, ty = tid >> 4, n0 = blockIdx.x * 64;
  const int arow = tid >> 2, akq = (tid & 3) * 4, bk = tid >> 4, bn = (tid & 15) * 4;
  const int r = m0 + arow; const size_t slot = (size_t)off[e] + (r < c ? r : 0);
  const float* wd = Wd + (size_t)e * DE * DM;
  float acc[4][4];
#pragma unroll
  for (int i = 0; i < 4; ++i)
#pragma unroll
    for (int j = 0; j < 4; ++j) acc[i][j] = 0.f;
  for (int k0 = 0; k0 < DE; k0 += 16) {
    const float4 av = *(const float4*)(Hact + slot * DE + k0 + akq);
    As[akq + 0][arow] = av.x; As[akq + 1][arow] = av.y; As[akq + 2][arow] = av.z; As[akq + 3][arow] = av.w;
    *(float4*)&Bs[bk][bn] = *(const float4*)(wd + (size_t)(k0 + bk) * DM + n0 + bn);
    __syncthreads();
#pragma unroll
    for (int kk = 0; kk < 16; ++kk) {
      const float4 a4 = *(const float4*)&As[kk][ty * 4];
      const float4 b4 = *(const float4*)&Bs[kk][tx * 4];
      const float a[4] = {a4.x, a4.y, a4.z, a4.w}, bb[4] = {b4.x, b4.y, b4.z, b4.w};
#pragma unroll
      for (int i = 0; i < 4; ++i)
#pragma unroll
        for (int j = 0; j < 4; ++j) acc[i][j] = fmaf(a[i], bb[j], acc[i][j]);
    }
    __syncthreads();
  }
#pragma unroll
  for (int i = 0; i < 4; ++i) {
    const int rr = m0 + ty * 4 + i; if (rr >= c) continue;
    *(float4*)(Y + (size_t)(off[e] + rr) * DM + n0 + tx * 4) = make_float4(acc[i][0], acc[i][1], acc[i][2], acc[i][3]);
  }
}
__global__ __launch_bounds__(256) void k_final(float* hio, const float* __restrict__ Y, const int* __restrict__ off, const int* __restrict__ tok_e,
                                               const int* __restrict__ tok_pos, const float* __restrict__ tok_w, const float* __restrict__ w) {
  __shared__ float red[4];
  const size_t row = blockIdx.x; const int tid = threadIdx.x;
  const int e1 = tok_e[row * 2], e2 = tok_e[row * 2 + 1];
  const size_t s1 = (size_t)off[e1] + tok_pos[row * 2], s2 = (size_t)off[e2] + tok_pos[row * 2 + 1];
  const float w1 = tok_w[row * 2], w2 = tok_w[row * 2 + 1];
  float4* hr = (float4*)(hio + row * DM);
  const float4* y1 = (const float4*)(Y + s1 * DM); const float4* y2 = (const float4*)(Y + s2 * DM);
  float4 v[2];
#pragma unroll
  for (int i = 0; i < 2; ++i) {
    const float4 a = hr[tid + 256 * i], p = y1[tid + 256 * i], q = y2[tid + 256 * i];
    v[i] = make_float4(a.x + (w1 * p.x + w2 * q.x), a.y + (w1 * p.y + w2 * q.y), a.z + (w1 * p.z + w2 * q.z), a.w + (w1 * p.w + w2 * q.w));
  }
  float s = v[0].x * v[0].x + v[0].y * v[0].y + v[0].z * v[0].z + v[0].w * v[0].w + v[1].x * v[1].x + v[1].y * v[1].y + v[1].z * v[1].z + v[1].w * v[1].w;
  s = wave_sum(s);
  if ((tid & 63) == 0) red[tid >> 6] = s;
  __syncthreads();
  const float rs = rsqrtf((red[0] + red[1] + red[2] + red[3]) * (1.f / DM) + EPS);
#pragma unroll
  for (int i = 0; i < 2; ++i) { const float4 ww = ((const float4*)w)[tid + 256 * i]; hr[tid + 256 * i] = make_float4(v[i].x * rs * ww.x, v[i].y * rs * ww.y, v[i].z * rs * ww.z, v[i].w * rs * ww.w); }
}
}

extern "C" void kernel_launch(void* const* d_in, const int* in_sizes, int n_in, void* d_out, int out_size, void* d_ws, size_t ws_size, hipStream_t stream) {
  const float* x = (const float*)d_in[0];        const float* mem = (const float*)d_in[1];     const float* norm_mix_w = (const float*)d_in[2];
  const float* w_in = (const float*)d_in[3];     const float* conv_w = (const float*)d_in[4];  const float* conv_b = (const float*)d_in[5];
  const float* dt_bias = (const float*)d_in[6];  const float* a_log = (const float*)d_in[7];   const float* d_skip = (const float*)d_in[8];
  const float* attn_norm_w = (const float*)d_in[9]; const float* ssm_norm_w = (const float*)d_in[10]; const float* w_out = (const float*)d_in[11];
  const float* norm_cross_w = (const float*)d_in[12]; const float* mem_norm_w = (const float*)d_in[13];
  const float* w_cq = (const float*)d_in[14];    const float* w_ck = (const float*)d_in[15];   const float* w_cv = (const float*)d_in[16];
  const float* w_co = (const float*)d_in[17];    const float* norm_ffn_w = (const float*)d_in[18];
  const float* w_rg = (const float*)d_in[19];    const float* b_rg = (const float*)d_in[20];   const float* w_re = (const float*)d_in[21];
  const float* b_re = (const float*)d_in[22];    const float* w_gate = (const float*)d_in[23]; const float* w_up = (const float*)d_in[24];
  const float* w_down = (const float*)d_in[25];  const float* final_norm_w = (const float*)d_in[26];
  float* out = (float*)d_out;
  char* ws = (char*)d_ws;
  constexpr size_t MiB = 1u << 20;
  constexpr size_t O_CTL = 0;
  constexpr size_t O_LIST = 1 * MiB;
  constexpr size_t O_TOK = 4 * MiB;
  constexpr size_t O_KMEAN = 5 * MiB;
  constexpr size_t O_LOGITS = 6 * MiB;
  constexpr size_t O_KC = 9 * MiB, O_VC = 13 * MiB;
  constexpr size_t O_MN = 17 * MiB;
  constexpr size_t O_QC = 33 * MiB, O_OC = 65 * MiB;
  constexpr size_t O_T = 97 * MiB;
  constexpr size_t O_MIX = 225 * MiB;
  constexpr size_t O_PROJ = 417 * MiB;
  static_assert(O_PROJ + (size_t)M * INW * 4 <= 1024 * MiB, "ws map");
  int* cnt = (int*)(ws + O_CTL); int* off = cnt + 64;
  int* list = (int*)(ws + O_LIST);
  int* tok_e = (int*)(ws + O_TOK); int* tok_pos = tok_e + M * 2; float* tok_w = (float*)(tok_pos + M * 2);
  float* kmean = (float*)(ws + O_KMEAN); float* logits = (float*)(ws + O_LOGITS);
  float* kc = (float*)(ws + O_KC); float* vc = (float*)(ws + O_VC); float* mn = (float*)(ws + O_MN);
  float* qc = (float*)(ws + O_QC); float* oc = (float*)(ws + O_OC);
  float* T = (float*)(ws + O_T); float* yg = out  ; float* mix = (float*)(ws + O_MIX); float* Hact = mix;
  float* proj = (float*)(ws + O_PROJ); float* Y = proj;

  static RopeFreq rf; static bool init = false;
  if (!init) { for (int i = 0; i < 16; ++i) rf.f[i] = (float)pow(500000.0, -(double)i / 16.0); init = true; }

  hipMemsetAsync(cnt, 0, 512, stream);
  k_rmsnorm<<<M, 256, 0, stream>>>(x, norm_mix_w, T);
  k_gemm<<<dim3((INW + 63) / 64, M / 64), 256, 0, stream>>>(T, DM, w_in, INW, proj, INW, nullptr, 0, INW, DM);
  k_rope<<<(M * 256) / 256, 256, 0, stream>>>(proj, rf);
  k_kmean<<<BATCH * NB * 1024 / 256, 256, 0, stream>>>(proj, kmean);
  k_moba<<<M * AH / 4, 256, 0, stream>>>(proj, kmean, attn_norm_w, mix);
  k_ssd<<<BATCH * SH, 256, 0, stream>>>(proj, conv_w, conv_b, dt_bias, a_log, d_skip, yg);
  k_gnorm<<<M * SG / 4, 256, 0, stream>>>(yg, ssm_norm_w, mix);
  k_gemm<<<dim3(DM / 64, M / 64), 256, 0, stream>>>(mix, MIXW, w_out, DM, out, DM, x, DM, DM, MIXW);
  k_rmsnorm<<<M, 256, 0, stream>>>(out, norm_cross_w, T);
  k_gemm<<<dim3(CW / 64, M / 64), 256, 0, stream>>>(T, DM, w_cq, CW, qc, CW, nullptr, 0, CW, DM);
  k_rmsnorm<<<MROWS, 256, 0, stream>>>(mem, mem_norm_w, mn);
  k_gemm<<<dim3(CW / 64, MROWS / 64), 256, 0, stream>>>(mn, DM, w_ck, CW, kc, CW, nullptr, 0, CW, DM);
  k_gemm<<<dim3(CW / 64, MROWS / 64), 256, 0, stream>>>(mn, DM, w_cv, CW, vc, CW, nullptr, 0, CW, DM);
  k_xattn<<<M * CH / 4, 256, 0, stream>>>(qc, kc, vc, oc);
  k_gemm<<<dim3(DM / 64, M / 64), 256, 0, stream>>>(oc, CW, w_co, DM, out, DM, out, DM, DM, CW);
  k_rmsnorm<<<M, 256, 0, stream>>>(out, norm_ffn_w, T);
  k_gemm<<<dim3(1, M / 64), 256, 0, stream>>>(T, DM, w_rg, NG, logits, 36, nullptr, 0, NG, DM);
  k_gemm<<<dim3(1, M / 64), 256, 0, stream>>>(T, DM, w_re, NE, logits + 4, 36, nullptr, 0, NE, DM);
  k_route<<<M / 256, 256, 0, stream>>>(logits, b_rg, b_re, cnt, list, tok_e, tok_pos, tok_w);
  k_offsets<<<1, 64, 0, stream>>>(cnt, off);
  k_moe_gu<<<dim3(DE / 64, M / 64, NE), 256, 0, stream>>>(T, list, cnt, off, w_gate, w_up, Hact);
  k_moe_down<<<dim3(DM / 64, M / 64, NE), 256, 0, stream>>>(Hact, cnt, off, w_down, Y);
  k_final<<<M, 256, 0, stream>>>(out, Y, off, tok_e, tok_pos, tok_w, final_norm_w);
}
```

```cpp
#include <hip/hip_runtime.h>
#include <stdint.h>
#include <math.h>
#include <cstdio>

constexpr int DM = 2048, BATCH = 8, SEQ = 2048, M = BATCH * SEQ, MEM = 256, MROWS = BATCH * MEM;
constexpr float EPS = 1e-6f;
constexpr int AH = 8, HD = 128, AW = 1024;
constexpr int MB = 256, NB = SEQ / MB;
constexpr int SW = 2048, SH = 32, SG = 4, SCONV = 4, CONVD = 3072;
constexpr int MIXW = 3072, INW = 8224, LDP = 8448;
constexpr int C_Q = 0, C_K = 1024, C_V = 2048, C_Z = 3072, C_XBC = 5120, C_DT = 8192;
constexpr int CH = 4, CHD = 128, CW = 512;
constexpr int NG = 4, EPG = 8, NE = 32, DE = 1024;

#define LAS __attribute__((address_space(3)))
#define GAS __attribute__((address_space(1)))
typedef unsigned short bf16_t;
typedef short bf16x8 __attribute__((ext_vector_type(8)));
typedef float f32x4 __attribute__((ext_vector_type(4)));
typedef float f32x2 __attribute__((ext_vector_type(2)));
typedef unsigned u32x4 __attribute__((ext_vector_type(4)));
typedef unsigned u32x2 __attribute__((ext_vector_type(2)));
#define LDS_WAIT() asm volatile("s_waitcnt lgkmcnt(0)" ::: "memory")
#define VM_WAIT() asm volatile("s_waitcnt vmcnt(0)" ::: "memory")

__device__ __forceinline__ unsigned cvt_pk_bf16(float lo, float hi) { unsigned r; asm volatile("v_cvt_pk_bf16_f32 %0, %1, %2" : "=v"(r) : "v"(lo), "v"(hi)); return r; }
__device__ __forceinline__ float bf2f(bf16_t b) { return __uint_as_float(((unsigned)b) << 16); }
__device__ __forceinline__ float bflo(unsigned w) { return __uint_as_float(w << 16); }
__device__ __forceinline__ float bfhi(unsigned w) { return __uint_as_float(w & 0xffff0000u); }
__device__ __forceinline__ void ld8bf(const bf16_t* p, float (&o)[8]) { const u32x4 w = *(const u32x4*)p; o[0] = bflo(w.x); o[1] = bfhi(w.x); o[2] = bflo(w.y); o[3] = bfhi(w.y); o[4] = bflo(w.z); o[5] = bfhi(w.z); o[6] = bflo(w.w); o[7] = bfhi(w.w); }
__device__ __forceinline__ float wave_sum(float v) {
#pragma unroll
  for (int o = 1; o < 64; o <<= 1) v += __shfl_xor(v, o);
  return v;
}
__device__ __forceinline__ float wave_max(float v) {
#pragma unroll
  for (int o = 1; o < 64; o <<= 1) v = fmaxf(v, __shfl_xor(v, o));
  return v;
}
__device__ __forceinline__ float silu_f(float x) { return x / (1.f + __expf(-x)); }

constexpr size_t MiB = 1u << 20;
constexpr size_t WS_CTL = 0, CTL_ZERO_BYTES = 1 * MiB;
constexpr int CW_BAR = 4096;
constexpr int CW_CNT = 65536;
constexpr size_t WS_WIN_T = 1 * MiB;
constexpr size_t WS_WOUT_T = 34 * MiB;
constexpr size_t WS_WCQ_T = 46 * MiB;
constexpr size_t WS_WCKV_T = 48 * MiB;
constexpr size_t WS_WCO_T = 52 * MiB;
constexpr size_t WS_WR = 54 * MiB;
constexpr size_t WS_SMALL = 55 * MiB;
constexpr size_t WS_ROPE = WS_SMALL, WS_RSX = WS_SMALL + 256 * 1024, WS_RSMEM = WS_RSX + 64 * 1024, WS_RS2 = WS_RSMEM + 64 * 1024, WS_KMEAN = WS_RS2 + 64 * 1024;
constexpr size_t WS_DTRAW = 56 * MiB;
constexpr size_t WS_SS = 58 * MiB;
constexpr size_t WS_MEMB = 62 * MiB;
constexpr size_t WS_XB = 70 * MiB;
constexpr size_t WS_PROJ = 134 * MiB;
constexpr size_t WS_MIXB = 398 * MiB;
constexpr size_t WS_QC = 494 * MiB, WS_OC = 510 * MiB;
constexpr size_t WS_KVC = 526 * MiB;
constexpr size_t WS_WGU_T = 530 * MiB;
constexpr size_t WS_WD_T = 786 * MiB;
constexpr size_t WS_LIST = 914 * MiB;
constexpr size_t WS_TOK = 916 * MiB;
constexpr size_t WS_HACT = WS_PROJ;
constexpr size_t WS_Y = WS_PROJ + 66 * MiB;
constexpr size_t WS_AFTER = 917 * MiB;
#define XB_TMO      128
#define XB_XCNT(j)  (256  + 64 * (j))
#define XB_XSUB(j)  (1280 + 64 * (j))
#define XB_XGEN(j)  (2304 + 64 * (j))
#define XB_TOP      3328
#define XB_TOPGEN   3392
#define XCD_BAR_WORDS 3456
#define XB_SPIN_CAP (1u << 18)

__device__ __forceinline__ unsigned xb_ld(unsigned* p)              { return __hip_atomic_load(p, __ATOMIC_RELAXED, __HIP_MEMORY_SCOPE_AGENT); }
__device__ __forceinline__ unsigned xb_add(unsigned* p, unsigned v) { return __hip_atomic_fetch_add(p, v, __ATOMIC_RELAXED, __HIP_MEMORY_SCOPE_AGENT); }
__device__ __forceinline__ unsigned xb_xcc_id() { return (unsigned)__builtin_amdgcn_s_getreg((3 << 11) | 20) & 0xFu; }
#define XB_SPIN(cond, bar) do { unsigned _sp = 0; while (cond) { __builtin_amdgcn_s_sleep(1); \
    if ((++_sp & 255u) == 0u) { if (xb_ld(&(bar)[XB_TMO])) break; if (_sp > XB_SPIN_CAP) { atomicAdd(&(bar)[XB_TMO], 1u); break; } } } } while (0)

struct XcdBarrier {
    unsigned* bar; unsigned x;
    volatile LAS unsigned* st;
};

__device__ __forceinline__ XcdBarrier xcd_barrier_post(unsigned* bar, volatile LAS unsigned* st) {
    XcdBarrier b; b.bar = bar; b.x = xb_xcc_id(); b.st = st;
    if (threadIdx.x == 0) (void)xb_add(&bar[XB_XCNT(b.x)], 1u);
    return b;
}
__device__ __forceinline__ void xcd_barrier_complete(unsigned* bar, unsigned x, unsigned& nloc, unsigned& nx) {
    const unsigned G = gridDim.x * gridDim.y * gridDim.z;
    unsigned sum, cnt, mine, sp = 0u;
    for (;;) {
        sum = 0u; cnt = 0u; mine = 0u;
#pragma unroll
        for (unsigned j = 0; j < 16; ++j) { const unsigned c = xb_ld(&bar[XB_XCNT(j)]); sum += c; cnt += (c > 0u) ? 1u : 0u; mine = (j == x) ? c : mine; }
        if (sum == G) break;
        __builtin_amdgcn_s_sleep(1);
        if ((++sp & 255u) == 0u) { if (xb_ld(&bar[XB_TMO])) break; if (sp > XB_SPIN_CAP) { atomicAdd(&bar[XB_TMO], 1u); break; } }
    }
    nloc = mine > 0u ? mine : 1u; nx = cnt > 0u ? cnt : 1u;
}

__device__ __forceinline__ void xcd_barrier(const XcdBarrier& b) {
    asm volatile("s_waitcnt vmcnt(0)" ::: "memory");
    __syncthreads();
    if (threadIdx.x == 0) {
        unsigned* bar = b.bar;
        __builtin_amdgcn_s_waitcnt(0);
        unsigned nloc = b.st[0], nx = b.st[1];
        if (nloc == 0u) { xcd_barrier_complete(bar, b.x, nloc, nx); b.st[0] = nloc; b.st[1] = nx; }
        const unsigned old = xb_add(&bar[XB_XSUB(b.x)], 1u);
        const unsigned gen = old / nloc;
        if (old + 1u == (gen + 1u) * nloc) {
            __builtin_amdgcn_fence(__ATOMIC_RELEASE, "agent");
            asm volatile("s_waitcnt vmcnt(0)" ::: "memory");
            const unsigned og = xb_add(&bar[XB_TOP], 1u);
            const unsigned tg = og / nx;
            if (og + 1u == (tg + 1u) * nx) xb_add(&bar[XB_TOPGEN], 1u);
            else XB_SPIN(xb_ld(&bar[XB_TOPGEN]) == tg, bar);
            __builtin_amdgcn_fence(__ATOMIC_ACQUIRE, "agent");
            xb_add(&bar[XB_XGEN(b.x)], 1u);
            asm volatile("s_waitcnt vmcnt(0)" ::: "memory");
        } else {
            XB_SPIN(xb_ld(&bar[XB_XGEN(b.x)]) == gen, bar);
            __builtin_amdgcn_fence(__ATOMIC_ACQUIRE, "agent");
            asm volatile("s_waitcnt vmcnt(0)" ::: "memory");
        }
    }
    __syncthreads();
}

namespace gm {
constexpr int BM = 256, BK = 64, HALF = 128, HTB = HALF * BK * 2, STAGE_BYTES = 8 * HTB, NXCD = 8, WGM = 8;
__host__ __device__ __forceinline__ int lds_byte(int r, int c) { const int st = (r >> 4) * 2 + (c >> 5), rr = r & 15, cc = c & 31, ob = rr * 64 + cc * 2; return st * 1024 + (ob ^ (((ob >> 9) & 1) << 5)); }
__host__ __device__ __forceinline__ void stage_rc(int b, int& R, int& C) { const int st = b / 1024, sb = b % 1024, swz = sb ^ (((sb >> 9) & 1) << 5); R = (st >> 1) * 16 + swz / 64; C = (st & 1) * 32 + (swz % 64) / 2; }
__host__ __device__ __forceinline__ int perm32(int rho) { const int n = rho >> 4, i = rho & 15; return 8 * (i >> 2) + 4 * n + (i & 3); }

struct Unit { const char* a; const char* b; int pm, pn, kind, ti; };

__device__ __forceinline__ void tile_of(int L, int nM, int nN, int& pm, int& pn) {
    const int nwg = nM * nN; int wgid = L;
    { const int q = nwg / NXCD, r = nwg % NXCD, xcd = wgid % NXCD, off = wgid / NXCD; wgid = (xcd < r ? xcd * (q + 1) : r * (q + 1) + (xcd - r) * q) + off; }
    const int nig = WGM * nN, gid = wgid / nig, fm = gid * WGM, gsz = (nM - fm) < WGM ? (nM - fm) : WGM;
    pm = fm + ((wgid % nig) % gsz); pn = (wgid % nig) / gsz;
}

template <class Epi, class Sched, bool GATHER>
__device__ __forceinline__ void gemm_phase(LAS unsigned char* lds, const LAS int* tab, const int K, const Sched& S, const Epi& E) {
    const int tid = threadIdx.x, wid = __builtin_amdgcn_readfirstlane(tid >> 6), lane = tid & 63, wr = wid >> 2, wc = wid & 3, fr = lane & 15, fq = lane >> 4;
    const int nt = K / BK;
    unsigned voffA0[2], voffA1[2], voffB[2];
    const size_t kstep = (size_t)(BK * 2);
    const size_t hstep = (size_t)HALF * K * 2;
#pragma unroll
    for (int i = 0; i < 2; ++i) { int R, C; stage_rc(tid * 16 + i * 8192, R, C); const int Rb = (R & ~31) + perm32(R & 31);
        voffB[i] = (unsigned)(Rb * K + C) * 2u; voffA0[i] = (unsigned)(R * K + C) * 2u; voffA1[i] = 0u; }
#define GM_SETVOFF(u) do { if constexpr (GATHER) { _Pragma("unroll") for (int _i = 0; _i < 2; ++_i) { int R_, C_; stage_rc(tid * 16 + _i * 8192, R_, C_); \
        const int r0_ = tab[(u).ti * 256 + R_], r1_ = tab[(u).ti * 256 + 128 + R_]; voffA0[_i] = (unsigned)(r0_ * K + C_) * 2u; voffA1[_i] = (unsigned)(r1_ * K + C_) * 2u; } } } while (0)
    const unsigned ldsw = (unsigned)wid * 1024u;
    const int aoff = lds_byte(wr * 64 + fr, fq * 8), boff = lds_byte(wc * 32 + fr, fq * 8);
#define PG8_SA(b, h) (((b) * 2 + (h)) * HTB)
#define PG8_SB(b, h) ((4 + (b) * 2 + (h)) * HTB)
#define PG8_STAGE(bufoff, gbase, voff) do { _Pragma("unroll") for (int _i = 0; _i < 2; ++_i) \
        __builtin_amdgcn_global_load_lds((const unsigned*)((const char*)(gbase) + (voff)[_i]), (LAS unsigned*)(lds + (bufoff) + ldsw + _i * 8192), 16, 0, 0); } while (0)
#define PG8_LDA(dst, b, h) do { _Pragma("unroll") for (int m = 0; m < 4; ++m) _Pragma("unroll") for (int k = 0; k < 2; ++k) dst[m][k] = *(const LAS bf16x8*)(lds + PG8_SA(b, h) + aoff + m * 2048 + k * 1024); } while (0)
#define PG8_LDB(dst, b, h) do { _Pragma("unroll") for (int n = 0; n < 2; ++n) _Pragma("unroll") for (int k = 0; k < 2; ++k) dst[n][k] = *(const LAS bf16x8*)(lds + PG8_SB(b, h) + boff + n * 2048 + k * 1024); } while (0)
#define PG8_MMA(ai, bj, At, Bt) do { __builtin_amdgcn_s_setprio(1); _Pragma("unroll") for (int m = 0; m < 4; ++m) _Pragma("unroll") for (int n = 0; n < 2; ++n) _Pragma("unroll") for (int k = 0; k < 2; ++k) \
        acc[ai][bj][m][n] = __builtin_amdgcn_mfma_f32_16x16x32_bf16(Bt[n][k], At[m][k], acc[ai][bj][m][n], 0, 0, 0); __builtin_amdgcn_s_setprio(0); } while (0)
#define GM_STAGE_A1(bufoff, gbase) do { if constexpr (GATHER) { PG8_STAGE(bufoff, gbase, voffA1); } else { PG8_STAGE(bufoff, (gbase) + hstep, voffA0); } } while (0)
#define PG8_WAIT_V(n) asm volatile("s_waitcnt vmcnt(" #n ")" ::: "memory")
#define PG8_WAIT_L(n) asm volatile("s_waitcnt lgkmcnt(" #n ")" ::: "memory")
#define PG8_BAR __builtin_amdgcn_s_barrier()
#define PG8_SCHED __builtin_amdgcn_sched_barrier(0)
    Unit cur, nxt; int ui = 0;
    if (!S.next(0, cur)) return;
    GM_SETVOFF(cur);
    f32x4 acc[2][2][4][2];
#pragma unroll
    for (int a = 0; a < 2; ++a)
#pragma unroll
        for (int b = 0; b < 2; ++b)
#pragma unroll
            for (int m = 0; m < 4; ++m)
#pragma unroll
                for (int n = 0; n < 2; ++n) acc[a][b][m][n] = (f32x4){0.f, 0.f, 0.f, 0.f};
    bf16x8 At[4][2], B0[2][2], B1[2][2];
    const char* cA = cur.a; const char* cB = cur.b;
    PG8_STAGE(PG8_SB(0, 0), cB, voffB); PG8_STAGE(PG8_SB(0, 1), cB + hstep, voffB); PG8_STAGE(PG8_SA(0, 0), cA, voffA0); GM_STAGE_A1(PG8_SA(0, 1), cA);
    if (wr == 1) PG8_BAR;
    PG8_WAIT_V(2); PG8_BAR;
    PG8_STAGE(PG8_SB(1, 0), cB + kstep, voffB); PG8_STAGE(PG8_SA(1, 0), cA + kstep, voffA0); PG8_STAGE(PG8_SB(1, 1), cB + hstep + kstep, voffB);
    PG8_WAIT_V(6); PG8_BAR;
    for (;;) {
        const bool has_next = S.next(ui + 1, nxt);
        const char* nA = has_next ? nxt.a : cA; const char* nB = has_next ? nxt.b : cB;
        for (int t = 0; t < nt; t += 2) {
            const bool last = (t == nt - 2);
            const char* a1 = cA + (size_t)(t + 1) * kstep;
            const char* a2 = last ? nA : cA + (size_t)(t + 2) * kstep; const char* b2 = last ? nB : cB + (size_t)(t + 2) * kstep;
            const char* a3 = a2 + kstep; const char* b3 = b2 + kstep;
            PG8_LDB(B0, 0, 0); PG8_LDB(B1, 0, 1); PG8_SCHED; PG8_LDA(At, 0, 0); GM_STAGE_A1(PG8_SA(1, 1), a1);
            PG8_WAIT_V(8); PG8_WAIT_L(0); PG8_BAR; PG8_MMA(0, 0, At, B0); PG8_MMA(0, 1, At, B1); PG8_BAR; PG8_SCHED;
            if constexpr (GATHER) { if (last && has_next) { GM_SETVOFF(nxt); } }
            PG8_LDA(At, 0, 1); PG8_STAGE(PG8_SB(0, 0), b2, voffB); PG8_STAGE(PG8_SB(0, 1), b2 + hstep, voffB); PG8_STAGE(PG8_SA(0, 0), a2, voffA0);
            PG8_WAIT_V(8); PG8_WAIT_L(0); PG8_BAR; PG8_MMA(1, 0, At, B0); PG8_MMA(1, 1, At, B1); PG8_BAR; PG8_SCHED;
            PG8_LDB(B0, 1, 0); PG8_LDB(B1, 1, 1); PG8_SCHED; PG8_LDA(At, 1, 0); GM_STAGE_A1(PG8_SA(0, 1), a2);
            PG8_WAIT_V(8); PG8_WAIT_L(0); PG8_BAR; PG8_MMA(0, 0, At, B0); PG8_MMA(0, 1, At, B1); PG8_BAR; PG8_SCHED;
            PG8_LDA(At, 1, 1); PG8_STAGE(PG8_SB(1, 0), b3, voffB); PG8_STAGE(PG8_SB(1, 1), b3 + hstep, voffB); PG8_STAGE(PG8_SA(1, 0), a3, voffA0);
            PG8_WAIT_V(8); PG8_WAIT_L(0); PG8_BAR; PG8_MMA(1, 0, At, B0); PG8_MMA(1, 1, At, B1); PG8_BAR; PG8_SCHED;
        }
        if (wr == 0) PG8_BAR;
        E(acc, cur, wr, wc, fr, fq);
        if (!has_next) break;
#pragma unroll
        for (int a = 0; a < 2; ++a)
#pragma unroll
            for (int b = 0; b < 2; ++b)
#pragma unroll
                for (int m = 0; m < 4; ++m)
#pragma unroll
                    for (int n = 0; n < 2; ++n) acc[a][b][m][n] = (f32x4){0.f, 0.f, 0.f, 0.f};
        cur = nxt; cA = nA; cB = nB; ++ui;
        if (wr == 1) PG8_BAR;
    }
    PG8_WAIT_V(0);
    PG8_BAR;
#undef GM_SETVOFF
#undef GM_STAGE_A1
#undef PG8_SA
#undef PG8_SB
#undef PG8_STAGE
#undef PG8_LDA
#undef PG8_LDB
#undef PG8_MMA
#undef PG8_WAIT_V
#undef PG8_WAIT_L
#undef PG8_BAR
#undef PG8_SCHED
}
}
constexpr int RING_OFF = 0, RING_BYTES = 131072;
constexpr int TAB_OFF = RING_BYTES;
constexpr int RSL_OFF = TAB_OFF + 8192;
constexpr int MOE_OFF = RSL_OFF + 1024;
constexpr int LDSCTL_OFF = MOE_OFF + 512;
constexpr int MISC_OFF = LDSCTL_OFF + 320;
constexpr int LDS_BYTES = 147456;
static_assert(MISC_OFF + 128 <= LDS_BYTES, "LDS map");
constexpr int NWAVES = 8;

struct Args { const float* in[27]; float* out; unsigned char* ws; float rf[16]; int ph_lo, ph_hi, li, pad; };

struct Frame {
    LAS unsigned char* lds;
    volatile LAS unsigned* MISC;
    unsigned* ctl;
    int tid, lane, wave, vcu, G;
};

__device__ __forceinline__ void p0_transpose_item(const float* __restrict__ W, int ldw, int k0, int n0, const float* __restrict__ sc, bf16_t* dst, int dK, LAS float* scr, int lane) {
#pragma unroll 8
    for (int i = 0; i < 32; ++i) { const int kk = 2 * i + (lane >> 5); float v = W[(size_t)(k0 + kk) * ldw + n0 + (lane & 31)]; if (sc) v *= sc[k0 + kk]; scr[kk * 33 + (lane & 31)] = v; }
    LDS_WAIT(); asm volatile("" ::: "memory");
    const int c = lane & 7;
#pragma unroll
    for (int j = 0; j < 4; ++j) { const int n = (lane >> 3) + 8 * j; const LAS float* s = scr + (8 * c) * 33 + n;
        u32x4 o; o.x = cvt_pk_bf16(s[0 * 33], s[1 * 33]); o.y = cvt_pk_bf16(s[2 * 33], s[3 * 33]); o.z = cvt_pk_bf16(s[4 * 33], s[5 * 33]); o.w = cvt_pk_bf16(s[6 * 33], s[7 * 33]);
        *(u32x4*)(dst + (size_t)n * dK + k0 + 8 * c) = o; }
    LDS_WAIT(); asm volatile("" ::: "memory");
}
__device__ __forceinline__ void row_to_bf16_rs(const float* xrow, bf16_t* orow, float* rs_out, int lane) {
    const f32x4* xr = (const f32x4*)xrow + lane;
    f32x4 v[8]; float s = 0.f;
#pragma unroll
    for (int j = 0; j < 8; ++j) { v[j] = xr[64 * j]; s += (v[j].x * v[j].x + v[j].y * v[j].y) + (v[j].z * v[j].z + v[j].w * v[j].w); }
    s = wave_sum(s);
    if (lane == 0) *rs_out = rsqrtf(s * (1.f / DM) + EPS);
    u32x2* o8 = (u32x2*)orow + lane;
#pragma unroll
    for (int j = 0; j < 8; ++j) { u32x2 w; w.x = cvt_pk_bf16(v[j].x, v[j].y); w.y = cvt_pk_bf16(v[j].z, v[j].w); o8[64 * j] = w; }
}
__device__ __forceinline__ void p0_prologue(Frame& F, const Args& args) {
    LAS float* scr = (LAS float*)(F.lds + RING_OFF + F.wave * 16384);
    const int gw = F.vcu * NWAVES + F.wave, NGW = F.G * NWAVES, lane = F.lane;
    unsigned char* ws = args.ws; asm volatile("" : "+s"(ws));
    const float* w_in = args.in[3]; const float* w_out = args.in[11];
    constexpr int I_IN = 32 * 257, I_OUT = 48 * 64, I_CQ = 32 * 16, I_CO = 8 * 64;
    constexpr int I_GU = 32 * 32 * 32, I_DN = 32 * 16 * 64;
    constexpr int NITEMS = I_IN + I_OUT + 3 * I_CQ + I_CO + 2 * I_GU + I_DN;
    for (int it = gw; it < NITEMS; it += NGW) {
        int r = it;
        if (r < I_IN) { const int kb = r / 257, nb = r % 257; p0_transpose_item(w_in, INW, 64 * kb, 32 * nb, args.in[2], (bf16_t*)(ws + WS_WIN_T) + (size_t)(32 * nb) * DM, DM, scr, lane); continue; } r -= I_IN;
        if (r < I_OUT) { const int kb = r / 64, nb = r % 64; const float* sc = (kb < 16) ? args.in[9] : (args.in[10] - AW);
            p0_transpose_item(w_out, DM, 64 * kb, 32 * nb, sc, (bf16_t*)(ws + WS_WOUT_T) + (size_t)(32 * nb) * MIXW, MIXW, scr, lane); continue; } r -= I_OUT;
        if (r < I_CQ) { const int kb = r / 16, nb = r % 16; p0_transpose_item(args.in[14], CW, 64 * kb, 32 * nb, args.in[12], (bf16_t*)(ws + WS_WCQ_T) + (size_t)(32 * nb) * DM, DM, scr, lane); continue; } r -= I_CQ;
        if (r < I_CQ) { const int kb = r / 16, nb = r % 16; p0_transpose_item(args.in[15], CW, 64 * kb, 32 * nb, args.in[13], (bf16_t*)(ws + WS_WCKV_T) + (size_t)(32 * nb) * DM, DM, scr, lane); continue; } r -= I_CQ;
        if (r < I_CQ) { const int kb = r / 16, nb = r % 16; p0_transpose_item(args.in[16], CW, 64 * kb, 32 * nb, args.in[13], (bf16_t*)(ws + WS_WCKV_T) + (size_t)(CW + 32 * nb) * DM, DM, scr, lane); continue; } r -= I_CQ;
        if (r < I_CO) { const int kb = r / 64, nb = r % 64; p0_transpose_item(args.in[17], DM, 64 * kb, 32 * nb, nullptr, (bf16_t*)(ws + WS_WCO_T) + (size_t)(32 * nb) * CW, CW, scr, lane); continue; } r -= I_CO;
        if (r < 2 * I_GU) { const int up = r >= I_GU; if (up) r -= I_GU; const int e = r >> 10, kb = (r >> 5) & 31, nb = r & 31, n0 = 32 * nb;
            p0_transpose_item(args.in[up ? 24 : 23] + (size_t)e * DM * DE, DE, 64 * kb, n0, args.in[18], (bf16_t*)(ws + WS_WGU_T) + ((size_t)e * 2048 + (n0 >> 7) * 256 + up * 128 + (n0 & 127)) * DM, DM, scr, lane); continue; } r -= 2 * I_GU;
        { const int e = r >> 10, kb = (r >> 6) & 15, nb = r & 63;
            p0_transpose_item(args.in[25] + (size_t)e * DE * DM, DM, 64 * kb, 32 * nb, nullptr, (bf16_t*)(ws + WS_WD_T) + ((size_t)e * 2048 + 32 * nb) * DE, DE, scr, lane); }
    }
    { u32x4* z = (u32x4*)((bf16_t*)(ws + WS_WIN_T) + (size_t)INW * DM); const int n16 = (LDP - INW) * DM * 2 / 16;
      for (int i = (F.vcu * NWAVES * 64) + F.tid; i < n16; i += F.G * NWAVES * 64) z[i] = (u32x4){0u, 0u, 0u, 0u}; }
    { float* tab = (float*)(ws + WS_ROPE);
      for (int i = (F.vcu * NWAVES * 64) + F.tid; i < SEQ * 16; i += F.G * NWAVES * 64) { const int pos = i >> 4, f = i & 15;
        const float ang = (float)pos * args.rf[f]; double r = (double)ang * 0.15915494309189533577; r -= rint(r); const float th = (float)(r * 6.283185307179586477);
        tab[pos * 32 + f] = cosf(th); tab[pos * 32 + 16 + f] = sinf(th); } }
    { float* wr = (float*)(ws + WS_WR); const float* nfw = args.in[18];
      for (int i = (F.vcu * NWAVES * 64) + F.tid; i < 36 * DM; i += F.G * NWAVES * 64) { const int n = i >> 11, k = i & (DM - 1);
        wr[i] = (n < NG ? args.in[19][k * NG + n] : args.in[21][k * NE + (n - NG)]) * nfw[k]; } }
    for (int m = gw; m < M; m += NGW) row_to_bf16_rs(args.in[0] + (size_t)m * DM, (bf16_t*)(ws + WS_XB) + (size_t)m * DM, (float*)(ws + WS_RSX) + m, lane);
    for (int m = gw; m < MROWS; m += NGW) row_to_bf16_rs(args.in[1] + (size_t)m * DM, (bf16_t*)(ws + WS_MEMB) + (size_t)m * DM, (float*)(ws + WS_RSMEM) + m, lane);
}

struct SchedG1 {
    const char* A; const char* Bt; int G, c;
    __device__ __forceinline__ bool next(int i, gm::Unit& u) const {
        const int L = i * G + c; if (L >= 64 * 33) return false;
        int pm, pn; gm::tile_of(L, 64, 33, pm, pn);
        u.pm = pm; u.pn = pn; u.kind = 0; u.ti = 0; u.a = A + (size_t)pm * 256 * DM * 2; u.b = Bt + (size_t)pn * 256 * DM * 2; return true;
    }
};
struct EpiG1 {
    bf16_t* proj; float* dtraw; const float* rsx; const float* ropetab;
    __device__ __forceinline__ void operator()(const f32x4 (&acc)[2][2][4][2], const gm::Unit& u, int wr, int wc, int fr, int fq) const {
        const int row0 = u.pm * 256 + wr * 64 + fr;
        const bool rope = (u.pn < 8) && (wc == 0), dtt = (u.pn == 32);
        const float sgn = (fq < 2) ? -1.f : 1.f;
#pragma unroll
        for (int ai = 0; ai < 2; ++ai)
#pragma unroll
            for (int m = 0; m < 4; ++m) {
                const int row = row0 + ai * 128 + m * 16; const float rs = rsx[row];
                f32x4 c0 = {1.f, 1.f, 1.f, 1.f}, c1 = c0, s0 = {0.f, 0.f, 0.f, 0.f}, s1 = s0;
                if (rope) { const float* rt = ropetab + (row & (SEQ - 1)) * 32 + 8 * (fq & 1); c0 = *(const f32x4*)rt; c1 = *(const f32x4*)(rt + 4); s0 = *(const f32x4*)(rt + 16); s1 = *(const f32x4*)(rt + 20); }
#pragma unroll
                for (int bj = 0; bj < 2; ++bj) {
                    f32x4 v0 = acc[ai][bj][m][0] * rs, v1 = acc[ai][bj][m][1] * rs;
                    if (rope) {
                        f32x4 p0, p1;
#pragma unroll
                        for (int e = 0; e < 4; ++e) { p0[e] = __shfl_xor(v0[e], 32); p1[e] = __shfl_xor(v1[e], 32); }
                        v0 = v0 * c0 + (p0 * s0) * sgn; v1 = v1 * c1 + (p1 * s1) * sgn;
                    }
                    if (!dtt) { u32x4 w; w.x = cvt_pk_bf16(v0[0], v0[1]); w.y = cvt_pk_bf16(v0[2], v0[3]); w.z = cvt_pk_bf16(v1[0], v1[1]); w.w = cvt_pk_bf16(v1[2], v1[3]);
                        *(u32x4*)(proj + (size_t)row * LDP + u.pn * 256 + bj * 128 + wc * 32 + 8 * fq) = w; }
                    else if (bj == 0 && wc == 0) { float* d = dtraw + (size_t)row * 32 + 8 * fq; *(f32x4*)d = v0; *(f32x4*)(d + 4) = v1; }
                }
                asm volatile("" ::: "memory");
            }
    }
};

struct SchedTiles {
    const char* A; const char* Bt; int nM, nN, K, G, c;
    __device__ __forceinline__ bool next(int i, gm::Unit& u) const {
        const int L = i * G + c; if (L >= nM * nN) return false;
        int pm, pn; gm::tile_of(L, nM, nN, pm, pn);
        u.pm = pm; u.pn = pn; u.kind = 0; u.ti = 0; u.a = A + (size_t)pm * 256 * K * 2; u.b = Bt + (size_t)pn * 256 * K * 2; return true;
    }
};
struct EpiRes {
    const float* base; float* outf; bf16_t* hb; float* ss;
    __device__ __forceinline__ void operator()(const f32x4 (&acc)[2][2][4][2], const gm::Unit& u, int wr, int wc, int fr, int fq) const {
        const int row0 = u.pm * 256 + wr * 64 + fr;
#pragma unroll
        for (int ai = 0; ai < 2; ++ai)
#pragma unroll
            for (int m = 0; m < 4; ++m) {
                const int row = row0 + ai * 128 + m * 16; float q = 0.f;
#pragma unroll
                for (int bj = 0; bj < 2; ++bj) {
                    const size_t o = (size_t)row * DM + u.pn * 256 + bj * 128 + wc * 32 + 8 * fq;
                    const f32x4 v0 = acc[ai][bj][m][0] + *(const f32x4*)(base + o), v1 = acc[ai][bj][m][1] + *(const f32x4*)(base + o + 4);
                    *(f32x4*)(outf + o) = v0; *(f32x4*)(outf + o + 4) = v1;
                    u32x4 w; w.x = cvt_pk_bf16(v0[0], v0[1]); w.y = cvt_pk_bf16(v0[2], v0[3]); w.z = cvt_pk_bf16(v1[0], v1[1]); w.w = cvt_pk_bf16(v1[2], v1[3]);
                    *(u32x4*)(hb + o) = w;
                    q += (v0[0] * v0[0] + v0[1] * v0[1]) + (v0[2] * v0[2] + v0[3] * v0[3]) + (v1[0] * v1[0] + v1[1] * v1[1]) + (v1[2] * v1[2] + v1[3] * v1[3]);
                }
                q += __shfl_xor(q, 16); q += __shfl_xor(q, 32);
                if (fq == 0) ss[(size_t)row * 32 + u.pn * 4 + wc] = q;
                asm volatile("" ::: "memory");
            }
    }
};
struct SchedQKV {
    const char* A0; const char* B0; const char* A1; const char* B1; int G, c;
    __device__ __forceinline__ bool next(int i, gm::Unit& u) const {
        const int L = i * G + c; int pm, pn;
        if (L < 128) { gm::tile_of(L, 64, 2, pm, pn); u.kind = 0; u.a = A0 + (size_t)pm * 256 * DM * 2; u.b = B0 + (size_t)pn * 256 * DM * 2; }
        else if (L < 160) { gm::tile_of(L - 128, 8, 4, pm, pn); u.kind = 1; u.a = A1 + (size_t)pm * 256 * DM * 2; u.b = B1 + (size_t)pn * 256 * DM * 2; }
        else return false;
        u.pm = pm; u.pn = pn; u.ti = 0; return true;
    }
};
struct EpiScale {
    bf16_t* O0; bf16_t* O1; int ld0, ld1; const LAS float* rsl;
    __device__ __forceinline__ void operator()(const f32x4 (&acc)[2][2][4][2], const gm::Unit& u, int wr, int wc, int fr, int fq) const {
        bf16_t* O = u.kind ? O1 : O0; const int ld = u.kind ? ld1 : ld0;
#pragma unroll
        for (int ai = 0; ai < 2; ++ai)
#pragma unroll
            for (int m = 0; m < 4; ++m) {
                const int r = ai * 128 + wr * 64 + m * 16 + fr; const float rs = rsl[r];
#pragma unroll
                for (int bj = 0; bj < 2; ++bj) {
                    const f32x4 v0 = acc[ai][bj][m][0] * rs, v1 = acc[ai][bj][m][1] * rs;
                    u32x4 w; w.x = cvt_pk_bf16(v0[0], v0[1]); w.y = cvt_pk_bf16(v0[2], v0[3]); w.z = cvt_pk_bf16(v1[0], v1[1]); w.w = cvt_pk_bf16(v1[2], v1[3]);
                    *(u32x4*)(O + (size_t)(u.pm * 256 + r) * ld + u.pn * 256 + bj * 128 + wc * 32 + 8 * fq) = w;
                }
            }
    }
};

__device__ __forceinline__ void moe_tables(LAS int* mt, const int* cnt_g, int tid) {
    if (tid < 32) mt[tid] = cnt_g[tid];
    LDS_WAIT(); __syncthreads();
    if (tid == 0) { int p = 0, o = 0; for (int e = 0; e < NE; ++e) { mt[32 + e] = p; mt[65 + e] = o; const int c = mt[e]; p += 8 * ((c + 255) >> 8); o += c; } mt[32 + NE] = p; mt[65 + NE] = o; }
    LDS_WAIT(); __syncthreads();
}
template <bool GU> struct SchedMoE {
    const LAS int* mt; const char* A; const char* Bt; int G, c;
    __device__ __forceinline__ bool next(int i, gm::Unit& u) const {
        const int L = i * G + c; if (L >= mt[32 + NE]) return false;
        int e = 0;
#pragma unroll 1
        for (int k = 1; k < NE; ++k) if (L >= mt[32 + k]) e = k;
        const int rem = L - mt[32 + e], te = (mt[e] + 255) >> 8, pn = rem / te, mtile = rem - pn * te;
        u.pm = mtile; u.pn = pn; u.kind = e; u.ti = i;
        if (GU) { u.a = A; u.b = Bt + ((size_t)e * 2048 + pn * 256) * DM * 2; }
        else { u.a = A + (size_t)(mt[65 + e] + mtile * 256) * DE * 2; u.b = Bt + ((size_t)e * 2048 + pn * 256) * DE * 2; }
        return true;
    }
};
struct EpiGU {
    bf16_t* Hact; const float* rs2; const LAS int* mt; const LAS int* tab;
    __device__ __forceinline__ void operator()(const f32x4 (&acc)[2][2][4][2], const gm::Unit& u, int wr, int wc, int fr, int fq) const {
        const int e = u.kind, valid = mt[e] - u.pm * 256, slot0 = mt[65 + e] + u.pm * 256;
#pragma unroll
        for (int ai = 0; ai < 2; ++ai)
#pragma unroll
            for (int m = 0; m < 4; ++m) {
                const int r = ai * 128 + wr * 64 + m * 16 + fr;
                if (r < valid) {
                    const float rs = rs2[tab[u.ti * 256 + r]];
                    const f32x4 g0 = acc[ai][0][m][0] * rs, g1 = acc[ai][0][m][1] * rs, u0 = acc[ai][1][m][0] * rs, u1 = acc[ai][1][m][1] * rs;
                    float o[8];
#pragma unroll
                    for (int j = 0; j < 4; ++j) { o[j] = g0[j] * __builtin_amdgcn_rcpf(1.f + __expf(-g0[j])) * u0[j]; o[4 + j] = g1[j] * __builtin_amdgcn_rcpf(1.f + __expf(-g1[j])) * u1[j]; }
                    u32x4 w; w.x = cvt_pk_bf16(o[0], o[1]); w.y = cvt_pk_bf16(o[2], o[3]); w.z = cvt_pk_bf16(o[4], o[5]); w.w = cvt_pk_bf16(o[6], o[7]);
                    *(u32x4*)(Hact + (size_t)(slot0 + r) * DE + u.pn * 128 + wc * 32 + 8 * fq) = w;
                }
            }
    }
};
struct EpiDown {
    bf16_t* Y; const LAS int* mt;
    __device__ __forceinline__ void operator()(const f32x4 (&acc)[2][2][4][2], const gm::Unit& u, int wr, int wc, int fr, int fq) const {
        const int e = u.kind, valid = mt[e] - u.pm * 256, slot0 = mt[65 + e] + u.pm * 256;
#pragma unroll
        for (int ai = 0; ai < 2; ++ai)
#pragma unroll
            for (int m = 0; m < 4; ++m) {
                const int r = ai * 128 + wr * 64 + m * 16 + fr;
                if (r < valid) {
#pragma unroll
                    for (int bj = 0; bj < 2; ++bj) { const f32x4 v0 = acc[ai][bj][m][0], v1 = acc[ai][bj][m][1];
                        u32x4 w; w.x = cvt_pk_bf16(v0[0], v0[1]); w.y = cvt_pk_bf16(v0[2], v0[3]); w.z = cvt_pk_bf16(v1[0], v1[1]); w.w = cvt_pk_bf16(v1[2], v1[3]);
                        *(u32x4*)(Y + (size_t)(slot0 + r) * DM + u.pn * 256 + bj * 128 + wc * 32 + 8 * fq) = w; }
                }
            }
    }
};
__device__ __forceinline__ void final_rows(Frame& F, float* hio, const bf16_t* Y, const int* tok_e, const int* tok_pos, const float* tok_w, const float* fw, const LAS int* mt) {
    const int gw = F.vcu * NWAVES + F.wave, NGW = F.G * NWAVES, lane = F.lane;
    for (int t = gw; t < M; t += NGW) {
        const int e1 = tok_e[2 * t], e2 = tok_e[2 * t + 1];
        const size_t s1 = (size_t)(mt[65 + e1] + tok_pos[2 * t]), s2 = (size_t)(mt[65 + e2] + tok_pos[2 * t + 1]);
        const float w1 = tok_w[2 * t], w2 = tok_w[2 * t + 1];
        f32x4* hr = (f32x4*)(hio + (size_t)t * DM) + 2 * lane;
        const u32x4* y1 = (const u32x4*)(Y + s1 * DM) + lane; const u32x4* y2 = (const u32x4*)(Y + s2 * DM) + lane;
        float v[4][8]; float ss = 0.f;
#pragma unroll
        for (int j = 0; j < 4; ++j) {
            const f32x4 a0 = hr[128 * j], a1 = hr[128 * j + 1]; const u32x4 p = y1[64 * j], q = y2[64 * j];
            const float pa[8] = {bflo(p.x), bfhi(p.x), bflo(p.y), bfhi(p.y), bflo(p.z), bfhi(p.z), bflo(p.w), bfhi(p.w)};
            const float qa[8] = {bflo(q.x), bfhi(q.x), bflo(q.y), bfhi(q.y), bflo(q.z), bfhi(q.z), bflo(q.w), bfhi(q.w)};
            const float ha[8] = {a0[0], a0[1], a0[2], a0[3], a1[0], a1[1], a1[2], a1[3]};
#pragma unroll
            for (int k = 0; k < 8; ++k) { v[j][k] = ha[k] + (w1 * pa[k] + w2 * qa[k]); ss += v[j][k] * v[j][k]; }
        }
        ss = wave_sum(ss);
        const float rs = rsqrtf(ss * (1.f / DM) + EPS);
#pragma unroll
        for (int j = 0; j < 4; ++j) {
            const f32x4 g0 = *((const f32x4*)fw + 2 * lane + 128 * j), g1 = *((const f32x4*)fw + 2 * lane + 128 * j + 1);
            hr[128 * j] = (f32x4){v[j][0] * rs * g0[0], v[j][1] * rs * g0[1], v[j][2] * rs * g0[2], v[j][3] * rs * g0[3]};
            hr[128 * j + 1] = (f32x4){v[j][4] * rs * g1[0], v[j][5] * rs * g1[1], v[j][6] * rs * g1[2], v[j][7] * rs * g1[3]};
        }
    }
}

__device__ __forceinline__ void kmean_simple(Frame& F, const bf16_t* proj, float* kmean) {
    for (int gid = F.vcu * NWAVES * 64 + F.tid; gid < BATCH * NB * 1024; gid += F.G * NWAVES * 64) {
        const int col = gid & 1023, bb = gid >> 10; const bf16_t* p = proj + (size_t)bb * MB * LDP + C_K + col; float s = 0.f;
        for (int t = 0; t < MB; ++t) s += bf2f(p[(size_t)t * LDP]);
        kmean[gid] = s * (1.f / MB);
    }
}
__device__ __forceinline__ void ssd_simple(Frame& F, int b, int h, const bf16_t* proj, const float* dtraw, const float* conv_w, const float* conv_b,
                                           const float* dt_bias, const float* a_log, const float* d_skip, float* yg) {
    constexpr int T = 16;
    LAS float* xs = (LAS float*)(F.lds + RING_OFF); LAS float* Bs = xs + T * 64; LAS float* Cs = Bs + T * 128; LAS float* dts = Cs + T * 128;
    const int g = h / (SH / SG), tid = F.tid, p = (tid >> 2) & 63, nq = tid & 3;
    const float a = -__expf(a_log[h]), dtb = dt_bias[h], Dh = d_skip[h];
    float st[32];
#pragma unroll
    for (int i = 0; i < 32; ++i) st[i] = 0.f;
    for (int t0 = 0; t0 < SEQ; t0 += T) {
        __syncthreads();
        for (int idx = tid; idx < T * 320; idx += NWAVES * 64) {
            const int tt = idx / 320, c = idx % 320, t = t0 + tt;
            int ch; if (c < 64) ch = h * 64 + c; else if (c < 192) ch = 2048 + g * 128 + (c - 64); else ch = 2560 + g * 128 + (c - 192);
            float v = conv_b[ch];
#pragma unroll
            for (int i = 0; i < SCONV; ++i) { const int ts = t - 3 + i; if (ts >= 0) v += conv_w[i * CONVD + ch] * bf2f(proj[(size_t)(b * SEQ + ts) * LDP + C_XBC + ch]); }
            v = silu_f(v);
            if (c < 64) xs[tt * 64 + c] = v; else if (c < 192) Bs[tt * 128 + c - 64] = v; else Cs[tt * 128 + c - 192] = v;
        }
        if (tid < T) { const float r = dtraw[(size_t)(b * SEQ + t0 + tid) * 32 + h] + dtb; dts[tid] = fmaxf(r, 0.f) + log1pf(__expf(-fabsf(r))); }
        __syncthreads();
        if (tid < 256) {
            for (int tt = 0; tt < T; ++tt) {
                const float dt = dts[tt], dA = __expf(dt * a), xv = xs[tt * 64 + p], xdt = xv * dt;
                float y = 0.f;
                const LAS f32x4* B4 = (const LAS f32x4*)(Bs + tt * 128 + nq * 32); const LAS f32x4* C4 = (const LAS f32x4*)(Cs + tt * 128 + nq * 32);
#pragma unroll
                for (int i = 0; i < 8; ++i) { const f32x4 bv = B4[i], cv = C4[i];
#pragma unroll
                    for (int e = 0; e < 4; ++e) { st[4 * i + e] = st[4 * i + e] * dA + xdt * bv[e]; y += cv[e] * st[4 * i + e]; } }
                y += __shfl_xor(y, 1); y += __shfl_xor(y, 2);
                if (nq == 0) { const size_t tok = (size_t)(b * SEQ + t0 + tt); const float z = bf2f(proj[tok * LDP + C_Z + h * 64 + p]); yg[tok * SW + h * 64 + p] = (y + xv * Dh) * silu_f(z); }
            }
        }
    }
    __syncthreads();
}
__device__ __forceinline__ void gnorm_simple(Frame& F, const float* yg, bf16_t* mixb) {
    const int gw = F.vcu * NWAVES + F.wave, NGW = F.G * NWAVES, lane = F.lane;
    for (int it = gw; it < M * SG; it += NGW) {
        const int g = it & 3; const size_t tok = it >> 2; const float* p = yg + tok * SW + g * 512;
        float v[8]; float s = 0.f;
#pragma unroll
        for (int i = 0; i < 8; ++i) { v[i] = p[lane + 64 * i]; s += v[i] * v[i]; }
        s = wave_sum(s); const float rs = rsqrtf(s * (1.f / 512.f) + EPS);
        bf16_t* o = mixb + tok * MIXW + AW + g * 512;
#pragma unroll
        for (int i = 0; i < 8; ++i) o[lane + 64 * i] = (bf16_t)(cvt_pk_bf16(v[i] * rs, 0.f) & 0xffffu);
    }
}
__device__ __forceinline__ void moba_simple(Frame& F, const bf16_t* proj, const float* kmean, bf16_t* mixb) {
    const int gw = F.vcu * NWAVES + F.wave, NGW = F.G * NWAVES, lane = F.lane;
    LAS float* qs = (LAS float*)(F.lds + RING_OFF) + F.wave * 1280; LAS float* sc = qs + 128;
    for (int it = gw; it < M * AH; it += NGW) {
        const int h = it & 7, tok = it >> 3, b = tok / SEQ, s = tok % SEQ, j = s / MB;
        const bf16_t* qp = proj + (size_t)tok * LDP + C_Q + h * HD;
        const float q0 = bf2f(qp[lane]), q1 = bf2f(qp[lane + 64]);
        LDS_WAIT(); qs[lane] = q0; qs[lane + 64] = q1;
        float gate[NB];
#pragma unroll
        for (int kb = 0; kb < NB; ++kb) { float g = -INFINITY;
            if (kb < j) { const float* km = kmean + (size_t)(b * NB + kb) * 1024 + h * HD; g = wave_sum(q0 * km[lane] + q1 * km[lane + 64]); }
            gate[kb] = g; }
        unsigned selmask = 0;
#pragma unroll
        for (int r = 0; r < 3; ++r) { float best = -INFINITY; int bi = -1;
#pragma unroll
            for (int kb = 0; kb < NB; ++kb) { const bool ok = (kb < j) && !((selmask >> kb) & 1u) && (gate[kb] > best || bi < 0); if (ok) { best = gate[kb]; bi = kb; } }
            if (bi >= 0) selmask |= 1u << bi; }
        LDS_WAIT();
        const float scale = 0.08838834764831845f; int nslot = 0; float mx = -INFINITY;
        for (int kb = 0; kb <= j; ++kb) {
            const bool own = (kb == j); if (!own && !((selmask >> kb) & 1u)) continue;
#pragma unroll 1
            for (int i = 0; i < 4; ++i) { const int kl = lane + 64 * i, key = kb * MB + kl; const bf16_t* kp = proj + (size_t)(b * SEQ + key) * LDP + C_K + h * HD; float d = 0.f;
#pragma unroll 4
                for (int dd = 0; dd < 128; dd += 8) { float kv[8]; ld8bf(kp + dd, kv);
#pragma unroll
                    for (int e = 0; e < 8; ++e) d += qs[dd + e] * kv[e]; }
                d *= scale; if (own && key > s) d = -INFINITY; sc[nslot * 256 + kl] = d; mx = fmaxf(mx, d); }
            ++nslot; }
        mx = wave_max(mx); float sum = 0.f; LDS_WAIT();
        for (int i = lane; i < nslot * 256; i += 64) { const float e = __expf(sc[i] - mx); sc[i] = e; sum += e; }
        sum = wave_sum(sum); LDS_WAIT();
        float o0 = 0.f, o1 = 0.f; int slot = 0;
        for (int kb = 0; kb <= j; ++kb) {
            const bool own = (kb == j); if (!own && !((selmask >> kb) & 1u)) continue;
            const bf16_t* vp = proj + (size_t)(b * SEQ + kb * MB) * LDP + C_V + h * HD; const int lim = own ? (s - kb * MB + 1) : MB;
#pragma unroll 4
            for (int kl = 0; kl < lim; ++kl) { const float pr = sc[slot * 256 + kl]; o0 += pr * bf2f(vp[(size_t)kl * LDP + lane]); o1 += pr * bf2f(vp[(size_t)kl * LDP + lane + 64]); }
            ++slot; }
        const float inv = 1.f / sum; o0 *= inv; o1 *= inv;
        const float rs = rsqrtf(wave_sum(o0 * o0 + o1 * o1) * (1.f / HD) + EPS);
        bf16_t* mp = mixb + (size_t)tok * MIXW + h * HD;
        mp[lane] = (bf16_t)(cvt_pk_bf16(o0 * rs, 0.f) & 0xffffu); mp[lane + 64] = (bf16_t)(cvt_pk_bf16(o1 * rs, 0.f) & 0xffffu);
    }
}
__device__ __forceinline__ void xattn_simple(Frame& F, const bf16_t* qc, const bf16_t* kvc, bf16_t* oc) {
    const int gw = F.vcu * NWAVES + F.wave, NGW = F.G * NWAVES, lane = F.lane;
    LAS float* qs = (LAS float*)(F.lds + RING_OFF) + F.wave * 384; LAS float* sc = qs + 128;
    for (int it = gw; it < M * CH; it += NGW) {
        const int h = it & 3, tok = it >> 2, b = tok / SEQ;
        const bf16_t* qp = qc + (size_t)tok * CW + h * CHD;
        LDS_WAIT(); qs[lane] = bf2f(qp[lane]); qs[lane + 64] = bf2f(qp[lane + 64]); LDS_WAIT();
        const float scale = 0.08838834764831845f; float mx = -INFINITY;
#pragma unroll 1
        for (int i = 0; i < 4; ++i) { const int m = lane + 64 * i; const bf16_t* kp = kvc + (size_t)(b * MEM + m) * (2 * CW) + h * CHD; float d = 0.f;
#pragma unroll 4
            for (int dd = 0; dd < 128; dd += 8) { float kv[8]; ld8bf(kp + dd, kv);
#pragma unroll
                for (int e = 0; e < 8; ++e) d += qs[dd + e] * kv[e]; }
            d *= scale; sc[m] = d; mx = fmaxf(mx, d); }
        mx = wave_max(mx); float sum = 0.f; LDS_WAIT();
#pragma unroll
        for (int i = 0; i < 4; ++i) { const int m = lane + 64 * i; const float e = __expf(sc[m] - mx); sc[m] = e; sum += e; }
        sum = wave_sum(sum); LDS_WAIT();
        float o0 = 0.f, o1 = 0.f; const bf16_t* vp = kvc + (size_t)(b * MEM) * (2 * CW) + CW + h * CHD;
#pragma unroll 4
        for (int m = 0; m < MEM; ++m) { const float pr = sc[m]; o0 += pr * bf2f(vp[(size_t)m * (2 * CW) + lane]); o1 += pr * bf2f(vp[(size_t)m * (2 * CW) + lane + 64]); }
        const float inv = 1.f / sum; bf16_t* op = oc + (size_t)tok * CW + h * CHD;
        op[lane] = (bf16_t)(cvt_pk_bf16(o0 * inv, 0.f) & 0xffffu); op[lane + 64] = (bf16_t)(cvt_pk_bf16(o1 * inv, 0.f) & 0xffffu);
    }
}
__device__ __forceinline__ void router_rows(Frame& F, const float* h2, const float* wr, const float* b_rg, const float* b_re, float* rs2, int* cnt, int* list, int* tok_e, int* tok_pos, float* tok_w) {
    const int gw = F.vcu * NWAVES + F.wave, NGW = F.G * NWAVES, lane = F.lane;
    LAS float* lgl = (LAS float*)(F.lds + RING_OFF) + F.wave * 64;
    for (int t = gw; t < M; t += NGW) {
        const f32x4* hr = (const f32x4*)(h2 + (size_t)t * DM) + lane;
        f32x4 v[8]; float ss = 0.f;
#pragma unroll
        for (int j = 0; j < 8; ++j) { v[j] = hr[64 * j]; ss += (v[j][0] * v[j][0] + v[j][1] * v[j][1]) + (v[j][2] * v[j][2] + v[j][3] * v[j][3]); }
        ss = wave_sum(ss); const float rs = rsqrtf(ss * (1.f / DM) + EPS);
        LDS_WAIT();
#pragma unroll 1
        for (int n = 0; n < 36; ++n) { const f32x4* w = (const f32x4*)(wr + (size_t)n * DM) + lane; float d = 0.f;
#pragma unroll
            for (int j = 0; j < 8; ++j) { const f32x4 ww = w[64 * j]; d += (v[j][0] * ww[0] + v[j][1] * ww[1]) + (v[j][2] * ww[2] + v[j][3] * ww[3]); }
            d = wave_sum(d) * rs; if (lane == 0) lgl[n] = d; }
        LDS_WAIT();
        float gm_ = -INFINITY; int gi = 0; float g[4];
#pragma unroll
        for (int i = 0; i < 4; ++i) { g[i] = lgl[i] + b_rg[i]; if (g[i] > gm_) { gm_ = g[i]; gi = i; } }
        float gs = 0.f;
#pragma unroll
        for (int i = 0; i < 4; ++i) gs += __expf(g[i] - gm_);
        const float gwt = 1.f / gs;
        float e1 = -INFINITY, e2 = -INFINITY; int i1 = 0, i2 = 0;
#pragma unroll
        for (int i = 0; i < 8; ++i) { const float vv = lgl[4 + gi * 8 + i] + b_re[gi * 8 + i]; if (vv > e1) { e2 = e1; i2 = i1; e1 = vv; i1 = i; } else if (vv > e2) { e2 = vv; i2 = i; } }
        const float p2 = 1.f / (1.f + __expf(e1 - e2)), p1 = 1.f - p2;
        const int ea = gi * 8 + i1, eb = gi * 8 + i2;
        if (lane == 0) {
            const int pa = atomicAdd(&cnt[ea], 1), pb = atomicAdd(&cnt[eb], 1);
            list[ea * M + pa] = t; list[eb * M + pb] = t;
            tok_e[t * 2] = ea; tok_e[t * 2 + 1] = eb; tok_pos[t * 2] = pa; tok_pos[t * 2 + 1] = pb; tok_w[t * 2] = gwt * p1; tok_w[t * 2 + 1] = gwt * p2; rs2[t] = rs;
        }
    }
}

__global__ void __launch_bounds__(NWAVES * 64, 2) fwd(Args args) {
    extern __shared__ __attribute__((aligned(16))) unsigned char lds_raw[];
    Frame F;
    F.lds = (LAS unsigned char*)lds_raw;
    F.MISC = (volatile LAS unsigned*)(F.lds + MISC_OFF);
    F.tid = threadIdx.x; F.lane = F.tid & 63; F.wave = __builtin_amdgcn_readfirstlane(F.tid >> 6);
    F.G = gridDim.x; { const int bx = blockIdx.x; F.vcu = (F.G % 8 == 0) ? (bx % 8) * (F.G / 8) + bx / 8 : bx; }
    F.ctl = (unsigned*)(args.ws + WS_CTL);
    for (int u = F.tid; u < (LDS_BYTES - LDSCTL_OFF) / 4; u += NWAVES * 64) ((LAS unsigned*)(F.lds + LDSCTL_OFF))[u] = 0u;
    __syncthreads();
    XcdBarrier bar = xcd_barrier_post(F.ctl + CW_BAR + args.li * XCD_BAR_WORDS, F.MISC + 8);
    const int lo = args.ph_lo, hi = args.ph_hi;
#define IN(k) (lo <= (k) && (k) < hi)
#define BOTH(k) (IN(k) && IN((k) + 1))
#define PHASE_WS() unsigned char* ws = args.ws; asm volatile("" : "+s"(ws))
    if (IN(0)) { p0_prologue(F, args); if (BOTH(0)) xcd_barrier(bar); }
    if (IN(1)) {
        PHASE_WS();
        SchedG1 S{(const char*)(ws + WS_XB), (const char*)(ws + WS_WIN_T), F.G, (int)blockIdx.x};
        EpiG1 E{(bf16_t*)(ws + WS_PROJ), (float*)(ws + WS_DTRAW), (const float*)(ws + WS_RSX), (const float*)(ws + WS_ROPE)};
        gm::gemm_phase<EpiG1, SchedG1, false>(F.lds + RING_OFF, (const LAS int*)(F.lds + TAB_OFF), DM, S, E);
        if (BOTH(1)) xcd_barrier(bar);
    }
    if (IN(2)) {
        PHASE_WS();
        kmean_simple(F, (const bf16_t*)(ws + WS_PROJ), (float*)(ws + WS_KMEAN));
        for (int L = F.vcu; L < BATCH * SH; L += F.G)
            ssd_simple(F, L / SH, L % SH, (const bf16_t*)(ws + WS_PROJ), (const float*)(ws + WS_DTRAW), args.in[4], args.in[5], args.in[6], args.in[7], args.in[8], args.out);
        if (BOTH(2)) xcd_barrier(bar);
    }
    if (IN(3)) {
        PHASE_WS();
        moba_simple(F, (const bf16_t*)(ws + WS_PROJ), (const float*)(ws + WS_KMEAN), (bf16_t*)(ws + WS_MIXB));
        gnorm_simple(F, args.out, (bf16_t*)(ws + WS_MIXB));
        if (BOTH(3)) xcd_barrier(bar);
    }
    if (IN(4)) {
        PHASE_WS();
        SchedTiles S{(const char*)(ws + WS_MIXB), (const char*)(ws + WS_WOUT_T), 64, 8, MIXW, F.G, (int)blockIdx.x};
        EpiRes E{args.in[0], args.out, (bf16_t*)(ws + WS_XB), (float*)(ws + WS_SS)};
        gm::gemm_phase<EpiRes, SchedTiles, false>(F.lds + RING_OFF, (const LAS int*)(F.lds + TAB_OFF), MIXW, S, E);
        if (BOTH(4)) xcd_barrier(bar);
    }
    if (IN(5)) {
        PHASE_WS();
        SchedQKV S{(const char*)(ws + WS_XB), (const char*)(ws + WS_WCQ_T), (const char*)(ws + WS_MEMB), (const char*)(ws + WS_WCKV_T), F.G, (int)blockIdx.x};
        gm::Unit u0; LAS float* rsl = (LAS float*)(F.lds + RSL_OFF);
        if (S.next(0, u0) && F.tid < 256) {
            const int row = u0.pm * 256 + F.tid;
            if (u0.kind == 0) { const f32x4* p = (const f32x4*)((const float*)(ws + WS_SS) + (size_t)row * 32); float q = 0.f;
#pragma unroll
                for (int j = 0; j < 8; ++j) { const f32x4 v = p[j]; q += (v[0] + v[1]) + (v[2] + v[3]); }
                rsl[F.tid] = rsqrtf(q * (1.f / DM) + EPS); }
            else rsl[F.tid] = ((const float*)(ws + WS_RSMEM))[row];
        }
        VM_WAIT(); LDS_WAIT(); __syncthreads();
        EpiScale E{(bf16_t*)(ws + WS_QC), (bf16_t*)(ws + WS_KVC), CW, 2 * CW, rsl};
        gm::gemm_phase<EpiScale, SchedQKV, false>(F.lds + RING_OFF, (const LAS int*)(F.lds + TAB_OFF), DM, S, E);
        if (BOTH(5)) xcd_barrier(bar);
    }
    if (IN(6)) {
        PHASE_WS();
        xattn_simple(F, (const bf16_t*)(ws + WS_QC), (const bf16_t*)(ws + WS_KVC), (bf16_t*)(ws + WS_OC));
        if (BOTH(6)) xcd_barrier(bar);
    }
    if (IN(7)) {
        PHASE_WS();
        SchedTiles S{(const char*)(ws + WS_OC), (const char*)(ws + WS_WCO_T), 64, 8, CW, F.G, (int)blockIdx.x};
        EpiRes E{args.out, args.out, (bf16_t*)(ws + WS_XB), (float*)(ws + WS_SS) + (size_t)M * 32};
        gm::gemm_phase<EpiRes, SchedTiles, false>(F.lds + RING_OFF, (const LAS int*)(F.lds + TAB_OFF), CW, S, E);
        if (BOTH(7)) xcd_barrier(bar);
    }
    if (IN(8)) {
        PHASE_WS();
        int* tok_e = (int*)(ws + WS_TOK);
        router_rows(F, args.out, (const float*)(ws + WS_WR), args.in[20], args.in[22], (float*)(ws + WS_RS2), (int*)(F.ctl + CW_CNT), (int*)(ws + WS_LIST), tok_e, tok_e + 2 * M, (float*)(tok_e + 4 * M));
        if (BOTH(8)) xcd_barrier(bar);
    }
    if (IN(9)) {
        PHASE_WS();
        LAS int* mt = (LAS int*)(F.lds + MOE_OFF); LAS int* tab = (LAS int*)(F.lds + TAB_OFF);
        moe_tables(mt, (const int*)(F.ctl + CW_CNT), F.tid);
        SchedMoE<true> S{mt, (const char*)(ws + WS_XB), (const char*)(ws + WS_WGU_T), F.G, F.vcu};
        { const int* list = (const int*)(ws + WS_LIST); gm::Unit u;
          for (int i = 0; i < 8 && S.next(i, u); ++i) if (F.tid < 256) { const int rg = u.pm * 256 + F.tid; tab[i * 256 + F.tid] = list[u.kind * M + (rg < mt[u.kind] ? rg : 0)]; } }
        VM_WAIT(); LDS_WAIT(); __syncthreads();
        EpiGU E{(bf16_t*)(ws + WS_HACT), (const float*)(ws + WS_RS2), mt, tab};
        gm::gemm_phase<EpiGU, SchedMoE<true>, true>(F.lds + RING_OFF, tab, DM, S, E);
        if (BOTH(9)) xcd_barrier(bar);
    }
    if (IN(10)) {
        PHASE_WS();
        LAS int* mt = (LAS int*)(F.lds + MOE_OFF);
        moe_tables(mt, (const int*)(F.ctl + CW_CNT), F.tid);
        SchedMoE<false> S{mt, (const char*)(ws + WS_HACT), (const char*)(ws + WS_WD_T), F.G, F.vcu};
        EpiDown E{(bf16_t*)(ws + WS_Y), mt};
        gm::gemm_phase<EpiDown, SchedMoE<false>, false>(F.lds + RING_OFF, (const LAS int*)(F.lds + TAB_OFF), DE, S, E);
        if (BOTH(10)) xcd_barrier(bar);
    }
    if (IN(11)) {
        PHASE_WS();
        LAS int* mt = (LAS int*)(F.lds + MOE_OFF);
        moe_tables(mt, (const int*)(F.ctl + CW_CNT), F.tid);
        const int* tok_e = (const int*)(ws + WS_TOK);
        final_rows(F, args.out, (const bf16_t*)(ws + WS_Y), tok_e, tok_e + 2 * M, (const float*)(tok_e + 4 * M), args.in[26], mt);
    }
#undef IN
#undef BOTH
}
extern "C" void kernel_launch(void* const* d_in, const int* in_sizes, int n_in, void* d_out, int out_size, void* d_ws, size_t ws_size, hipStream_t stream) {
  static int grid = 0;
  static float rfv[16];
  if (grid == 0) {
    int dev = 0, cus = 0;
    if (hipGetDevice(&dev) != hipSuccess || hipDeviceGetAttribute(&cus, hipDeviceAttributeMultiprocessorCount, dev) != hipSuccess) { fprintf(stderr, "kernel_launch: device query failed\n"); grid = -1; return; }
    if (hipFuncSetAttribute((const void*)fwd, hipFuncAttributeMaxDynamicSharedMemorySize, LDS_BYTES) != hipSuccess) { fprintf(stderr, "kernel_launch: hipFuncSetAttribute failed\n"); grid = -1; return; }
    int per_cu = 0;
    if (hipOccupancyMaxActiveBlocksPerMultiprocessor(&per_cu, (const void*)fwd, NWAVES * 64, LDS_BYTES) != hipSuccess || per_cu < 1) fprintf(stderr, "kernel_launch: occupancy query says %d\n", per_cu);
    (void)hipGetLastError();
    for (int i = 0; i < 16; ++i) rfv[i] = (float)pow(500000.0, -(double)i / 16.0);
    grid = cus;
  }
  if (grid < 0) return;
  float* out = (float*)d_out;
  unsigned char* ws = (unsigned char*)d_ws;
  (void)hipMemsetAsync(ws + WS_CTL, 0, CTL_ZERO_BYTES, stream);
  Args a{};
  for (int i = 0; i < 27; ++i) a.in[i] = (const float*)d_in[i];
  a.out = out; a.ws = ws; for (int i = 0; i < 16; ++i) a.rf[i] = rfv[i];
  a.ph_lo = 0; a.ph_hi = 12; a.li = 0;
  hipLaunchKernelGGL(fwd, dim3(grid), dim3(NWAVES * 64), LDS_BYTES, stream, a);
}
```

```cpp
#include <hip/hip_runtime.h>
#include <stdint.h>
#include <math.h>
#include <cstdio>

constexpr int DM = 2048, BATCH = 8, SEQ = 2048, M = BATCH * SEQ, MEM = 256, MROWS = BATCH * MEM;
constexpr float EPS = 1e-6f;
constexpr int AH = 8, HD = 128, AW = 1024;
constexpr int MB = 256, NB = SEQ / MB;
constexpr int SW = 2048, SH = 32, SG = 4, SCONV = 4, CONVD = 3072;
constexpr int MIXW = 3072, INW = 8224, LDP = 8448;
constexpr int C_Q = 0, C_K = 1024, C_V = 2048, C_Z = 3072, C_XBC = 5120, C_DT = 8192;
constexpr int CH = 4, CHD = 128, CW = 512;
constexpr int NG = 4, EPG = 8, NE = 32, DE = 1024;

#define LAS __attribute__((address_space(3)))
#define GAS __attribute__((address_space(1)))
typedef unsigned short bf16_t;
typedef short bf16x8 __attribute__((ext_vector_type(8)));
typedef float f32x4 __attribute__((ext_vector_type(4)));
typedef float f32x2 __attribute__((ext_vector_type(2)));
typedef unsigned u32x4 __attribute__((ext_vector_type(4)));
typedef unsigned u32x2 __attribute__((ext_vector_type(2)));
#define LDS_WAIT() asm volatile("s_waitcnt lgkmcnt(0)" ::: "memory")
#define VM_WAIT() asm volatile("s_waitcnt vmcnt(0)" ::: "memory")

__device__ __forceinline__ unsigned cvt_pk_bf16(float lo, float hi) { unsigned r; asm volatile("v_cvt_pk_bf16_f32 %0, %1, %2" : "=v"(r) : "v"(lo), "v"(hi)); return r; }
__device__ __forceinline__ float bf2f(bf16_t b) { return __uint_as_float(((unsigned)b) << 16); }
__device__ __forceinline__ float bflo(unsigned w) { return __uint_as_float(w << 16); }
__device__ __forceinline__ float bfhi(unsigned w) { return __uint_as_float(w & 0xffff0000u); }
__device__ __forceinline__ void ld8bf(const bf16_t* p, float (&o)[8]) { const u32x4 w = *(const u32x4*)p; o[0] = bflo(w.x); o[1] = bfhi(w.x); o[2] = bflo(w.y); o[3] = bfhi(w.y); o[4] = bflo(w.z); o[5] = bfhi(w.z); o[6] = bflo(w.w); o[7] = bfhi(w.w); }
__device__ __forceinline__ float wave_sum(float v) {
#pragma unroll
  for (int o = 1; o < 64; o <<= 1) v += __shfl_xor(v, o);
  return v;
}
__device__ __forceinline__ float wave_max(float v) {
#pragma unroll
  for (int o = 1; o < 64; o <<= 1) v = fmaxf(v, __shfl_xor(v, o));
  return v;
}
__device__ __forceinline__ int lane_id_now() { int l; asm volatile("v_mbcnt_lo_u32_b32 %0, -1, 0\n\tv_mbcnt_hi_u32_b32 %0, -1, %0" : "=v"(l)); return l; }
__device__ __forceinline__ float silu_f(float x) { return x / (1.f + __expf(-x)); }

constexpr size_t MiB = 1u << 20;
constexpr size_t WS_CTL = 0, CTL_ZERO_BYTES = 1 * MiB;
constexpr int CW_BAR = 4096;
constexpr int CW_CNT = 65536;
constexpr size_t WS_WIN_T = 1 * MiB;
constexpr size_t WS_WOUT_T = 34 * MiB;
constexpr size_t WS_WCQ_T = 46 * MiB;
constexpr size_t WS_WCKV_T = 48 * MiB;
constexpr size_t WS_WCO_T = 52 * MiB;
constexpr size_t WS_WR = 54 * MiB;
constexpr size_t WS_SMALL = 55 * MiB;
constexpr size_t WS_ROPE = WS_SMALL, WS_RSX = WS_SMALL + 256 * 1024, WS_RSMEM = WS_RSX + 64 * 1024, WS_RS2 = WS_RSMEM + 64 * 1024, WS_KMEAN = WS_RS2 + 64 * 1024;
constexpr size_t WS_DTRAW = 56 * MiB;
constexpr size_t WS_SS = 58 * MiB;
constexpr size_t WS_MEMB = 62 * MiB;
constexpr size_t WS_XB = 70 * MiB;
constexpr size_t WS_PROJ = 134 * MiB;
constexpr size_t WS_MIXB = 398 * MiB;
constexpr size_t WS_QC = 494 * MiB, WS_OC = 510 * MiB;
constexpr size_t WS_KVC = 526 * MiB;
constexpr size_t WS_WGU_T = 530 * MiB;
constexpr size_t WS_WD_T = 786 * MiB;
constexpr size_t WS_LIST = 914 * MiB;
constexpr size_t WS_TOK = 916 * MiB;
constexpr size_t WS_HACT = WS_PROJ;
constexpr size_t WS_Y = WS_PROJ + 66 * MiB;
constexpr size_t WS_AFTER = 917 * MiB;
#define XB_TMO      128
#define XB_XCNT(j)  (256  + 64 * (j))
#define XB_XSUB(j)  (1280 + 64 * (j))
#define XB_XGEN(j)  (2304 + 64 * (j))
#define XB_TOP      3328
#define XB_TOPGEN   3392
#define XCD_BAR_WORDS 3456
#define XB_SPIN_CAP (1u << 18)

__device__ __forceinline__ unsigned xb_ld(unsigned* p)              { return __hip_atomic_load(p, __ATOMIC_RELAXED, __HIP_MEMORY_SCOPE_AGENT); }
__device__ __forceinline__ unsigned xb_add(unsigned* p, unsigned v) { return __hip_atomic_fetch_add(p, v, __ATOMIC_RELAXED, __HIP_MEMORY_SCOPE_AGENT); }
__device__ __forceinline__ unsigned xb_xcc_id() { return (unsigned)__builtin_amdgcn_s_getreg((3 << 11) | 20) & 0xFu; }
#define XB_SPIN(cond, bar) do { unsigned _sp = 0; while (cond) { __builtin_amdgcn_s_sleep(1); \
    if ((++_sp & 255u) == 0u) { if (xb_ld(&(bar)[XB_TMO])) break; if (_sp > XB_SPIN_CAP) { atomicAdd(&(bar)[XB_TMO], 1u); break; } } } } while (0)

struct XcdBarrier {
    unsigned* bar; unsigned x;
    volatile LAS unsigned* st;
};

__device__ __forceinline__ XcdBarrier xcd_barrier_post(unsigned* bar, volatile LAS unsigned* st) {
    XcdBarrier b; b.bar = bar; b.x = xb_xcc_id(); b.st = st;
    if (threadIdx.x == 0) (void)xb_add(&bar[XB_XCNT(b.x)], 1u);
    return b;
}
__device__ __forceinline__ void xcd_barrier_complete(unsigned* bar, unsigned x, unsigned& nloc, unsigned& nx) {
    const unsigned G = gridDim.x * gridDim.y * gridDim.z;
    unsigned sum, cnt, mine, sp = 0u;
    for (;;) {
        sum = 0u; cnt = 0u; mine = 0u;
#pragma unroll
        for (unsigned j = 0; j < 16; ++j) { const unsigned c = xb_ld(&bar[XB_XCNT(j)]); sum += c; cnt += (c > 0u) ? 1u : 0u; mine = (j == x) ? c : mine; }
        if (sum == G) break;
        __builtin_amdgcn_s_sleep(1);
        if ((++sp & 255u) == 0u) { if (xb_ld(&bar[XB_TMO])) break; if (sp > XB_SPIN_CAP) { atomicAdd(&bar[XB_TMO], 1u); break; } }
    }
    nloc = mine > 0u ? mine : 1u; nx = cnt > 0u ? cnt : 1u;
}

__device__ __forceinline__ void xcd_barrier(const XcdBarrier& b, const int xb_tid) {
    asm volatile("s_waitcnt vmcnt(0)" ::: "memory");
    __syncthreads();
    if (xb_tid == 0) {
        unsigned* bar = b.bar;
        __builtin_amdgcn_s_waitcnt(0);
        unsigned nloc = b.st[0], nx = b.st[1];
        if (nloc == 0u) { xcd_barrier_complete(bar, b.x, nloc, nx); b.st[0] = nloc; b.st[1] = nx; }
        const unsigned old = xb_add(&bar[XB_XSUB(b.x)], 1u);
        const unsigned gen = old / nloc;
        if (old + 1u == (gen + 1u) * nloc) {
            __builtin_amdgcn_fence(__ATOMIC_RELEASE, "agent");
            asm volatile("s_waitcnt vmcnt(0)" ::: "memory");
            const unsigned og = xb_add(&bar[XB_TOP], 1u);
            const unsigned tg = og / nx;
            if (og + 1u == (tg + 1u) * nx) xb_add(&bar[XB_TOPGEN], 1u);
            else XB_SPIN(xb_ld(&bar[XB_TOPGEN]) == tg, bar);
            __builtin_amdgcn_fence(__ATOMIC_ACQUIRE, "agent");
            xb_add(&bar[XB_XGEN(b.x)], 1u);
            asm volatile("s_waitcnt vmcnt(0)" ::: "memory");
        } else {
            XB_SPIN(xb_ld(&bar[XB_XGEN(b.x)]) == gen, bar);
            __builtin_amdgcn_fence(__ATOMIC_ACQUIRE, "agent");
            asm volatile("s_waitcnt vmcnt(0)" ::: "memory");
        }
    }
    __syncthreads();
}

namespace gm {
constexpr int BM = 256, BK = 64, HALF = 128, HTB = HALF * BK * 2, STAGE_BYTES = 8 * HTB, NXCD = 8, WGM = 8;
__host__ __device__ __forceinline__ int lds_byte(int r, int c) { const int st = (r >> 4) * 2 + (c >> 5), rr = r & 15, cc = c & 31, ob = rr * 64 + cc * 2; return st * 1024 + (ob ^ (((ob >> 9) & 1) << 5)); }
__host__ __device__ __forceinline__ void stage_rc(int b, int& R, int& C) { const int st = b / 1024, sb = b % 1024, swz = sb ^ (((sb >> 9) & 1) << 5); R = (st >> 1) * 16 + swz / 64; C = (st & 1) * 32 + (swz % 64) / 2; }
__host__ __device__ __forceinline__ int perm32(int rho) { const int n = rho >> 4, i = rho & 15; return 8 * (i >> 2) + 4 * n + (i & 3); }

struct Unit { const char* a; const char* b; int pm, pn, kind, ti; };

__device__ __forceinline__ void tile_of(int L, int nM, int nN, int& pm, int& pn) {
    const int nwg = nM * nN; int wgid = L;
    { const int q = nwg / NXCD, r = nwg % NXCD, xcd = wgid % NXCD, off = wgid / NXCD; wgid = (xcd < r ? xcd * (q + 1) : r * (q + 1) + (xcd - r) * q) + off; }
    const int nig = WGM * nN, gid = wgid / nig, fm = gid * WGM, gsz = (nM - fm) < WGM ? (nM - fm) : WGM;
    pm = fm + ((wgid % nig) % gsz); pn = (wgid % nig) / gsz;
}

template <class Epi, class Sched, bool GATHER>
__device__ __forceinline__ void gemm_phase(const int tid, LAS unsigned char* lds, const LAS int* tab, const int K, const Sched& S, const Epi& E) {
    const int wid = __builtin_amdgcn_readfirstlane(tid >> 6), lane = tid & 63, wr = wid >> 2, wc = wid & 3, fr = lane & 15, fq = lane >> 4;
    const int nt = K / BK;
    unsigned voffA0[2], voffA1[2], voffB[2];
    const size_t kstep = (size_t)(BK * 2);
    const size_t hstep = (size_t)HALF * K * 2;
#pragma unroll
    for (int i = 0; i < 2; ++i) { int R, C; stage_rc(tid * 16 + i * 8192, R, C); const int Rb = (R & ~31) + perm32(R & 31);
        voffB[i] = (unsigned)(Rb * K + C) * 2u; voffA0[i] = (unsigned)(R * K + C) * 2u; voffA1[i] = 0u; }
#define GM_SETVOFF(u) do { if constexpr (GATHER) { _Pragma("unroll") for (int _i = 0; _i < 2; ++_i) { int R_, C_; stage_rc(tid * 16 + _i * 8192, R_, C_); \
        const int r0_ = tab[(u).ti * 256 + R_], r1_ = tab[(u).ti * 256 + 128 + R_]; voffA0[_i] = (unsigned)(r0_ * K + C_) * 2u; voffA1[_i] = (unsigned)(r1_ * K + C_) * 2u; } } } while (0)
    const unsigned ldsw = (unsigned)wid * 1024u;
    const int aoff = lds_byte(wr * 64 + fr, fq * 8), boff = lds_byte(wc * 32 + fr, fq * 8);
#define PG8_SA(b, h) (((b) * 2 + (h)) * HTB)
#define PG8_SB(b, h) ((4 + (b) * 2 + (h)) * HTB)
#define PG8_STAGE(bufoff, gbase, voff) do { _Pragma("unroll") for (int _i = 0; _i < 2; ++_i) \
        __builtin_amdgcn_global_load_lds((const unsigned*)((const char*)(gbase) + (voff)[_i]), (LAS unsigned*)(lds + (bufoff) + ldsw + _i * 8192), 16, 0, 0); } while (0)
#define PG8_LDA(dst, b, h) do { _Pragma("unroll") for (int m = 0; m < 4; ++m) _Pragma("unroll") for (int k = 0; k < 2; ++k) dst[m][k] = *(const LAS bf16x8*)(lds + PG8_SA(b, h) + aoff + m * 2048 + k * 1024); } while (0)
#define PG8_LDB(dst, b, h) do { _Pragma("unroll") for (int n = 0; n < 2; ++n) _Pragma("unroll") for (int k = 0; k < 2; ++k) dst[n][k] = *(const LAS bf16x8*)(lds + PG8_SB(b, h) + boff + n * 2048 + k * 1024); } while (0)
#define PG8_MMA(ai, bj, At, Bt) do { __builtin_amdgcn_s_setprio(1); _Pragma("unroll") for (int m = 0; m < 4; ++m) _Pragma("unroll") for (int n = 0; n < 2; ++n) _Pragma("unroll") for (int k = 0; k < 2; ++k) \
        acc[ai][bj][m][n] = __builtin_amdgcn_mfma_f32_16x16x32_bf16(Bt[n][k], At[m][k], acc[ai][bj][m][n], 0, 0, 0); __builtin_amdgcn_s_setprio(0); } while (0)
#define GM_STAGE_A1(bufoff, gbase) do { if constexpr (GATHER) { PG8_STAGE(bufoff, gbase, voffA1); } else { PG8_STAGE(bufoff, (gbase) + hstep, voffA0); } } while (0)
#define PG8_WAIT_V(n) asm volatile("s_waitcnt vmcnt(" #n ")" ::: "memory")
#define PG8_WAIT_L(n) asm volatile("s_waitcnt lgkmcnt(" #n ")" ::: "memory")
#define PG8_BAR __builtin_amdgcn_s_barrier()
#define PG8_SCHED __builtin_amdgcn_sched_barrier(0)
    Unit cur, nxt; int ui = 0;
    if (!S.next(0, cur)) return;
    GM_SETVOFF(cur);
    f32x4 acc[2][2][4][2];
#pragma unroll
    for (int a = 0; a < 2; ++a)
#pragma unroll
        for (int b = 0; b < 2; ++b)
#pragma unroll
            for (int m = 0; m < 4; ++m)
#pragma unroll
                for (int n = 0; n < 2; ++n) acc[a][b][m][n] = (f32x4){0.f, 0.f, 0.f, 0.f};
    bf16x8 At[4][2], B0[2][2], B1[2][2];
    const char* cA = cur.a; const char* cB = cur.b;
    PG8_STAGE(PG8_SB(0, 0), cB, voffB); PG8_STAGE(PG8_SB(0, 1), cB + hstep, voffB); PG8_STAGE(PG8_SA(0, 0), cA, voffA0); GM_STAGE_A1(PG8_SA(0, 1), cA);
    if (wr == 1) PG8_BAR;
    PG8_WAIT_V(2); PG8_BAR;
    PG8_STAGE(PG8_SB(1, 0), cB + kstep, voffB); PG8_STAGE(PG8_SA(1, 0), cA + kstep, voffA0); PG8_STAGE(PG8_SB(1, 1), cB + hstep + kstep, voffB);
    PG8_WAIT_V(6); PG8_BAR;
    for (;;) {
        const bool has_next = S.next(ui + 1, nxt);
        const char* nA = has_next ? nxt.a : cA; const char* nB = has_next ? nxt.b : cB;
        for (int t = 0; t < nt; t += 2) {
            const bool last = (t == nt - 2);
            const char* a1 = cA + (size_t)(t + 1) * kstep;
            const char* a2 = last ? nA : cA + (size_t)(t + 2) * kstep; const char* b2 = last ? nB : cB + (size_t)(t + 2) * kstep;
            const char* a3 = a2 + kstep; const char* b3 = b2 + kstep;
            PG8_LDB(B0, 0, 0); PG8_LDB(B1, 0, 1); PG8_SCHED; PG8_LDA(At, 0, 0); GM_STAGE_A1(PG8_SA(1, 1), a1);
            PG8_WAIT_V(8); PG8_WAIT_L(0); PG8_BAR; PG8_MMA(0, 0, At, B0); PG8_MMA(0, 1, At, B1); PG8_BAR; PG8_SCHED;
            if constexpr (GATHER) { if (last && has_next) { GM_SETVOFF(nxt); } }
            PG8_LDA(At, 0, 1); PG8_STAGE(PG8_SB(0, 0), b2, voffB); PG8_STAGE(PG8_SB(0, 1), b2 + hstep, voffB); PG8_STAGE(PG8_SA(0, 0), a2, voffA0);
            PG8_WAIT_V(8); PG8_WAIT_L(0); PG8_BAR; PG8_MMA(1, 0, At, B0); PG8_MMA(1, 1, At, B1); PG8_BAR; PG8_SCHED;
            PG8_LDB(B0, 1, 0); PG8_LDB(B1, 1, 1); PG8_SCHED; PG8_LDA(At, 1, 0); GM_STAGE_A1(PG8_SA(0, 1), a2);
            PG8_WAIT_V(8); PG8_WAIT_L(0); PG8_BAR; PG8_MMA(0, 0, At, B0); PG8_MMA(0, 1, At, B1); PG8_BAR; PG8_SCHED;
            PG8_LDA(At, 1, 1); PG8_STAGE(PG8_SB(1, 0), b3, voffB); PG8_STAGE(PG8_SB(1, 1), b3 + hstep, voffB); PG8_STAGE(PG8_SA(1, 0), a3, voffA0);
            PG8_WAIT_V(8); PG8_WAIT_L(0); PG8_BAR; PG8_MMA(1, 0, At, B0); PG8_MMA(1, 1, At, B1); PG8_BAR; PG8_SCHED;
        }
        if (wr == 0) PG8_BAR;
        E(acc, cur, wr, wc, fr, fq);
        if (!has_next) break;
#pragma unroll
        for (int a = 0; a < 2; ++a)
#pragma unroll
            for (int b = 0; b < 2; ++b)
#pragma unroll
                for (int m = 0; m < 4; ++m)
#pragma unroll
                    for (int n = 0; n < 2; ++n) acc[a][b][m][n] = (f32x4){0.f, 0.f, 0.f, 0.f};
        cur = nxt; cA = nA; cB = nB; ++ui;
        if (wr == 1) PG8_BAR;
    }
    PG8_WAIT_V(0);
    PG8_BAR;
#undef GM_SETVOFF
#undef GM_STAGE_A1
#undef PG8_SA
#undef PG8_SB
#undef PG8_STAGE
#undef PG8_LDA
#undef PG8_LDB
#undef PG8_MMA
#undef PG8_WAIT_V
#undef PG8_WAIT_L
#undef PG8_BAR
#undef PG8_SCHED
}
}
namespace at {
using f32x16 = __attribute__((ext_vector_type(16))) float;
using s16x4 = __attribute__((ext_vector_type(4))) short;
constexpr int D = 128, NW = 8, QBLK = 32, KVBLK = 64;
constexpr float SCALE = 0.088388347648318440f;
constexpr float THR = 8.f;
constexpr int SHM_V = KVBLK * D * 2, SHM_K = KVBLK * D * 2, SHM_ATTN = 2 * SHM_V + 2 * SHM_K + NW * 64 * 4;
constexpr int KM_OFF = SHM_ATTN;
constexpr int QL_OFF = KM_OFF + 4096;
#define KSWZ(row, colB) ((row) * 256 + ((colB) ^ (((row) & 7) << 4)))
#define SBAR() __builtin_amdgcn_sched_barrier(0)
__device__ __forceinline__ int crow(int r, int hi) { return (r & 3) + 8 * (r >> 2) + 4 * hi; }

__device__ __forceinline__ void partialSM(f32x16& p0, f32x16& p1, float& m_reg, float& mn, float& alpha, bool dead) {
  constexpr float C = SCALE * 1.4426950408889634f;
  float pmax = p0[0];
#pragma unroll
  for (int r = 1; r < 16; ++r) pmax = fmaxf(pmax, p0[r]);
#pragma unroll
  for (int r = 0; r < 16; ++r) pmax = fmaxf(pmax, p1[r]);
  { auto rr = __builtin_amdgcn_permlane32_swap(__float_as_uint(pmax), __float_as_uint(pmax), false, false);
    pmax = fmaxf(__uint_as_float(rr[0]), __uint_as_float(rr[1])); }
  if (dead) pmax = -1e30f;
  if (__builtin_expect(__all(pmax - m_reg <= THR / SCALE), 1)) { mn = m_reg; alpha = 1.f; }
  else { mn = fmaxf(m_reg, pmax); alpha = __builtin_amdgcn_exp2f((m_reg - mn) * C); m_reg = mn; }
  const float mnC = dead ? -INFINITY : -mn * C;
#pragma unroll
  for (int r = 0; r < 16; ++r) p0[r] = fmaf(p0[r], C, mnC);
#pragma unroll
  for (int r = 0; r < 16; ++r) p1[r] = fmaf(p1[r], C, mnC);
#pragma unroll
  for (int r = 0; r < 16; ++r) p0[r] = __builtin_amdgcn_exp2f(p0[r]);
}
__device__ __forceinline__ void finishSM(f32x16& p0, f32x16& p1, float alpha, float& l_reg, bf16x8& pa0, bf16x8& pa1, bf16x8& pa2, bf16x8& pa3) {
#pragma unroll
  for (int r = 0; r < 16; ++r) p1[r] = __builtin_amdgcn_exp2f(p1[r]);
  float ps = 0;
#pragma unroll
  for (int r = 0; r < 16; ++r) ps += p0[r];
#pragma unroll
  for (int r = 0; r < 16; ++r) ps += p1[r];
  { auto rr = __builtin_amdgcn_permlane32_swap(__float_as_uint(ps), __float_as_uint(ps), false, false);
    ps = __uint_as_float(rr[0]) + __uint_as_float(rr[1]); }
  l_reg = l_reg * alpha + ps;
#define PK4(P, BASE, OUT) do { unsigned a0 = cvt_pk_bf16(P[BASE + 0], P[BASE + 1]), a1 = cvt_pk_bf16(P[BASE + 2], P[BASE + 3]);   \
    unsigned b0 = cvt_pk_bf16(P[BASE + 4], P[BASE + 5]), b1 = cvt_pk_bf16(P[BASE + 6], P[BASE + 7]);                              \
    auto r0 = __builtin_amdgcn_permlane32_swap(a0, b0, false, false); auto r1 = __builtin_amdgcn_permlane32_swap(a1, b1, false, false); \
    u32x4 w = {r0[0], r1[0], r0[1], r1[1]}; OUT = *reinterpret_cast<bf16x8*>(&w); } while (0)
  PK4(p0, 0, pa0); PK4(p0, 8, pa1); PK4(p1, 0, pa2); PK4(p1, 8, pa3);
#undef PK4
}
template <bool QLDS>
__device__ __forceinline__ void qkt(f32x16& p0, f32x16& p1, const LAS char* Ks, const bf16x8* qr, const LAS char* ql, int r32, int hi) {
  p0 = f32x16{}; p1 = f32x16{};
#pragma unroll
  for (int d0 = 0; d0 < 8; ++d0) { int cb = (d0 * 16 + hi * 8) * 2;
    bf16x8 b0 = *(const LAS bf16x8*)(Ks + KSWZ(r32, cb));
    bf16x8 b1 = *(const LAS bf16x8*)(Ks + KSWZ(32 + r32, cb));
    bf16x8 q; if constexpr (QLDS) q = *(const LAS bf16x8*)(ql + d0 * 8192); else q = qr[d0];
    p0 = __builtin_amdgcn_mfma_f32_32x32x16_bf16(b0, q, p0, 0, 0, 0);
    p1 = __builtin_amdgcn_mfma_f32_32x32x16_bf16(b1, q, p1, 0, 0, 0); }
}
__device__ __forceinline__ int v_st(int k, int c) { const int kk = (k & ~0xC) | ((k & 4) << 1) | ((k & 8) >> 1); return ((kk >> 3) * 4 + (c >> 5)) * 512 + ((kk & 7) * 32 + (c & 31)) * 2; }
__device__ __forceinline__ int v_rd_base(int lane) { return ((lane & 3) << 3) | (((lane >> 2) & 3) << 6) | (((lane >> 4) & 1) << 5) | (((lane >> 5) & 1) << 8); }
constexpr int v_rd_off(int d0, int ks, int half) { return d0 * 512 + ks * 4096 + half * 2048; }
template <int OFF> __device__ __forceinline__ s16x4 tr_read(int vb) {
  s16x4 r; asm volatile("ds_read_b64_tr_b16 %0, %1 offset:%2" : "=&v"(r) : "v"(vb), "i"(OFF) : "memory"); return r;
}
template <int D0> __device__ __forceinline__ void pv_one(f32x16& od, int vb, bf16x8 pa0, bf16x8 pa1, bf16x8 pa2, bf16x8 pa3) {
  const s16x4 l0 = tr_read<v_rd_off(D0, 0, 0)>(vb), h0 = tr_read<v_rd_off(D0, 0, 1)>(vb), l1 = tr_read<v_rd_off(D0, 1, 0)>(vb), h1 = tr_read<v_rd_off(D0, 1, 1)>(vb);
  const s16x4 l2 = tr_read<v_rd_off(D0, 2, 0)>(vb), h2 = tr_read<v_rd_off(D0, 2, 1)>(vb), l3 = tr_read<v_rd_off(D0, 3, 0)>(vb), h3 = tr_read<v_rd_off(D0, 3, 1)>(vb);
  asm volatile("s_waitcnt lgkmcnt(0)" ::: "memory"); SBAR();
#define PK(L, H) (bf16x8){L[0], L[1], L[2], L[3], H[0], H[1], H[2], H[3]}
  od = __builtin_amdgcn_mfma_f32_32x32x16_bf16(pa0, PK(l0, h0), od, 0, 0, 0);
  od = __builtin_amdgcn_mfma_f32_32x32x16_bf16(pa1, PK(l1, h1), od, 0, 0, 0);
  od = __builtin_amdgcn_mfma_f32_32x32x16_bf16(pa2, PK(l2, h2), od, 0, 0, 0);
  od = __builtin_amdgcn_mfma_f32_32x32x16_bf16(pa3, PK(l3, h3), od, 0, 0, 0);
#undef PK
}
__device__ __forceinline__ void pv_d0(f32x16* o, int vb, bf16x8 pa0, bf16x8 pa1, bf16x8 pa2, bf16x8 pa3) {
  pv_one<0>(o[0], vb, pa0, pa1, pa2, pa3); pv_one<1>(o[1], vb, pa0, pa1, pa2, pa3); pv_one<2>(o[2], vb, pa0, pa1, pa2, pa3); pv_one<3>(o[3], vb, pa0, pa1, pa2, pa3);
}

template <bool MOBA>
__device__ __forceinline__ void attn_unit(const int tid, const bf16_t* __restrict__ Qb, const bf16_t* __restrict__ Kh, bf16_t* __restrict__ Ob, int NT, int jb, const float* __restrict__ kmean_bh, LAS char* lds) {
  constexpr int ldq = MOBA ? LDP : CW, ldk = MOBA ? LDP : 2 * CW, ldo = MOBA ? MIXW : CW, VOFF = MOBA ? (C_V - C_K) : CW;
  const bf16_t* __restrict__ Vh = Kh + VOFF;
  const int wid = __builtin_amdgcn_readfirstlane(tid >> 6), lane = tid & 63, r32 = lane & 31, hi = lane >> 5;
  LAS char* V_lds = lds; LAS char* K_lds = lds + 2 * SHM_V;
  LAS float* wsf = (LAS float*)(lds + 2 * SHM_V + 2 * SHM_K) + wid * 64; LAS float* li_l = wsf; LAS float* al_l = wsf + 32;
  float m_reg = -1e30f, l_reg = 0; f32x16 o[4] = {}; bf16x8 qr[8];
  const bf16_t* Qw = Qb + (long)(wid * QBLK + r32) * ldq + hi * 8;
#pragma unroll
  for (int d0 = 0; d0 < 8; ++d0) qr[d0] = *reinterpret_cast<const bf16x8*>(Qw + d0 * 16);
  unsigned selmask = 0;
  if constexpr (MOBA) {
    LAS float* kml = (LAS float*)(lds + KM_OFF);
    __syncthreads();
    for (int i = tid; i < 8 * 128; i += NW * 64) kml[i] = kmean_bh[(i >> 7) * 1024 + (i & 127)];
    __syncthreads();
    float gate[8];
#pragma unroll
    for (int kb = 0; kb < 8; ++kb) {
      float g = 0.f;
      if (kb < jb) {
#pragma unroll
        for (int d0 = 0; d0 < 8; ++d0) { const f32x4 k0 = *(const LAS f32x4*)(kml + kb * 128 + d0 * 16 + hi * 8), k1 = *(const LAS f32x4*)(kml + kb * 128 + d0 * 16 + hi * 8 + 4);
          const u32x4 qw = *reinterpret_cast<const u32x4*>(&qr[d0]);
          g += bflo(qw.x) * k0[0] + bfhi(qw.x) * k0[1] + bflo(qw.y) * k0[2] + bfhi(qw.y) * k0[3] + bflo(qw.z) * k1[0] + bfhi(qw.z) * k1[1] + bflo(qw.w) * k1[2] + bfhi(qw.w) * k1[3]; }
        g += __shfl_xor(g, 32);
      }
      gate[kb] = g;
    }
#pragma unroll
    for (int r = 0; r < 3; ++r) { float best = -INFINITY; int bi = -1;
#pragma unroll
      for (int kb = 0; kb < 8; ++kb) { const bool ok = (kb < jb) && !((selmask >> kb) & 1u) && (gate[kb] > best || bi < 0); if (ok) { best = gate[kb]; bi = kb; } }
      if (bi >= 0) selmask |= 1u << bi; }
  }
  const LAS char* ql = lds + QL_OFF + tid * 16;
  if constexpr (MOBA) {
#pragma unroll
    for (int d0 = 0; d0 < 8; ++d0) *(LAS bf16x8*)(lds + QL_OFF + tid * 16 + d0 * 8192) = qr[d0];
  }
  const int rowb = wid * QBLK + r32;
#define MASK(P0, P1, T, DEAD) do { DEAD = false; if constexpr (MOBA) { const int kb_ = (T) >> 2; \
    if (kb_ < jb) { DEAD = !((selmask >> kb_) & 1u); } \
    else { const int lim_ = rowb - 64 * ((T) - 4 * jb); \
      if (!__all(lim_ >= 63)) { const int lh_ = lim_ - 4 * hi;     \
        _Pragma("unroll") for (int r_ = 0; r_ < 16; ++r_) { if ((r_ & 3) + 8 * (r_ >> 2) > lh_) P0[r_] = -INFINITY; if (32 + (r_ & 3) + 8 * (r_ >> 2) > lh_) P1[r_] = -INFINITY; } } } } } while (0)
  const int sr = tid >> 4, sc = (tid & 15) * 8, vst0 = v_st(sr, sc), vst1 = v_st(32 + sr, sc);
  const int vb0 = (int)(size_t)V_lds + v_rd_base(lane);
  constexpr int SDEPTH = MOBA ? 1 : 2;
  struct { bf16x8 vs0, vs1, ks0, ks1; } sr_[SDEPTH];
#define SLOAD(i, k0) do { sr_[i].vs0 = *reinterpret_cast<const bf16x8*>(&Vh[(long)((k0) + sr) * ldk + sc]); sr_[i].vs1 = *reinterpret_cast<const bf16x8*>(&Vh[(long)((k0) + 32 + sr) * ldk + sc]); \
    sr_[i].ks0 = *reinterpret_cast<const bf16x8*>(&Kh[(long)((k0) + sr) * ldk + sc]); sr_[i].ks1 = *reinterpret_cast<const bf16x8*>(&Kh[(long)((k0) + 32 + sr) * ldk + sc]); } while (0)
#define SWRITE(b, i) do { *(LAS bf16x8*)(V_lds + (b) * SHM_V + vst0) = sr_[i].vs0;          \
    *(LAS bf16x8*)(V_lds + (b) * SHM_V + vst1) = sr_[i].vs1; int kc = sc * 2;               \
    *(LAS bf16x8*)(K_lds + (b) * SHM_K + KSWZ(sr, kc)) = sr_[i].ks0;                       \
    *(LAS bf16x8*)(K_lds + (b) * SHM_K + KSWZ(32 + sr, kc)) = sr_[i].ks1; } while (0)
#define SWAIT() do { if constexpr (SDEPTH == 2) asm volatile("s_waitcnt vmcnt(4)" ::: "memory"); else asm volatile("s_waitcnt vmcnt(0)" ::: "memory"); } while (0)
#define RESC(a) do { if (__any((a) < 1.f)) { if (hi == 0) al_l[r32] = (a); asm volatile("s_waitcnt lgkmcnt(0)" ::: "memory"); \
    _Pragma("unroll") for (int d = 0; d < 4; ++d) _Pragma("unroll") for (int r = 0; r < 16; ++r) o[d][r] *= al_l[crow(r, hi)]; } } while (0)
  f32x16 pA0, pA1, pB0, pB1; float mnA, mnB, alA, alB; bf16x8 pa0, pa1, pa2, pa3; bool deadA, deadB;
  constexpr int SE = 0, SO = SDEPTH - 1;
  if constexpr (!MOBA) __syncthreads();
  SLOAD(SE, 0); asm volatile("s_waitcnt vmcnt(0)" ::: "memory"); SWRITE(0, SE); __syncthreads();
  qkt<MOBA>(pA0, pA1, K_lds, qr, ql, r32, hi); MASK(pA0, pA1, 0, deadA); partialSM(pA0, pA1, m_reg, mnA, alA, deadA);
  SLOAD(SO, KVBLK); if constexpr (SDEPTH == 2) { if (2 < NT) SLOAD(SE, 2 * KVBLK); }
  SWAIT(); SWRITE(1, SO); __syncthreads();
  for (int j = 1; j + 1 < NT; j += 2) {
    SBAR(); qkt<MOBA>(pB0, pB1, K_lds + SHM_K, qr, ql, r32, hi);
    finishSM(pA0, pA1, alA, l_reg, pa0, pa1, pa2, pa3); SBAR();
    SLOAD(SO, (j + SDEPTH) * KVBLK); SBAR();
    pv_d0(o, vb0, pa0, pa1, pa2, pa3); MASK(pB0, pB1, j, deadB); partialSM(pB0, pB1, m_reg, mnB, alB, deadB);
    __syncthreads(); SWAIT(); SWRITE(0, SE);
    RESC(alB); __syncthreads();
    SBAR(); qkt<MOBA>(pA0, pA1, K_lds, qr, ql, r32, hi);
    finishSM(pB0, pB1, alB, l_reg, pa0, pa1, pa2, pa3); SBAR();
    if (SDEPTH == 1 || j + 3 < NT) SLOAD(SE, (j + 1 + SDEPTH) * KVBLK); SBAR();
    pv_d0(o, vb0 + SHM_V, pa0, pa1, pa2, pa3); MASK(pA0, pA1, j + 1, deadA); partialSM(pA0, pA1, m_reg, mnA, alA, deadA);
    __syncthreads(); SWAIT(); SWRITE(1, SO);
    RESC(alA); __syncthreads();
  }
  SBAR(); qkt<MOBA>(pB0, pB1, K_lds + SHM_K, qr, ql, r32, hi);
  finishSM(pA0, pA1, alA, l_reg, pa0, pa1, pa2, pa3); SBAR();
  pv_d0(o, vb0, pa0, pa1, pa2, pa3); MASK(pB0, pB1, NT - 1, deadB); partialSM(pB0, pB1, m_reg, mnB, alB, deadB);
  __syncthreads(); RESC(alB);
  finishSM(pB0, pB1, alB, l_reg, pa0, pa1, pa2, pa3); SBAR();
  pv_d0(o, vb0 + SHM_V, pa0, pa1, pa2, pa3);
  if (hi == 0) li_l[r32] = l_reg; asm volatile("s_waitcnt lgkmcnt(0)" ::: "memory");
  float rli[16];
#pragma unroll
  for (int r = 0; r < 16; ++r) rli[r] = __builtin_amdgcn_rcpf(li_l[crow(r, hi)]);
  if constexpr (MOBA) {
#pragma unroll
    for (int r = 0; r < 16; ++r) {
      float q = 0.f;
#pragma unroll
      for (int d0 = 0; d0 < 4; ++d0) { const float v = o[d0][r] * rli[r]; q += v * v; }
      q += __shfl_xor(q, 1); q += __shfl_xor(q, 2); q += __shfl_xor(q, 4); q += __shfl_xor(q, 8); q += __shfl_xor(q, 16);
      rli[r] *= rsqrtf(q * (1.f / 128.f) + EPS);
    }
  }
  bf16_t* Ow = Ob + (long)(wid * QBLK) * ldo;
#pragma unroll
  for (int r = 0; r < 16; ++r) { const int orow = crow(r, hi);
#pragma unroll
    for (int d0 = 0; d0 < 4; ++d0) Ow[(long)orow * ldo + d0 * 32 + r32] = (bf16_t)(cvt_pk_bf16(o[d0][r] * rli[r], 0.f) & 0xffffu); }
#undef MASK
#undef SLOAD
#undef SWRITE
#undef SWAIT
#undef RESC
}
#undef KSWZ
#undef SBAR
}
constexpr int RING_OFF = 0, RING_BYTES = 131072;
constexpr int TAB_OFF = RING_BYTES;
constexpr int RSL_OFF = TAB_OFF + 8192;
constexpr int MOE_OFF = RSL_OFF + 1024;
constexpr int LDSCTL_OFF = MOE_OFF + 512;
constexpr int MISC_OFF = LDSCTL_OFF + 320;
constexpr int LDS_BYTES = 147456;
static_assert(MISC_OFF + 128 <= LDS_BYTES, "LDS map");
constexpr int NWAVES = 8;

struct Args { const float* in[27]; float* out; unsigned char* ws; float rf[16]; int ph_lo, ph_hi, li, pad; };

struct Frame {
    LAS unsigned char* lds;
    volatile LAS unsigned* MISC;
    int tid, lane, wave, vcu, G;
};

__device__ __forceinline__ void p0_transpose_item(const float* __restrict__ W, int ldw, int k0, int n0, const float* __restrict__ sc, bf16_t* dst, int dK, LAS float* scr, int lane) {
#pragma unroll 8
    for (int i = 0; i < 32; ++i) { const int kk = 2 * i + (lane >> 5); float v = W[(size_t)(k0 + kk) * ldw + n0 + (lane & 31)]; if (sc) v *= sc[k0 + kk]; scr[kk * 33 + (lane & 31)] = v; }
    LDS_WAIT(); asm volatile("" ::: "memory");
    const int c = lane & 7;
#pragma unroll
    for (int j = 0; j < 4; ++j) { const int n = (lane >> 3) + 8 * j; const LAS float* s = scr + (8 * c) * 33 + n;
        u32x4 o; o.x = cvt_pk_bf16(s[0 * 33], s[1 * 33]); o.y = cvt_pk_bf16(s[2 * 33], s[3 * 33]); o.z = cvt_pk_bf16(s[4 * 33], s[5 * 33]); o.w = cvt_pk_bf16(s[6 * 33], s[7 * 33]);
        *(u32x4*)(dst + (size_t)n * dK + k0 + 8 * c) = o; }
    LDS_WAIT(); asm volatile("" ::: "memory");
}
__device__ __forceinline__ void row_to_bf16_rs(const float* xrow, bf16_t* orow, float* rs_out, int lane) {
    const f32x4* xr = (const f32x4*)xrow + lane;
    f32x4 v[8]; float s = 0.f;
#pragma unroll
    for (int j = 0; j < 8; ++j) { v[j] = xr[64 * j]; s += (v[j].x * v[j].x + v[j].y * v[j].y) + (v[j].z * v[j].z + v[j].w * v[j].w); }
    s = wave_sum(s);
    if (lane == 0) *rs_out = rsqrtf(s * (1.f / DM) + EPS);
    u32x2* o8 = (u32x2*)orow + lane;
#pragma unroll
    for (int j = 0; j < 8; ++j) { u32x2 w; w.x = cvt_pk_bf16(v[j].x, v[j].y); w.y = cvt_pk_bf16(v[j].z, v[j].w); o8[64 * j] = w; }
}
__device__ __forceinline__ void p0_prologue(Frame& F, const Args& args) {
    LAS float* scr = (LAS float*)(F.lds + RING_OFF + F.wave * 16384);
    const int gw = F.vcu * NWAVES + F.wave, NGW = F.G * NWAVES, lane = F.lane;
    GAS unsigned char* wsg_ = (GAS unsigned char*)args.ws; asm volatile("" : "+s"(wsg_)); unsigned char* ws = (unsigned char*)wsg_;
    const float* w_in = args.in[3]; const float* w_out = args.in[11];
    constexpr int I_IN = 32 * 257, I_OUT = 48 * 64, I_CQ = 32 * 16, I_CO = 8 * 64;
    constexpr int I_GU = 32 * 32 * 32, I_DN = 32 * 16 * 64;
    constexpr int NITEMS = I_IN + I_OUT + 3 * I_CQ + I_CO + 2 * I_GU + I_DN;
    for (int it = gw; it < NITEMS; it += NGW) {
        int r = it;
        if (r < I_IN) { const int kb = r / 257, nb = r % 257; p0_transpose_item(w_in, INW, 64 * kb, 32 * nb, args.in[2], (bf16_t*)(ws + WS_WIN_T) + (size_t)(32 * nb) * DM, DM, scr, lane); continue; } r -= I_IN;
        if (r < I_OUT) { const int kb = r / 64, nb = r % 64; const float* sc = (kb < 16) ? args.in[9] : (args.in[10] - AW);
            p0_transpose_item(w_out, DM, 64 * kb, 32 * nb, sc, (bf16_t*)(ws + WS_WOUT_T) + (size_t)(32 * nb) * MIXW, MIXW, scr, lane); continue; } r -= I_OUT;
        if (r < I_CQ) { const int kb = r / 16, nb = r % 16; p0_transpose_item(args.in[14], CW, 64 * kb, 32 * nb, args.in[12], (bf16_t*)(ws + WS_WCQ_T) + (size_t)(32 * nb) * DM, DM, scr, lane); continue; } r -= I_CQ;
        if (r < I_CQ) { const int kb = r / 16, nb = r % 16; p0_transpose_item(args.in[15], CW, 64 * kb, 32 * nb, args.in[13], (bf16_t*)(ws + WS_WCKV_T) + (size_t)(32 * nb) * DM, DM, scr, lane); continue; } r -= I_CQ;
        if (r < I_CQ) { const int kb = r / 16, nb = r % 16; p0_transpose_item(args.in[16], CW, 64 * kb, 32 * nb, args.in[13], (bf16_t*)(ws + WS_WCKV_T) + (size_t)(CW + 32 * nb) * DM, DM, scr, lane); continue; } r -= I_CQ;
        if (r < I_CO) { const int kb = r / 64, nb = r % 64; p0_transpose_item(args.in[17], DM, 64 * kb, 32 * nb, nullptr, (bf16_t*)(ws + WS_WCO_T) + (size_t)(32 * nb) * CW, CW, scr, lane); continue; } r -= I_CO;
        if (r < 2 * I_GU) { const int up = r >= I_GU; if (up) r -= I_GU; const int e = r >> 10, kb = (r >> 5) & 31, nb = r & 31, n0 = 32 * nb;
            p0_transpose_item(args.in[up ? 24 : 23] + (size_t)e * DM * DE, DE, 64 * kb, n0, args.in[18], (bf16_t*)(ws + WS_WGU_T) + ((size_t)e * 2048 + (n0 >> 7) * 256 + up * 128 + (n0 & 127)) * DM, DM, scr, lane); continue; } r -= 2 * I_GU;
        { const int e = r >> 10, kb = (r >> 6) & 15, nb = r & 63;
            p0_transpose_item(args.in[25] + (size_t)e * DE * DM, DM, 64 * kb, 32 * nb, nullptr, (bf16_t*)(ws + WS_WD_T) + ((size_t)e * 2048 + 32 * nb) * DE, DE, scr, lane); }
    }
    { u32x4* z = (u32x4*)((bf16_t*)(ws + WS_WIN_T) + (size_t)INW * DM); const int n16 = (LDP - INW) * DM * 2 / 16;
      for (int i = (F.vcu * NWAVES * 64) + F.tid; i < n16; i += F.G * NWAVES * 64) z[i] = (u32x4){0u, 0u, 0u, 0u}; }
    { float* tab = (float*)(ws + WS_ROPE);
      for (int i = (F.vcu * NWAVES * 64) + F.tid; i < SEQ * 16; i += F.G * NWAVES * 64) { const int pos = i >> 4, f = i & 15;
        const float ang = (float)pos * args.rf[f]; double r = (double)ang * 0.15915494309189533577; r -= rint(r); const float th = (float)(r * 6.283185307179586477);
        tab[pos * 32 + f] = cosf(th); tab[pos * 32 + 16 + f] = sinf(th); } }
    { float* wr = (float*)(ws + WS_WR); const float* nfw = args.in[18];
      for (int i = (F.vcu * NWAVES * 64) + F.tid; i < 36 * DM; i += F.G * NWAVES * 64) { const int n = i >> 11, k = i & (DM - 1);
        wr[i] = (n < NG ? args.in[19][k * NG + n] : args.in[21][k * NE + (n - NG)]) * nfw[k]; } }
    for (int m = gw; m < M; m += NGW) row_to_bf16_rs(args.in[0] + (size_t)m * DM, (bf16_t*)(ws + WS_XB) + (size_t)m * DM, (float*)(ws + WS_RSX) + m, lane);
    for (int m = gw; m < MROWS; m += NGW) row_to_bf16_rs(args.in[1] + (size_t)m * DM, (bf16_t*)(ws + WS_MEMB) + (size_t)m * DM, (float*)(ws + WS_RSMEM) + m, lane);
}

struct SchedG1 {
    const char* A; const char* Bt; int G, c;
    __device__ __forceinline__ bool next(int i, gm::Unit& u) const {
        const int L = i * G + c; if (L >= 64 * 33) return false;
        int pm, pn; gm::tile_of(L, 64, 33, pm, pn);
        u.pm = pm; u.pn = pn; u.kind = 0; u.ti = 0; u.a = A + (size_t)pm * 256 * DM * 2; u.b = Bt + (size_t)pn * 256 * DM * 2; return true;
    }
};
struct EpiG1 {
    bf16_t* proj; float* dtraw; const float* rsx; const float* ropetab;
    __device__ __forceinline__ void operator()(const f32x4 (&acc)[2][2][4][2], const gm::Unit& u, int wr, int wc, int fr, int fq) const {
        const int row0 = u.pm * 256 + wr * 64 + fr;
        const bool rope = (u.pn < 8) && (wc == 0), dtt = (u.pn == 32);
        const float sgn = (fq < 2) ? -1.f : 1.f;
#pragma unroll
        for (int ai = 0; ai < 2; ++ai)
#pragma unroll
            for (int m = 0; m < 4; ++m) {
                const int row = row0 + ai * 128 + m * 16; const float rs = rsx[row];
                f32x4 c0 = {1.f, 1.f, 1.f, 1.f}, c1 = c0, s0 = {0.f, 0.f, 0.f, 0.f}, s1 = s0;
                if (rope) { const float* rt = ropetab + (row & (SEQ - 1)) * 32 + 8 * (fq & 1); c0 = *(const f32x4*)rt; c1 = *(const f32x4*)(rt + 4); s0 = *(const f32x4*)(rt + 16); s1 = *(const f32x4*)(rt + 20); }
#pragma unroll
                for (int bj = 0; bj < 2; ++bj) {
                    f32x4 v0 = acc[ai][bj][m][0] * rs, v1 = acc[ai][bj][m][1] * rs;
                    if (rope) {
                        f32x4 p0, p1;
#pragma unroll
                        for (int e = 0; e < 4; ++e) { p0[e] = __shfl_xor(v0[e], 32); p1[e] = __shfl_xor(v1[e], 32); }
                        v0 = v0 * c0 + (p0 * s0) * sgn; v1 = v1 * c1 + (p1 * s1) * sgn;
                    }
                    if (!dtt) { u32x4 w; w.x = cvt_pk_bf16(v0[0], v0[1]); w.y = cvt_pk_bf16(v0[2], v0[3]); w.z = cvt_pk_bf16(v1[0], v1[1]); w.w = cvt_pk_bf16(v1[2], v1[3]);
                        *(u32x4*)(proj + (size_t)row * LDP + u.pn * 256 + bj * 128 + wc * 32 + 8 * fq) = w; }
                    else if (bj == 0 && wc == 0) { float* d = dtraw + (size_t)row * 32 + 8 * fq; *(f32x4*)d = v0; *(f32x4*)(d + 4) = v1; }
                }
                asm volatile("" ::: "memory");
            }
    }
};

struct SchedTiles {
    const char* A; const char* Bt; int nM, nN, K, G, c;
    __device__ __forceinline__ bool next(int i, gm::Unit& u) const {
        const int L = i * G + c; if (L >= nM * nN) return false;
        int pm, pn; gm::tile_of(L, nM, nN, pm, pn);
        u.pm = pm; u.pn = pn; u.kind = 0; u.ti = 0; u.a = A + (size_t)pm * 256 * K * 2; u.b = Bt + (size_t)pn * 256 * K * 2; return true;
    }
};
struct EpiRes {
    const float* base; float* outf; bf16_t* hb; float* ss;
    __device__ __forceinline__ void operator()(const f32x4 (&acc)[2][2][4][2], const gm::Unit& u, int wr, int wc, int fr, int fq) const {
        const int row0 = u.pm * 256 + wr * 64 + fr;
#pragma unroll
        for (int ai = 0; ai < 2; ++ai)
#pragma unroll
            for (int m = 0; m < 4; ++m) {
                const int row = row0 + ai * 128 + m * 16; float q = 0.f;
#pragma unroll
                for (int bj = 0; bj < 2; ++bj) {
                    const size_t o = (size_t)row * DM + u.pn * 256 + bj * 128 + wc * 32 + 8 * fq;
                    const f32x4 v0 = acc[ai][bj][m][0] + *(const f32x4*)(base + o), v1 = acc[ai][bj][m][1] + *(const f32x4*)(base + o + 4);
                    *(f32x4*)(outf + o) = v0; *(f32x4*)(outf + o + 4) = v1;
                    u32x4 w; w.x = cvt_pk_bf16(v0[0], v0[1]); w.y = cvt_pk_bf16(v0[2], v0[3]); w.z = cvt_pk_bf16(v1[0], v1[1]); w.w = cvt_pk_bf16(v1[2], v1[3]);
                    *(u32x4*)(hb + o) = w;
                    q += (v0[0] * v0[0] + v0[1] * v0[1]) + (v0[2] * v0[2] + v0[3] * v0[3]) + (v1[0] * v1[0] + v1[1] * v1[1]) + (v1[2] * v1[2] + v1[3] * v1[3]);
                }
                q += __shfl_xor(q, 16); q += __shfl_xor(q, 32);
                if (fq == 0) ss[(size_t)row * 32 + u.pn * 4 + wc] = q;
                asm volatile("" ::: "memory");
            }
    }
};
struct SchedQKV {
    const char* A0; const char* B0; const char* A1; const char* B1; int G, c;
    __device__ __forceinline__ bool next(int i, gm::Unit& u) const {
        const int L = i * G + c; int pm, pn;
        if (L < 128) { gm::tile_of(L, 64, 2, pm, pn); u.kind = 0; u.a = A0 + (size_t)pm * 256 * DM * 2; u.b = B0 + (size_t)pn * 256 * DM * 2; }
        else if (L < 160) { gm::tile_of(L - 128, 8, 4, pm, pn); u.kind = 1; u.a = A1 + (size_t)pm * 256 * DM * 2; u.b = B1 + (size_t)pn * 256 * DM * 2; }
        else return false;
        u.pm = pm; u.pn = pn; u.ti = 0; return true;
    }
};
struct EpiScale {
    bf16_t* O0; bf16_t* O1; int ld0, ld1; const LAS float* rsl;
    __device__ __forceinline__ void operator()(const f32x4 (&acc)[2][2][4][2], const gm::Unit& u, int wr, int wc, int fr, int fq) const {
        bf16_t* O = u.kind ? O1 : O0; const int ld = u.kind ? ld1 : ld0;
#pragma unroll
        for (int ai = 0; ai < 2; ++ai)
#pragma unroll
            for (int m = 0; m < 4; ++m) {
                const int r = ai * 128 + wr * 64 + m * 16 + fr; const float rs = rsl[r];
#pragma unroll
                for (int bj = 0; bj < 2; ++bj) {
                    const f32x4 v0 = acc[ai][bj][m][0] * rs, v1 = acc[ai][bj][m][1] * rs;
                    u32x4 w; w.x = cvt_pk_bf16(v0[0], v0[1]); w.y = cvt_pk_bf16(v0[2], v0[3]); w.z = cvt_pk_bf16(v1[0], v1[1]); w.w = cvt_pk_bf16(v1[2], v1[3]);
                    *(u32x4*)(O + (size_t)(u.pm * 256 + r) * ld + u.pn * 256 + bj * 128 + wc * 32 + 8 * fq) = w;
                }
            }
    }
};

__device__ __forceinline__ void moe_tables(LAS int* mt, const int* cnt_g, int tid) {
    if (tid < 32) mt[tid] = cnt_g[tid];
    LDS_WAIT(); __syncthreads();
    if (tid == 0) { int p = 0, o = 0; for (int e = 0; e < NE; ++e) { mt[32 + e] = p; mt[65 + e] = o; const int c = mt[e]; p += 8 * ((c + 255) >> 8); o += c; } mt[32 + NE] = p; mt[65 + NE] = o; }
    LDS_WAIT(); __syncthreads();
}
template <bool GU> struct SchedMoE {
    const LAS int* mt; const char* A; const char* Bt; int G, c;
    __device__ __forceinline__ bool next(int i, gm::Unit& u) const {
        const int L = i * G + c; if (L >= mt[32 + NE]) return false;
        int e = 0;
#pragma unroll 1
        for (int k = 1; k < NE; ++k) if (L >= mt[32 + k]) e = k;
        const int rem = L - mt[32 + e], te = (mt[e] + 255) >> 8, pn = rem / te, mtile = rem - pn * te;
        u.pm = mtile; u.pn = pn; u.kind = e; u.ti = i;
        if (GU) { u.a = A; u.b = Bt + ((size_t)e * 2048 + pn * 256) * DM * 2; }
        else { u.a = A + (size_t)(mt[65 + e] + mtile * 256) * DE * 2; u.b = Bt + ((size_t)e * 2048 + pn * 256) * DE * 2; }
        return true;
    }
};
struct EpiGU {
    bf16_t* Hact; const float* rs2; const LAS int* mt; const LAS int* tab;
    __device__ __forceinline__ void operator()(const f32x4 (&acc)[2][2][4][2], const gm::Unit& u, int wr, int wc, int fr, int fq) const {
        const int e = u.kind, valid = mt[e] - u.pm * 256, slot0 = mt[65 + e] + u.pm * 256;
#pragma unroll
        for (int ai = 0; ai < 2; ++ai)
#pragma unroll
            for (int m = 0; m < 4; ++m) {
                const int r = ai * 128 + wr * 64 + m * 16 + fr;
                if (r < valid) {
                    const float rs = rs2[tab[u.ti * 256 + r]];
                    const f32x4 g0 = acc[ai][0][m][0] * rs, g1 = acc[ai][0][m][1] * rs, u0 = acc[ai][1][m][0] * rs, u1 = acc[ai][1][m][1] * rs;
                    float o[8];
#pragma unroll
                    for (int j = 0; j < 4; ++j) { o[j] = g0[j] * __builtin_amdgcn_rcpf(1.f + __expf(-g0[j])) * u0[j]; o[4 + j] = g1[j] * __builtin_amdgcn_rcpf(1.f + __expf(-g1[j])) * u1[j]; }
                    u32x4 w; w.x = cvt_pk_bf16(o[0], o[1]); w.y = cvt_pk_bf16(o[2], o[3]); w.z = cvt_pk_bf16(o[4], o[5]); w.w = cvt_pk_bf16(o[6], o[7]);
                    *(u32x4*)(Hact + (size_t)(slot0 + r) * DE + u.pn * 128 + wc * 32 + 8 * fq) = w;
                }
            }
    }
};
struct EpiDown {
    bf16_t* Y; const LAS int* mt;
    __device__ __forceinline__ void operator()(const f32x4 (&acc)[2][2][4][2], const gm::Unit& u, int wr, int wc, int fr, int fq) const {
        const int e = u.kind, valid = mt[e] - u.pm * 256, slot0 = mt[65 + e] + u.pm * 256;
#pragma unroll
        for (int ai = 0; ai < 2; ++ai)
#pragma unroll
            for (int m = 0; m < 4; ++m) {
                const int r = ai * 128 + wr * 64 + m * 16 + fr;
                if (r < valid) {
#pragma unroll
                    for (int bj = 0; bj < 2; ++bj) { const f32x4 v0 = acc[ai][bj][m][0], v1 = acc[ai][bj][m][1];
                        u32x4 w; w.x = cvt_pk_bf16(v0[0], v0[1]); w.y = cvt_pk_bf16(v0[2], v0[3]); w.z = cvt_pk_bf16(v1[0], v1[1]); w.w = cvt_pk_bf16(v1[2], v1[3]);
                        *(u32x4*)(Y + (size_t)(slot0 + r) * DM + u.pn * 256 + bj * 128 + wc * 32 + 8 * fq) = w; }
                }
            }
    }
};
__device__ __forceinline__ void final_rows(Frame& F, float* hio, const bf16_t* Y, const int* tok_e, const int* tok_pos, const float* tok_w, const float* fw, const LAS int* mt) {
    const int gw = F.vcu * NWAVES + F.wave, NGW = F.G * NWAVES, lane = F.lane;
    for (int t = gw; t < M; t += NGW) {
        const int e1 = tok_e[2 * t], e2 = tok_e[2 * t + 1];
        const size_t s1 = (size_t)(mt[65 + e1] + tok_pos[2 * t]), s2 = (size_t)(mt[65 + e2] + tok_pos[2 * t + 1]);
        const float w1 = tok_w[2 * t], w2 = tok_w[2 * t + 1];
        f32x4* hr = (f32x4*)(hio + (size_t)t * DM) + 2 * lane;
        const u32x4* y1 = (const u32x4*)(Y + s1 * DM) + lane; const u32x4* y2 = (const u32x4*)(Y + s2 * DM) + lane;
        float v[4][8]; float ss = 0.f;
#pragma unroll
        for (int j = 0; j < 4; ++j) {
            const f32x4 a0 = hr[128 * j], a1 = hr[128 * j + 1]; const u32x4 p = y1[64 * j], q = y2[64 * j];
            const float pa[8] = {bflo(p.x), bfhi(p.x), bflo(p.y), bfhi(p.y), bflo(p.z), bfhi(p.z), bflo(p.w), bfhi(p.w)};
            const float qa[8] = {bflo(q.x), bfhi(q.x), bflo(q.y), bfhi(q.y), bflo(q.z), bfhi(q.z), bflo(q.w), bfhi(q.w)};
            const float ha[8] = {a0[0], a0[1], a0[2], a0[3], a1[0], a1[1], a1[2], a1[3]};
#pragma unroll
            for (int k = 0; k < 8; ++k) { v[j][k] = ha[k] + (w1 * pa[k] + w2 * qa[k]); ss += v[j][k] * v[j][k]; }
        }
        ss = wave_sum(ss);
        const float rs = rsqrtf(ss * (1.f / DM) + EPS);
#pragma unroll
        for (int j = 0; j < 4; ++j) {
            const f32x4 g0 = *((const f32x4*)fw + 2 * lane + 128 * j), g1 = *((const f32x4*)fw + 2 * lane + 128 * j + 1);
            hr[128 * j] = (f32x4){v[j][0] * rs * g0[0], v[j][1] * rs * g0[1], v[j][2] * rs * g0[2], v[j][3] * rs * g0[3]};
            hr[128 * j + 1] = (f32x4){v[j][4] * rs * g1[0], v[j][5] * rs * g1[1], v[j][6] * rs * g1[2], v[j][7] * rs * g1[3]};
        }
    }
}

__device__ __forceinline__ void kmean_simple(Frame& F, const bf16_t* proj, float* kmean) {
    for (int gid = F.vcu * NWAVES * 64 + F.tid; gid < BATCH * NB * 1024; gid += F.G * NWAVES * 64) {
        const int col = gid & 1023, bb = gid >> 10; const bf16_t* p = proj + (size_t)bb * MB * LDP + C_K + col; float s = 0.f;
        for (int t = 0; t < MB; ++t) s += bf2f(p[(size_t)t * LDP]);
        kmean[gid] = s * (1.f / MB);
    }
}
__device__ __forceinline__ void ssd_simple(Frame& F, int b, int h, const bf16_t* proj, const float* dtraw, const float* conv_w, const float* conv_b,
                                           const float* dt_bias, const float* a_log, const float* d_skip, float* yg) {
    constexpr int T = 16;
    LAS float* xs = (LAS float*)(F.lds + RING_OFF); LAS float* Bs = xs + T * 64; LAS float* Cs = Bs + T * 128; LAS float* dts = Cs + T * 128;
    const int g = h / (SH / SG), tid = F.tid, p = (tid >> 2) & 63, nq = tid & 3;
    const float a = -__expf(a_log[h]), dtb = dt_bias[h], Dh = d_skip[h];
    float st[32];
#pragma unroll
    for (int i = 0; i < 32; ++i) st[i] = 0.f;
    for (int t0 = 0; t0 < SEQ; t0 += T) {
        __syncthreads();
        for (int idx = tid; idx < T * 320; idx += NWAVES * 64) {
            const int tt = idx / 320, c = idx % 320, t = t0 + tt;
            int ch; if (c < 64) ch = h * 64 + c; else if (c < 192) ch = 2048 + g * 128 + (c - 64); else ch = 2560 + g * 128 + (c - 192);
            float v = conv_b[ch];
#pragma unroll
            for (int i = 0; i < SCONV; ++i) { const int ts = t - 3 + i; if (ts >= 0) v += conv_w[i * CONVD + ch] * bf2f(proj[(size_t)(b * SEQ + ts) * LDP + C_XBC + ch]); }
            v = silu_f(v);
            if (c < 64) xs[tt * 64 + c] = v; else if (c < 192) Bs[tt * 128 + c - 64] = v; else Cs[tt * 128 + c - 192] = v;
        }
        if (tid < T) { const float r = dtraw[(size_t)(b * SEQ + t0 + tid) * 32 + h] + dtb; dts[tid] = fmaxf(r, 0.f) + log1pf(__expf(-fabsf(r))); }
        __syncthreads();
        if (tid < 256) {
            for (int tt = 0; tt < T; ++tt) {
                const float dt = dts[tt], dA = __expf(dt * a), xv = xs[tt * 64 + p], xdt = xv * dt;
                float y = 0.f;
                const LAS f32x4* B4 = (const LAS f32x4*)(Bs + tt * 128 + nq * 32); const LAS f32x4* C4 = (const LAS f32x4*)(Cs + tt * 128 + nq * 32);
#pragma unroll
                for (int i = 0; i < 8; ++i) { const f32x4 bv = B4[i], cv = C4[i];
#pragma unroll
                    for (int e = 0; e < 4; ++e) { st[4 * i + e] = st[4 * i + e] * dA + xdt * bv[e]; y += cv[e] * st[4 * i + e]; } }
                y += __shfl_xor(y, 1); y += __shfl_xor(y, 2);
                if (nq == 0) { const size_t tok = (size_t)(b * SEQ + t0 + tt); const float z = bf2f(proj[tok * LDP + C_Z + h * 64 + p]); yg[tok * SW + h * 64 + p] = (y + xv * Dh) * silu_f(z); }
            }
        }
    }
    __syncthreads();
}
__device__ __forceinline__ void gnorm_simple(Frame& F, const float* yg, bf16_t* mixb) {
    const int gw = F.vcu * NWAVES + F.wave, NGW = F.G * NWAVES, lane = F.lane;
    for (int it = gw; it < M * SG; it += NGW) {
        const int g = it & 3; const size_t tok = it >> 2; const float* p = yg + tok * SW + g * 512;
        float v[8]; float s = 0.f;
#pragma unroll
        for (int i = 0; i < 8; ++i) { v[i] = p[lane + 64 * i]; s += v[i] * v[i]; }
        s = wave_sum(s); const float rs = rsqrtf(s * (1.f / 512.f) + EPS);
        bf16_t* o = mixb + tok * MIXW + AW + g * 512;
#pragma unroll
        for (int i = 0; i < 8; ++i) o[lane + 64 * i] = (bf16_t)(cvt_pk_bf16(v[i] * rs, 0.f) & 0xffffu);
    }
}
__device__ __forceinline__ void moba_simple(Frame& F, const bf16_t* proj, const float* kmean, bf16_t* mixb) {
    const int gw = F.vcu * NWAVES + F.wave, NGW = F.G * NWAVES, lane = F.lane;
    LAS float* qs = (LAS float*)(F.lds + RING_OFF) + F.wave * 1280; LAS float* sc = qs + 128;
    for (int it = gw; it < M * AH; it += NGW) {
        const int h = it & 7, tok = it >> 3, b = tok / SEQ, s = tok % SEQ, j = s / MB;
        const bf16_t* qp = proj + (size_t)tok * LDP + C_Q + h * HD;
        const float q0 = bf2f(qp[lane]), q1 = bf2f(qp[lane + 64]);
        LDS_WAIT(); qs[lane] = q0; qs[lane + 64] = q1;
        float gate[NB];
#pragma unroll
        for (int kb = 0; kb < NB; ++kb) { float g = -INFINITY;
            if (kb < j) { const float* km = kmean + (size_t)(b * NB + kb) * 1024 + h * HD; g = wave_sum(q0 * km[lane] + q1 * km[lane + 64]); }
            gate[kb] = g; }
        unsigned selmask = 0;
#pragma unroll
        for (int r = 0; r < 3; ++r) { float best = -INFINITY; int bi = -1;
#pragma unroll
            for (int kb = 0; kb < NB; ++kb) { const bool ok = (kb < j) && !((selmask >> kb) & 1u) && (gate[kb] > best || bi < 0); if (ok) { best = gate[kb]; bi = kb; } }
            if (bi >= 0) selmask |= 1u << bi; }
        LDS_WAIT();
        const float scale = 0.08838834764831845f; int nslot = 0; float mx = -INFINITY;
        for (int kb = 0; kb <= j; ++kb) {
            const bool own = (kb == j); if (!own && !((selmask >> kb) & 1u)) continue;
#pragma unroll 1
            for (int i = 0; i < 4; ++i) { const int kl = lane + 64 * i, key = kb * MB + kl; const bf16_t* kp = proj + (size_t)(b * SEQ + key) * LDP + C_K + h * HD; float d = 0.f;
#pragma unroll 4
                for (int dd = 0; dd < 128; dd += 8) { float kv[8]; ld8bf(kp + dd, kv);
#pragma unroll
                    for (int e = 0; e < 8; ++e) d += qs[dd + e] * kv[e]; }
                d *= scale; if (own && key > s) d = -INFINITY; sc[nslot * 256 + kl] = d; mx = fmaxf(mx, d); }
            ++nslot; }
        mx = wave_max(mx); float sum = 0.f; LDS_WAIT();
        for (int i = lane; i < nslot * 256; i += 64) { const float e = __expf(sc[i] - mx); sc[i] = e; sum += e; }
        sum = wave_sum(sum); LDS_WAIT();
        float o0 = 0.f, o1 = 0.f; int slot = 0;
        for (int kb = 0; kb <= j; ++kb) {
            const bool own = (kb == j); if (!own && !((selmask >> kb) & 1u)) continue;
            const bf16_t* vp = proj + (size_t)(b * SEQ + kb * MB) * LDP + C_V + h * HD; const int lim = own ? (s - kb * MB + 1) : MB;
#pragma unroll 4
            for (int kl = 0; kl < lim; ++kl) { const float pr = sc[slot * 256 + kl]; o0 += pr * bf2f(vp[(size_t)kl * LDP + lane]); o1 += pr * bf2f(vp[(size_t)kl * LDP + lane + 64]); }
            ++slot; }
        const float inv = 1.f / sum; o0 *= inv; o1 *= inv;
        const float rs = rsqrtf(wave_sum(o0 * o0 + o1 * o1) * (1.f / HD) + EPS);
        bf16_t* mp = mixb + (size_t)tok * MIXW + h * HD;
        mp[lane] = (bf16_t)(cvt_pk_bf16(o0 * rs, 0.f) & 0xffffu); mp[lane + 64] = (bf16_t)(cvt_pk_bf16(o1 * rs, 0.f) & 0xffffu);
    }
}
__device__ __forceinline__ void xattn_simple(Frame& F, const bf16_t* qc, const bf16_t* kvc, bf16_t* oc) {
    const int gw = F.vcu * NWAVES + F.wave, NGW = F.G * NWAVES, lane = F.lane;
    LAS float* qs = (LAS float*)(F.lds + RING_OFF) + F.wave * 384; LAS float* sc = qs + 128;
    for (int it = gw; it < M * CH; it += NGW) {
        const int h = it & 3, tok = it >> 2, b = tok / SEQ;
        const bf16_t* qp = qc + (size_t)tok * CW + h * CHD;
        LDS_WAIT(); qs[lane] = bf2f(qp[lane]); qs[lane + 64] = bf2f(qp[lane + 64]); LDS_WAIT();
        const float scale = 0.08838834764831845f; float mx = -INFINITY;
#pragma unroll 1
        for (int i = 0; i < 4; ++i) { const int m = lane + 64 * i; const bf16_t* kp = kvc + (size_t)(b * MEM + m) * (2 * CW) + h * CHD; float d = 0.f;
#pragma unroll 4
            for (int dd = 0; dd < 128; dd += 8) { float kv[8]; ld8bf(kp + dd, kv);
#pragma unroll
                for (int e = 0; e < 8; ++e) d += qs[dd + e] * kv[e]; }
            d *= scale; sc[m] = d; mx = fmaxf(mx, d); }
        mx = wave_max(mx); float sum = 0.f; LDS_WAIT();
#pragma unroll
        for (int i = 0; i < 4; ++i) { const int m = lane + 64 * i; const float e = __expf(sc[m] - mx); sc[m] = e; sum += e; }
        sum = wave_sum(sum); LDS_WAIT();
        float o0 = 0.f, o1 = 0.f; const bf16_t* vp = kvc + (size_t)(b * MEM) * (2 * CW) + CW + h * CHD;
#pragma unroll 4
        for (int m = 0; m < MEM; ++m) { const float pr = sc[m]; o0 += pr * bf2f(vp[(size_t)m * (2 * CW) + lane]); o1 += pr * bf2f(vp[(size_t)m * (2 * CW) + lane + 64]); }
        const float inv = 1.f / sum; bf16_t* op = oc + (size_t)tok * CW + h * CHD;
        op[lane] = (bf16_t)(cvt_pk_bf16(o0 * inv, 0.f) & 0xffffu); op[lane + 64] = (bf16_t)(cvt_pk_bf16(o1 * inv, 0.f) & 0xffffu);
    }
}
__device__ __forceinline__ void router_rows(Frame& F, const float* h2, const float* wr, const float* b_rg, const float* b_re, float* rs2, int* cnt, int* list, int* tok_e, int* tok_pos, float* tok_w) {
    const int gw = F.vcu * NWAVES + F.wave, NGW = F.G * NWAVES, lane = F.lane;
    LAS float* lgl = (LAS float*)(F.lds + RING_OFF) + F.wave * 64;
    for (int t = gw; t < M; t += NGW) {
        const f32x4* hr = (const f32x4*)(h2 + (size_t)t * DM) + lane;
        f32x4 v[8]; float ss = 0.f;
#pragma unroll
        for (int j = 0; j < 8; ++j) { v[j] = hr[64 * j]; ss += (v[j][0] * v[j][0] + v[j][1] * v[j][1]) + (v[j][2] * v[j][2] + v[j][3] * v[j][3]); }
        ss = wave_sum(ss); const float rs = rsqrtf(ss * (1.f / DM) + EPS);
        LDS_WAIT();
#pragma unroll 1
        for (int n = 0; n < 36; ++n) { const f32x4* w = (const f32x4*)(wr + (size_t)n * DM) + lane; float d = 0.f;
#pragma unroll
            for (int j = 0; j < 8; ++j) { const f32x4 ww = w[64 * j]; d += (v[j][0] * ww[0] + v[j][1] * ww[1]) + (v[j][2] * ww[2] + v[j][3] * ww[3]); }
            d = wave_sum(d) * rs; if (lane == 0) lgl[n] = d; }
        LDS_WAIT();
        float gm_ = -INFINITY; int gi = 0; float g[4];
#pragma unroll
        for (int i = 0; i < 4; ++i) { g[i] = lgl[i] + b_rg[i]; if (g[i] > gm_) { gm_ = g[i]; gi = i; } }
        float gs = 0.f;
#pragma unroll
        for (int i = 0; i < 4; ++i) gs += __expf(g[i] - gm_);
        const float gwt = 1.f / gs;
        float e1 = -INFINITY, e2 = -INFINITY; int i1 = 0, i2 = 0;
#pragma unroll
        for (int i = 0; i < 8; ++i) { const float vv = lgl[4 + gi * 8 + i] + b_re[gi * 8 + i]; if (vv > e1) { e2 = e1; i2 = i1; e1 = vv; i1 = i; } else if (vv > e2) { e2 = vv; i2 = i; } }
        const float p2 = 1.f / (1.f + __expf(e1 - e2)), p1 = 1.f - p2;
        const int ea = gi * 8 + i1, eb = gi * 8 + i2;
        if (lane == 0) {
            const int pa = atomicAdd(&cnt[ea], 1), pb = atomicAdd(&cnt[eb], 1);
            list[ea * M + pa] = t; list[eb * M + pb] = t;
            tok_e[t * 2] = ea; tok_e[t * 2 + 1] = eb; tok_pos[t * 2] = pa; tok_pos[t * 2 + 1] = pb; tok_w[t * 2] = gwt * p1; tok_w[t * 2 + 1] = gwt * p2; rs2[t] = rs;
        }
    }
}

__global__ void __launch_bounds__(NWAVES * 64, 2) fwd(Args args) {
    extern __shared__ __attribute__((aligned(16))) unsigned char lds_raw[];
    Frame F;
    F.lds = (LAS unsigned char*)lds_raw;
    F.MISC = (volatile LAS unsigned*)(F.lds + MISC_OFF);
    F.tid = threadIdx.x; F.lane = F.tid & 63; F.wave = __builtin_amdgcn_readfirstlane(F.tid >> 6);
    F.G = gridDim.x; { const int bx = blockIdx.x; F.vcu = (F.G % 8 == 0) ? (bx % 8) * (F.G / 8) + bx / 8 : bx; }
    for (int u = F.tid; u < (LDS_BYTES - LDSCTL_OFF) / 4; u += NWAVES * 64) ((LAS unsigned*)(F.lds + LDSCTL_OFF))[u] = 0u;
    __syncthreads();
    (void)xcd_barrier_post((unsigned*)(args.ws + WS_CTL) + CW_BAR + args.li * XCD_BAR_WORDS, F.MISC + 8);
#define GRID_BAR() do { GAS unsigned char* wb_ = (GAS unsigned char*)args.ws; asm volatile("" : "+s"(wb_)); XcdBarrier b_; \
        b_.bar = (unsigned*)((unsigned char*)wb_ + WS_CTL) + CW_BAR + args.li * XCD_BAR_WORDS; b_.x = xb_xcc_id(); b_.st = F.MISC + 8; xcd_barrier(b_, F.wave * 64 + lane_id_now()); } while (0)
    const int lo = args.ph_lo, hi = args.ph_hi;
#define IN(k) (lo <= (k) && (k) < hi)
#define BOTH(k) (IN(k) && IN((k) + 1))
#define PHASE_WS() F.lane = lane_id_now(); F.tid = F.wave * 64 + F.lane; GAS unsigned char* wsg_ = (GAS unsigned char*)args.ws; asm volatile("" : "+s"(wsg_)); unsigned char* ws = (unsigned char*)wsg_
    if (IN(0)) { F.lane = lane_id_now(); F.tid = F.wave * 64 + F.lane; p0_prologue(F, args); if (BOTH(0)) GRID_BAR(); }
    if (IN(1)) {
        PHASE_WS();
        SchedG1 S{(const char*)(ws + WS_XB), (const char*)(ws + WS_WIN_T), F.G, (int)blockIdx.x};
        EpiG1 E{(bf16_t*)(ws + WS_PROJ), (float*)(ws + WS_DTRAW), (const float*)(ws + WS_RSX), (const float*)(ws + WS_ROPE)};
        gm::gemm_phase<EpiG1, SchedG1, false>(F.tid, F.lds + RING_OFF, (const LAS int*)(F.lds + TAB_OFF), DM, S, E);
        if (BOTH(1)) GRID_BAR();
    }
    if (IN(2)) {
        PHASE_WS();
        kmean_simple(F, (const bf16_t*)(ws + WS_PROJ), (float*)(ws + WS_KMEAN));
        for (int L = F.vcu; L < BATCH * SH; L += F.G)
            ssd_simple(F, L / SH, L % SH, (const bf16_t*)(ws + WS_PROJ), (const float*)(ws + WS_DTRAW), args.in[4], args.in[5], args.in[6], args.in[7], args.in[8], args.out);
        if (BOTH(2)) GRID_BAR();
    }
    if (IN(3)) {
        PHASE_WS();
        for (int L = F.vcu; L < BATCH * AH * 4; L += F.G) {
            const int b = L >> 5, h = (L >> 2) & 7, pi = L & 3;
            const bf16_t* pb = (const bf16_t*)(ws + WS_PROJ) + (size_t)b * SEQ * LDP + h * HD;
#pragma unroll 1
            for (int k = 0; k < 2; ++k) { const int jb = k ? pi : 7 - pi;
                at::attn_unit<true>(F.tid, pb + (size_t)jb * MB * LDP + C_Q, pb + C_K, (bf16_t*)(ws + WS_MIXB) + (size_t)(b * SEQ + jb * MB) * MIXW + h * HD,
                                    4 * (jb + 1), jb, (const float*)(ws + WS_KMEAN) + (size_t)b * NB * 1024 + h * HD, (LAS char*)(F.lds + RING_OFF)); }
        }
        __syncthreads();
        gnorm_simple(F, args.out, (bf16_t*)(ws + WS_MIXB));
        if (BOTH(3)) GRID_BAR();
    }
    if (IN(4)) {
        PHASE_WS();
        SchedTiles S{(const char*)(ws + WS_MIXB), (const char*)(ws + WS_WOUT_T), 64, 8, MIXW, F.G, (int)blockIdx.x};
        EpiRes E{args.in[0], args.out, (bf16_t*)(ws + WS_XB), (float*)(ws + WS_SS)};
        gm::gemm_phase<EpiRes, SchedTiles, false>(F.tid, F.lds + RING_OFF, (const LAS int*)(F.lds + TAB_OFF), MIXW, S, E);
        if (BOTH(4)) GRID_BAR();
    }
    if (IN(5)) {
        PHASE_WS();
        SchedQKV S{(const char*)(ws + WS_XB), (const char*)(ws + WS_WCQ_T), (const char*)(ws + WS_MEMB), (const char*)(ws + WS_WCKV_T), F.G, (int)blockIdx.x};
        gm::Unit u0; LAS float* rsl = (LAS float*)(F.lds + RSL_OFF);
        if (S.next(0, u0) && F.tid < 256) {
            const int row = u0.pm * 256 + F.tid;
            if (u0.kind == 0) { const f32x4* p = (const f32x4*)((const float*)(ws + WS_SS) + (size_t)row * 32); float q = 0.f;
#pragma unroll
                for (int j = 0; j < 8; ++j) { const f32x4 v = p[j]; q += (v[0] + v[1]) + (v[2] + v[3]); }
                rsl[F.tid] = rsqrtf(q * (1.f / DM) + EPS); }
            else rsl[F.tid] = ((const float*)(ws + WS_RSMEM))[row];
        }
        VM_WAIT(); LDS_WAIT(); __syncthreads();
        EpiScale E{(bf16_t*)(ws + WS_QC), (bf16_t*)(ws + WS_KVC), CW, 2 * CW, rsl};
        gm::gemm_phase<EpiScale, SchedQKV, false>(F.tid, F.lds + RING_OFF, (const LAS int*)(F.lds + TAB_OFF), DM, S, E);
        if (BOTH(5)) GRID_BAR();
    }
    if (IN(6)) {
        PHASE_WS();
        for (int L = F.vcu; L < BATCH * CH * 8; L += F.G) {
            const int b = L >> 5, h = (L >> 3) & 3, qt = L & 7;
            const bf16_t* kb_ = (const bf16_t*)(ws + WS_KVC) + (size_t)b * MEM * (2 * CW) + h * CHD;
            at::attn_unit<false>(F.tid, (const bf16_t*)(ws + WS_QC) + (size_t)(b * SEQ + qt * 256) * CW + h * CHD, kb_,
                                 (bf16_t*)(ws + WS_OC) + (size_t)(b * SEQ + qt * 256) * CW + h * CHD, 4, 0, nullptr, (LAS char*)(F.lds + RING_OFF));
        }
        __syncthreads();
        if (BOTH(6)) GRID_BAR();
    }
    if (IN(7)) {
        PHASE_WS();
        SchedTiles S{(const char*)(ws + WS_OC), (const char*)(ws + WS_WCO_T), 64, 8, CW, F.G, (int)blockIdx.x};
        EpiRes E{args.out, args.out, (bf16_t*)(ws + WS_XB), (float*)(ws + WS_SS) + (size_t)M * 32};
        gm::gemm_phase<EpiRes, SchedTiles, false>(F.tid, F.lds + RING_OFF, (const LAS int*)(F.lds + TAB_OFF), CW, S, E);
        if (BOTH(7)) GRID_BAR();
    }
    if (IN(8)) {
        PHASE_WS();
        int* tok_e = (int*)(ws + WS_TOK);
        router_rows(F, args.out, (const float*)(ws + WS_WR), args.in[20], args.in[22], (float*)(ws + WS_RS2), (int*)(ws + WS_CTL) + CW_CNT, (int*)(ws + WS_LIST), tok_e, tok_e + 2 * M, (float*)(tok_e + 4 * M));
        if (BOTH(8)) GRID_BAR();
    }
    if (IN(9)) {
        PHASE_WS();
        LAS int* mt = (LAS int*)(F.lds + MOE_OFF); LAS int* tab = (LAS int*)(F.lds + TAB_OFF);
        moe_tables(mt, (const int*)(ws + WS_CTL) + CW_CNT, F.tid);
        SchedMoE<true> S{mt, (const char*)(ws + WS_XB), (const char*)(ws + WS_WGU_T), F.G, F.vcu};
        { const int* list = (const int*)(ws + WS_LIST); gm::Unit u;
          for (int i = 0; i < 8 && S.next(i, u); ++i) if (F.tid < 256) { const int rg = u.pm * 256 + F.tid; tab[i * 256 + F.tid] = list[u.kind * M + (rg < mt[u.kind] ? rg : 0)]; } }
        VM_WAIT(); LDS_WAIT(); __syncthreads();
        EpiGU E{(bf16_t*)(ws + WS_HACT), (const float*)(ws + WS_RS2), mt, tab};
        gm::gemm_phase<EpiGU, SchedMoE<true>, true>(F.tid, F.lds + RING_OFF, tab, DM, S, E);
        if (BOTH(9)) GRID_BAR();
    }
    if (IN(10)) {
        PHASE_WS();
        LAS int* mt = (LAS int*)(F.lds + MOE_OFF);
        moe_tables(mt, (const int*)(ws + WS_CTL) + CW_CNT, F.tid);
        SchedMoE<false> S{mt, (const char*)(ws + WS_HACT), (const char*)(ws + WS_WD_T), F.G, F.vcu};
        EpiDown E{(bf16_t*)(ws + WS_Y), mt};
        gm::gemm_phase<EpiDown, SchedMoE<false>, false>(F.tid, F.lds + RING_OFF, (const LAS int*)(F.lds + TAB_OFF), DE, S, E);
        if (BOTH(10)) GRID_BAR();
    }
    if (IN(11)) {
        PHASE_WS();
        LAS int* mt = (LAS int*)(F.lds + MOE_OFF);
        moe_tables(mt, (const int*)(ws + WS_CTL) + CW_CNT, F.tid);
        const int* tok_e = (const int*)(ws + WS_TOK);
        final_rows(F, args.out, (const bf16_t*)(ws + WS_Y), tok_e, tok_e + 2 * M, (const float*)(tok_e + 4 * M), args.in[26], mt);
    }
#undef IN
#undef BOTH
}
extern "C" void kernel_launch(void* const* d_in, const int* in_sizes, int n_in, void* d_out, int out_size, void* d_ws, size_t ws_size, hipStream_t stream) {
  static int grid = 0;
  static float rfv[16];
  if (grid == 0) {
    int dev = 0, cus = 0;
    if (hipGetDevice(&dev) != hipSuccess || hipDeviceGetAttribute(&cus, hipDeviceAttributeMultiprocessorCount, dev) != hipSuccess) { fprintf(stderr, "kernel_launch: device query failed\n"); grid = -1; return; }
    if (hipFuncSetAttribute((const void*)fwd, hipFuncAttributeMaxDynamicSharedMemorySize, LDS_BYTES) != hipSuccess) { fprintf(stderr, "kernel_launch: hipFuncSetAttribute failed\n"); grid = -1; return; }
    int per_cu = 0;
    if (hipOccupancyMaxActiveBlocksPerMultiprocessor(&per_cu, (const void*)fwd, NWAVES * 64, LDS_BYTES) != hipSuccess || per_cu < 1) fprintf(stderr, "kernel_launch: occupancy query says %d\n", per_cu);
    (void)hipGetLastError();
    for (int i = 0; i < 16; ++i) rfv[i] = (float)pow(500000.0, -(double)i / 16.0);
    grid = cus;
  }
  if (grid < 0) return;
  float* out = (float*)d_out;
  unsigned char* ws = (unsigned char*)d_ws;
  (void)hipMemsetAsync(ws + WS_CTL, 0, CTL_ZERO_BYTES, stream);
  Args a{};
  for (int i = 0; i < 27; ++i) a.in[i] = (const float*)d_in[i];
  a.out = out; a.ws = ws; for (int i = 0; i < 16; ++i) a.rf[i] = rfv[i];
  a.ph_lo = 0; a.ph_hi = 12; a.li = 0;
  hipLaunchKernelGGL(fwd, dim3(grid), dim3(NWAVES * 64), LDS_BYTES, stream, a);
}
```

```cpp
#include <hip/hip_runtime.h>
#include <stdint.h>
#include <math.h>
#include <cstdio>

constexpr int DM = 2048, BATCH = 8, SEQ = 2048, M = BATCH * SEQ, MEM = 256, MROWS = BATCH * MEM;
constexpr float EPS = 1e-6f;
constexpr int AH = 8, HD = 128, AW = 1024;
constexpr int MB = 256, NB = SEQ / MB;
constexpr int SW = 2048, SH = 32, SG = 4, SCONV = 4, CONVD = 3072;
constexpr int MIXW = 3072, INW = 8224, LDP = 8448;
constexpr int C_Q = 0, C_K = 1024, C_V = 2048, C_Z = 3072, C_XBC = 5120, C_DT = 8192;
constexpr int CH = 4, CHD = 128, CW = 512;
constexpr int NG = 4, EPG = 8, NE = 32, DE = 1024;

#define LAS __attribute__((address_space(3)))
#define GAS __attribute__((address_space(1)))
typedef unsigned short bf16_t;
typedef short bf16x8 __attribute__((ext_vector_type(8)));
typedef float f32x4 __attribute__((ext_vector_type(4)));
typedef float f32x2 __attribute__((ext_vector_type(2)));
typedef unsigned u32x4 __attribute__((ext_vector_type(4)));
typedef unsigned u32x2 __attribute__((ext_vector_type(2)));
#define LDS_WAIT() asm volatile("s_waitcnt lgkmcnt(0)" ::: "memory")
#define VM_WAIT() asm volatile("s_waitcnt vmcnt(0)" ::: "memory")

__device__ __forceinline__ unsigned cvt_pk_bf16(float lo, float hi) { unsigned r; asm volatile("v_cvt_pk_bf16_f32 %0, %1, %2" : "=v"(r) : "v"(lo), "v"(hi)); return r; }
__device__ __forceinline__ float bf2f(bf16_t b) { return __uint_as_float(((unsigned)b) << 16); }
__device__ __forceinline__ float bflo(unsigned w) { return __uint_as_float(w << 16); }
__device__ __forceinline__ float bfhi(unsigned w) { return __uint_as_float(w & 0xffff0000u); }
__device__ __forceinline__ void ld8bf(const bf16_t* p, float (&o)[8]) { const u32x4 w = *(const u32x4*)p; o[0] = bflo(w.x); o[1] = bfhi(w.x); o[2] = bflo(w.y); o[3] = bfhi(w.y); o[4] = bflo(w.z); o[5] = bfhi(w.z); o[6] = bflo(w.w); o[7] = bfhi(w.w); }
__device__ __forceinline__ float wave_sum(float v) {
#pragma unroll
  for (int o = 1; o < 64; o <<= 1) v += __shfl_xor(v, o);
  return v;
}
__device__ __forceinline__ float wave_max(float v) {
#pragma unroll
  for (int o = 1; o < 64; o <<= 1) v = fmaxf(v, __shfl_xor(v, o));
  return v;
}
__device__ __forceinline__ int lane_id_now() { int l; asm volatile("v_mbcnt_lo_u32_b32 %0, -1, 0\n\tv_mbcnt_hi_u32_b32 %0, -1, %0" : "=v"(l)); return l; }
__device__ __forceinline__ float silu_f(float x) { return x / (1.f + __expf(-x)); }

constexpr size_t MiB = 1u << 20;
constexpr size_t WS_CTL = 0, CTL_ZERO_BYTES = 1 * MiB;
constexpr int CW_BAR = 4096;
constexpr int CW_CNT = 65536;
constexpr size_t WS_WIN_T = 1 * MiB;
constexpr size_t WS_WOUT_T = 34 * MiB;
constexpr size_t WS_WCQ_T = 46 * MiB;
constexpr size_t WS_WCKV_T = 48 * MiB;
constexpr size_t WS_WCO_T = 52 * MiB;
constexpr size_t WS_WR = 54 * MiB;
constexpr size_t WS_SMALL = 55 * MiB;
constexpr size_t WS_ROPE = WS_SMALL, WS_RSX = WS_SMALL + 256 * 1024, WS_RSMEM = WS_RSX + 64 * 1024, WS_RS2 = WS_RSMEM + 64 * 1024, WS_KMEAN = WS_RS2 + 64 * 1024;
constexpr size_t WS_DTRAW = 56 * MiB;
constexpr size_t WS_SS = 58 * MiB;
constexpr size_t WS_MEMB = 62 * MiB;
constexpr size_t WS_XB = 70 * MiB;
constexpr size_t WS_PROJ = 134 * MiB;
constexpr size_t WS_MIXB = 398 * MiB;
constexpr size_t WS_QC = 494 * MiB, WS_OC = 510 * MiB;
constexpr size_t WS_KVC = 526 * MiB;
constexpr size_t WS_WGU_T = 530 * MiB;
constexpr size_t WS_WD_T = 786 * MiB;
constexpr size_t WS_LIST = 914 * MiB;
constexpr size_t WS_TOK = 916 * MiB;
constexpr size_t WS_HACT = WS_PROJ;
constexpr size_t WS_Y = WS_PROJ + 66 * MiB;
constexpr size_t WS_AFTER = 917 * MiB;
#define XB_TMO      128
#define XB_XCNT(j)  (256  + 64 * (j))
#define XB_XSUB(j)  (1280 + 64 * (j))
#define XB_XGEN(j)  (2304 + 64 * (j))
#define XB_TOP      3328
#define XB_TOPGEN   3392
#define XCD_BAR_WORDS 3456
#define XB_SPIN_CAP (1u << 18)

__device__ __forceinline__ unsigned xb_ld(unsigned* p)              { return __hip_atomic_load(p, __ATOMIC_RELAXED, __HIP_MEMORY_SCOPE_AGENT); }
__device__ __forceinline__ unsigned xb_add(unsigned* p, unsigned v) { return __hip_atomic_fetch_add(p, v, __ATOMIC_RELAXED, __HIP_MEMORY_SCOPE_AGENT); }
__device__ __forceinline__ unsigned xb_xcc_id() { return (unsigned)__builtin_amdgcn_s_getreg((3 << 11) | 20) & 0xFu; }
#define XB_SPIN(cond, bar) do { unsigned _sp = 0; while (cond) { __builtin_amdgcn_s_sleep(1); \
    if ((++_sp & 255u) == 0u) { if (xb_ld(&(bar)[XB_TMO])) break; if (_sp > XB_SPIN_CAP) { atomicAdd(&(bar)[XB_TMO], 1u); break; } } } } while (0)

struct XcdBarrier {
    unsigned* bar; unsigned x;
    volatile LAS unsigned* st;
};

__device__ __forceinline__ XcdBarrier xcd_barrier_post(unsigned* bar, volatile LAS unsigned* st) {
    XcdBarrier b; b.bar = bar; b.x = xb_xcc_id(); b.st = st;
    if (threadIdx.x == 0) (void)xb_add(&bar[XB_XCNT(b.x)], 1u);
    return b;
}
__device__ __forceinline__ void xcd_barrier_complete(unsigned* bar, unsigned x, unsigned& nloc, unsigned& nx) {
    const unsigned G = gridDim.x * gridDim.y * gridDim.z;
    unsigned sum, cnt, mine, sp = 0u;
    for (;;) {
        sum = 0u; cnt = 0u; mine = 0u;
#pragma unroll
        for (unsigned j = 0; j < 16; ++j) { const unsigned c = xb_ld(&bar[XB_XCNT(j)]); sum += c; cnt += (c > 0u) ? 1u : 0u; mine = (j == x) ? c : mine; }
        if (sum == G) break;
        __builtin_amdgcn_s_sleep(1);
        if ((++sp & 255u) == 0u) { if (xb_ld(&bar[XB_TMO])) break; if (sp > XB_SPIN_CAP) { atomicAdd(&bar[XB_TMO], 1u); break; } }
    }
    nloc = mine > 0u ? mine : 1u; nx = cnt > 0u ? cnt : 1u;
}

__device__ __forceinline__ void xcd_barrier(const XcdBarrier& b, const int xb_tid) {
    asm volatile("s_waitcnt vmcnt(0)" ::: "memory");
    __syncthreads();
    if (xb_tid == 0) {
        unsigned* bar = b.bar;
        __builtin_amdgcn_s_waitcnt(0);
        unsigned nloc = b.st[0], nx = b.st[1];
        if (nloc == 0u) { xcd_barrier_complete(bar, b.x, nloc, nx); b.st[0] = nloc; b.st[1] = nx; }
        const unsigned old = xb_add(&bar[XB_XSUB(b.x)], 1u);
        const unsigned gen = old / nloc;
        if (old + 1u == (gen + 1u) * nloc) {
            __builtin_amdgcn_fence(__ATOMIC_RELEASE, "agent");
            asm volatile("s_waitcnt vmcnt(0)" ::: "memory");
            const unsigned og = xb_add(&bar[XB_TOP], 1u);
            const unsigned tg = og / nx;
            if (og + 1u == (tg + 1u) * nx) xb_add(&bar[XB_TOPGEN], 1u);
            else XB_SPIN(xb_ld(&bar[XB_TOPGEN]) == tg, bar);
            __builtin_amdgcn_fence(__ATOMIC_ACQUIRE, "agent");
            xb_add(&bar[XB_XGEN(b.x)], 1u);
            asm volatile("s_waitcnt vmcnt(0)" ::: "memory");
        } else {
            XB_SPIN(xb_ld(&bar[XB_XGEN(b.x)]) == gen, bar);
            __builtin_amdgcn_fence(__ATOMIC_ACQUIRE, "agent");
            asm volatile("s_waitcnt vmcnt(0)" ::: "memory");
        }
    }
    __syncthreads();
}

namespace gm {
constexpr int BM = 256, BK = 64, HALF = 128, HTB = HALF * BK * 2, STAGE_BYTES = 8 * HTB, NXCD = 8, WGM = 8;
__host__ __device__ __forceinline__ int lds_byte(int r, int c) { const int st = (r >> 4) * 2 + (c >> 5), rr = r & 15, cc = c & 31, ob = rr * 64 + cc * 2; return st * 1024 + (ob ^ (((ob >> 9) & 1) << 5)); }
__host__ __device__ __forceinline__ void stage_rc(int b, int& R, int& C) { const int st = b / 1024, sb = b % 1024, swz = sb ^ (((sb >> 9) & 1) << 5); R = (st >> 1) * 16 + swz / 64; C = (st & 1) * 32 + (swz % 64) / 2; }
__host__ __device__ __forceinline__ int perm32(int rho) { const int n = rho >> 4, i = rho & 15; return 8 * (i >> 2) + 4 * n + (i & 3); }

struct Unit { const char* a; const char* b; int pm, pn, kind, ti; };

__device__ __forceinline__ void tile_of(int L, int nM, int nN, int& pm, int& pn) {
    const int nwg = nM * nN; int wgid = L;
    { const int q = nwg / NXCD, r = nwg % NXCD, xcd = wgid % NXCD, off = wgid / NXCD; wgid = (xcd < r ? xcd * (q + 1) : r * (q + 1) + (xcd - r) * q) + off; }
    const int nig = WGM * nN, gid = wgid / nig, fm = gid * WGM, gsz = (nM - fm) < WGM ? (nM - fm) : WGM;
    pm = fm + ((wgid % nig) % gsz); pn = (wgid % nig) / gsz;
}

template <class Epi, class Sched, bool GATHER>
__device__ __forceinline__ void gemm_phase(const int tid, LAS unsigned char* lds, const LAS int* tab, const int K, const Sched& S, const Epi& E) {
    const int wid = __builtin_amdgcn_readfirstlane(tid >> 6), lane = tid & 63, wr = wid >> 2, wc = wid & 3, fr = lane & 15, fq = lane >> 4;
    const int nt = K / BK;
    unsigned voffA0[2], voffA1[2], voffB[2];
    const size_t kstep = (size_t)(BK * 2);
    const size_t hstep = (size_t)HALF * K * 2;
#pragma unroll
    for (int i = 0; i < 2; ++i) { int R, C; stage_rc(tid * 16 + i * 8192, R, C); const int Rb = (R & ~31) + perm32(R & 31);
        voffB[i] = (unsigned)(Rb * K + C) * 2u; voffA0[i] = (unsigned)(R * K + C) * 2u; voffA1[i] = 0u; }
#define GM_SETVOFF(u) do { if constexpr (GATHER) { _Pragma("unroll") for (int _i = 0; _i < 2; ++_i) { int R_, C_; stage_rc(tid * 16 + _i * 8192, R_, C_); \
        const int r0_ = tab[(u).ti * 256 + R_], r1_ = tab[(u).ti * 256 + 128 + R_]; voffA0[_i] = (unsigned)(r0_ * K + C_) * 2u; voffA1[_i] = (unsigned)(r1_ * K + C_) * 2u; } } } while (0)
    const unsigned ldsw = (unsigned)wid * 1024u;
    const int aoff = lds_byte(wr * 64 + fr, fq * 8), boff = lds_byte(wc * 32 + fr, fq * 8);
#define PG8_SA(b, h) (((b) * 2 + (h)) * HTB)
#define PG8_SB(b, h) ((4 + (b) * 2 + (h)) * HTB)
#define PG8_STAGE(bufoff, gbase, voff) do { _Pragma("unroll") for (int _i = 0; _i < 2; ++_i) \
        __builtin_amdgcn_global_load_lds((const unsigned*)((const char*)(gbase) + (voff)[_i]), (LAS unsigned*)(lds + (bufoff) + ldsw + _i * 8192), 16, 0, 0); } while (0)
#define PG8_LDA(dst, b, h) do { _Pragma("unroll") for (int m = 0; m < 4; ++m) _Pragma("unroll") for (int k = 0; k < 2; ++k) dst[m][k] = *(const LAS bf16x8*)(lds + PG8_SA(b, h) + aoff + m * 2048 + k * 1024); } while (0)
#define PG8_LDB(dst, b, h) do { _Pragma("unroll") for (int n = 0; n < 2; ++n) _Pragma("unroll") for (int k = 0; k < 2; ++k) dst[n][k] = *(const LAS bf16x8*)(lds + PG8_SB(b, h) + boff + n * 2048 + k * 1024); } while (0)
#define PG8_MMA(ai, bj, At, Bt) do { __builtin_amdgcn_s_setprio(1); _Pragma("unroll") for (int m = 0; m < 4; ++m) _Pragma("unroll") for (int n = 0; n < 2; ++n) _Pragma("unroll") for (int k = 0; k < 2; ++k) \
        acc[ai][bj][m][n] = __builtin_amdgcn_mfma_f32_16x16x32_bf16(Bt[n][k], At[m][k], acc[ai][bj][m][n], 0, 0, 0); __builtin_amdgcn_s_setprio(0); } while (0)
#define GM_STAGE_A1(bufoff, gbase) do { if constexpr (GATHER) { PG8_STAGE(bufoff, gbase, voffA1); } else { PG8_STAGE(bufoff, (gbase) + hstep, voffA0); } } while (0)
#define PG8_WAIT_V(n) asm volatile("s_waitcnt vmcnt(" #n ")" ::: "memory")
#define PG8_WAIT_L(n) asm volatile("s_waitcnt lgkmcnt(" #n ")" ::: "memory")
#define PG8_BAR __builtin_amdgcn_s_barrier()
#define PG8_SCHED __builtin_amdgcn_sched_barrier(0)
    Unit cur, nxt; int ui = 0;
    if (!S.next(0, cur)) return;
    GM_SETVOFF(cur);
    f32x4 acc[2][2][4][2];
#pragma unroll
    for (int a = 0; a < 2; ++a)
#pragma unroll
        for (int b = 0; b < 2; ++b)
#pragma unroll
            for (int m = 0; m < 4; ++m)
#pragma unroll
                for (int n = 0; n < 2; ++n) acc[a][b][m][n] = (f32x4){0.f, 0.f, 0.f, 0.f};
    bf16x8 At[4][2], B0[2][2], B1[2][2];
    const char* cA = cur.a; const char* cB = cur.b;
    PG8_STAGE(PG8_SB(0, 0), cB, voffB); PG8_STAGE(PG8_SB(0, 1), cB + hstep, voffB); PG8_STAGE(PG8_SA(0, 0), cA, voffA0); GM_STAGE_A1(PG8_SA(0, 1), cA);
    if (wr == 1) PG8_BAR;
    PG8_WAIT_V(2); PG8_BAR;
    PG8_STAGE(PG8_SB(1, 0), cB + kstep, voffB); PG8_STAGE(PG8_SA(1, 0), cA + kstep, voffA0); PG8_STAGE(PG8_SB(1, 1), cB + hstep + kstep, voffB);
    PG8_WAIT_V(6); PG8_BAR;
    for (;;) {
        const bool has_next = S.next(ui + 1, nxt);
        const char* nA = has_next ? nxt.a : cA; const char* nB = has_next ? nxt.b : cB;
        for (int t = 0; t < nt; t += 2) {
            const bool last = (t == nt - 2);
            const char* a1 = cA + (size_t)(t + 1) * kstep;
            const char* a2 = last ? nA : cA + (size_t)(t + 2) * kstep; const char* b2 = last ? nB : cB + (size_t)(t + 2) * kstep;
            const char* a3 = a2 + kstep; const char* b3 = b2 + kstep;
            PG8_LDB(B0, 0, 0); PG8_LDB(B1, 0, 1); PG8_SCHED; PG8_LDA(At, 0, 0); GM_STAGE_A1(PG8_SA(1, 1), a1);
            PG8_WAIT_V(8); PG8_WAIT_L(0); PG8_BAR; PG8_MMA(0, 0, At, B0); PG8_MMA(0, 1, At, B1); PG8_BAR; PG8_SCHED;
            if constexpr (GATHER) { if (last && has_next) { GM_SETVOFF(nxt); } }
            PG8_LDA(At, 0, 1); PG8_STAGE(PG8_SB(0, 0), b2, voffB); PG8_STAGE(PG8_SB(0, 1), b2 + hstep, voffB); PG8_STAGE(PG8_SA(0, 0), a2, voffA0);
            PG8_WAIT_V(8); PG8_WAIT_L(0); PG8_BAR; PG8_MMA(1, 0, At, B0); PG8_MMA(1, 1, At, B1); PG8_BAR; PG8_SCHED;
            PG8_LDB(B0, 1, 0); PG8_LDB(B1, 1, 1); PG8_SCHED; PG8_LDA(At, 1, 0); GM_STAGE_A1(PG8_SA(0, 1), a2);
            PG8_WAIT_V(8); PG8_WAIT_L(0); PG8_BAR; PG8_MMA(0, 0, At, B0); PG8_MMA(0, 1, At, B1); PG8_BAR; PG8_SCHED;
            PG8_LDA(At, 1, 1); PG8_STAGE(PG8_SB(1, 0), b3, voffB); PG8_STAGE(PG8_SB(1, 1), b3 + hstep, voffB); PG8_STAGE(PG8_SA(1, 0), a3, voffA0);
            PG8_WAIT_V(8); PG8_WAIT_L(0); PG8_BAR; PG8_MMA(1, 0, At, B0); PG8_MMA(1, 1, At, B1); PG8_BAR; PG8_SCHED;
        }
        if (wr == 0) PG8_BAR;
        E(acc, cur, wr, wc, fr, fq);
        if (!has_next) break;
#pragma unroll
        for (int a = 0; a < 2; ++a)
#pragma unroll
            for (int b = 0; b < 2; ++b)
#pragma unroll
                for (int m = 0; m < 4; ++m)
#pragma unroll
                    for (int n = 0; n < 2; ++n) acc[a][b][m][n] = (f32x4){0.f, 0.f, 0.f, 0.f};
        cur = nxt; cA = nA; cB = nB; ++ui;
        if (wr == 1) PG8_BAR;
    }
    PG8_WAIT_V(0);
    PG8_BAR;
#undef GM_SETVOFF
#undef GM_STAGE_A1
#undef PG8_SA
#undef PG8_SB
#undef PG8_STAGE
#undef PG8_LDA
#undef PG8_LDB
#undef PG8_MMA
#undef PG8_WAIT_V
#undef PG8_WAIT_L
#undef PG8_BAR
#undef PG8_SCHED
}
}
namespace at {
using f32x16 = __attribute__((ext_vector_type(16))) float;
using s16x4 = __attribute__((ext_vector_type(4))) short;
constexpr int D = 128, NW = 8, QBLK = 32, KVBLK = 64;
constexpr float SCALE = 0.088388347648318440f;
constexpr float THR = 8.f;
constexpr int SHM_V = KVBLK * D * 2, SHM_K = KVBLK * D * 2, SHM_ATTN = 2 * SHM_V + 2 * SHM_K + NW * 64 * 4;
constexpr int KM_OFF = SHM_ATTN;
constexpr int QL_OFF = KM_OFF + 4096;
#define KSWZ(row, colB) ((row) * 256 + ((colB) ^ (((row) & 7) << 4)))
#define SBAR() __builtin_amdgcn_sched_barrier(0)
__device__ __forceinline__ int crow(int r, int hi) { return (r & 3) + 8 * (r >> 2) + 4 * hi; }

__device__ __forceinline__ void partialSM(f32x16& p0, f32x16& p1, float& m_reg, float& mn, float& alpha, bool dead) {
  constexpr float C = SCALE * 1.4426950408889634f;
  float pmax = p0[0];
#pragma unroll
  for (int r = 1; r < 16; ++r) pmax = fmaxf(pmax, p0[r]);
#pragma unroll
  for (int r = 0; r < 16; ++r) pmax = fmaxf(pmax, p1[r]);
  { auto rr = __builtin_amdgcn_permlane32_swap(__float_as_uint(pmax), __float_as_uint(pmax), false, false);
    pmax = fmaxf(__uint_as_float(rr[0]), __uint_as_float(rr[1])); }
  if (dead) pmax = -1e30f;
  if (__builtin_expect(__all(pmax - m_reg <= THR / SCALE), 1)) { mn = m_reg; alpha = 1.f; }
  else { mn = fmaxf(m_reg, pmax); alpha = __builtin_amdgcn_exp2f((m_reg - mn) * C); m_reg = mn; }
  const float mnC = dead ? -INFINITY : -mn * C;
#pragma unroll
  for (int r = 0; r < 16; ++r) p0[r] = fmaf(p0[r], C, mnC);
#pragma unroll
  for (int r = 0; r < 16; ++r) p1[r] = fmaf(p1[r], C, mnC);
#pragma unroll
  for (int r = 0; r < 16; ++r) p0[r] = __builtin_amdgcn_exp2f(p0[r]);
}
__device__ __forceinline__ void finishSM(f32x16& p0, f32x16& p1, float alpha, float& l_reg, bf16x8& pa0, bf16x8& pa1, bf16x8& pa2, bf16x8& pa3) {
#pragma unroll
  for (int r = 0; r < 16; ++r) p1[r] = __builtin_amdgcn_exp2f(p1[r]);
  float ps = 0;
#pragma unroll
  for (int r = 0; r < 16; ++r) ps += p0[r];
#pragma unroll
  for (int r = 0; r < 16; ++r) ps += p1[r];
  { auto rr = __builtin_amdgcn_permlane32_swap(__float_as_uint(ps), __float_as_uint(ps), false, false);
    ps = __uint_as_float(rr[0]) + __uint_as_float(rr[1]); }
  l_reg = l_reg * alpha + ps;
#define PK4(P, BASE, OUT) do { unsigned a0 = cvt_pk_bf16(P[BASE + 0], P[BASE + 1]), a1 = cvt_pk_bf16(P[BASE + 2], P[BASE + 3]);   \
    unsigned b0 = cvt_pk_bf16(P[BASE + 4], P[BASE + 5]), b1 = cvt_pk_bf16(P[BASE + 6], P[BASE + 7]);                              \
    auto r0 = __builtin_amdgcn_permlane32_swap(a0, b0, false, false); auto r1 = __builtin_amdgcn_permlane32_swap(a1, b1, false, false); \
    u32x4 w = {r0[0], r1[0], r0[1], r1[1]}; OUT = *reinterpret_cast<bf16x8*>(&w); } while (0)
  PK4(p0, 0, pa0); PK4(p0, 8, pa1); PK4(p1, 0, pa2); PK4(p1, 8, pa3);
#undef PK4
}
template <bool QLDS>
__device__ __forceinline__ void qkt(f32x16& p0, f32x16& p1, const LAS char* Ks, const bf16x8* qr, const LAS char* ql, int r32, int hi) {
  p0 = f32x16{}; p1 = f32x16{};
#pragma unroll
  for (int d0 = 0; d0 < 8; ++d0) { int cb = (d0 * 16 + hi * 8) * 2;
    bf16x8 b0 = *(const LAS bf16x8*)(Ks + KSWZ(r32, cb));
    bf16x8 b1 = *(const LAS bf16x8*)(Ks + KSWZ(32 + r32, cb));
    bf16x8 q; if constexpr (QLDS) q = *(const LAS bf16x8*)(ql + d0 * 8192); else q = qr[d0];
    p0 = __builtin_amdgcn_mfma_f32_32x32x16_bf16(b0, q, p0, 0, 0, 0);
    p1 = __builtin_amdgcn_mfma_f32_32x32x16_bf16(b1, q, p1, 0, 0, 0); }
}
__device__ __forceinline__ int v_st(int k, int c) { const int kk = (k & ~0xC) | ((k & 4) << 1) | ((k & 8) >> 1); return ((kk >> 3) * 4 + (c >> 5)) * 512 + ((kk & 7) * 32 + (c & 31)) * 2; }
__device__ __forceinline__ int v_rd_base(int lane) { return ((lane & 3) << 3) | (((lane >> 2) & 3) << 6) | (((lane >> 4) & 1) << 5) | (((lane >> 5) & 1) << 8); }
constexpr int v_rd_off(int d0, int ks, int half) { return d0 * 512 + ks * 4096 + half * 2048; }
template <int OFF> __device__ __forceinline__ s16x4 tr_read(int vb) {
  s16x4 r; asm volatile("ds_read_b64_tr_b16 %0, %1 offset:%2" : "=&v"(r) : "v"(vb), "i"(OFF) : "memory"); return r;
}
template <int D0> __device__ __forceinline__ void pv_one(f32x16& od, int vb, bf16x8 pa0, bf16x8 pa1, bf16x8 pa2, bf16x8 pa3) {
  const s16x4 l0 = tr_read<v_rd_off(D0, 0, 0)>(vb), h0 = tr_read<v_rd_off(D0, 0, 1)>(vb), l1 = tr_read<v_rd_off(D0, 1, 0)>(vb), h1 = tr_read<v_rd_off(D0, 1, 1)>(vb);
  const s16x4 l2 = tr_read<v_rd_off(D0, 2, 0)>(vb), h2 = tr_read<v_rd_off(D0, 2, 1)>(vb), l3 = tr_read<v_rd_off(D0, 3, 0)>(vb), h3 = tr_read<v_rd_off(D0, 3, 1)>(vb);
  asm volatile("s_waitcnt lgkmcnt(0)" ::: "memory"); SBAR();
#define PK(L, H) (bf16x8){L[0], L[1], L[2], L[3], H[0], H[1], H[2], H[3]}
  od = __builtin_amdgcn_mfma_f32_32x32x16_bf16(pa0, PK(l0, h0), od, 0, 0, 0);
  od = __builtin_amdgcn_mfma_f32_32x32x16_bf16(pa1, PK(l1, h1), od, 0, 0, 0);
  od = __builtin_amdgcn_mfma_f32_32x32x16_bf16(pa2, PK(l2, h2), od, 0, 0, 0);
  od = __builtin_amdgcn_mfma_f32_32x32x16_bf16(pa3, PK(l3, h3), od, 0, 0, 0);
#undef PK
}
__device__ __forceinline__ void pv_d0(f32x16* o, int vb, bf16x8 pa0, bf16x8 pa1, bf16x8 pa2, bf16x8 pa3) {
  pv_one<0>(o[0], vb, pa0, pa1, pa2, pa3); pv_one<1>(o[1], vb, pa0, pa1, pa2, pa3); pv_one<2>(o[2], vb, pa0, pa1, pa2, pa3); pv_one<3>(o[3], vb, pa0, pa1, pa2, pa3);
}

template <bool MOBA>
__device__ __forceinline__ void attn_unit(const int tid, const bf16_t* __restrict__ Qb, const bf16_t* __restrict__ Kh, bf16_t* __restrict__ Ob, int NT, int jb, const float* __restrict__ kmean_bh, LAS char* lds) {
  constexpr int ldq = MOBA ? LDP : CW, ldk = MOBA ? LDP : 2 * CW, ldo = MOBA ? MIXW : CW, VOFF = MOBA ? (C_V - C_K) : CW;
  const bf16_t* __restrict__ Vh = Kh + VOFF;
  const int wid = __builtin_amdgcn_readfirstlane(tid >> 6), lane = tid & 63, r32 = lane & 31, hi = lane >> 5;
  LAS char* V_lds = lds; LAS char* K_lds = lds + 2 * SHM_V;
  LAS float* wsf = (LAS float*)(lds + 2 * SHM_V + 2 * SHM_K) + wid * 64; LAS float* li_l = wsf; LAS float* al_l = wsf + 32;
  float m_reg = -1e30f, l_reg = 0; f32x16 o[4] = {}; bf16x8 qr[8];
  const bf16_t* Qw = Qb + (long)(wid * QBLK + r32) * ldq + hi * 8;
#pragma unroll
  for (int d0 = 0; d0 < 8; ++d0) qr[d0] = *reinterpret_cast<const bf16x8*>(Qw + d0 * 16);
  unsigned selmask = 0;
  if constexpr (MOBA) {
    LAS float* kml = (LAS float*)(lds + KM_OFF);
    __syncthreads();
    for (int i = tid; i < 8 * 128; i += NW * 64) kml[i] = kmean_bh[(i >> 7) * 1024 + (i & 127)];
    __syncthreads();
    float gate[8];
#pragma unroll
    for (int kb = 0; kb < 8; ++kb) {
      float g = 0.f;
      if (kb < jb) {
#pragma unroll
        for (int d0 = 0; d0 < 8; ++d0) { const f32x4 k0 = *(const LAS f32x4*)(kml + kb * 128 + d0 * 16 + hi * 8), k1 = *(const LAS f32x4*)(kml + kb * 128 + d0 * 16 + hi * 8 + 4);
          const u32x4 qw = *reinterpret_cast<const u32x4*>(&qr[d0]);
          g += bflo(qw.x) * k0[0] + bfhi(qw.x) * k0[1] + bflo(qw.y) * k0[2] + bfhi(qw.y) * k0[3] + bflo(qw.z) * k1[0] + bfhi(qw.z) * k1[1] + bflo(qw.w) * k1[2] + bfhi(qw.w) * k1[3]; }
        g += __shfl_xor(g, 32);
      }
      gate[kb] = g;
    }
#pragma unroll
    for (int r = 0; r < 3; ++r) { float best = -INFINITY; int bi = -1;
#pragma unroll
      for (int kb = 0; kb < 8; ++kb) { const bool ok = (kb < jb) && !((selmask >> kb) & 1u) && (gate[kb] > best || bi < 0); if (ok) { best = gate[kb]; bi = kb; } }
      if (bi >= 0) selmask |= 1u << bi; }
  }
  const LAS char* ql = lds + QL_OFF + tid * 16;
  if constexpr (MOBA) {
#pragma unroll
    for (int d0 = 0; d0 < 8; ++d0) *(LAS bf16x8*)(lds + QL_OFF + tid * 16 + d0 * 8192) = qr[d0];
  }
  const int rowb = wid * QBLK + r32;
#define MASK(P0, P1, T, DEAD) do { DEAD = false; if constexpr (MOBA) { const int kb_ = (T) >> 2; \
    if (kb_ < jb) { DEAD = !((selmask >> kb_) & 1u); } \
    else { const int lim_ = rowb - 64 * ((T) - 4 * jb); \
      if (!__all(lim_ >= 63)) { const int lh_ = lim_ - 4 * hi;     \
        _Pragma("unroll") for (int r_ = 0; r_ < 16; ++r_) { if ((r_ & 3) + 8 * (r_ >> 2) > lh_) P0[r_] = -INFINITY; if (32 + (r_ & 3) + 8 * (r_ >> 2) > lh_) P1[r_] = -INFINITY; } } } } } while (0)
  const int sr = tid >> 4, sc = (tid & 15) * 8, vst0 = v_st(sr, sc), vst1 = v_st(32 + sr, sc);
  const int vb0 = (int)(size_t)V_lds + v_rd_base(lane);
  constexpr int SDEPTH = MOBA ? 1 : 2;
  struct { bf16x8 vs0, vs1, ks0, ks1; } sr_[SDEPTH];
#define SLOAD(i, k0) do { sr_[i].vs0 = *reinterpret_cast<const bf16x8*>(&Vh[(long)((k0) + sr) * ldk + sc]); sr_[i].vs1 = *reinterpret_cast<const bf16x8*>(&Vh[(long)((k0) + 32 + sr) * ldk + sc]); \
    sr_[i].ks0 = *reinterpret_cast<const bf16x8*>(&Kh[(long)((k0) + sr) * ldk + sc]); sr_[i].ks1 = *reinterpret_cast<const bf16x8*>(&Kh[(long)((k0) + 32 + sr) * ldk + sc]); } while (0)
#define SWRITE(b, i) do { *(LAS bf16x8*)(V_lds + (b) * SHM_V + vst0) = sr_[i].vs0;          \
    *(LAS bf16x8*)(V_lds + (b) * SHM_V + vst1) = sr_[i].vs1; int kc = sc * 2;               \
    *(LAS bf16x8*)(K_lds + (b) * SHM_K + KSWZ(sr, kc)) = sr_[i].ks0;                       \
    *(LAS bf16x8*)(K_lds + (b) * SHM_K + KSWZ(32 + sr, kc)) = sr_[i].ks1; } while (0)
#define SWAIT() do { if constexpr (SDEPTH == 2) asm volatile("s_waitcnt vmcnt(4)" ::: "memory"); else asm volatile("s_waitcnt vmcnt(0)" ::: "memory"); } while (0)
#define RESC(a) do { if (__any((a) < 1.f)) { if (hi == 0) al_l[r32] = (a); asm volatile("s_waitcnt lgkmcnt(0)" ::: "memory"); \
    _Pragma("unroll") for (int d = 0; d < 4; ++d) _Pragma("unroll") for (int r = 0; r < 16; ++r) o[d][r] *= al_l[crow(r, hi)]; } } while (0)
  f32x16 pA0, pA1, pB0, pB1; float mnA, mnB, alA, alB; bf16x8 pa0, pa1, pa2, pa3; bool deadA, deadB;
  constexpr int SE = 0, SO = SDEPTH - 1;
  if constexpr (!MOBA) __syncthreads();
  SLOAD(SE, 0); asm volatile("s_waitcnt vmcnt(0)" ::: "memory"); SWRITE(0, SE); __syncthreads();
  qkt<MOBA>(pA0, pA1, K_lds, qr, ql, r32, hi); MASK(pA0, pA1, 0, deadA); partialSM(pA0, pA1, m_reg, mnA, alA, deadA);
  SLOAD(SO, KVBLK); if constexpr (SDEPTH == 2) { if (2 < NT) SLOAD(SE, 2 * KVBLK); }
  SWAIT(); SWRITE(1, SO); __syncthreads();
  for (int j = 1; j + 1 < NT; j += 2) {
    SBAR(); qkt<MOBA>(pB0, pB1, K_lds + SHM_K, qr, ql, r32, hi);
    finishSM(pA0, pA1, alA, l_reg, pa0, pa1, pa2, pa3); SBAR();
    SLOAD(SO, (j + SDEPTH) * KVBLK); SBAR();
    pv_d0(o, vb0, pa0, pa1, pa2, pa3); MASK(pB0, pB1, j, deadB); partialSM(pB0, pB1, m_reg, mnB, alB, deadB);
    __syncthreads(); SWAIT(); SWRITE(0, SE);
    RESC(alB); __syncthreads();
    SBAR(); qkt<MOBA>(pA0, pA1, K_lds, qr, ql, r32, hi);
    finishSM(pB0, pB1, alB, l_reg, pa0, pa1, pa2, pa3); SBAR();
    if (SDEPTH == 1 || j + 3 < NT) SLOAD(SE, (j + 1 + SDEPTH) * KVBLK); SBAR();
    pv_d0(o, vb0 + SHM_V, pa0, pa1, pa2, pa3); MASK(pA0, pA1, j + 1, deadA); partialSM(pA0, pA1, m_reg, mnA, alA, deadA);
    __syncthreads(); SWAIT(); SWRITE(1, SO);
    RESC(alA); __syncthreads();
  }
  SBAR(); qkt<MOBA>(pB0, pB1, K_lds + SHM_K, qr, ql, r32, hi);
  finishSM(pA0, pA1, alA, l_reg, pa0, pa1, pa2, pa3); SBAR();
  pv_d0(o, vb0, pa0, pa1, pa2, pa3); MASK(pB0, pB1, NT - 1, deadB); partialSM(pB0, pB1, m_reg, mnB, alB, deadB);
  __syncthreads(); RESC(alB);
  finishSM(pB0, pB1, alB, l_reg, pa0, pa1, pa2, pa3); SBAR();
  pv_d0(o, vb0 + SHM_V, pa0, pa1, pa2, pa3);
  if (hi == 0) li_l[r32] = l_reg; asm volatile("s_waitcnt lgkmcnt(0)" ::: "memory");
  float rli[16];
#pragma unroll
  for (int r = 0; r < 16; ++r) rli[r] = __builtin_amdgcn_rcpf(li_l[crow(r, hi)]);
  if constexpr (MOBA) {
#pragma unroll
    for (int r = 0; r < 16; ++r) {
      float q = 0.f;
#pragma unroll
      for (int d0 = 0; d0 < 4; ++d0) { const float v = o[d0][r] * rli[r]; q += v * v; }
      q += __shfl_xor(q, 1); q += __shfl_xor(q, 2); q += __shfl_xor(q, 4); q += __shfl_xor(q, 8); q += __shfl_xor(q, 16);
      rli[r] *= rsqrtf(q * (1.f / 128.f) + EPS);
    }
  }
  bf16_t* Ow = Ob + (long)(wid * QBLK) * ldo;
#pragma unroll
  for (int r = 0; r < 16; ++r) { const int orow = crow(r, hi);
#pragma unroll
    for (int d0 = 0; d0 < 4; ++d0) Ow[(long)orow * ldo + d0 * 32 + r32] = (bf16_t)(cvt_pk_bf16(o[d0][r] * rli[r], 0.f) & 0xffffu); }
#undef MASK
#undef SLOAD
#undef SWRITE
#undef SWAIT
#undef RESC
}
#undef KSWZ
#undef SBAR
}
namespace sd {
using f32x16 = __attribute__((ext_vector_type(16))) float;
typedef short v4i16_t __attribute__((ext_vector_type(4)));
constexpr int IMG_C = 0, IMG_B = 32768, IMG_X = 65536, IMG_S = 98304, TBL = 114688;
__device__ __forceinline__ unsigned off_b(unsigned row, unsigned ch) { return 256u * row + 16u * (ch ^ (((row & 3) << 2) | ((row >> 2) & 3))); }
__device__ __forceinline__ unsigned row_read_addr(unsigned lane, unsigned s) { return off_b(lane & 31, 2 * s + (lane >> 5)); }
__device__ __forceinline__ unsigned tr_read_addr(unsigned lane, unsigned c, unsigned ks, unsigned t) {
  const unsigned h = lane >> 5, blk = (lane >> 4) & 1, q = (lane & 15) >> 2, p = lane & 3;
  return off_b(16 * ks + 8 * h + 4 * t + q, 4 * c + 2 * blk + (p >> 1)) + 8 * (p & 1);
}
__device__ __forceinline__ unsigned elem_addr(unsigned row, unsigned col) { return (row >> 5) * 8192u + off_b(row & 31, col >> 3) + (col & 7) * 2u; }
__device__ __forceinline__ bf16x8 tr_frag(const LAS char* img, unsigned a0, unsigned a1) {
  const v4i16_t l = __builtin_amdgcn_ds_read_tr16_b64_v4i16((LAS v4i16_t*)(img + a0)), h = __builtin_amdgcn_ds_read_tr16_b64_v4i16((LAS v4i16_t*)(img + a1));
  return (bf16x8){l[0], l[1], l[2], l[3], h[0], h[1], h[2], h[3]};
}
__device__ __forceinline__ int crow(int r, int hi) { return (r & 3) + 8 * (r >> 2) + 4 * hi; }
__device__ __forceinline__ float softplus_f(float r) { return fmaxf(r, 0.f) + log1pf(__expf(-fabsf(r))); }

__device__ __forceinline__ void ssd_unit(const int tid, const int b, const int h, const bf16_t* __restrict__ proj, const float* __restrict__ dtraw, const float* __restrict__ conv_w,
                                         const float* __restrict__ conv_b, const float* __restrict__ dt_bias, const float* __restrict__ a_log, const float* __restrict__ d_skip,
                                         bf16_t* __restrict__ mixb, float* __restrict__ ssq, LAS char* lds) {
  const int wid = __builtin_amdgcn_readfirstlane(tid >> 6), lane = tid & 63, r32 = lane & 31, hi = lane >> 5;
  const int rb = wid >> 1, ph = wid & 1;
  LAS char* IC = lds + IMG_C; LAS char* IB = lds + IMG_B; LAS char* IX = lds + IMG_X; LAS char* IS = lds + IMG_S;
  LAS float* Tdt = (LAS float*)(lds + TBL); LAS float* Tacs = Tdt + 2048; LAS float* Tw2 = Tacs + 2048;
  const int grp = h >> 3;
  const float a = -__expf(a_log[h]), dtb = dt_bias[h], Dh = d_skip[h];
  __syncthreads();
  { const u32x4 z = {0u, 0u, 0u, 0u}; *(LAS u32x4*)(IS + tid * 32) = z; *(LAS u32x4*)(IS + tid * 32 + 16) = z; }
#pragma unroll 1
  for (int cc = 0; cc < 2; ++cc) {
    const int t0 = (wid * 2 + cc) * 128 + 2 * lane;
    const float d0 = softplus_f(dtraw[(size_t)(b * SEQ + t0) * 32 + h] + dtb), d1 = softplus_f(dtraw[(size_t)(b * SEQ + t0 + 1) * 32 + h] + dtb);
    const float v0 = d0 * a, ps = v0 + d1 * a;
    float sc = ps;
#pragma unroll
    for (int o = 1; o < 64; o <<= 1) { const float n = __shfl_up(sc, o); if (lane >= o) sc += n; }
    const float a0 = (sc - ps) + v0, a1 = sc, tot = __shfl(sc, 63);
    Tdt[t0] = d0; Tdt[t0 + 1] = d1; Tacs[t0] = a0; Tacs[t0 + 1] = a1; Tw2[t0] = d0 * __expf(tot - a0); Tw2[t0 + 1] = d1 * __expf(tot - a1);
  }
  f32x16 S = {};
  const unsigned xr = ((r32 & 3) << 2) | ((r32 >> 2) & 3);
#define RROW(k) (256u * r32 + 16u * ((2u * (k) + hi) ^ xr))
#pragma unroll 1
  for (int c = 0; c < 16; ++c) {
    __syncthreads();
    if (c > 0) {
#pragma unroll
      for (int r = 0; r < 16; ++r) *(LAS bf16_t*)(IS + elem_addr(32 * ph + crow(r, hi), 32 * rb + r32)) = (bf16_t)(cvt_pk_bf16(S[r], 0.f) & 0xffffu);
    }
#pragma unroll 1
    for (int j = 0; j < 10; ++j) {
      const int it = tid + 512 * j, tk = it / 40, g = it - tk * 40, T = c * 128 + tk;
      const int chb = g < 8 ? h * 64 + 8 * g : (g < 24 ? 2048 + grp * 128 + 8 * (g - 8) : 2560 + grp * 128 + 8 * (g - 24));
      float acc[8];
      { const f32x4 b0 = *(const f32x4*)(conv_b + chb), b1 = *(const f32x4*)(conv_b + chb + 4);
        acc[0] = b0[0]; acc[1] = b0[1]; acc[2] = b0[2]; acc[3] = b0[3]; acc[4] = b1[0]; acc[5] = b1[1]; acc[6] = b1[2]; acc[7] = b1[3]; }
#pragma unroll
      for (int i = 0; i < SCONV; ++i) {
        if (T - 3 + i >= 0) {
          float xv[8]; ld8bf(proj + (size_t)(b * SEQ + T - 3 + i) * LDP + C_XBC + chb, xv);
          const f32x4 w0 = *(const f32x4*)(conv_w + i * CONVD + chb), w1 = *(const f32x4*)(conv_w + i * CONVD + chb + 4);
          acc[0] += w0[0] * xv[0]; acc[1] += w0[1] * xv[1]; acc[2] += w0[2] * xv[2]; acc[3] += w0[3] * xv[3];
          acc[4] += w1[0] * xv[4]; acc[5] += w1[1] * xv[5]; acc[6] += w1[2] * xv[6]; acc[7] += w1[3] * xv[7];
        }
      }
#pragma unroll
      for (int e = 0; e < 8; ++e) acc[e] = acc[e] * __builtin_amdgcn_rcpf(1.f + __expf(-acc[e]));
      u32x4 w; w.x = cvt_pk_bf16(acc[0], acc[1]); w.y = cvt_pk_bf16(acc[2], acc[3]); w.z = cvt_pk_bf16(acc[4], acc[5]); w.w = cvt_pk_bf16(acc[6], acc[7]);
      const unsigned tbase = (unsigned)(tk >> 5) * 8192u, trow = (unsigned)(tk & 31);
      if (g < 8) {
        *(LAS u32x4*)(IX + tbase + off_b(trow, g)) = w;
        const float w2 = Tw2[T];
        u32x4 v; v.x = cvt_pk_bf16(acc[0] * w2, acc[1] * w2); v.y = cvt_pk_bf16(acc[2] * w2, acc[3] * w2); v.z = cvt_pk_bf16(acc[4] * w2, acc[5] * w2); v.w = cvt_pk_bf16(acc[6] * w2, acc[7] * w2);
        *(LAS u32x4*)(IX + tbase + off_b(trow, 8 + g)) = v;
      } else if (g < 24) *(LAS u32x4*)(IB + tbase + off_b(trow, g - 8)) = w;
      else *(LAS u32x4*)(IC + tbase + off_b(trow, g - 24)) = w;
    }
    __syncthreads();
    const LAS float* acs = Tacs + c * 128; const LAS float* dts = Tdt + c * 128;
    f32x16 Y = {};
    const float acl = acs[32 * rb + r32];
#pragma unroll 1
    for (int st = 0; st <= rb; ++st) {
      f32x16 Dm = {};
#pragma unroll
      for (int k = 0; k < 8; ++k) { const bf16x8 af = *(const LAS bf16x8*)(IB + st * 8192 + RROW(k)), bq = *(const LAS bf16x8*)(IC + rb * 8192 + RROW(k));
        Dm = __builtin_amdgcn_mfma_f32_32x32x16_bf16(af, bq, Dm, 0, 0, 0); }
#pragma unroll
      for (int q4 = 0; q4 < 4; ++q4) { const f32x4 as4 = *(const LAS f32x4*)(acs + 32 * st + 8 * q4 + 4 * hi), dt4 = *(const LAS f32x4*)(dts + 32 * st + 8 * q4 + 4 * hi);
#pragma unroll
        for (int e = 0; e < 4; ++e) { const int r = 4 * q4 + e; const bool dead = (st == rb) && (8 * q4 + 4 * hi + e > r32);
          const float f = dead ? 0.f : __expf(acl - as4[e]) * dt4[e]; Dm[r] *= f; } }
      bf16x8 pa0, pa1;
#define PK4(P, BASE, OUT) do { unsigned a0_ = cvt_pk_bf16(P[BASE + 0], P[BASE + 1]), a1_ = cvt_pk_bf16(P[BASE + 2], P[BASE + 3]);   \
    unsigned b0_ = cvt_pk_bf16(P[BASE + 4], P[BASE + 5]), b1_ = cvt_pk_bf16(P[BASE + 6], P[BASE + 7]);                              \
    auto r0_ = __builtin_amdgcn_permlane32_swap(a0_, b0_, false, false); auto r1_ = __builtin_amdgcn_permlane32_swap(a1_, b1_, false, false); \
    u32x4 w_ = {r0_[0], r1_[0], r0_[1], r1_[1]}; OUT = *reinterpret_cast<bf16x8*>(&w_); } while (0)
      PK4(Dm, 0, pa0); PK4(Dm, 8, pa1);
#undef PK4
      Y = __builtin_amdgcn_mfma_f32_32x32x16_bf16(pa0, tr_frag(IX + st * 8192, tr_read_addr(lane, ph, 0, 0), tr_read_addr(lane, ph, 0, 1)), Y, 0, 0, 0);
      Y = __builtin_amdgcn_mfma_f32_32x32x16_bf16(pa1, tr_frag(IX + st * 8192, tr_read_addr(lane, ph, 1, 0), tr_read_addr(lane, ph, 1, 1)), Y, 0, 0, 0);
    }
    {
      f32x16 CS = {};
#pragma unroll
      for (int k = 0; k < 8; ++k) { const bf16x8 af = *(const LAS bf16x8*)(IC + rb * 8192 + RROW(k)), bq = *(const LAS bf16x8*)(IS + ph * 8192 + RROW(k));
        CS = __builtin_amdgcn_mfma_f32_32x32x16_bf16(af, bq, CS, 0, 0, 0); }
#pragma unroll
      for (int q4 = 0; q4 < 4; ++q4) { const f32x4 as4 = *(const LAS f32x4*)(acs + 32 * rb + 8 * q4 + 4 * hi);
#pragma unroll
        for (int e = 0; e < 4; ++e) Y[4 * q4 + e] += CS[4 * q4 + e] * __expf(as4[e]); }
    }
    {
      const float dec = __expf(acs[127]);
#pragma unroll
      for (int r = 0; r < 16; ++r) S[r] *= dec;
#pragma unroll
      for (int st = 0; st < 4; ++st)
#pragma unroll
        for (int ks = 0; ks < 2; ++ks) {
          const bf16x8 af = tr_frag(IX + st * 8192, tr_read_addr(lane, 2 + ph, ks, 0), tr_read_addr(lane, 2 + ph, ks, 1));
          const bf16x8 bq = tr_frag(IB + st * 8192, tr_read_addr(lane, rb, ks, 0), tr_read_addr(lane, rb, ks, 1));
          S = __builtin_amdgcn_mfma_f32_32x32x16_bf16(af, bq, S, 0, 0, 0);
        }
    }
    {
      const int p = 32 * ph + r32;
#pragma unroll
      for (int r = 0; r < 16; ++r) {
        const int l = 32 * rb + crow(r, hi); const size_t tok = (size_t)(b * SEQ + c * 128 + l);
        const float xv = bf2f(*(const LAS bf16_t*)(IX + elem_addr(l, p)));
        const float z = bf2f(proj[tok * LDP + C_Z + h * 64 + p]);
        const float yg = (Y[r] + xv * Dh) * (z * __builtin_amdgcn_rcpf(1.f + __expf(-z)));
        mixb[tok * MIXW + AW + h * 64 + p] = (bf16_t)(cvt_pk_bf16(yg, 0.f) & 0xffffu);
        float q = yg * yg;
        q += __shfl_xor(q, 1); q += __shfl_xor(q, 2); q += __shfl_xor(q, 4); q += __shfl_xor(q, 8); q += __shfl_xor(q, 16);
        if (r32 == 0) ssq[tok * 64 + h * 2 + ph] = q;
      }
    }
  }
#undef RROW
  __syncthreads();
}
}
constexpr int RING_OFF = 0, RING_BYTES = 131072;
constexpr int TAB_OFF = RING_BYTES;
constexpr int RSL_OFF = TAB_OFF + 8192;
constexpr int MOE_OFF = RSL_OFF + 1024;
constexpr int LDSCTL_OFF = MOE_OFF + 512;
constexpr int MISC_OFF = LDSCTL_OFF + 320;
constexpr int LDS_BYTES = 147456;
static_assert(MISC_OFF + 128 <= LDS_BYTES, "LDS map");
constexpr int NWAVES = 8;

struct Args { const float* in[27]; float* out; unsigned char* ws; float rf[16]; int ph_lo, ph_hi, li, pad; };

struct Frame {
    LAS unsigned char* lds;
    volatile LAS unsigned* MISC;
    int tid, lane, wave, vcu, G;
};

__device__ __forceinline__ void p0_transpose_item(const float* __restrict__ W, int ldw, int k0, int n0, const float* __restrict__ sc, bf16_t* dst, int dK, LAS float* scr, int lane) {
#pragma unroll 8
    for (int i = 0; i < 32; ++i) { const int kk = 2 * i + (lane >> 5); float v = W[(size_t)(k0 + kk) * ldw + n0 + (lane & 31)]; if (sc) v *= sc[k0 + kk]; scr[kk * 33 + (lane & 31)] = v; }
    LDS_WAIT(); asm volatile("" ::: "memory");
    const int c = lane & 7;
#pragma unroll
    for (int j = 0; j < 4; ++j) { const int n = (lane >> 3) + 8 * j; const LAS float* s = scr + (8 * c) * 33 + n;
        u32x4 o; o.x = cvt_pk_bf16(s[0 * 33], s[1 * 33]); o.y = cvt_pk_bf16(s[2 * 33], s[3 * 33]); o.z = cvt_pk_bf16(s[4 * 33], s[5 * 33]); o.w = cvt_pk_bf16(s[6 * 33], s[7 * 33]);
        *(u32x4*)(dst + (size_t)n * dK + k0 + 8 * c) = o; }
    LDS_WAIT(); asm volatile("" ::: "memory");
}
__device__ __forceinline__ void row_to_bf16_rs(const float* xrow, bf16_t* orow, float* rs_out, int lane) {
    const f32x4* xr = (const f32x4*)xrow + lane;
    f32x4 v[8]; float s = 0.f;
#pragma unroll
    for (int j = 0; j < 8; ++j) { v[j] = xr[64 * j]; s += (v[j].x * v[j].x + v[j].y * v[j].y) + (v[j].z * v[j].z + v[j].w * v[j].w); }
    s = wave_sum(s);
    if (lane == 0) *rs_out = rsqrtf(s * (1.f / DM) + EPS);
    u32x2* o8 = (u32x2*)orow + lane;
#pragma unroll
    for (int j = 0; j < 8; ++j) { u32x2 w; w.x = cvt_pk_bf16(v[j].x, v[j].y); w.y = cvt_pk_bf16(v[j].z, v[j].w); o8[64 * j] = w; }
}
__device__ __forceinline__ void p0_prologue(Frame& F, const Args& args) {
    LAS float* scr = (LAS float*)(F.lds + RING_OFF + F.wave * 16384);
    const int gw = F.vcu * NWAVES + F.wave, NGW = F.G * NWAVES, lane = F.lane;
    GAS unsigned char* wsg_ = (GAS unsigned char*)args.ws; asm volatile("" : "+s"(wsg_)); unsigned char* ws = (unsigned char*)wsg_;
    const float* w_in = args.in[3]; const float* w_out = args.in[11];
    constexpr int I_IN = 32 * 257, I_OUT = 48 * 64, I_CQ = 32 * 16, I_CO = 8 * 64;
    constexpr int I_GU = 32 * 32 * 32, I_DN = 32 * 16 * 64;
    constexpr int NITEMS = I_IN + I_OUT + 3 * I_CQ + I_CO + 2 * I_GU + I_DN;
    for (int it = gw; it < NITEMS; it += NGW) {
        int r = it;
        if (r < I_IN) { const int kb = r / 257, nb = r % 257; p0_transpose_item(w_in, INW, 64 * kb, 32 * nb, args.in[2], (bf16_t*)(ws + WS_WIN_T) + (size_t)(32 * nb) * DM, DM, scr, lane); continue; } r -= I_IN;
        if (r < I_OUT) { const int kb = r / 64, nb = r % 64; const float* sc = (kb < 16) ? args.in[9] : (args.in[10] - AW);
            p0_transpose_item(w_out, DM, 64 * kb, 32 * nb, sc, (bf16_t*)(ws + WS_WOUT_T) + (size_t)(32 * nb) * MIXW, MIXW, scr, lane); continue; } r -= I_OUT;
        if (r < I_CQ) { const int kb = r / 16, nb = r % 16; p0_transpose_item(args.in[14], CW, 64 * kb, 32 * nb, args.in[12], (bf16_t*)(ws + WS_WCQ_T) + (size_t)(32 * nb) * DM, DM, scr, lane); continue; } r -= I_CQ;
        if (r < I_CQ) { const int kb = r / 16, nb = r % 16; p0_transpose_item(args.in[15], CW, 64 * kb, 32 * nb, args.in[13], (bf16_t*)(ws + WS_WCKV_T) + (size_t)(32 * nb) * DM, DM, scr, lane); continue; } r -= I_CQ;
        if (r < I_CQ) { const int kb = r / 16, nb = r % 16; p0_transpose_item(args.in[16], CW, 64 * kb, 32 * nb, args.in[13], (bf16_t*)(ws + WS_WCKV_T) + (size_t)(CW + 32 * nb) * DM, DM, scr, lane); continue; } r -= I_CQ;
        if (r < I_CO) { const int kb = r / 64, nb = r % 64; p0_transpose_item(args.in[17], DM, 64 * kb, 32 * nb, nullptr, (bf16_t*)(ws + WS_WCO_T) + (size_t)(32 * nb) * CW, CW, scr, lane); continue; } r -= I_CO;
        if (r < 2 * I_GU) { const int up = r >= I_GU; if (up) r -= I_GU; const int e = r >> 10, kb = (r >> 5) & 31, nb = r & 31, n0 = 32 * nb;
            p0_transpose_item(args.in[up ? 24 : 23] + (size_t)e * DM * DE, DE, 64 * kb, n0, args.in[18], (bf16_t*)(ws + WS_WGU_T) + ((size_t)e * 2048 + (n0 >> 7) * 256 + up * 128 + (n0 & 127)) * DM, DM, scr, lane); continue; } r -= 2 * I_GU;
        { const int e = r >> 10, kb = (r >> 6) & 15, nb = r & 63;
            p0_transpose_item(args.in[25] + (size_t)e * DE * DM, DM, 64 * kb, 32 * nb, nullptr, (bf16_t*)(ws + WS_WD_T) + ((size_t)e * 2048 + 32 * nb) * DE, DE, scr, lane); }
    }
    { u32x4* z = (u32x4*)((bf16_t*)(ws + WS_WIN_T) + (size_t)INW * DM); const int n16 = (LDP - INW) * DM * 2 / 16;
      for (int i = (F.vcu * NWAVES * 64) + F.tid; i < n16; i += F.G * NWAVES * 64) z[i] = (u32x4){0u, 0u, 0u, 0u}; }
    { float* tab = (float*)(ws + WS_ROPE);
      for (int i = (F.vcu * NWAVES * 64) + F.tid; i < SEQ * 16; i += F.G * NWAVES * 64) { const int pos = i >> 4, f = i & 15;
        const float ang = (float)pos * args.rf[f]; double r = (double)ang * 0.15915494309189533577; r -= rint(r); const float th = (float)(r * 6.283185307179586477);
        tab[pos * 32 + f] = cosf(th); tab[pos * 32 + 16 + f] = sinf(th); } }
    { float* wr = (float*)(ws + WS_WR); const float* nfw = args.in[18];
      for (int i = (F.vcu * NWAVES * 64) + F.tid; i < 36 * DM; i += F.G * NWAVES * 64) { const int n = i >> 11, k = i & (DM - 1);
        wr[i] = (n < NG ? args.in[19][k * NG + n] : args.in[21][k * NE + (n - NG)]) * nfw[k]; } }
    for (int m = gw; m < M; m += NGW) row_to_bf16_rs(args.in[0] + (size_t)m * DM, (bf16_t*)(ws + WS_XB) + (size_t)m * DM, (float*)(ws + WS_RSX) + m, lane);
    for (int m = gw; m < MROWS; m += NGW) row_to_bf16_rs(args.in[1] + (size_t)m * DM, (bf16_t*)(ws + WS_MEMB) + (size_t)m * DM, (float*)(ws + WS_RSMEM) + m, lane);
}

struct SchedG1 {
    const char* A; const char* Bt; int G, c;
    __device__ __forceinline__ bool next(int i, gm::Unit& u) const {
        const int L = i * G + c; if (L >= 64 * 33) return false;
        int pm, pn; gm::tile_of(L, 64, 33, pm, pn);
        u.pm = pm; u.pn = pn; u.kind = 0; u.ti = 0; u.a = A + (size_t)pm * 256 * DM * 2; u.b = Bt + (size_t)pn * 256 * DM * 2; return true;
    }
};
struct EpiG1 {
    bf16_t* proj; float* dtraw; const float* rsx; const float* ropetab;
    __device__ __forceinline__ void operator()(const f32x4 (&acc)[2][2][4][2], const gm::Unit& u, int wr, int wc, int fr, int fq) const {
        const int row0 = u.pm * 256 + wr * 64 + fr;
        const bool rope = (u.pn < 8) && (wc == 0), dtt = (u.pn == 32);
        const float sgn = (fq < 2) ? -1.f : 1.f;
#pragma unroll
        for (int ai = 0; ai < 2; ++ai)
#pragma unroll
            for (int m = 0; m < 4; ++m) {
                const int row = row0 + ai * 128 + m * 16; const float rs = rsx[row];
                f32x4 c0 = {1.f, 1.f, 1.f, 1.f}, c1 = c0, s0 = {0.f, 0.f, 0.f, 0.f}, s1 = s0;
                if (rope) { const float* rt = ropetab + (row & (SEQ - 1)) * 32 + 8 * (fq & 1); c0 = *(const f32x4*)rt; c1 = *(const f32x4*)(rt + 4); s0 = *(const f32x4*)(rt + 16); s1 = *(const f32x4*)(rt + 20); }
#pragma unroll
                for (int bj = 0; bj < 2; ++bj) {
                    f32x4 v0 = acc[ai][bj][m][0] * rs, v1 = acc[ai][bj][m][1] * rs;
                    if (rope) {
                        f32x4 p0, p1;
#pragma unroll
                        for (int e = 0; e < 4; ++e) { p0[e] = __shfl_xor(v0[e], 32); p1[e] = __shfl_xor(v1[e], 32); }
                        v0 = v0 * c0 + (p0 * s0) * sgn; v1 = v1 * c1 + (p1 * s1) * sgn;
                    }
                    if (!dtt) { u32x4 w; w.x = cvt_pk_bf16(v0[0], v0[1]); w.y = cvt_pk_bf16(v0[2], v0[3]); w.z = cvt_pk_bf16(v1[0], v1[1]); w.w = cvt_pk_bf16(v1[2], v1[3]);
                        *(u32x4*)(proj + (size_t)row * LDP + u.pn * 256 + bj * 128 + wc * 32 + 8 * fq) = w; }
                    else if (bj == 0 && wc == 0) { float* d = dtraw + (size_t)row * 32 + 8 * fq; *(f32x4*)d = v0; *(f32x4*)(d + 4) = v1; }
                }
                asm volatile("" ::: "memory");
            }
    }
};

struct SchedTiles {
    const char* A; const char* Bt; int nM, nN, K, G, c;
    __device__ __forceinline__ bool next(int i, gm::Unit& u) const {
        const int L = i * G + c; if (L >= nM * nN) return false;
        int pm, pn; gm::tile_of(L, nM, nN, pm, pn);
        u.pm = pm; u.pn = pn; u.kind = 0; u.ti = 0; u.a = A + (size_t)pm * 256 * K * 2; u.b = Bt + (size_t)pn * 256 * K * 2; return true;
    }
};
struct EpiRes {
    const float* base; float* outf; bf16_t* hb; float* ss;
    __device__ __forceinline__ void operator()(const f32x4 (&acc)[2][2][4][2], const gm::Unit& u, int wr, int wc, int fr, int fq) const {
        const int row0 = u.pm * 256 + wr * 64 + fr;
#pragma unroll
        for (int ai = 0; ai < 2; ++ai)
#pragma unroll
            for (int m = 0; m < 4; ++m) {
                const int row = row0 + ai * 128 + m * 16; float q = 0.f;
#pragma unroll
                for (int bj = 0; bj < 2; ++bj) {
                    const size_t o = (size_t)row * DM + u.pn * 256 + bj * 128 + wc * 32 + 8 * fq;
                    const f32x4 v0 = acc[ai][bj][m][0] + *(const f32x4*)(base + o), v1 = acc[ai][bj][m][1] + *(const f32x4*)(base + o + 4);
                    *(f32x4*)(outf + o) = v0; *(f32x4*)(outf + o + 4) = v1;
                    u32x4 w; w.x = cvt_pk_bf16(v0[0], v0[1]); w.y = cvt_pk_bf16(v0[2], v0[3]); w.z = cvt_pk_bf16(v1[0], v1[1]); w.w = cvt_pk_bf16(v1[2], v1[3]);
                    *(u32x4*)(hb + o) = w;
                    q += (v0[0] * v0[0] + v0[1] * v0[1]) + (v0[2] * v0[2] + v0[3] * v0[3]) + (v1[0] * v1[0] + v1[1] * v1[1]) + (v1[2] * v1[2] + v1[3] * v1[3]);
                }
                q += __shfl_xor(q, 16); q += __shfl_xor(q, 32);
                if (fq == 0) ss[(size_t)row * 32 + u.pn * 4 + wc] = q;
                asm volatile("" ::: "memory");
            }
    }
};
struct SchedQKV {
    const char* A0; const char* B0; const char* A1; const char* B1; int G, c;
    __device__ __forceinline__ bool next(int i, gm::Unit& u) const {
        const int L = i * G + c; int pm, pn;
        if (L < 128) { gm::tile_of(L, 64, 2, pm, pn); u.kind = 0; u.a = A0 + (size_t)pm * 256 * DM * 2; u.b = B0 + (size_t)pn * 256 * DM * 2; }
        else if (L < 160) { gm::tile_of(L - 128, 8, 4, pm, pn); u.kind = 1; u.a = A1 + (size_t)pm * 256 * DM * 2; u.b = B1 + (size_t)pn * 256 * DM * 2; }
        else return false;
        u.pm = pm; u.pn = pn; u.ti = 0; return true;
    }
};
struct EpiScale {
    bf16_t* O0; bf16_t* O1; int ld0, ld1; const LAS float* rsl;
    __device__ __forceinline__ void operator()(const f32x4 (&acc)[2][2][4][2], const gm::Unit& u, int wr, int wc, int fr, int fq) const {
        bf16_t* O = u.kind ? O1 : O0; const int ld = u.kind ? ld1 : ld0;
#pragma unroll
        for (int ai = 0; ai < 2; ++ai)
#pragma unroll
            for (int m = 0; m < 4; ++m) {
                const int r = ai * 128 + wr * 64 + m * 16 + fr; const float rs = rsl[r];
#pragma unroll
                for (int bj = 0; bj < 2; ++bj) {
                    const f32x4 v0 = acc[ai][bj][m][0] * rs, v1 = acc[ai][bj][m][1] * rs;
                    u32x4 w; w.x = cvt_pk_bf16(v0[0], v0[1]); w.y = cvt_pk_bf16(v0[2], v0[3]); w.z = cvt_pk_bf16(v1[0], v1[1]); w.w = cvt_pk_bf16(v1[2], v1[3]);
                    *(u32x4*)(O + (size_t)(u.pm * 256 + r) * ld + u.pn * 256 + bj * 128 + wc * 32 + 8 * fq) = w;
                }
            }
    }
};

__device__ __forceinline__ void moe_tables(LAS int* mt, const int* cnt_g, int tid) {
    if (tid < 32) mt[tid] = cnt_g[tid];
    LDS_WAIT(); __syncthreads();
    if (tid == 0) { int p = 0, o = 0; for (int e = 0; e < NE; ++e) { mt[32 + e] = p; mt[65 + e] = o; const int c = mt[e]; p += 8 * ((c + 255) >> 8); o += c; } mt[32 + NE] = p; mt[65 + NE] = o; }
    LDS_WAIT(); __syncthreads();
}
template <bool GU> struct SchedMoE {
    const LAS int* mt; const char* A; const char* Bt; int G, c;
    __device__ __forceinline__ bool next(int i, gm::Unit& u) const {
        const int L = i * G + c; if (L >= mt[32 + NE]) return false;
        int e = 0;
#pragma unroll 1
        for (int k = 1; k < NE; ++k) if (L >= mt[32 + k]) e = k;
        const int rem = L - mt[32 + e], te = (mt[e] + 255) >> 8, pn = rem / te, mtile = rem - pn * te;
        u.pm = mtile; u.pn = pn; u.kind = e; u.ti = i;
        if (GU) { u.a = A; u.b = Bt + ((size_t)e * 2048 + pn * 256) * DM * 2; }
        else { u.a = A + (size_t)(mt[65 + e] + mtile * 256) * DE * 2; u.b = Bt + ((size_t)e * 2048 + pn * 256) * DE * 2; }
        return true;
    }
};
struct EpiGU {
    bf16_t* Hact; const float* rs2; const LAS int* mt; const LAS int* tab;
    __device__ __forceinline__ void operator()(const f32x4 (&acc)[2][2][4][2], const gm::Unit& u, int wr, int wc, int fr, int fq) const {
        const int e = u.kind, valid = mt[e] - u.pm * 256, slot0 = mt[65 + e] + u.pm * 256;
#pragma unroll
        for (int ai = 0; ai < 2; ++ai)
#pragma unroll
            for (int m = 0; m < 4; ++m) {
                const int r = ai * 128 + wr * 64 + m * 16 + fr;
                if (r < valid) {
                    const float rs = rs2[tab[u.ti * 256 + r]];
                    const f32x4 g0 = acc[ai][0][m][0] * rs, g1 = acc[ai][0][m][1] * rs, u0 = acc[ai][1][m][0] * rs, u1 = acc[ai][1][m][1] * rs;
                    float o[8];
#pragma unroll
                    for (int j = 0; j < 4; ++j) { o[j] = g0[j] * __builtin_amdgcn_rcpf(1.f + __expf(-g0[j])) * u0[j]; o[4 + j] = g1[j] * __builtin_amdgcn_rcpf(1.f + __expf(-g1[j])) * u1[j]; }
                    u32x4 w; w.x = cvt_pk_bf16(o[0], o[1]); w.y = cvt_pk_bf16(o[2], o[3]); w.z = cvt_pk_bf16(o[4], o[5]); w.w = cvt_pk_bf16(o[6], o[7]);
                    *(u32x4*)(Hact + (size_t)(slot0 + r) * DE + u.pn * 128 + wc * 32 + 8 * fq) = w;
                }
            }
    }
};
struct EpiDown {
    bf16_t* Y; const LAS int* mt;
    __device__ __forceinline__ void operator()(const f32x4 (&acc)[2][2][4][2], const gm::Unit& u, int wr, int wc, int fr, int fq) const {
        const int e = u.kind, valid = mt[e] - u.pm * 256, slot0 = mt[65 + e] + u.pm * 256;
#pragma unroll
        for (int ai = 0; ai < 2; ++ai)
#pragma unroll
            for (int m = 0; m < 4; ++m) {
                const int r = ai * 128 + wr * 64 + m * 16 + fr;
                if (r < valid) {
#pragma unroll
                    for (int bj = 0; bj < 2; ++bj) { const f32x4 v0 = acc[ai][bj][m][0], v1 = acc[ai][bj][m][1];
                        u32x4 w; w.x = cvt_pk_bf16(v0[0], v0[1]); w.y = cvt_pk_bf16(v0[2], v0[3]); w.z = cvt_pk_bf16(v1[0], v1[1]); w.w = cvt_pk_bf16(v1[2], v1[3]);
                        *(u32x4*)(Y + (size_t)(slot0 + r) * DM + u.pn * 256 + bj * 128 + wc * 32 + 8 * fq) = w; }
                }
            }
    }
};
__device__ __forceinline__ void final_rows(Frame& F, float* hio, const bf16_t* Y, const int* tok_e, const int* tok_pos, const float* tok_w, const float* fw, const LAS int* mt) {
    const int gw = F.vcu * NWAVES + F.wave, NGW = F.G * NWAVES, lane = F.lane;
    for (int t = gw; t < M; t += NGW) {
        const int e1 = tok_e[2 * t], e2 = tok_e[2 * t + 1];
        const size_t s1 = (size_t)(mt[65 + e1] + tok_pos[2 * t]), s2 = (size_t)(mt[65 + e2] + tok_pos[2 * t + 1]);
        const float w1 = tok_w[2 * t], w2 = tok_w[2 * t + 1];
        f32x4* hr = (f32x4*)(hio + (size_t)t * DM) + 2 * lane;
        const u32x4* y1 = (const u32x4*)(Y + s1 * DM) + lane; const u32x4* y2 = (const u32x4*)(Y + s2 * DM) + lane;
        float v[4][8]; float ss = 0.f;
#pragma unroll
        for (int j = 0; j < 4; ++j) {
            const f32x4 a0 = hr[128 * j], a1 = hr[128 * j + 1]; const u32x4 p = y1[64 * j], q = y2[64 * j];
            const float pa[8] = {bflo(p.x), bfhi(p.x), bflo(p.y), bfhi(p.y), bflo(p.z), bfhi(p.z), bflo(p.w), bfhi(p.w)};
            const float qa[8] = {bflo(q.x), bfhi(q.x), bflo(q.y), bfhi(q.y), bflo(q.z), bfhi(q.z), bflo(q.w), bfhi(q.w)};
            const float ha[8] = {a0[0], a0[1], a0[2], a0[3], a1[0], a1[1], a1[2], a1[3]};
#pragma unroll
            for (int k = 0; k < 8; ++k) { v[j][k] = ha[k] + (w1 * pa[k] + w2 * qa[k]); ss += v[j][k] * v[j][k]; }
        }
        ss = wave_sum(ss);
        const float rs = rsqrtf(ss * (1.f / DM) + EPS);
#pragma unroll
        for (int j = 0; j < 4; ++j) {
            const f32x4 g0 = *((const f32x4*)fw + 2 * lane + 128 * j), g1 = *((const f32x4*)fw + 2 * lane + 128 * j + 1);
            hr[128 * j] = (f32x4){v[j][0] * rs * g0[0], v[j][1] * rs * g0[1], v[j][2] * rs * g0[2], v[j][3] * rs * g0[3]};
            hr[128 * j + 1] = (f32x4){v[j][4] * rs * g1[0], v[j][5] * rs * g1[1], v[j][6] * rs * g1[2], v[j][7] * rs * g1[3]};
        }
    }
}

__device__ __forceinline__ void kmean_simple(Frame& F, const bf16_t* proj, float* kmean) {
    for (int gid = F.vcu * NWAVES * 64 + F.tid; gid < BATCH * NB * 1024; gid += F.G * NWAVES * 64) {
        const int col = gid & 1023, bb = gid >> 10; const bf16_t* p = proj + (size_t)bb * MB * LDP + C_K + col; float s = 0.f;
        for (int t = 0; t < MB; ++t) s += bf2f(p[(size_t)t * LDP]);
        kmean[gid] = s * (1.f / MB);
    }
}
__device__ __forceinline__ void router_rows(Frame& F, const float* h2, const float* wr, const float* b_rg, const float* b_re, float* rs2, int* cnt, int* list, int* tok_e, int* tok_pos, float* tok_w) {
    const int gw = F.vcu * NWAVES + F.wave, NGW = F.G * NWAVES, lane = F.lane;
    LAS float* lgl = (LAS float*)(F.lds + RING_OFF) + F.wave * 64;
    for (int t = gw; t < M; t += NGW) {
        const f32x4* hr = (const f32x4*)(h2 + (size_t)t * DM) + lane;
        f32x4 v[8]; float ss = 0.f;
#pragma unroll
        for (int j = 0; j < 8; ++j) { v[j] = hr[64 * j]; ss += (v[j][0] * v[j][0] + v[j][1] * v[j][1]) + (v[j][2] * v[j][2] + v[j][3] * v[j][3]); }
        ss = wave_sum(ss); const float rs = rsqrtf(ss * (1.f / DM) + EPS);
        LDS_WAIT();
#pragma unroll 1
        for (int n = 0; n < 36; ++n) { const f32x4* w = (const f32x4*)(wr + (size_t)n * DM) + lane; float d = 0.f;
#pragma unroll
            for (int j = 0; j < 8; ++j) { const f32x4 ww = w[64 * j]; d += (v[j][0] * ww[0] + v[j][1] * ww[1]) + (v[j][2] * ww[2] + v[j][3] * ww[3]); }
            d = wave_sum(d) * rs; if (lane == 0) lgl[n] = d; }
        LDS_WAIT();
        float gm_ = -INFINITY; int gi = 0; float g[4];
#pragma unroll
        for (int i = 0; i < 4; ++i) { g[i] = lgl[i] + b_rg[i]; if (g[i] > gm_) { gm_ = g[i]; gi = i; } }
        float gs = 0.f;
#pragma unroll
        for (int i = 0; i < 4; ++i) gs += __expf(g[i] - gm_);
        const float gwt = 1.f / gs;
        float e1 = -INFINITY, e2 = -INFINITY; int i1 = 0, i2 = 0;
#pragma unroll
        for (int i = 0; i < 8; ++i) { const float vv = lgl[4 + gi * 8 + i] + b_re[gi * 8 + i]; if (vv > e1) { e2 = e1; i2 = i1; e1 = vv; i1 = i; } else if (vv > e2) { e2 = vv; i2 = i; } }
        const float p2 = 1.f / (1.f + __expf(e1 - e2)), p1 = 1.f - p2;
        const int ea = gi * 8 + i1, eb = gi * 8 + i2;
        if (lane == 0) {
            const int pa = atomicAdd(&cnt[ea], 1), pb = atomicAdd(&cnt[eb], 1);
            list[ea * M + pa] = t; list[eb * M + pb] = t;
            tok_e[t * 2] = ea; tok_e[t * 2 + 1] = eb; tok_pos[t * 2] = pa; tok_pos[t * 2 + 1] = pb; tok_w[t * 2] = gwt * p1; tok_w[t * 2 + 1] = gwt * p2; rs2[t] = rs;
        }
    }
}

__device__ __forceinline__ void gnorm_rows(Frame& F, const float* ssq, bf16_t* mixb) {
    const int gw = F.vcu * NWAVES + F.wave, NGW = F.G * NWAVES, lane = F.lane;
    for (int it = gw; it < M * SG; it += NGW) {
        const int g = it & 3; const size_t tok = it >> 2;
        const float part = lane < 16 ? ssq[tok * 64 + g * 16 + lane] : 0.f;
        const float rs = rsqrtf(wave_sum(part) * (1.f / 512.f) + EPS);
        u32x4* p = (u32x4*)(mixb + tok * MIXW + AW + g * 512) + lane;
        const u32x4 w = *p; u32x4 o;
        o.x = cvt_pk_bf16(bflo(w.x) * rs, bfhi(w.x) * rs); o.y = cvt_pk_bf16(bflo(w.y) * rs, bfhi(w.y) * rs); o.z = cvt_pk_bf16(bflo(w.z) * rs, bfhi(w.z) * rs); o.w = cvt_pk_bf16(bflo(w.w) * rs, bfhi(w.w) * rs);
        *p = o;
    }
}

#ifndef REP_P0
#define REP_P0 1
#endif
#ifndef REP_G1
#define REP_G1 1
#endif
#ifndef REP_SSD
#define REP_SSD 1
#endif
#ifndef REP_MOE
#define REP_MOE 1
#endif
__global__ void __launch_bounds__(NWAVES * 64, 2) fwd(Args args) {
    extern __shared__ __attribute__((aligned(16))) unsigned char lds_raw[];
    Frame F;
    F.lds = (LAS unsigned char*)lds_raw;
    F.MISC = (volatile LAS unsigned*)(F.lds + MISC_OFF);
    F.tid = threadIdx.x; F.lane = F.tid & 63; F.wave = __builtin_amdgcn_readfirstlane(F.tid >> 6);
    F.G = gridDim.x; { const int bx = blockIdx.x; F.vcu = (F.G % 8 == 0) ? (bx % 8) * (F.G / 8) + bx / 8 : bx; }
    for (int u = F.tid; u < (LDS_BYTES - LDSCTL_OFF) / 4; u += NWAVES * 64) ((LAS unsigned*)(F.lds + LDSCTL_OFF))[u] = 0u;
    __syncthreads();
    (void)xcd_barrier_post((unsigned*)(args.ws + WS_CTL) + CW_BAR + args.li * XCD_BAR_WORDS, F.MISC + 8);
#define GRID_BAR() do { GAS unsigned char* wb_ = (GAS unsigned char*)args.ws; asm volatile("" : "+s"(wb_)); XcdBarrier b_; \
        b_.bar = (unsigned*)((unsigned char*)wb_ + WS_CTL) + CW_BAR + args.li * XCD_BAR_WORDS; b_.x = xb_xcc_id(); b_.st = F.MISC + 8; xcd_barrier(b_, F.wave * 64 + lane_id_now()); } while (0)
    const int lo = args.ph_lo, hi = args.ph_hi;
#define IN(k) (lo <= (k) && (k) < hi)
#define BOTH(k) (IN(k) && IN((k) + 1))
#define PHASE_WS() F.lane = lane_id_now(); F.tid = F.wave * 64 + F.lane; GAS unsigned char* wsg_ = (GAS unsigned char*)args.ws; asm volatile("" : "+s"(wsg_)); unsigned char* ws = (unsigned char*)wsg_
    if (IN(0)) { F.lane = lane_id_now(); F.tid = F.wave * 64 + F.lane;
p0_prologue(F, args); if constexpr (REP_P0 > 1) p0_prologue(F, args); if (BOTH(0)) GRID_BAR(); }
    if (IN(1)) {
        PHASE_WS();
        SchedG1 S{(const char*)(ws + WS_XB), (const char*)(ws + WS_WIN_T), F.G, (int)blockIdx.x};
        EpiG1 E{(bf16_t*)(ws + WS_PROJ), (float*)(ws + WS_DTRAW), (const float*)(ws + WS_RSX), (const float*)(ws + WS_ROPE)};
gm::gemm_phase<EpiG1, SchedG1, false>(F.tid, F.lds + RING_OFF, (const LAS int*)(F.lds + TAB_OFF), DM, S, E);
        if constexpr (REP_G1 > 1) { __syncthreads(); gm::gemm_phase<EpiG1, SchedG1, false>(F.tid, F.lds + RING_OFF, (const LAS int*)(F.lds + TAB_OFF), DM, S, E); }
        if (BOTH(1)) GRID_BAR();
    }
    if (IN(2)) {
        PHASE_WS();
        kmean_simple(F, (const bf16_t*)(ws + WS_PROJ), (float*)(ws + WS_KMEAN));
        for (int L = F.vcu; L < BATCH * SH; L += F.G)
            sd::ssd_unit(F.tid, L / SH, L % SH, (const bf16_t*)(ws + WS_PROJ), (const float*)(ws + WS_DTRAW), args.in[4], args.in[5], args.in[6], args.in[7], args.in[8],
                         (bf16_t*)(ws + WS_MIXB), (float*)(ws + WS_SS), (LAS char*)(F.lds + RING_OFF));
        if (BOTH(2)) GRID_BAR();
    }
    if (IN(3)) {
        PHASE_WS();
        for (int L = F.vcu; L < BATCH * AH * 4; L += F.G) {
            const int b = L >> 5, h = (L >> 2) & 7, pi = L & 3;
            const bf16_t* pb = (const bf16_t*)(ws + WS_PROJ) + (size_t)b * SEQ * LDP + h * HD;
#pragma unroll 1
            for (int k = 0; k < 2; ++k) { const int jb = k ? pi : 7 - pi;
                at::attn_unit<true>(F.tid, pb + (size_t)jb * MB * LDP + C_Q, pb + C_K, (bf16_t*)(ws + WS_MIXB) + (size_t)(b * SEQ + jb * MB) * MIXW + h * HD,
                                    4 * (jb + 1), jb, (const float*)(ws + WS_KMEAN) + (size_t)b * NB * 1024 + h * HD, (LAS char*)(F.lds + RING_OFF)); }
        }
        __syncthreads();
        gnorm_rows(F, (const float*)(ws + WS_SS), (bf16_t*)(ws + WS_MIXB));
        if (BOTH(3)) GRID_BAR();
    }
    if (IN(4)) {
        PHASE_WS();
        SchedTiles S{(const char*)(ws + WS_MIXB), (const char*)(ws + WS_WOUT_T), 64, 8, MIXW, F.G, (int)blockIdx.x};
        EpiRes E{args.in[0], args.out, (bf16_t*)(ws + WS_XB), (float*)(ws + WS_SS)};
        gm::gemm_phase<EpiRes, SchedTiles, false>(F.tid, F.lds + RING_OFF, (const LAS int*)(F.lds + TAB_OFF), MIXW, S, E);
        if (BOTH(4)) GRID_BAR();
    }
    if (IN(5)) {
        PHASE_WS();
        SchedQKV S{(const char*)(ws + WS_XB), (const char*)(ws + WS_WCQ_T), (const char*)(ws + WS_MEMB), (const char*)(ws + WS_WCKV_T), F.G, (int)blockIdx.x};
        gm::Unit u0; LAS float* rsl = (LAS float*)(F.lds + RSL_OFF);
        if (S.next(0, u0) && F.tid < 256) {
            const int row = u0.pm * 256 + F.tid;
            if (u0.kind == 0) { const f32x4* p = (const f32x4*)((const float*)(ws + WS_SS) + (size_t)row * 32); float q = 0.f;
#pragma unroll
                for (int j = 0; j < 8; ++j) { const f32x4 v = p[j]; q += (v[0] + v[1]) + (v[2] + v[3]); }
                rsl[F.tid] = rsqrtf(q * (1.f / DM) + EPS); }
            else rsl[F.tid] = ((const float*)(ws + WS_RSMEM))[row];
        }
        VM_WAIT(); LDS_WAIT(); __syncthreads();
        EpiScale E{(bf16_t*)(ws + WS_QC), (bf16_t*)(ws + WS_KVC), CW, 2 * CW, rsl};
        gm::gemm_phase<EpiScale, SchedQKV, false>(F.tid, F.lds + RING_OFF, (const LAS int*)(F.lds + TAB_OFF), DM, S, E);
        if (BOTH(5)) GRID_BAR();
    }
    if (IN(6)) {
        PHASE_WS();
        for (int L = F.vcu; L < BATCH * CH * 8; L += F.G) {
            const int b = L >> 5, h = (L >> 3) & 3, qt = L & 7;
            const bf16_t* kb_ = (const bf16_t*)(ws + WS_KVC) + (size_t)b * MEM * (2 * CW) + h * CHD;
            at::attn_unit<false>(F.tid, (const bf16_t*)(ws + WS_QC) + (size_t)(b * SEQ + qt * 256) * CW + h * CHD, kb_,
                                 (bf16_t*)(ws + WS_OC) + (size_t)(b * SEQ + qt * 256) * CW + h * CHD, 4, 0, nullptr, (LAS char*)(F.lds + RING_OFF));
        }
        __syncthreads();
        if (BOTH(6)) GRID_BAR();
    }
    if (IN(7)) {
        PHASE_WS();
        SchedTiles S{(const char*)(ws + WS_OC), (const char*)(ws + WS_WCO_T), 64, 8, CW, F.G, (int)blockIdx.x};
        EpiRes E{args.out, args.out, (bf16_t*)(ws + WS_XB), (float*)(ws + WS_SS) + (size_t)M * 32};
        gm::gemm_phase<EpiRes, SchedTiles, false>(F.tid, F.lds + RING_OFF, (const LAS int*)(F.lds + TAB_OFF), CW, S, E);
        if (BOTH(7)) GRID_BAR();
    }
    if (IN(8)) {
        PHASE_WS();
        int* tok_e = (int*)(ws + WS_TOK);
        router_rows(F, args.out, (const float*)(ws + WS_WR), args.in[20], args.in[22], (float*)(ws + WS_RS2), (int*)(ws + WS_CTL) + CW_CNT, (int*)(ws + WS_LIST), tok_e, tok_e + 2 * M, (float*)(tok_e + 4 * M));
        if (BOTH(8)) GRID_BAR();
    }
    if (IN(9)) {
        PHASE_WS();
        LAS int* mt = (LAS int*)(F.lds + MOE_OFF); LAS int* tab = (LAS int*)(F.lds + TAB_OFF);
        moe_tables(mt, (const int*)(ws + WS_CTL) + CW_CNT, F.tid);
        SchedMoE<true> S{mt, (const char*)(ws + WS_XB), (const char*)(ws + WS_WGU_T), F.G, F.vcu};
        { const int* list = (const int*)(ws + WS_LIST); gm::Unit u;
          for (int i = 0; i < 8 && S.next(i, u); ++i) if (F.tid < 256) { const int rg = u.pm * 256 + F.tid; tab[i * 256 + F.tid] = list[u.kind * M + (rg < mt[u.kind] ? rg : 0)]; } }
        VM_WAIT(); LDS_WAIT(); __syncthreads();
        EpiGU E{(bf16_t*)(ws + WS_HACT), (const float*)(ws + WS_RS2), mt, tab};
gm::gemm_phase<EpiGU, SchedMoE<true>, true>(F.tid, F.lds + RING_OFF, tab, DM, S, E);
        if constexpr (REP_MOE > 1) { __syncthreads(); gm::gemm_phase<EpiGU, SchedMoE<true>, true>(F.tid, F.lds + RING_OFF, tab, DM, S, E); }
        if (BOTH(9)) GRID_BAR();
    }
    if (IN(10)) {
        PHASE_WS();
        LAS int* mt = (LAS int*)(F.lds + MOE_OFF);
        moe_tables(mt, (const int*)(ws + WS_CTL) + CW_CNT, F.tid);
        SchedMoE<false> S{mt, (const char*)(ws + WS_HACT), (const char*)(ws + WS_WD_T), F.G, F.vcu};
        EpiDown E{(bf16_t*)(ws + WS_Y), mt};
gm::gemm_phase<EpiDown, SchedMoE<false>, false>(F.tid, F.lds + RING_OFF, (const LAS int*)(F.lds + TAB_OFF), DE, S, E);
        if constexpr (REP_MOE > 1) { __syncthreads(); gm::gemm_phase<EpiDown, SchedMoE<false>, false>(F.tid, F.lds + RING_OFF, (const LAS int*)(F.lds + TAB_OFF), DE, S, E); }
        if (BOTH(10)) GRID_BAR();
    }
    if (IN(11)) {
        PHASE_WS();
        LAS int* mt = (LAS int*)(F.lds + MOE_OFF);
        moe_tables(mt, (const int*)(ws + WS_CTL) + CW_CNT, F.tid);
        const int* tok_e = (const int*)(ws + WS_TOK);
        final_rows(F, args.out, (const bf16_t*)(ws + WS_Y), tok_e, tok_e + 2 * M, (const float*)(tok_e + 4 * M), args.in[26], mt);
    }
#undef IN
#undef BOTH
}
extern "C" void kernel_launch(void* const* d_in, const int* in_sizes, int n_in, void* d_out, int out_size, void* d_ws, size_t ws_size, hipStream_t stream) {
  static int grid = 0;
  static float rfv[16];
  if (grid == 0) {
    int dev = 0, cus = 0;
    if (hipGetDevice(&dev) != hipSuccess || hipDeviceGetAttribute(&cus, hipDeviceAttributeMultiprocessorCount, dev) != hipSuccess) { fprintf(stderr, "kernel_launch: device query failed\n"); grid = -1; return; }
    if (hipFuncSetAttribute((const void*)fwd, hipFuncAttributeMaxDynamicSharedMemorySize, LDS_BYTES) != hipSuccess) { fprintf(stderr, "kernel_launch: hipFuncSetAttribute failed\n"); grid = -1; return; }
    int per_cu = 0;
    if (hipOccupancyMaxActiveBlocksPerMultiprocessor(&per_cu, (const void*)fwd, NWAVES * 64, LDS_BYTES) != hipSuccess || per_cu < 1) fprintf(stderr, "kernel_launch: occupancy query says %d\n", per_cu);
    (void)hipGetLastError();
    for (int i = 0; i < 16; ++i) rfv[i] = (float)pow(500000.0, -(double)i / 16.0);
    grid = cus;
  }
  if (grid < 0) return;
  float* out = (float*)d_out;
  unsigned char* ws = (unsigned char*)d_ws;
  (void)hipMemsetAsync(ws + WS_CTL, 0, CTL_ZERO_BYTES, stream);
  Args a{};
  for (int i = 0; i < 27; ++i) a.in[i] = (const float*)d_in[i];
  a.out = out; a.ws = ws; for (int i = 0; i < 16; ++i) a.rf[i] = rfv[i];
  a.ph_lo = 0; a.ph_hi = 12; a.li = 0;
  hipLaunchKernelGGL(fwd, dim3(grid), dim3(NWAVES * 64), LDS_BYTES, stream, a);
}
```

```cpp
#include <hip/hip_runtime.h>
#include <stdint.h>
#include <math.h>
#include <cstdio>

constexpr int DM = 2048, BATCH = 8, SEQ = 2048, M = BATCH * SEQ, MEM = 256, MROWS = BATCH * MEM;
constexpr float EPS = 1e-6f;
constexpr int AH = 8, HD = 128, AW = 1024;
constexpr int MB = 256, NB = SEQ / MB;
constexpr int SW = 2048, SH = 32, SG = 4, SCONV = 4, CONVD = 3072;
constexpr int MIXW = 3072, INW = 8224, LDP = 8448;
constexpr int C_Q = 0, C_K = 1024, C_V = 2048, C_Z = 3072, C_XBC = 5120, C_DT = 8192;
constexpr int CH = 4, CHD = 128, CW = 512;
constexpr int NG = 4, EPG = 8, NE = 32, DE = 1024;

#define LAS __attribute__((address_space(3)))
#define GAS __attribute__((address_space(1)))
typedef unsigned short bf16_t;
typedef short bf16x8 __attribute__((ext_vector_type(8)));
typedef float f32x4 __attribute__((ext_vector_type(4)));
typedef float f32x2 __attribute__((ext_vector_type(2)));
typedef unsigned u32x4 __attribute__((ext_vector_type(4)));
typedef unsigned u32x2 __attribute__((ext_vector_type(2)));
#define LDS_WAIT() asm volatile("s_waitcnt lgkmcnt(0)" ::: "memory")
#define VM_WAIT() asm volatile("s_waitcnt vmcnt(0)" ::: "memory")

__device__ __forceinline__ unsigned cvt_pk_bf16(float lo, float hi) { unsigned r; asm volatile("v_cvt_pk_bf16_f32 %0, %1, %2" : "=v"(r) : "v"(lo), "v"(hi)); return r; }
__device__ __forceinline__ float bf2f(bf16_t b) { return __uint_as_float(((unsigned)b) << 16); }
__device__ __forceinline__ float bflo(unsigned w) { return __uint_as_float(w << 16); }
__device__ __forceinline__ float bfhi(unsigned w) { return __uint_as_float(w & 0xffff0000u); }
__device__ __forceinline__ void ld8bf(const bf16_t* p, float (&o)[8]) { const u32x4 w = *(const u32x4*)p; o[0] = bflo(w.x); o[1] = bfhi(w.x); o[2] = bflo(w.y); o[3] = bfhi(w.y); o[4] = bflo(w.z); o[5] = bfhi(w.z); o[6] = bflo(w.w); o[7] = bfhi(w.w); }
__device__ __forceinline__ float wave_sum(float v) {
#pragma unroll
  for (int o = 1; o < 64; o <<= 1) v += __shfl_xor(v, o);
  return v;
}
__device__ __forceinline__ float wave_max(float v) {
#pragma unroll
  for (int o = 1; o < 64; o <<= 1) v = fmaxf(v, __shfl_xor(v, o));
  return v;
}
__device__ __forceinline__ int lane_id_now() { int l; asm volatile("v_mbcnt_lo_u32_b32 %0, -1, 0\n\tv_mbcnt_hi_u32_b32 %0, -1, %0" : "=v"(l)); return l; }
__device__ __forceinline__ float silu_f(float x) { return x / (1.f + __expf(-x)); }

constexpr size_t MiB = 1u << 20;
constexpr size_t WS_CTL = 0, CTL_ZERO_BYTES = 1 * MiB;
constexpr int CW_BAR = 4096;
constexpr int CW_CNT = 65536;
constexpr size_t WS_WIN_T = 1 * MiB;
constexpr size_t WS_WOUT_T = 34 * MiB;
constexpr size_t WS_WCQ_T = 46 * MiB;
constexpr size_t WS_WCKV_T = 48 * MiB;
constexpr size_t WS_WCO_T = 52 * MiB;
constexpr size_t WS_WR = 54 * MiB;
constexpr size_t WS_SMALL = 55 * MiB;
constexpr size_t WS_ROPE = WS_SMALL, WS_RSX = WS_SMALL + 256 * 1024, WS_RSMEM = WS_RSX + 64 * 1024, WS_RS2 = WS_RSMEM + 64 * 1024, WS_KMEAN = WS_RS2 + 64 * 1024;
constexpr size_t WS_DTRAW = 56 * MiB;
constexpr size_t WS_SS = 58 * MiB;
constexpr size_t WS_MEMB = 62 * MiB;
constexpr size_t WS_XB = 70 * MiB;
constexpr size_t WS_PROJ = 134 * MiB;
constexpr size_t WS_MIXB = 398 * MiB;
constexpr size_t WS_QC = 494 * MiB, WS_OC = 510 * MiB;
constexpr size_t WS_KVC = 526 * MiB;
constexpr size_t WS_WGU_T = 530 * MiB;
constexpr size_t WS_WD_T = 786 * MiB;
constexpr size_t WS_LIST = 914 * MiB;
constexpr size_t WS_TOK = 916 * MiB;
constexpr size_t WS_HACT = WS_PROJ;
constexpr size_t WS_Y = WS_PROJ + 66 * MiB;
constexpr size_t WS_XBCC = 918 * MiB;
constexpr size_t WS_AFTER = 1014 * MiB;
#define XB_TMO      128
#define XB_XCNT(j)  (256  + 64 * (j))
#define XB_XSUB(j)  (1280 + 64 * (j))
#define XB_XGEN(j)  (2304 + 64 * (j))
#define XB_TOP      3328
#define XB_TOPGEN   3392
#define XCD_BAR_WORDS 3456
#define XB_SPIN_CAP (1u << 18)

__device__ __forceinline__ unsigned xb_ld(unsigned* p)              { return __hip_atomic_load(p, __ATOMIC_RELAXED, __HIP_MEMORY_SCOPE_AGENT); }
__device__ __forceinline__ unsigned xb_add(unsigned* p, unsigned v) { return __hip_atomic_fetch_add(p, v, __ATOMIC_RELAXED, __HIP_MEMORY_SCOPE_AGENT); }
__device__ __forceinline__ unsigned xb_xcc_id() { return (unsigned)__builtin_amdgcn_s_getreg((3 << 11) | 20) & 0xFu; }
#define XB_SPIN(cond, bar) do { unsigned _sp = 0; while (cond) { __builtin_amdgcn_s_sleep(1); \
    if ((++_sp & 255u) == 0u) { if (xb_ld(&(bar)[XB_TMO])) break; if (_sp > XB_SPIN_CAP) { atomicAdd(&(bar)[XB_TMO], 1u); break; } } } } while (0)

struct XcdBarrier {
    unsigned* bar; unsigned x;
    volatile LAS unsigned* st;
};

__device__ __forceinline__ XcdBarrier xcd_barrier_post(unsigned* bar, volatile LAS unsigned* st) {
    XcdBarrier b; b.bar = bar; b.x = xb_xcc_id(); b.st = st;
    if (threadIdx.x == 0) (void)xb_add(&bar[XB_XCNT(b.x)], 1u);
    return b;
}
__device__ __forceinline__ void xcd_barrier_complete(unsigned* bar, unsigned x, unsigned& nloc, unsigned& nx) {
    const unsigned G = gridDim.x * gridDim.y * gridDim.z;
    unsigned sum, cnt, mine, sp = 0u;
    for (;;) {
        sum = 0u; cnt = 0u; mine = 0u;
#pragma unroll
        for (unsigned j = 0; j < 16; ++j) { const unsigned c = xb_ld(&bar[XB_XCNT(j)]); sum += c; cnt += (c > 0u) ? 1u : 0u; mine = (j == x) ? c : mine; }
        if (sum == G) break;
        __builtin_amdgcn_s_sleep(1);
        if ((++sp & 255u) == 0u) { if (xb_ld(&bar[XB_TMO])) break; if (sp > XB_SPIN_CAP) { atomicAdd(&bar[XB_TMO], 1u); break; } }
    }
    nloc = mine > 0u ? mine : 1u; nx = cnt > 0u ? cnt : 1u;
}

__device__ __forceinline__ void xcd_barrier(const XcdBarrier& b, const int xb_tid) {
    asm volatile("s_waitcnt vmcnt(0)" ::: "memory");
    __syncthreads();
    if (xb_tid == 0) {
        unsigned* bar = b.bar;
        __builtin_amdgcn_s_waitcnt(0);
        unsigned nloc = b.st[0], nx = b.st[1];
        if (nloc == 0u) { xcd_barrier_complete(bar, b.x, nloc, nx); b.st[0] = nloc; b.st[1] = nx; }
        const unsigned old = xb_add(&bar[XB_XSUB(b.x)], 1u);
        const unsigned gen = old / nloc;
        if (old + 1u == (gen + 1u) * nloc) {
            __builtin_amdgcn_fence(__ATOMIC_RELEASE, "agent");
            asm volatile("s_waitcnt vmcnt(0)" ::: "memory");
            const unsigned og = xb_add(&bar[XB_TOP], 1u);
            const unsigned tg = og / nx;
            if (og + 1u == (tg + 1u) * nx) xb_add(&bar[XB_TOPGEN], 1u);
            else XB_SPIN(xb_ld(&bar[XB_TOPGEN]) == tg, bar);
            __builtin_amdgcn_fence(__ATOMIC_ACQUIRE, "agent");
            xb_add(&bar[XB_XGEN(b.x)], 1u);
            asm volatile("s_waitcnt vmcnt(0)" ::: "memory");
        } else {
            XB_SPIN(xb_ld(&bar[XB_XGEN(b.x)]) == gen, bar);
            __builtin_amdgcn_fence(__ATOMIC_ACQUIRE, "agent");
            asm volatile("s_waitcnt vmcnt(0)" ::: "memory");
        }
    }
    __syncthreads();
}

namespace gm {
constexpr int BM = 256, BK = 64, HALF = 128, HTB = HALF * BK * 2, STAGE_BYTES = 8 * HTB, NXCD = 8, WGM = 8;
__host__ __device__ __forceinline__ int lds_byte(int r, int c) { const int st = (r >> 4) * 2 + (c >> 5), rr = r & 15, cc = c & 31, ob = rr * 64 + cc * 2; return st * 1024 + (ob ^ (((ob >> 9) & 1) << 5)); }
__host__ __device__ __forceinline__ void stage_rc(int b, int& R, int& C) { const int st = b / 1024, sb = b % 1024, swz = sb ^ (((sb >> 9) & 1) << 5); R = (st >> 1) * 16 + swz / 64; C = (st & 1) * 32 + (swz % 64) / 2; }
__host__ __device__ __forceinline__ int perm32(int rho) { const int n = rho >> 4, i = rho & 15; return 8 * (i >> 2) + 4 * n + (i & 3); }

struct Unit { const char* a; const char* b; int pm, pn, kind, ti; };

__device__ __forceinline__ void tile_of(int L, int nM, int nN, int& pm, int& pn) {
    const int nwg = nM * nN; int wgid = L;
    { const int q = nwg / NXCD, r = nwg % NXCD, xcd = wgid % NXCD, off = wgid / NXCD; wgid = (xcd < r ? xcd * (q + 1) : r * (q + 1) + (xcd - r) * q) + off; }
    const int nig = WGM * nN, gid = wgid / nig, fm = gid * WGM, gsz = (nM - fm) < WGM ? (nM - fm) : WGM;
    pm = fm + ((wgid % nig) % gsz); pn = (wgid % nig) / gsz;
}

template <class Epi, class Sched, bool GATHER>
__device__ __forceinline__ void gemm_phase(const int tid, LAS unsigned char* lds, const LAS int* tab, const int K, const Sched& S, const Epi& E) {
    const int wid = __builtin_amdgcn_readfirstlane(tid >> 6), lane = tid & 63, wr = wid >> 2, wc = wid & 3, fr = lane & 15, fq = lane >> 4;
    const int nt = K / BK;
    unsigned voffA0[2], voffA1[2], voffB[2];
    const size_t kstep = (size_t)(BK * 2);
    const size_t hstep = (size_t)HALF * K * 2;
#pragma unroll
    for (int i = 0; i < 2; ++i) { int R, C; stage_rc(tid * 16 + i * 8192, R, C); const int Rb = (R & ~31) + perm32(R & 31);
        voffB[i] = (unsigned)(Rb * K + C) * 2u; voffA0[i] = (unsigned)(R * K + C) * 2u; voffA1[i] = 0u; }
#define GM_SETVOFF(u) do { if constexpr (GATHER) { _Pragma("unroll") for (int _i = 0; _i < 2; ++_i) { int R_, C_; stage_rc(tid * 16 + _i * 8192, R_, C_); \
        const int r0_ = tab[(u).ti * 256 + R_], r1_ = tab[(u).ti * 256 + 128 + R_]; voffA0[_i] = (unsigned)(r0_ * K + C_) * 2u; voffA1[_i] = (unsigned)(r1_ * K + C_) * 2u; } } } while (0)
    const unsigned ldsw = (unsigned)wid * 1024u;
    const int aoff = lds_byte(wr * 64 + fr, fq * 8), boff = lds_byte(wc * 32 + fr, fq * 8);
#define PG8_SA(b, h) (((b) * 2 + (h)) * HTB)
#define PG8_SB(b, h) ((4 + (b) * 2 + (h)) * HTB)
#define PG8_STAGE(bufoff, gbase, voff) do { _Pragma("unroll") for (int _i = 0; _i < 2; ++_i) \
        __builtin_amdgcn_global_load_lds((const unsigned*)((const char*)(gbase) + (voff)[_i]), (LAS unsigned*)(lds + (bufoff) + ldsw + _i * 8192), 16, 0, 0); } while (0)
#define PG8_LDA(dst, b, h) do { _Pragma("unroll") for (int m = 0; m < 4; ++m) _Pragma("unroll") for (int k = 0; k < 2; ++k) dst[m][k] = *(const LAS bf16x8*)(lds + PG8_SA(b, h) + aoff + m * 2048 + k * 1024); } while (0)
#define PG8_LDB(dst, b, h) do { _Pragma("unroll") for (int n = 0; n < 2; ++n) _Pragma("unroll") for (int k = 0; k < 2; ++k) dst[n][k] = *(const LAS bf16x8*)(lds + PG8_SB(b, h) + boff + n * 2048 + k * 1024); } while (0)
#define PG8_MMA(ai, bj, At, Bt) do { __builtin_amdgcn_s_setprio(1); _Pragma("unroll") for (int m = 0; m < 4; ++m) _Pragma("unroll") for (int n = 0; n < 2; ++n) _Pragma("unroll") for (int k = 0; k < 2; ++k) \
        acc[ai][bj][m][n] = __builtin_amdgcn_mfma_f32_16x16x32_bf16(Bt[n][k], At[m][k], acc[ai][bj][m][n], 0, 0, 0); __builtin_amdgcn_s_setprio(0); } while (0)
#define GM_STAGE_A1(bufoff, gbase) do { if constexpr (GATHER) { PG8_STAGE(bufoff, gbase, voffA1); } else { PG8_STAGE(bufoff, (gbase) + hstep, voffA0); } } while (0)
#define PG8_WAIT_V(n) asm volatile("s_waitcnt vmcnt(" #n ")" ::: "memory")
#define PG8_WAIT_L(n) asm volatile("s_waitcnt lgkmcnt(" #n ")" ::: "memory")
#define PG8_BAR __builtin_amdgcn_s_barrier()
#define PG8_SCHED __builtin_amdgcn_sched_barrier(0)
    Unit cur, nxt; int ui = 0;
    if (!S.next(0, cur)) return;
    GM_SETVOFF(cur);
    f32x4 acc[2][2][4][2];
#pragma unroll
    for (int a = 0; a < 2; ++a)
#pragma unroll
        for (int b = 0; b < 2; ++b)
#pragma unroll
            for (int m = 0; m < 4; ++m)
#pragma unroll
                for (int n = 0; n < 2; ++n) acc[a][b][m][n] = (f32x4){0.f, 0.f, 0.f, 0.f};
    bf16x8 At[4][2], B0[2][2], B1[2][2];
    const char* cA = cur.a; const char* cB = cur.b;
    PG8_STAGE(PG8_SB(0, 0), cB, voffB); PG8_STAGE(PG8_SB(0, 1), cB + hstep, voffB); PG8_STAGE(PG8_SA(0, 0), cA, voffA0); GM_STAGE_A1(PG8_SA(0, 1), cA);
    if (wr == 1) PG8_BAR;
    PG8_WAIT_V(2); PG8_BAR;
    PG8_STAGE(PG8_SB(1, 0), cB + kstep, voffB); PG8_STAGE(PG8_SA(1, 0), cA + kstep, voffA0); PG8_STAGE(PG8_SB(1, 1), cB + hstep + kstep, voffB);
    PG8_WAIT_V(6); PG8_BAR;
    for (;;) {
        const bool has_next = S.next(ui + 1, nxt);
        const char* nA = has_next ? nxt.a : cA; const char* nB = has_next ? nxt.b : cB;
        for (int t = 0; t < nt; t += 2) {
            const bool last = (t == nt - 2);
            const char* a1 = cA + (size_t)(t + 1) * kstep;
            const char* a2 = last ? nA : cA + (size_t)(t + 2) * kstep; const char* b2 = last ? nB : cB + (size_t)(t + 2) * kstep;
            const char* a3 = a2 + kstep; const char* b3 = b2 + kstep;
            PG8_LDB(B0, 0, 0); PG8_LDB(B1, 0, 1); PG8_SCHED; PG8_LDA(At, 0, 0); GM_STAGE_A1(PG8_SA(1, 1), a1);
            PG8_WAIT_V(8); PG8_WAIT_L(0); PG8_BAR; PG8_MMA(0, 0, At, B0); PG8_MMA(0, 1, At, B1); PG8_BAR; PG8_SCHED;
            if constexpr (GATHER) { if (last && has_next) { GM_SETVOFF(nxt); } }
            PG8_LDA(At, 0, 1); PG8_STAGE(PG8_SB(0, 0), b2, voffB); PG8_STAGE(PG8_SB(0, 1), b2 + hstep, voffB); PG8_STAGE(PG8_SA(0, 0), a2, voffA0);
            PG8_WAIT_V(8); PG8_WAIT_L(0); PG8_BAR; PG8_MMA(1, 0, At, B0); PG8_MMA(1, 1, At, B1); PG8_BAR; PG8_SCHED;
            PG8_LDB(B0, 1, 0); PG8_LDB(B1, 1, 1); PG8_SCHED; PG8_LDA(At, 1, 0); GM_STAGE_A1(PG8_SA(0, 1), a2);
            PG8_WAIT_V(8); PG8_WAIT_L(0); PG8_BAR; PG8_MMA(0, 0, At, B0); PG8_MMA(0, 1, At, B1); PG8_BAR; PG8_SCHED;
            PG8_LDA(At, 1, 1); PG8_STAGE(PG8_SB(1, 0), b3, voffB); PG8_STAGE(PG8_SB(1, 1), b3 + hstep, voffB); PG8_STAGE(PG8_SA(1, 0), a3, voffA0);
            PG8_WAIT_V(8); PG8_WAIT_L(0); PG8_BAR; PG8_MMA(1, 0, At, B0); PG8_MMA(1, 1, At, B1); PG8_BAR; PG8_SCHED;
        }
        if (wr == 0) PG8_BAR;
        E(acc, cur, wr, wc, fr, fq);
        if (!has_next) break;
#pragma unroll
        for (int a = 0; a < 2; ++a)
#pragma unroll
            for (int b = 0; b < 2; ++b)
#pragma unroll
                for (int m = 0; m < 4; ++m)
#pragma unroll
                    for (int n = 0; n < 2; ++n) acc[a][b][m][n] = (f32x4){0.f, 0.f, 0.f, 0.f};
        cur = nxt; cA = nA; cB = nB; ++ui;
        if (wr == 1) PG8_BAR;
    }
    PG8_WAIT_V(0);
    PG8_BAR;
#undef GM_SETVOFF
#undef GM_STAGE_A1
#undef PG8_SA
#undef PG8_SB
#undef PG8_STAGE
#undef PG8_LDA
#undef PG8_LDB
#undef PG8_MMA
#undef PG8_WAIT_V
#undef PG8_WAIT_L
#undef PG8_BAR
#undef PG8_SCHED
}
}
namespace at {
using f32x16 = __attribute__((ext_vector_type(16))) float;
using s16x4 = __attribute__((ext_vector_type(4))) short;
constexpr int D = 128, NW = 8, QBLK = 32, KVBLK = 64;
constexpr float SCALE = 0.088388347648318440f;
constexpr float THR = 8.f;
constexpr int SHM_V = KVBLK * D * 2, SHM_K = KVBLK * D * 2, SHM_ATTN = 2 * SHM_V + 2 * SHM_K + NW * 64 * 4;
constexpr int KM_OFF = SHM_ATTN;
constexpr int QL_OFF = KM_OFF + 4096;
#define KSWZ(row, colB) ((row) * 256 + ((colB) ^ (((row) & 7) << 4)))
#define SBAR() __builtin_amdgcn_sched_barrier(0)
__device__ __forceinline__ int crow(int r, int hi) { return (r & 3) + 8 * (r >> 2) + 4 * hi; }

__device__ __forceinline__ void partialSM(f32x16& p0, f32x16& p1, float& m_reg, float& mn, float& alpha, bool dead) {
  constexpr float C = SCALE * 1.4426950408889634f;
  float pmax = p0[0];
#pragma unroll
  for (int r = 1; r < 16; ++r) pmax = fmaxf(pmax, p0[r]);
#pragma unroll
  for (int r = 0; r < 16; ++r) pmax = fmaxf(pmax, p1[r]);
  { auto rr = __builtin_amdgcn_permlane32_swap(__float_as_uint(pmax), __float_as_uint(pmax), false, false);
    pmax = fmaxf(__uint_as_float(rr[0]), __uint_as_float(rr[1])); }
  if (dead) pmax = -1e30f;
  if (__builtin_expect(__all(pmax - m_reg <= THR / SCALE), 1)) { mn = m_reg; alpha = 1.f; }
  else { mn = fmaxf(m_reg, pmax); alpha = __builtin_amdgcn_exp2f((m_reg - mn) * C); m_reg = mn; }
  const float mnC = dead ? -INFINITY : -mn * C;
#pragma unroll
  for (int r = 0; r < 16; ++r) p0[r] = fmaf(p0[r], C, mnC);
#pragma unroll
  for (int r = 0; r < 16; ++r) p1[r] = fmaf(p1[r], C, mnC);
#pragma unroll
  for (int r = 0; r < 16; ++r) p0[r] = __builtin_amdgcn_exp2f(p0[r]);
}
__device__ __forceinline__ void finishSM(f32x16& p0, f32x16& p1, float alpha, float& l_reg, bf16x8& pa0, bf16x8& pa1, bf16x8& pa2, bf16x8& pa3) {
#pragma unroll
  for (int r = 0; r < 16; ++r) p1[r] = __builtin_amdgcn_exp2f(p1[r]);
  float ps = 0;
#pragma unroll
  for (int r = 0; r < 16; ++r) ps += p0[r];
#pragma unroll
  for (int r = 0; r < 16; ++r) ps += p1[r];
  { auto rr = __builtin_amdgcn_permlane32_swap(__float_as_uint(ps), __float_as_uint(ps), false, false);
    ps = __uint_as_float(rr[0]) + __uint_as_float(rr[1]); }
  l_reg = l_reg * alpha + ps;
#define PK4(P, BASE, OUT) do { unsigned a0 = cvt_pk_bf16(P[BASE + 0], P[BASE + 1]), a1 = cvt_pk_bf16(P[BASE + 2], P[BASE + 3]);   \
    unsigned b0 = cvt_pk_bf16(P[BASE + 4], P[BASE + 5]), b1 = cvt_pk_bf16(P[BASE + 6], P[BASE + 7]);                              \
    auto r0 = __builtin_amdgcn_permlane32_swap(a0, b0, false, false); auto r1 = __builtin_amdgcn_permlane32_swap(a1, b1, false, false); \
    u32x4 w = {r0[0], r1[0], r0[1], r1[1]}; OUT = *reinterpret_cast<bf16x8*>(&w); } while (0)
  PK4(p0, 0, pa0); PK4(p0, 8, pa1); PK4(p1, 0, pa2); PK4(p1, 8, pa3);
#undef PK4
}
template <bool QLDS>
__device__ __forceinline__ void qkt(f32x16& p0, f32x16& p1, const LAS char* Ks, const bf16x8* qr, const LAS char* ql, int r32, int hi) {
  p0 = f32x16{}; p1 = f32x16{};
#pragma unroll
  for (int d0 = 0; d0 < 8; ++d0) { int cb = (d0 * 16 + hi * 8) * 2;
    bf16x8 b0 = *(const LAS bf16x8*)(Ks + KSWZ(r32, cb));
    bf16x8 b1 = *(const LAS bf16x8*)(Ks + KSWZ(32 + r32, cb));
    bf16x8 q; if constexpr (QLDS) q = *(const LAS bf16x8*)(ql + d0 * 8192); else q = qr[d0];
    p0 = __builtin_amdgcn_mfma_f32_32x32x16_bf16(b0, q, p0, 0, 0, 0);
    p1 = __builtin_amdgcn_mfma_f32_32x32x16_bf16(b1, q, p1, 0, 0, 0); }
}
__device__ __forceinline__ int v_st(int k, int c) { const int kk = (k & ~0xC) | ((k & 4) << 1) | ((k & 8) >> 1); return ((kk >> 3) * 4 + (c >> 5)) * 512 + ((kk & 7) * 32 + (c & 31)) * 2; }
__device__ __forceinline__ int v_rd_base(int lane) { return ((lane & 3) << 3) | (((lane >> 2) & 3) << 6) | (((lane >> 4) & 1) << 5) | (((lane >> 5) & 1) << 8); }
constexpr int v_rd_off(int d0, int ks, int half) { return d0 * 512 + ks * 4096 + half * 2048; }
template <int OFF> __device__ __forceinline__ s16x4 tr_read(int vb) {
  s16x4 r; asm volatile("ds_read_b64_tr_b16 %0, %1 offset:%2" : "=&v"(r) : "v"(vb), "i"(OFF) : "memory"); return r;
}
template <int D0> __device__ __forceinline__ void pv_one(f32x16& od, int vb, bf16x8 pa0, bf16x8 pa1, bf16x8 pa2, bf16x8 pa3) {
  const s16x4 l0 = tr_read<v_rd_off(D0, 0, 0)>(vb), h0 = tr_read<v_rd_off(D0, 0, 1)>(vb), l1 = tr_read<v_rd_off(D0, 1, 0)>(vb), h1 = tr_read<v_rd_off(D0, 1, 1)>(vb);
  const s16x4 l2 = tr_read<v_rd_off(D0, 2, 0)>(vb), h2 = tr_read<v_rd_off(D0, 2, 1)>(vb), l3 = tr_read<v_rd_off(D0, 3, 0)>(vb), h3 = tr_read<v_rd_off(D0, 3, 1)>(vb);
  asm volatile("s_waitcnt lgkmcnt(0)" ::: "memory"); SBAR();
#define PK(L, H) (bf16x8){L[0], L[1], L[2], L[3], H[0], H[1], H[2], H[3]}
  od = __builtin_amdgcn_mfma_f32_32x32x16_bf16(pa0, PK(l0, h0), od, 0, 0, 0);
  od = __builtin_amdgcn_mfma_f32_32x32x16_bf16(pa1, PK(l1, h1), od, 0, 0, 0);
  od = __builtin_amdgcn_mfma_f32_32x32x16_bf16(pa2, PK(l2, h2), od, 0, 0, 0);
  od = __builtin_amdgcn_mfma_f32_32x32x16_bf16(pa3, PK(l3, h3), od, 0, 0, 0);
#undef PK
}
__device__ __forceinline__ void pv_d0(f32x16* o, int vb, bf16x8 pa0, bf16x8 pa1, bf16x8 pa2, bf16x8 pa3) {
  pv_one<0>(o[0], vb, pa0, pa1, pa2, pa3); pv_one<1>(o[1], vb, pa0, pa1, pa2, pa3); pv_one<2>(o[2], vb, pa0, pa1, pa2, pa3); pv_one<3>(o[3], vb, pa0, pa1, pa2, pa3);
}

template <bool MOBA>
__device__ __forceinline__ void attn_unit(const int tid, const bf16_t* __restrict__ Qb, const bf16_t* __restrict__ Kh, bf16_t* __restrict__ Ob, int NT, int jb, const float* __restrict__ kmean_bh, LAS char* lds) {
  constexpr int ldq = MOBA ? LDP : CW, ldk = MOBA ? LDP : 2 * CW, ldo = MOBA ? MIXW : CW, VOFF = MOBA ? (C_V - C_K) : CW;
  const bf16_t* __restrict__ Vh = Kh + VOFF;
  const int wid = __builtin_amdgcn_readfirstlane(tid >> 6), lane = tid & 63, r32 = lane & 31, hi = lane >> 5;
  LAS char* V_lds = lds; LAS char* K_lds = lds + 2 * SHM_V;
  LAS float* wsf = (LAS float*)(lds + 2 * SHM_V + 2 * SHM_K) + wid * 64; LAS float* li_l = wsf; LAS float* al_l = wsf + 32;
  float m_reg = -1e30f, l_reg = 0; f32x16 o[4] = {}; bf16x8 qr[8];
  const bf16_t* Qw = Qb + (long)(wid * QBLK + r32) * ldq + hi * 8;
#pragma unroll
  for (int d0 = 0; d0 < 8; ++d0) qr[d0] = *reinterpret_cast<const bf16x8*>(Qw + d0 * 16);
  unsigned selmask = 0;
  if constexpr (MOBA) {
    LAS float* kml = (LAS float*)(lds + KM_OFF);
    __syncthreads();
    for (int i = tid; i < 8 * 128; i += NW * 64) kml[i] = kmean_bh[(i >> 7) * 1024 + (i & 127)];
    __syncthreads();
    float gate[8];
#pragma unroll
    for (int kb = 0; kb < 8; ++kb) {
      float g = 0.f;
      if (kb < jb) {
#pragma unroll
        for (int d0 = 0; d0 < 8; ++d0) { const f32x4 k0 = *(const LAS f32x4*)(kml + kb * 128 + d0 * 16 + hi * 8), k1 = *(const LAS f32x4*)(kml + kb * 128 + d0 * 16 + hi * 8 + 4);
          const u32x4 qw = *reinterpret_cast<const u32x4*>(&qr[d0]);
          g += bflo(qw.x) * k0[0] + bfhi(qw.x) * k0[1] + bflo(qw.y) * k0[2] + bfhi(qw.y) * k0[3] + bflo(qw.z) * k1[0] + bfhi(qw.z) * k1[1] + bflo(qw.w) * k1[2] + bfhi(qw.w) * k1[3]; }
        g += __shfl_xor(g, 32);
      }
      gate[kb] = g;
    }
#pragma unroll
    for (int r = 0; r < 3; ++r) { float best = -INFINITY; int bi = -1;
#pragma unroll
      for (int kb = 0; kb < 8; ++kb) { const bool ok = (kb < jb) && !((selmask >> kb) & 1u) && (gate[kb] > best || bi < 0); if (ok) { best = gate[kb]; bi = kb; } }
      if (bi >= 0) selmask |= 1u << bi; }
  }
  const LAS char* ql = lds + QL_OFF + tid * 16;
  if constexpr (MOBA) {
#pragma unroll
    for (int d0 = 0; d0 < 8; ++d0) *(LAS bf16x8*)(lds + QL_OFF + tid * 16 + d0 * 8192) = qr[d0];
  }
  const int rowb = wid * QBLK + r32;
#define MASK(P0, P1, T, DEAD) do { DEAD = false; if constexpr (MOBA) { const int kb_ = (T) >> 2; \
    if (kb_ < jb) { DEAD = !((selmask >> kb_) & 1u); } \
    else { const int lim_ = rowb - 64 * ((T) - 4 * jb); \
      if (!__all(lim_ >= 63)) { const int lh_ = lim_ - 4 * hi;     \
        _Pragma("unroll") for (int r_ = 0; r_ < 16; ++r_) { if ((r_ & 3) + 8 * (r_ >> 2) > lh_) P0[r_] = -INFINITY; if (32 + (r_ & 3) + 8 * (r_ >> 2) > lh_) P1[r_] = -INFINITY; } } } } } while (0)
  const int sr = tid >> 4, sc = (tid & 15) * 8, vst0 = v_st(sr, sc), vst1 = v_st(32 + sr, sc);
  const int vb0 = (int)(size_t)V_lds + v_rd_base(lane);
  constexpr int SDEPTH = MOBA ? 1 : 2;
  struct { bf16x8 vs0, vs1, ks0, ks1; } sr_[SDEPTH];
#define SLOAD(i, k0) do { sr_[i].vs0 = *reinterpret_cast<const bf16x8*>(&Vh[(long)((k0) + sr) * ldk + sc]); sr_[i].vs1 = *reinterpret_cast<const bf16x8*>(&Vh[(long)((k0) + 32 + sr) * ldk + sc]); \
    sr_[i].ks0 = *reinterpret_cast<const bf16x8*>(&Kh[(long)((k0) + sr) * ldk + sc]); sr_[i].ks1 = *reinterpret_cast<const bf16x8*>(&Kh[(long)((k0) + 32 + sr) * ldk + sc]); } while (0)
#define SWRITE(b, i) do { *(LAS bf16x8*)(V_lds + (b) * SHM_V + vst0) = sr_[i].vs0;          \
    *(LAS bf16x8*)(V_lds + (b) * SHM_V + vst1) = sr_[i].vs1; int kc = sc * 2;               \
    *(LAS bf16x8*)(K_lds + (b) * SHM_K + KSWZ(sr, kc)) = sr_[i].ks0;                       \
    *(LAS bf16x8*)(K_lds + (b) * SHM_K + KSWZ(32 + sr, kc)) = sr_[i].ks1; } while (0)
#define SWAIT() do { if constexpr (SDEPTH == 2) asm volatile("s_waitcnt vmcnt(4)" ::: "memory"); else asm volatile("s_waitcnt vmcnt(0)" ::: "memory"); } while (0)
#define RESC(a) do { if (__any((a) < 1.f)) { if (hi == 0) al_l[r32] = (a); asm volatile("s_waitcnt lgkmcnt(0)" ::: "memory"); \
    _Pragma("unroll") for (int d = 0; d < 4; ++d) _Pragma("unroll") for (int r = 0; r < 16; ++r) o[d][r] *= al_l[crow(r, hi)]; } } while (0)
  f32x16 pA0, pA1, pB0, pB1; float mnA, mnB, alA, alB; bf16x8 pa0, pa1, pa2, pa3; bool deadA, deadB;
  constexpr int SE = 0, SO = SDEPTH - 1;
  if constexpr (!MOBA) __syncthreads();
  SLOAD(SE, 0); asm volatile("s_waitcnt vmcnt(0)" ::: "memory"); SWRITE(0, SE); __syncthreads();
  qkt<MOBA>(pA0, pA1, K_lds, qr, ql, r32, hi); MASK(pA0, pA1, 0, deadA); partialSM(pA0, pA1, m_reg, mnA, alA, deadA);
  SLOAD(SO, KVBLK); if constexpr (SDEPTH == 2) { if (2 < NT) SLOAD(SE, 2 * KVBLK); }
  SWAIT(); SWRITE(1, SO); __syncthreads();
  for (int j = 1; j + 1 < NT; j += 2) {
    SBAR(); qkt<MOBA>(pB0, pB1, K_lds + SHM_K, qr, ql, r32, hi);
    finishSM(pA0, pA1, alA, l_reg, pa0, pa1, pa2, pa3); SBAR();
    SLOAD(SO, (j + SDEPTH) * KVBLK); SBAR();
    pv_d0(o, vb0, pa0, pa1, pa2, pa3); MASK(pB0, pB1, j, deadB); partialSM(pB0, pB1, m_reg, mnB, alB, deadB);
    __syncthreads(); SWAIT(); SWRITE(0, SE);
    RESC(alB); __syncthreads();
    SBAR(); qkt<MOBA>(pA0, pA1, K_lds, qr, ql, r32, hi);
    finishSM(pB0, pB1, alB, l_reg, pa0, pa1, pa2, pa3); SBAR();
    if (SDEPTH == 1 || j + 3 < NT) SLOAD(SE, (j + 1 + SDEPTH) * KVBLK); SBAR();
    pv_d0(o, vb0 + SHM_V, pa0, pa1, pa2, pa3); MASK(pA0, pA1, j + 1, deadA); partialSM(pA0, pA1, m_reg, mnA, alA, deadA);
    __syncthreads(); SWAIT(); SWRITE(1, SO);
    RESC(alA); __syncthreads();
  }
  SBAR(); qkt<MOBA>(pB0, pB1, K_lds + SHM_K, qr, ql, r32, hi);
  finishSM(pA0, pA1, alA, l_reg, pa0, pa1, pa2, pa3); SBAR();
  pv_d0(o, vb0, pa0, pa1, pa2, pa3); MASK(pB0, pB1, NT - 1, deadB); partialSM(pB0, pB1, m_reg, mnB, alB, deadB);
  __syncthreads(); RESC(alB);
  finishSM(pB0, pB1, alB, l_reg, pa0, pa1, pa2, pa3); SBAR();
  pv_d0(o, vb0 + SHM_V, pa0, pa1, pa2, pa3);
  if (hi == 0) li_l[r32] = l_reg; asm volatile("s_waitcnt lgkmcnt(0)" ::: "memory");
  float rli[16];
#pragma unroll
  for (int r = 0; r < 16; ++r) rli[r] = __builtin_amdgcn_rcpf(li_l[crow(r, hi)]);
  if constexpr (MOBA) {
#pragma unroll
    for (int r = 0; r < 16; ++r) {
      float q = 0.f;
#pragma unroll
      for (int d0 = 0; d0 < 4; ++d0) { const float v = o[d0][r] * rli[r]; q += v * v; }
      q += __shfl_xor(q, 1); q += __shfl_xor(q, 2); q += __shfl_xor(q, 4); q += __shfl_xor(q, 8); q += __shfl_xor(q, 16);
      rli[r] *= rsqrtf(q * (1.f / 128.f) + EPS);
    }
  }
  bf16_t* Ow = Ob + (long)(wid * QBLK) * ldo;
#pragma unroll
  for (int r = 0; r < 16; ++r) { const int orow = crow(r, hi);
#pragma unroll
    for (int d0 = 0; d0 < 4; ++d0) Ow[(long)orow * ldo + d0 * 32 + r32] = (bf16_t)(cvt_pk_bf16(o[d0][r] * rli[r], 0.f) & 0xffffu); }
#undef MASK
#undef SLOAD
#undef SWRITE
#undef SWAIT
#undef RESC
}
#undef KSWZ
#undef SBAR
}
namespace sd {
using f32x16 = __attribute__((ext_vector_type(16))) float;
typedef short v4i16_t __attribute__((ext_vector_type(4)));
constexpr int IMG_C = 0, IMG_B = 32768, IMG_X = 65536, IMG_S = 98304, TBL = 114688;
__device__ __forceinline__ unsigned off_b(unsigned row, unsigned ch) { return 256u * row + 16u * (ch ^ (((row & 3) << 2) | ((row >> 2) & 3))); }
__device__ __forceinline__ unsigned row_read_addr(unsigned lane, unsigned s) { return off_b(lane & 31, 2 * s + (lane >> 5)); }
__device__ __forceinline__ unsigned tr_read_addr(unsigned lane, unsigned c, unsigned ks, unsigned t) {
  const unsigned h = lane >> 5, blk = (lane >> 4) & 1, q = (lane & 15) >> 2, p = lane & 3;
  return off_b(16 * ks + 8 * h + 4 * t + q, 4 * c + 2 * blk + (p >> 1)) + 8 * (p & 1);
}
__device__ __forceinline__ unsigned elem_addr(unsigned row, unsigned col) { return (row >> 5) * 8192u + off_b(row & 31, col >> 3) + (col & 7) * 2u; }
__device__ __forceinline__ bf16x8 tr_frag(const LAS char* img, unsigned a0, unsigned a1) {
  const v4i16_t l = __builtin_amdgcn_ds_read_tr16_b64_v4i16((LAS v4i16_t*)(img + a0)), h = __builtin_amdgcn_ds_read_tr16_b64_v4i16((LAS v4i16_t*)(img + a1));
  return (bf16x8){l[0], l[1], l[2], l[3], h[0], h[1], h[2], h[3]};
}
__device__ __forceinline__ int crow(int r, int hi) { return (r & 3) + 8 * (r >> 2) + 4 * hi; }
__device__ __forceinline__ float softplus_f(float r) { return fmaxf(r, 0.f) + log1pf(__expf(-fabsf(r))); }

__device__ __forceinline__ void conv_prepass(const int gtid, const int nthr, const bf16_t* __restrict__ proj, const float* __restrict__ conv_w, const float* __restrict__ conv_b, bf16_t* __restrict__ xbcc) {
  constexpr int NITEM = (CONVD / 8) * (M / 16);
#pragma unroll 1
  for (int it = gtid; it < NITEM; it += nthr) {
    const int cgp = it % (CONVD / 8), run = it / (CONVD / 8), tok0 = run * 16, T0 = tok0 & (SEQ - 1), ch = 8 * cgp;
    const bf16_t* rawp = proj + (size_t)(tok0 - T0) * LDP + C_XBC + ch;
    u32x4 raw[19];
#pragma unroll
    for (int j = 0; j < 19; ++j) { const int T = T0 - 3 + j; raw[j] = (T >= 0) ? *(const u32x4*)(rawp + (size_t)T * LDP) : (u32x4){0u, 0u, 0u, 0u}; }
    f32x4 w[5][2];
#pragma unroll
    for (int tp = 0; tp < 4; ++tp) { w[tp][0] = *(const f32x4*)(conv_w + tp * CONVD + ch); w[tp][1] = *(const f32x4*)(conv_w + tp * CONVD + ch + 4); }
    w[4][0] = *(const f32x4*)(conv_b + ch); w[4][1] = *(const f32x4*)(conv_b + ch + 4);
    float ac[4][8];
#pragma unroll
    for (int j = 0; j < 19; ++j) {
      const u32x4 rw = raw[j];
      const float x[8] = {bflo(rw.x), bfhi(rw.x), bflo(rw.y), bfhi(rw.y), bflo(rw.z), bfhi(rw.z), bflo(rw.w), bfhi(rw.w)};
#pragma unroll
      for (int tp = 0; tp < 4; ++tp) {
        const int i = j - tp;
        if (i >= 0 && i < 16) { const int sl = i & 3;
#pragma unroll
          for (int e = 0; e < 8; ++e) ac[sl][e] = (tp == 0 ? w[4][e >> 2][e & 3] : ac[sl][e]) + w[tp][e >> 2][e & 3] * x[e]; }
      }
      if (j >= 3) {
        const int sl = (j - 3) & 3; float o8[8];
#pragma unroll
        for (int e = 0; e < 8; ++e) o8[e] = ac[sl][e] * __builtin_amdgcn_rcpf(1.f + __expf(-ac[sl][e]));
        u32x4 o; o.x = cvt_pk_bf16(o8[0], o8[1]); o.y = cvt_pk_bf16(o8[2], o8[3]); o.z = cvt_pk_bf16(o8[4], o8[5]); o.w = cvt_pk_bf16(o8[6], o8[7]);
        *(u32x4*)(xbcc + (size_t)(tok0 + j - 3) * CONVD + ch) = o;
      }
    }
  }
}

__device__ __forceinline__ void ssd_unit(const int tid, const int b, const int h, const bf16_t* __restrict__ proj, const bf16_t* __restrict__ xbcc, const float* __restrict__ dtraw,
                                         const float* __restrict__ dt_bias, const float* __restrict__ a_log, const float* __restrict__ d_skip,
                                         bf16_t* __restrict__ mixb, float* __restrict__ ssq, LAS char* lds) {
  const int wid = __builtin_amdgcn_readfirstlane(tid >> 6), lane = tid & 63, r32 = lane & 31, hi = lane >> 5;
  const int rb = wid >> 1, ph = wid & 1;
  LAS char* IC = lds + IMG_C; LAS char* IB = lds + IMG_B; LAS char* IX = lds + IMG_X; LAS char* IS = lds + IMG_S;
  LAS float* Tdt = (LAS float*)(lds + TBL); LAS float* Tacs = Tdt + 2048;
  const int grp = h >> 3;
  const float a = -__expf(a_log[h]), dtb = dt_bias[h], Dh = d_skip[h];
  __syncthreads();
  { const u32x4 z = {0u, 0u, 0u, 0u}; *(LAS u32x4*)(IS + tid * 32) = z; *(LAS u32x4*)(IS + tid * 32 + 16) = z; }
#pragma unroll 1
  for (int cc = 0; cc < 2; ++cc) {
    const int t0 = (wid * 2 + cc) * 128 + 2 * lane;
    const float d0 = softplus_f(dtraw[(size_t)(b * SEQ + t0) * 32 + h] + dtb), d1 = softplus_f(dtraw[(size_t)(b * SEQ + t0 + 1) * 32 + h] + dtb);
    const float v0 = d0 * a, ps = v0 + d1 * a;
    float sc = ps;
#pragma unroll
    for (int o = 1; o < 64; o <<= 1) { const float n = __shfl_up(sc, o); if (lane >= o) sc += n; }
    const float a0 = (sc - ps) + v0, a1 = sc, tot = __shfl(sc, 63);
    Tdt[t0] = d0; Tdt[t0 + 1] = d1; Tacs[t0] = a0; Tacs[t0 + 1] = a1;
  }
  f32x16 S = {};
  const unsigned xr = ((r32 & 3) << 2) | ((r32 >> 2) & 3);
#define RROW(k) (256u * r32 + 16u * ((2u * (k) + hi) ^ xr))
#pragma unroll 1
  for (int c = 0; c < 16; ++c) {
    int tq_ = tid; asm volatile("" : "+v"(tq_));
    const bf16_t* xsrc = xbcc + (size_t)(b * SEQ + c * 128) * CONVD;
    u32x4 rx[2], rB[4], rC[4];
#pragma unroll
    for (int i = 0; i < 2; ++i) rx[i] = *(const u32x4*)(xsrc + (size_t)((tq_ >> 3) + 64 * i) * CONVD + h * 64 + 8 * (tq_ & 7));
#pragma unroll
    for (int i = 0; i < 4; ++i) { rB[i] = *(const u32x4*)(xsrc + (size_t)((tq_ >> 4) + 32 * i) * CONVD + 2048 + grp * 128 + 8 * (tq_ & 15));
      rC[i] = *(const u32x4*)(xsrc + (size_t)((tq_ >> 4) + 32 * i) * CONVD + 2560 + grp * 128 + 8 * (tq_ & 15)); }
    __syncthreads();
    if (c > 0) {
      int lq_ = lane; asm volatile("" : "+v"(lq_)); const int r32 = lq_ & 31, hi = lq_ >> 5;
#pragma unroll
      for (int r = 0; r < 16; ++r) *(LAS bf16_t*)(IS + elem_addr(32 * ph + crow(r, hi), 32 * rb + r32)) = (bf16_t)(cvt_pk_bf16(S[r], 0.f) & 0xffffu);
    }
    {
      const float ace = Tacs[c * 128 + 127];
#pragma unroll
      for (int i = 0; i < 2; ++i) { const unsigned tk = (unsigned)(tq_ >> 3) + 64u * i, trow = tk & 31, xo = ((trow & 3) << 2) | ((trow >> 2) & 3), rowb = IMG_X + (tk >> 5) * 8192u + 256u * trow, cch = tq_ & 7;
        *(LAS u32x4*)(lds + rowb + 16u * (cch ^ xo)) = rx[i];
        const float w2 = Tdt[c * 128 + tk] * __expf(ace - Tacs[c * 128 + tk]);
        u32x4 v; v.x = cvt_pk_bf16(bflo(rx[i].x) * w2, bfhi(rx[i].x) * w2); v.y = cvt_pk_bf16(bflo(rx[i].y) * w2, bfhi(rx[i].y) * w2); v.z = cvt_pk_bf16(bflo(rx[i].z) * w2, bfhi(rx[i].z) * w2); v.w = cvt_pk_bf16(bflo(rx[i].w) * w2, bfhi(rx[i].w) * w2);
        *(LAS u32x4*)(lds + rowb + 16u * ((8u + cch) ^ xo)) = v; }
#pragma unroll
      for (int i = 0; i < 4; ++i) { const unsigned tk = (unsigned)(tq_ >> 4) + 32u * i, trow = tk & 31, xo = ((trow & 3) << 2) | ((trow >> 2) & 3), ro = (tk >> 5) * 8192u + 256u * trow + 16u * ((unsigned)(tq_ & 15) ^ xo);
        *(LAS u32x4*)(lds + IMG_B + ro) = rB[i]; *(LAS u32x4*)(lds + IMG_C + ro) = rC[i]; }
    }
    __syncthreads();
    int lq_ = lane; asm volatile("" : "+v"(lq_));
    const int lane = lq_, r32 = lane & 31, hi = lane >> 5; const unsigned xr = ((r32 & 3) << 2) | ((r32 >> 2) & 3);
    const LAS float* acs = Tacs + c * 128; const LAS float* dts = Tdt + c * 128;
    f32x16 Y = {};
    const float acl = acs[32 * rb + r32];
#pragma unroll 1
    for (int st = 0; st <= rb; ++st) {
      f32x16 Dm = {};
#pragma unroll
      for (int k = 0; k < 8; ++k) { const bf16x8 af = *(const LAS bf16x8*)(IB + st * 8192 + RROW(k)), bq = *(const LAS bf16x8*)(IC + rb * 8192 + RROW(k));
        Dm = __builtin_amdgcn_mfma_f32_32x32x16_bf16(af, bq, Dm, 0, 0, 0); }
#pragma unroll
      for (int q4 = 0; q4 < 4; ++q4) { const f32x4 as4 = *(const LAS f32x4*)(acs + 32 * st + 8 * q4 + 4 * hi), dt4 = *(const LAS f32x4*)(dts + 32 * st + 8 * q4 + 4 * hi);
#pragma unroll
        for (int e = 0; e < 4; ++e) { const int r = 4 * q4 + e; const bool dead = (st == rb) && (8 * q4 + 4 * hi + e > r32);
          const float f = dead ? 0.f : __expf(acl - as4[e]) * dt4[e]; Dm[r] *= f; } }
      bf16x8 pa0, pa1;
#define PK4(P, BASE, OUT) do { unsigned a0_ = cvt_pk_bf16(P[BASE + 0], P[BASE + 1]), a1_ = cvt_pk_bf16(P[BASE + 2], P[BASE + 3]);   \
    unsigned b0_ = cvt_pk_bf16(P[BASE + 4], P[BASE + 5]), b1_ = cvt_pk_bf16(P[BASE + 6], P[BASE + 7]);                              \
    auto r0_ = __builtin_amdgcn_permlane32_swap(a0_, b0_, false, false); auto r1_ = __builtin_amdgcn_permlane32_swap(a1_, b1_, false, false); \
    u32x4 w_ = {r0_[0], r1_[0], r0_[1], r1_[1]}; OUT = *reinterpret_cast<bf16x8*>(&w_); } while (0)
      PK4(Dm, 0, pa0); PK4(Dm, 8, pa1);
#undef PK4
      Y = __builtin_amdgcn_mfma_f32_32x32x16_bf16(pa0, tr_frag(IX + st * 8192, tr_read_addr(lane, ph, 0, 0), tr_read_addr(lane, ph, 0, 1)), Y, 0, 0, 0);
      Y = __builtin_amdgcn_mfma_f32_32x32x16_bf16(pa1, tr_frag(IX + st * 8192, tr_read_addr(lane, ph, 1, 0), tr_read_addr(lane, ph, 1, 1)), Y, 0, 0, 0);
    }
    {
      f32x16 CS = {};
#pragma unroll
      for (int k = 0; k < 8; ++k) { const bf16x8 af = *(const LAS bf16x8*)(IC + rb * 8192 + RROW(k)), bq = *(const LAS bf16x8*)(IS + ph * 8192 + RROW(k));
        CS = __builtin_amdgcn_mfma_f32_32x32x16_bf16(af, bq, CS, 0, 0, 0); }
#pragma unroll
      for (int q4 = 0; q4 < 4; ++q4) { const f32x4 as4 = *(const LAS f32x4*)(acs + 32 * rb + 8 * q4 + 4 * hi);
#pragma unroll
        for (int e = 0; e < 4; ++e) Y[4 * q4 + e] += CS[4 * q4 + e] * __expf(as4[e]); }
    }
    {
      const float dec = __expf(acs[127]);
#pragma unroll
      for (int r = 0; r < 16; ++r) S[r] *= dec;
#pragma unroll
      for (int st = 0; st < 4; ++st)
#pragma unroll
        for (int ks = 0; ks < 2; ++ks) {
          const bf16x8 af = tr_frag(IX + st * 8192, tr_read_addr(lane, 2 + ph, ks, 0), tr_read_addr(lane, 2 + ph, ks, 1));
          const bf16x8 bq = tr_frag(IB + st * 8192, tr_read_addr(lane, rb, ks, 0), tr_read_addr(lane, rb, ks, 1));
          S = __builtin_amdgcn_mfma_f32_32x32x16_bf16(af, bq, S, 0, 0, 0);
        }
    }
    {
      const int p = 32 * ph + r32;
#pragma unroll
      for (int r = 0; r < 16; ++r) {
        const int l = 32 * rb + crow(r, hi); const size_t tok = (size_t)(b * SEQ + c * 128 + l);
        const float xv = bf2f(*(const LAS bf16_t*)(IX + elem_addr(l, p)));
        const float z = bf2f(proj[tok * LDP + C_Z + h * 64 + p]);
        const float yg = (Y[r] + xv * Dh) * (z * __builtin_amdgcn_rcpf(1.f + __expf(-z)));
        mixb[tok * MIXW + AW + h * 64 + p] = (bf16_t)(cvt_pk_bf16(yg, 0.f) & 0xffffu);
        float q = yg * yg;
        q += __shfl_xor(q, 1); q += __shfl_xor(q, 2); q += __shfl_xor(q, 4); q += __shfl_xor(q, 8); q += __shfl_xor(q, 16);
        if (r32 == 0) ssq[tok * 64 + h * 2 + ph] = q;
      }
    }
  }
#undef RROW
  __syncthreads();
}
}
constexpr int RING_OFF = 0, RING_BYTES = 131072;
constexpr int TAB_OFF = RING_BYTES;
constexpr int RSL_OFF = TAB_OFF + 8192;
constexpr int MOE_OFF = RSL_OFF + 1024;
constexpr int LDSCTL_OFF = MOE_OFF + 512;
constexpr int MISC_OFF = LDSCTL_OFF + 320;
constexpr int LDS_BYTES = 147456;
static_assert(MISC_OFF + 128 <= LDS_BYTES, "LDS map");
constexpr int NWAVES = 8;

struct Args { const float* in[27]; float* out; unsigned char* ws; float rf[16]; int ph_lo, ph_hi, li, pad; };

struct Frame {
    LAS unsigned char* lds;
    volatile LAS unsigned* MISC;
    int tid, lane, wave, vcu, G;
};

__device__ __forceinline__ void p0_transpose_item(const float* __restrict__ W, int ldw, int k0, int n0, const float* __restrict__ sc, bf16_t* dst, int dK, LAS float* scr, int lane) {
    float v[32];
#pragma unroll
    for (int i = 0; i < 32; ++i) v[i] = W[(size_t)(k0 + 2 * i + (lane >> 5)) * ldw + n0 + (lane & 31)];
#pragma unroll
    for (int i = 0; i < 32; ++i) { const int kk = 2 * i + (lane >> 5); scr[kk * 33 + (lane & 31)] = sc ? v[i] * sc[k0 + kk] : v[i]; }
    LDS_WAIT(); asm volatile("" ::: "memory");
    const int c = lane & 7;
#pragma unroll
    for (int j = 0; j < 4; ++j) { const int n = (lane >> 3) + 8 * j; const LAS float* s = scr + (8 * c) * 33 + n;
        u32x4 o; o.x = cvt_pk_bf16(s[0 * 33], s[1 * 33]); o.y = cvt_pk_bf16(s[2 * 33], s[3 * 33]); o.z = cvt_pk_bf16(s[4 * 33], s[5 * 33]); o.w = cvt_pk_bf16(s[6 * 33], s[7 * 33]);
        *(u32x4*)(dst + (size_t)n * dK + k0 + 8 * c) = o; }
    LDS_WAIT(); asm volatile("" ::: "memory");
}
__device__ __forceinline__ void row_to_bf16_rs(const float* xrow, bf16_t* orow, float* rs_out, int lane) {
    const f32x4* xr = (const f32x4*)xrow + lane;
    f32x4 v[8]; float s = 0.f;
#pragma unroll
    for (int j = 0; j < 8; ++j) { v[j] = xr[64 * j]; s += (v[j].x * v[j].x + v[j].y * v[j].y) + (v[j].z * v[j].z + v[j].w * v[j].w); }
    s = wave_sum(s);
    if (lane == 0) *rs_out = rsqrtf(s * (1.f / DM) + EPS);
    u32x2* o8 = (u32x2*)orow + lane;
#pragma unroll
    for (int j = 0; j < 8; ++j) { u32x2 w; w.x = cvt_pk_bf16(v[j].x, v[j].y); w.y = cvt_pk_bf16(v[j].z, v[j].w); o8[64 * j] = w; }
}
__device__ __forceinline__ void p0_prologue(Frame& F, const Args& args) {
    LAS float* scr = (LAS float*)(F.lds + RING_OFF + F.wave * 16384);
    const int gw = F.vcu * NWAVES + F.wave, NGW = F.G * NWAVES, lane = F.lane;
    GAS unsigned char* wsg_ = (GAS unsigned char*)args.ws; asm volatile("" : "+s"(wsg_)); unsigned char* ws = (unsigned char*)wsg_;
    const float* w_in = args.in[3]; const float* w_out = args.in[11];
    constexpr int I_IN = 32 * 257, I_OUT = 48 * 64, I_CQ = 32 * 16, I_CO = 8 * 64;
    constexpr int I_GU = 32 * 32 * 32, I_DN = 32 * 16 * 64;
    constexpr int NITEMS = I_IN + I_OUT + 3 * I_CQ + I_CO + 2 * I_GU + I_DN;
    for (int it = gw; it < NITEMS; it += NGW) {
        int r = it;
        if (r < I_IN) { const int kb = r / 257, nb = r % 257; p0_transpose_item(w_in, INW, 64 * kb, 32 * nb, args.in[2], (bf16_t*)(ws + WS_WIN_T) + (size_t)(32 * nb) * DM, DM, scr, lane); continue; } r -= I_IN;
        if (r < I_OUT) { const int kb = r / 64, nb = r % 64; const float* sc = (kb < 16) ? args.in[9] : (args.in[10] - AW);
            p0_transpose_item(w_out, DM, 64 * kb, 32 * nb, sc, (bf16_t*)(ws + WS_WOUT_T) + (size_t)(32 * nb) * MIXW, MIXW, scr, lane); continue; } r -= I_OUT;
        if (r < I_CQ) { const int kb = r / 16, nb = r % 16; p0_transpose_item(args.in[14], CW, 64 * kb, 32 * nb, args.in[12], (bf16_t*)(ws + WS_WCQ_T) + (size_t)(32 * nb) * DM, DM, scr, lane); continue; } r -= I_CQ;
        if (r < I_CQ) { const int kb = r / 16, nb = r % 16; p0_transpose_item(args.in[15], CW, 64 * kb, 32 * nb, args.in[13], (bf16_t*)(ws + WS_WCKV_T) + (size_t)(32 * nb) * DM, DM, scr, lane); continue; } r -= I_CQ;
        if (r < I_CQ) { const int kb = r / 16, nb = r % 16; p0_transpose_item(args.in[16], CW, 64 * kb, 32 * nb, args.in[13], (bf16_t*)(ws + WS_WCKV_T) + (size_t)(CW + 32 * nb) * DM, DM, scr, lane); continue; } r -= I_CQ;
        if (r < I_CO) { const int kb = r / 64, nb = r % 64; p0_transpose_item(args.in[17], DM, 64 * kb, 32 * nb, nullptr, (bf16_t*)(ws + WS_WCO_T) + (size_t)(32 * nb) * CW, CW, scr, lane); continue; } r -= I_CO;
        if (r < 2 * I_GU) { const int up = r >= I_GU; if (up) r -= I_GU; const int e = r >> 10, kb = (r >> 5) & 31, nb = r & 31, n0 = 32 * nb;
            p0_transpose_item(args.in[up ? 24 : 23] + (size_t)e * DM * DE, DE, 64 * kb, n0, args.in[18], (bf16_t*)(ws + WS_WGU_T) + ((size_t)e * 2048 + (n0 >> 7) * 256 + up * 128 + (n0 & 127)) * DM, DM, scr, lane); continue; } r -= 2 * I_GU;
        { const int e = r >> 10, kb = (r >> 6) & 15, nb = r & 63;
            p0_transpose_item(args.in[25] + (size_t)e * DE * DM, DM, 64 * kb, 32 * nb, nullptr, (bf16_t*)(ws + WS_WD_T) + ((size_t)e * 2048 + 32 * nb) * DE, DE, scr, lane); }
    }
    { u32x4* z = (u32x4*)((bf16_t*)(ws + WS_WIN_T) + (size_t)INW * DM); const int n16 = (LDP - INW) * DM * 2 / 16;
      for (int i = (F.vcu * NWAVES * 64) + F.tid; i < n16; i += F.G * NWAVES * 64) z[i] = (u32x4){0u, 0u, 0u, 0u}; }
    { float* km = (float*)(ws + WS_KMEAN); for (int i = (F.vcu * NWAVES * 64) + F.tid; i < BATCH * NB * 1024; i += F.G * NWAVES * 64) km[i] = 0.f; }
    { float* tab = (float*)(ws + WS_ROPE);
      for (int i = (F.vcu * NWAVES * 64) + F.tid; i < SEQ * 16; i += F.G * NWAVES * 64) { const int pos = i >> 4, f = i & 15;
        const float ang = (float)pos * args.rf[f]; double r = (double)ang * 0.15915494309189533577; r -= rint(r); const float th = (float)(r * 6.283185307179586477);
        tab[pos * 32 + f] = cosf(th); tab[pos * 32 + 16 + f] = sinf(th); } }
    { bf16_t* wh = (bf16_t*)(ws + WS_WR); bf16_t* wl = wh + 48 * DM; const float* nfw = args.in[18];
      for (int i = (F.vcu * NWAVES * 64) + F.tid; i < 48 * DM; i += F.G * NWAVES * 64) { const int n = i >> 11, k = i & (DM - 1);
        const float v = n < NG ? args.in[19][k * NG + n] * nfw[k] : (n < 36 ? args.in[21][k * NE + (n - NG)] * nfw[k] : 0.f);
        const unsigned hb = cvt_pk_bf16(v, 0.f) & 0xffffu; wh[i] = (bf16_t)hb; wl[i] = (bf16_t)(cvt_pk_bf16(v - __uint_as_float(hb << 16), 0.f) & 0xffffu); } }
    for (int m = gw; m < M; m += NGW) row_to_bf16_rs(args.in[0] + (size_t)m * DM, (bf16_t*)(ws + WS_XB) + (size_t)m * DM, (float*)(ws + WS_RSX) + m, lane);
    for (int m = gw; m < MROWS; m += NGW) row_to_bf16_rs(args.in[1] + (size_t)m * DM, (bf16_t*)(ws + WS_MEMB) + (size_t)m * DM, (float*)(ws + WS_RSMEM) + m, lane);
}

struct SchedG1 {
    const char* A; const char* Bt; int G, c;
    __device__ __forceinline__ bool next(int i, gm::Unit& u) const {
        const int L = i * G + c; if (L >= 64 * 33) return false;
        int pm, pn; gm::tile_of(L, 64, 33, pm, pn);
        u.pm = pm; u.pn = pn; u.kind = 0; u.ti = 0; u.a = A + (size_t)pm * 256 * DM * 2; u.b = Bt + (size_t)pn * 256 * DM * 2; return true;
    }
};
struct EpiG1 {
    bf16_t* proj; float* dtraw; const float* rsx; const float* ropetab; float* kmean;
    __device__ __forceinline__ void operator()(const f32x4 (&acc)[2][2][4][2], const gm::Unit& u, int wr, int wc, int fr, int fq) const {
        const int row0 = u.pm * 256 + wr * 64 + fr;
        const bool rope = (u.pn < 8) && (wc == 0), dtt = (u.pn == 32), ktile = (u.pn >= 4) && (u.pn < 8);
        const float sgn = (fq < 2) ? -1.f : 1.f;
        f32x4 ks[2][2] = {{{0.f, 0.f, 0.f, 0.f}, {0.f, 0.f, 0.f, 0.f}}, {{0.f, 0.f, 0.f, 0.f}, {0.f, 0.f, 0.f, 0.f}}};
#pragma unroll
        for (int ai = 0; ai < 2; ++ai)
#pragma unroll
            for (int m = 0; m < 4; ++m) {
                const int row = row0 + ai * 128 + m * 16; const float rs = rsx[row];
                f32x4 c0 = {1.f, 1.f, 1.f, 1.f}, c1 = c0, s0 = {0.f, 0.f, 0.f, 0.f}, s1 = s0;
                if (rope) { const float* rt = ropetab + (row & (SEQ - 1)) * 32 + 8 * (fq & 1); c0 = *(const f32x4*)rt; c1 = *(const f32x4*)(rt + 4); s0 = *(const f32x4*)(rt + 16); s1 = *(const f32x4*)(rt + 20); }
#pragma unroll
                for (int bj = 0; bj < 2; ++bj) {
                    f32x4 v0 = acc[ai][bj][m][0] * rs, v1 = acc[ai][bj][m][1] * rs;
                    if (rope) {
                        f32x4 p0, p1;
#pragma unroll
                        for (int e = 0; e < 4; ++e) { p0[e] = __shfl_xor(v0[e], 32); p1[e] = __shfl_xor(v1[e], 32); }
                        v0 = v0 * c0 + (p0 * s0) * sgn; v1 = v1 * c1 + (p1 * s1) * sgn;
                    }
                    ks[bj][0] += v0; ks[bj][1] += v1;
                    if (!dtt) { u32x4 w; w.x = cvt_pk_bf16(v0[0], v0[1]); w.y = cvt_pk_bf16(v0[2], v0[3]); w.z = cvt_pk_bf16(v1[0], v1[1]); w.w = cvt_pk_bf16(v1[2], v1[3]);
                        *(u32x4*)(proj + (size_t)row * LDP + u.pn * 256 + bj * 128 + wc * 32 + 8 * fq) = w; }
                    else if (bj == 0 && wc == 0) { float* d = dtraw + (size_t)row * 32 + 8 * fq; *(f32x4*)d = v0; *(f32x4*)(d + 4) = v1; }
                }
                asm volatile("" ::: "memory");
            }
        if (ktile) {
#pragma unroll
            for (int bj = 0; bj < 2; ++bj)
#pragma unroll
                for (int n = 0; n < 2; ++n)
#pragma unroll
                    for (int e = 0; e < 4; ++e) { float s = ks[bj][n][e]; s += __shfl_xor(s, 1); s += __shfl_xor(s, 2); s += __shfl_xor(s, 4); s += __shfl_xor(s, 8);
                        if (fr == 0) atomicAdd(kmean + (size_t)u.pm * 1024 + (u.pn - 4) * 256 + bj * 128 + wc * 32 + 8 * fq + 4 * n + e, s * (1.f / MB)); }
        }
    }
};

struct SchedTiles {
    const char* A; const char* Bt; int nM, nN, K, G, c;
    __device__ __forceinline__ bool next(int i, gm::Unit& u) const {
        const int L = i * G + c; if (L >= nM * nN) return false;
        int pm, pn; gm::tile_of(L, nM, nN, pm, pn);
        u.pm = pm; u.pn = pn; u.kind = 0; u.ti = 0; u.a = A + (size_t)pm * 256 * K * 2; u.b = Bt + (size_t)pn * 256 * K * 2; return true;
    }
};
struct EpiRes {
    const float* base; float* outf; bf16_t* hb; float* ss;
    __device__ __forceinline__ void operator()(const f32x4 (&acc)[2][2][4][2], const gm::Unit& u, int wr, int wc, int fr, int fq) const {
        const int row0 = u.pm * 256 + wr * 64 + fr;
#pragma unroll
        for (int ai = 0; ai < 2; ++ai)
#pragma unroll
            for (int m = 0; m < 4; ++m) {
                const int row = row0 + ai * 128 + m * 16; float q = 0.f;
#pragma unroll
                for (int bj = 0; bj < 2; ++bj) {
                    const size_t o = (size_t)row * DM + u.pn * 256 + bj * 128 + wc * 32 + 8 * fq;
                    const f32x4 v0 = acc[ai][bj][m][0] + *(const f32x4*)(base + o), v1 = acc[ai][bj][m][1] + *(const f32x4*)(base + o + 4);
                    *(f32x4*)(outf + o) = v0; *(f32x4*)(outf + o + 4) = v1;
                    u32x4 w; w.x = cvt_pk_bf16(v0[0], v0[1]); w.y = cvt_pk_bf16(v0[2], v0[3]); w.z = cvt_pk_bf16(v1[0], v1[1]); w.w = cvt_pk_bf16(v1[2], v1[3]);
                    *(u32x4*)(hb + o) = w;
                    q += (v0[0] * v0[0] + v0[1] * v0[1]) + (v0[2] * v0[2] + v0[3] * v0[3]) + (v1[0] * v1[0] + v1[1] * v1[1]) + (v1[2] * v1[2] + v1[3] * v1[3]);
                }
                q += __shfl_xor(q, 16); q += __shfl_xor(q, 32);
                if (fq == 0) ss[(size_t)row * 32 + u.pn * 4 + wc] = q;
                asm volatile("" ::: "memory");
            }
    }
};
struct SchedQKV {
    const char* A0; const char* B0; const char* A1; const char* B1; int G, c;
    __device__ __forceinline__ bool next(int i, gm::Unit& u) const {
        const int L = i * G + c; int pm, pn;
        if (L < 128) { gm::tile_of(L, 64, 2, pm, pn); u.kind = 0; u.a = A0 + (size_t)pm * 256 * DM * 2; u.b = B0 + (size_t)pn * 256 * DM * 2; }
        else if (L < 160) { gm::tile_of(L - 128, 8, 4, pm, pn); u.kind = 1; u.a = A1 + (size_t)pm * 256 * DM * 2; u.b = B1 + (size_t)pn * 256 * DM * 2; }
        else return false;
        u.pm = pm; u.pn = pn; u.ti = 0; return true;
    }
};
struct EpiScale {
    bf16_t* O0; bf16_t* O1; int ld0, ld1; const LAS float* rsl;
    __device__ __forceinline__ void operator()(const f32x4 (&acc)[2][2][4][2], const gm::Unit& u, int wr, int wc, int fr, int fq) const {
        bf16_t* O = u.kind ? O1 : O0; const int ld = u.kind ? ld1 : ld0;
#pragma unroll
        for (int ai = 0; ai < 2; ++ai)
#pragma unroll
            for (int m = 0; m < 4; ++m) {
                const int r = ai * 128 + wr * 64 + m * 16 + fr; const float rs = rsl[r];
#pragma unroll
                for (int bj = 0; bj < 2; ++bj) {
                    const f32x4 v0 = acc[ai][bj][m][0] * rs, v1 = acc[ai][bj][m][1] * rs;
                    u32x4 w; w.x = cvt_pk_bf16(v0[0], v0[1]); w.y = cvt_pk_bf16(v0[2], v0[3]); w.z = cvt_pk_bf16(v1[0], v1[1]); w.w = cvt_pk_bf16(v1[2], v1[3]);
                    *(u32x4*)(O + (size_t)(u.pm * 256 + r) * ld + u.pn * 256 + bj * 128 + wc * 32 + 8 * fq) = w;
                }
            }
    }
};

__device__ __forceinline__ void moe_tables(LAS int* mt, const int* cnt_g, int tid) {
    if (tid < 32) mt[tid] = cnt_g[tid];
    LDS_WAIT(); __syncthreads();
    if (tid == 0) { int p = 0, o = 0; for (int e = 0; e < NE; ++e) { mt[32 + e] = p; mt[65 + e] = o; const int c = mt[e]; p += 8 * ((c + 255) >> 8); o += c; } mt[32 + NE] = p; mt[65 + NE] = o; }
    LDS_WAIT(); __syncthreads();
}
template <bool GU> struct SchedMoE {
    const LAS int* mt; const char* A; const char* Bt; int G, c;
    __device__ __forceinline__ bool next(int i, gm::Unit& u) const {
        const int L = i * G + c; if (L >= mt[32 + NE]) return false;
        int e = 0;
#pragma unroll 1
        for (int k = 1; k < NE; ++k) if (L >= mt[32 + k]) e = k;
        const int rem = L - mt[32 + e], te = (mt[e] + 255) >> 8, pn = rem / te, mtile = rem - pn * te;
        u.pm = mtile; u.pn = pn; u.kind = e; u.ti = i;
        if (GU) { u.a = A; u.b = Bt + ((size_t)e * 2048 + pn * 256) * DM * 2; }
        else { u.a = A + (size_t)(mt[65 + e] + mtile * 256) * DE * 2; u.b = Bt + ((size_t)e * 2048 + pn * 256) * DE * 2; }
        return true;
    }
};
struct EpiGU {
    bf16_t* Hact; const float* rs2; const LAS int* mt; const LAS int* tab;
    __device__ __forceinline__ void operator()(const f32x4 (&acc)[2][2][4][2], const gm::Unit& u, int wr, int wc, int fr, int fq) const {
        const int e = u.kind, valid = mt[e] - u.pm * 256, slot0 = mt[65 + e] + u.pm * 256;
#pragma unroll
        for (int ai = 0; ai < 2; ++ai)
#pragma unroll
            for (int m = 0; m < 4; ++m) {
                const int r = ai * 128 + wr * 64 + m * 16 + fr;
                if (r < valid) {
                    const float rs = rs2[tab[u.ti * 256 + r]];
                    const f32x4 g0 = acc[ai][0][m][0] * rs, g1 = acc[ai][0][m][1] * rs, u0 = acc[ai][1][m][0] * rs, u1 = acc[ai][1][m][1] * rs;
                    float o[8];
#pragma unroll
                    for (int j = 0; j < 4; ++j) { o[j] = g0[j] * __builtin_amdgcn_rcpf(1.f + __expf(-g0[j])) * u0[j]; o[4 + j] = g1[j] * __builtin_amdgcn_rcpf(1.f + __expf(-g1[j])) * u1[j]; }
                    u32x4 w; w.x = cvt_pk_bf16(o[0], o[1]); w.y = cvt_pk_bf16(o[2], o[3]); w.z = cvt_pk_bf16(o[4], o[5]); w.w = cvt_pk_bf16(o[6], o[7]);
                    *(u32x4*)(Hact + (size_t)(slot0 + r) * DE + u.pn * 128 + wc * 32 + 8 * fq) = w;
                }
            }
    }
};
struct EpiDown {
    bf16_t* Y; const LAS int* mt;
    __device__ __forceinline__ void operator()(const f32x4 (&acc)[2][2][4][2], const gm::Unit& u, int wr, int wc, int fr, int fq) const {
        const int e = u.kind, valid = mt[e] - u.pm * 256, slot0 = mt[65 + e] + u.pm * 256;
#pragma unroll
        for (int ai = 0; ai < 2; ++ai)
#pragma unroll
            for (int m = 0; m < 4; ++m) {
                const int r = ai * 128 + wr * 64 + m * 16 + fr;
                if (r < valid) {
#pragma unroll
                    for (int bj = 0; bj < 2; ++bj) { const f32x4 v0 = acc[ai][bj][m][0], v1 = acc[ai][bj][m][1];
                        u32x4 w; w.x = cvt_pk_bf16(v0[0], v0[1]); w.y = cvt_pk_bf16(v0[2], v0[3]); w.z = cvt_pk_bf16(v1[0], v1[1]); w.w = cvt_pk_bf16(v1[2], v1[3]);
                        *(u32x4*)(Y + (size_t)(slot0 + r) * DM + u.pn * 256 + bj * 128 + wc * 32 + 8 * fq) = w; }
                }
            }
    }
};
__device__ __forceinline__ void final_rows(Frame& F, float* hio, const bf16_t* Y, const int* tok_e, const int* tok_pos, const float* tok_w, const float* fw, const LAS int* mt) {
    const int gw = F.vcu * NWAVES + F.wave, NGW = F.G * NWAVES, lane = F.lane;
    for (int t = gw; t < M; t += NGW) {
        const int e1 = tok_e[2 * t], e2 = tok_e[2 * t + 1];
        const size_t s1 = (size_t)(mt[65 + e1] + tok_pos[2 * t]), s2 = (size_t)(mt[65 + e2] + tok_pos[2 * t + 1]);
        const float w1 = tok_w[2 * t], w2 = tok_w[2 * t + 1];
        f32x4* hr = (f32x4*)(hio + (size_t)t * DM) + 2 * lane;
        const u32x4* y1 = (const u32x4*)(Y + s1 * DM) + lane; const u32x4* y2 = (const u32x4*)(Y + s2 * DM) + lane;
        float v[4][8]; float ss = 0.f;
#pragma unroll
        for (int j = 0; j < 4; ++j) {
            const f32x4 a0 = hr[128 * j], a1 = hr[128 * j + 1]; const u32x4 p = y1[64 * j], q = y2[64 * j];
            const float pa[8] = {bflo(p.x), bfhi(p.x), bflo(p.y), bfhi(p.y), bflo(p.z), bfhi(p.z), bflo(p.w), bfhi(p.w)};
            const float qa[8] = {bflo(q.x), bfhi(q.x), bflo(q.y), bfhi(q.y), bflo(q.z), bfhi(q.z), bflo(q.w), bfhi(q.w)};
            const float ha[8] = {a0[0], a0[1], a0[2], a0[3], a1[0], a1[1], a1[2], a1[3]};
#pragma unroll
            for (int k = 0; k < 8; ++k) { v[j][k] = ha[k] + (w1 * pa[k] + w2 * qa[k]); ss += v[j][k] * v[j][k]; }
        }
        ss = wave_sum(ss);
        const float rs = rsqrtf(ss * (1.f / DM) + EPS);
#pragma unroll
        for (int j = 0; j < 4; ++j) {
            const f32x4 g0 = *((const f32x4*)fw + 2 * lane + 128 * j), g1 = *((const f32x4*)fw + 2 * lane + 128 * j + 1);
            hr[128 * j] = (f32x4){v[j][0] * rs * g0[0], v[j][1] * rs * g0[1], v[j][2] * rs * g0[2], v[j][3] * rs * g0[3]};
            hr[128 * j + 1] = (f32x4){v[j][4] * rs * g1[0], v[j][5] * rs * g1[1], v[j][6] * rs * g1[2], v[j][7] * rs * g1[3]};
        }
    }
}

__device__ __forceinline__ void router_rows(Frame& F, const float* h2, const bf16_t* wrh, const float* b_rg, const float* b_re, float* rs2, int* cnt, int* list, int* tok_e, int* tok_pos, float* tok_w) {
    const int lane = F.lane, tid = F.tid, w = F.wave, ti = lane & 15, kg = lane >> 4;
    LAS float* part = (LAS float*)(F.lds + RING_OFF);
    LAS float* sqp = part + 8 * 16 * 48;
    LAS float* lgt = sqp + 8 * 16;
    const bf16_t* wrl = wrh + 48 * DM;
    for (int g = F.vcu; g < M / 16; g += F.G) {
        const float* hr = h2 + (size_t)(g * 16 + ti) * DM + w * 256 + 8 * kg;
        f32x4 acc[3] = {{0.f, 0.f, 0.f, 0.f}, {0.f, 0.f, 0.f, 0.f}, {0.f, 0.f, 0.f, 0.f}}; float sq = 0.f;
#pragma unroll 2
        for (int s = 0; s < 8; ++s) {
            const f32x4 x0 = *(const f32x4*)(hr + 32 * s), x1 = *(const f32x4*)(hr + 32 * s + 4);
            bf16x8 bh[3], bl[3];
#pragma unroll
            for (int nt = 0; nt < 3; ++nt) { const size_t o = (size_t)(16 * nt + ti) * DM + w * 256 + 32 * s + 8 * kg; bh[nt] = *(const bf16x8*)(wrh + o); bl[nt] = *(const bf16x8*)(wrl + o); }
            sq += (x0[0] * x0[0] + x0[1] * x0[1]) + (x0[2] * x0[2] + x0[3] * x0[3]) + (x1[0] * x1[0] + x1[1] * x1[1]) + (x1[2] * x1[2] + x1[3] * x1[3]);
            u32x4 hw, lw;
            hw.x = cvt_pk_bf16(x0[0], x0[1]); hw.y = cvt_pk_bf16(x0[2], x0[3]); hw.z = cvt_pk_bf16(x1[0], x1[1]); hw.w = cvt_pk_bf16(x1[2], x1[3]);
            lw.x = cvt_pk_bf16(x0[0] - bflo(hw.x), x0[1] - bfhi(hw.x)); lw.y = cvt_pk_bf16(x0[2] - bflo(hw.y), x0[3] - bfhi(hw.y));
            lw.z = cvt_pk_bf16(x1[0] - bflo(hw.z), x1[1] - bfhi(hw.z)); lw.w = cvt_pk_bf16(x1[2] - bflo(hw.w), x1[3] - bfhi(hw.w));
            const bf16x8 ah = *reinterpret_cast<const bf16x8*>(&hw), al = *reinterpret_cast<const bf16x8*>(&lw);
#pragma unroll
            for (int nt = 0; nt < 3; ++nt) { acc[nt] = __builtin_amdgcn_mfma_f32_16x16x32_bf16(ah, bh[nt], acc[nt], 0, 0, 0); acc[nt] = __builtin_amdgcn_mfma_f32_16x16x32_bf16(ah, bl[nt], acc[nt], 0, 0, 0);
                acc[nt] = __builtin_amdgcn_mfma_f32_16x16x32_bf16(al, bh[nt], acc[nt], 0, 0, 0); }
        }
        sq += __shfl_xor(sq, 16); sq += __shfl_xor(sq, 32);
        __syncthreads();
#pragma unroll
        for (int nt = 0; nt < 3; ++nt)
#pragma unroll
            for (int r = 0; r < 4; ++r) part[(w * 16 + 4 * kg + r) * 48 + 16 * nt + ti] = acc[nt][r];
        if (kg == 0) sqp[w * 16 + ti] = sq;
        __syncthreads();
        for (int i = tid; i < 16 * 48 + 16; i += NWAVES * 64) { float s = 0.f;
            if (i < 16 * 48) {
#pragma unroll
                for (int ww = 0; ww < 8; ++ww) s += part[ww * 16 * 48 + i]; }
            else {
#pragma unroll
                for (int ww = 0; ww < 8; ++ww) s += sqp[ww * 16 + (i - 16 * 48)]; }
            lgt[i] = s; }
        __syncthreads();
        if (tid < 16) {
            const int tt = g * 16 + tid; const LAS float* lg = lgt + tid * 48;
            const float rs = rsqrtf(lgt[16 * 48 + tid] * (1.f / DM) + EPS);
            float gm_ = -INFINITY; int gi = 0; float gv[4];
#pragma unroll
            for (int i = 0; i < 4; ++i) { gv[i] = lg[i] * rs + b_rg[i]; if (gv[i] > gm_) { gm_ = gv[i]; gi = i; } }
            float gs = 0.f;
#pragma unroll
            for (int i = 0; i < 4; ++i) gs += __expf(gv[i] - gm_);
            const float gwt = 1.f / gs;
            float e1 = -INFINITY, e2 = -INFINITY; int i1 = 0, i2 = 0;
#pragma unroll
            for (int i = 0; i < 8; ++i) { const float vv = lg[4 + gi * 8 + i] * rs + b_re[gi * 8 + i]; if (vv > e1) { e2 = e1; i2 = i1; e1 = vv; i1 = i; } else if (vv > e2) { e2 = vv; i2 = i; } }
            const float p2 = 1.f / (1.f + __expf(e1 - e2)), p1 = 1.f - p2;
            const int ea = gi * 8 + i1, eb = gi * 8 + i2;
            const int pa = atomicAdd(&cnt[ea], 1), pb = atomicAdd(&cnt[eb], 1);
            list[ea * M + pa] = tt; list[eb * M + pb] = tt;
            tok_e[tt * 2] = ea; tok_e[tt * 2 + 1] = eb; tok_pos[tt * 2] = pa; tok_pos[tt * 2 + 1] = pb; tok_w[tt * 2] = gwt * p1; tok_w[tt * 2 + 1] = gwt * p2; rs2[tt] = rs;
        }
    }
    __syncthreads();
}

__device__ __forceinline__ void gnorm_rows(Frame& F, const float* ssq, bf16_t* mixb) {
    const int gw = F.vcu * NWAVES + F.wave, NGW = F.G * NWAVES, lane = F.lane;
#pragma unroll 2
    for (int tok = gw; tok < M; tok += NGW) {
        float part = ssq[(size_t)tok * 64 + lane];
        part += __shfl_xor(part, 1); part += __shfl_xor(part, 2); part += __shfl_xor(part, 4); part += __shfl_xor(part, 8);
        const float rsl = rsqrtf(part * (1.f / 512.f) + EPS);
        u32x4* p = (u32x4*)(mixb + (size_t)tok * MIXW + AW) + lane;
        u32x4 w[4];
#pragma unroll
        for (int g = 0; g < 4; ++g) w[g] = p[64 * g];
#pragma unroll
        for (int g = 0; g < 4; ++g) { const float rs = __shfl(rsl, 16 * g); u32x4 o;
            o.x = cvt_pk_bf16(bflo(w[g].x) * rs, bfhi(w[g].x) * rs); o.y = cvt_pk_bf16(bflo(w[g].y) * rs, bfhi(w[g].y) * rs); o.z = cvt_pk_bf16(bflo(w[g].z) * rs, bfhi(w[g].z) * rs); o.w = cvt_pk_bf16(bflo(w[g].w) * rs, bfhi(w[g].w) * rs);
            p[64 * g] = o; }
    }
}

#ifndef REP_P0
#define REP_P0 1
#endif
#ifndef REP_G1
#define REP_G1 1
#endif
#ifndef REP_SSD
#define REP_SSD 1
#endif
#ifndef REP_MOE
#define REP_MOE 1
#endif
#ifndef REP_ATT
#define REP_ATT 1
#endif
#ifndef REP_G2
#define REP_G2 1
#endif
__global__ void __launch_bounds__(NWAVES * 64, 2) fwd(Args args) {
    extern __shared__ __attribute__((aligned(16))) unsigned char lds_raw[];
    Frame F;
    F.lds = (LAS unsigned char*)lds_raw;
    F.MISC = (volatile LAS unsigned*)(F.lds + MISC_OFF);
    F.tid = threadIdx.x; F.lane = F.tid & 63; F.wave = __builtin_amdgcn_readfirstlane(F.tid >> 6);
    F.G = gridDim.x; { const int bx = blockIdx.x; F.vcu = (F.G % 8 == 0) ? (bx % 8) * (F.G / 8) + bx / 8 : bx; }
    for (int u = F.tid; u < (LDS_BYTES - LDSCTL_OFF) / 4; u += NWAVES * 64) ((LAS unsigned*)(F.lds + LDSCTL_OFF))[u] = 0u;
    __syncthreads();
    (void)xcd_barrier_post((unsigned*)(args.ws + WS_CTL) + CW_BAR + args.li * XCD_BAR_WORDS, F.MISC + 8);
#define GRID_BAR() do { GAS unsigned char* wb_ = (GAS unsigned char*)args.ws; asm volatile("" : "+s"(wb_)); XcdBarrier b_; \
        b_.bar = (unsigned*)((unsigned char*)wb_ + WS_CTL) + CW_BAR + args.li * XCD_BAR_WORDS; b_.x = xb_xcc_id(); b_.st = F.MISC + 8; xcd_barrier(b_, F.wave * 64 + lane_id_now()); } while (0)
    const int lo = args.ph_lo, hi = args.ph_hi;
#define IN(k) (lo <= (k) && (k) < hi)
#define BOTH(k) (IN(k) && IN((k) + 1))
#define PHASE_WS() F.lane = lane_id_now(); F.tid = F.wave * 64 + F.lane; GAS unsigned char* wsg_ = (GAS unsigned char*)args.ws; asm volatile("" : "+s"(wsg_)); unsigned char* ws = (unsigned char*)wsg_
    if (IN(0)) { F.lane = lane_id_now(); F.tid = F.wave * 64 + F.lane;
p0_prologue(F, args); if constexpr (REP_P0 > 1) p0_prologue(F, args); if (BOTH(0)) GRID_BAR(); }
    if (IN(1)) {
        PHASE_WS();
        SchedG1 S{(const char*)(ws + WS_XB), (const char*)(ws + WS_WIN_T), F.G, (int)blockIdx.x};
        EpiG1 E{(bf16_t*)(ws + WS_PROJ), (float*)(ws + WS_DTRAW), (const float*)(ws + WS_RSX), (const float*)(ws + WS_ROPE), (float*)(ws + WS_KMEAN)};
gm::gemm_phase<EpiG1, SchedG1, false>(F.tid, F.lds + RING_OFF, (const LAS int*)(F.lds + TAB_OFF), DM, S, E);
        if constexpr (REP_G1 > 1) { __syncthreads(); gm::gemm_phase<EpiG1, SchedG1, false>(F.tid, F.lds + RING_OFF, (const LAS int*)(F.lds + TAB_OFF), DM, S, E); }
        if (BOTH(1)) GRID_BAR();
    }
    if (IN(2)) {
        PHASE_WS();
        sd::conv_prepass(F.vcu * NWAVES * 64 + F.tid, F.G * NWAVES * 64, (const bf16_t*)(ws + WS_PROJ), args.in[4], args.in[5], (bf16_t*)(ws + WS_XBCC));
        if (BOTH(2)) GRID_BAR();
    }
    if (IN(3)) {
        PHASE_WS();
        for (int L = F.vcu; L < BATCH * SH; L += F.G)
            sd::ssd_unit(F.tid, L / SH, L % SH, (const bf16_t*)(ws + WS_PROJ), (const bf16_t*)(ws + WS_XBCC), (const float*)(ws + WS_DTRAW), args.in[6], args.in[7], args.in[8],
                         (bf16_t*)(ws + WS_MIXB), (float*)(ws + WS_SS), (LAS char*)(F.lds + RING_OFF));
        if constexpr (REP_SSD > 1) {
        for (int L = F.vcu; L < BATCH * SH; L += F.G)
            sd::ssd_unit(F.tid, L / SH, L % SH, (const bf16_t*)(ws + WS_PROJ), (const bf16_t*)(ws + WS_XBCC), (const float*)(ws + WS_DTRAW), args.in[6], args.in[7], args.in[8],
                         (bf16_t*)(ws + WS_MIXB), (float*)(ws + WS_SS), (LAS char*)(F.lds + RING_OFF));
        }
        if (BOTH(3)) GRID_BAR();
    }
    if (IN(4)) {
        PHASE_WS();
        for (int L = F.vcu; L < BATCH * AH * 4; L += F.G) {
            const int b = L >> 5, h = (L >> 2) & 7, pi = L & 3;
            const bf16_t* pb = (const bf16_t*)(ws + WS_PROJ) + (size_t)b * SEQ * LDP + h * HD;
#pragma unroll 1
            for (int k = 0; k < 2; ++k) { const int jb = k ? pi : 7 - pi;
                at::attn_unit<true>(F.tid, pb + (size_t)jb * MB * LDP + C_Q, pb + C_K, (bf16_t*)(ws + WS_MIXB) + (size_t)(b * SEQ + jb * MB) * MIXW + h * HD,
                                    4 * (jb + 1), jb, (const float*)(ws + WS_KMEAN) + (size_t)b * NB * 1024 + h * HD, (LAS char*)(F.lds + RING_OFF)); }
        }
        if constexpr (REP_ATT > 1) {
        for (int L = F.vcu; L < BATCH * AH * 4; L += F.G) {
            const int b = L >> 5, h = (L >> 2) & 7, pi = L & 3;
            const bf16_t* pb = (const bf16_t*)(ws + WS_PROJ) + (size_t)b * SEQ * LDP + h * HD;
#pragma unroll 1
            for (int k = 0; k < 2; ++k) { const int jb = k ? pi : 7 - pi;
                at::attn_unit<true>(F.tid, pb + (size_t)jb * MB * LDP + C_Q, pb + C_K, (bf16_t*)(ws + WS_MIXB) + (size_t)(b * SEQ + jb * MB) * MIXW + h * HD,
                                    4 * (jb + 1), jb, (const float*)(ws + WS_KMEAN) + (size_t)b * NB * 1024 + h * HD, (LAS char*)(F.lds + RING_OFF)); }
        }
        }
        __syncthreads();
        gnorm_rows(F, (const float*)(ws + WS_SS), (bf16_t*)(ws + WS_MIXB));
        if (BOTH(4)) GRID_BAR();
    }
    if (IN(5)) {
        PHASE_WS();
        SchedTiles S{(const char*)(ws + WS_MIXB), (const char*)(ws + WS_WOUT_T), 64, 8, MIXW, F.G, (int)blockIdx.x};
        EpiRes E{args.in[0], args.out, (bf16_t*)(ws + WS_XB), (float*)(ws + WS_SS)};
        gm::gemm_phase<EpiRes, SchedTiles, false>(F.tid, F.lds + RING_OFF, (const LAS int*)(F.lds + TAB_OFF), MIXW, S, E);
        if constexpr (REP_G2 > 1) { __syncthreads(); gm::gemm_phase<EpiRes, SchedTiles, false>(F.tid, F.lds + RING_OFF, (const LAS int*)(F.lds + TAB_OFF), MIXW, S, E); }
        if (BOTH(5)) GRID_BAR();
    }
    if (IN(6)) {
        PHASE_WS();
        SchedQKV S{(const char*)(ws + WS_XB), (const char*)(ws + WS_WCQ_T), (const char*)(ws + WS_MEMB), (const char*)(ws + WS_WCKV_T), F.G, (int)blockIdx.x};
        gm::Unit u0; LAS float* rsl = (LAS float*)(F.lds + RSL_OFF);
        if (S.next(0, u0) && F.tid < 256) {
            const int row = u0.pm * 256 + F.tid;
            if (u0.kind == 0) { const f32x4* p = (const f32x4*)((const float*)(ws + WS_SS) + (size_t)row * 32); float q = 0.f;
#pragma unroll
                for (int j = 0; j < 8; ++j) { const f32x4 v = p[j]; q += (v[0] + v[1]) + (v[2] + v[3]); }
                rsl[F.tid] = rsqrtf(q * (1.f / DM) + EPS); }
            else rsl[F.tid] = ((const float*)(ws + WS_RSMEM))[row];
        }
        VM_WAIT(); LDS_WAIT(); __syncthreads();
        EpiScale E{(bf16_t*)(ws + WS_QC), (bf16_t*)(ws + WS_KVC), CW, 2 * CW, rsl};
        gm::gemm_phase<EpiScale, SchedQKV, false>(F.tid, F.lds + RING_OFF, (const LAS int*)(F.lds + TAB_OFF), DM, S, E);
        if (BOTH(6)) GRID_BAR();
    }
    if (IN(7)) {
        PHASE_WS();
        for (int L = F.vcu; L < BATCH * CH * 8; L += F.G) {
            const int b = L >> 5, h = (L >> 3) & 3, qt = L & 7;
            const bf16_t* kb_ = (const bf16_t*)(ws + WS_KVC) + (size_t)b * MEM * (2 * CW) + h * CHD;
            at::attn_unit<false>(F.tid, (const bf16_t*)(ws + WS_QC) + (size_t)(b * SEQ + qt * 256) * CW + h * CHD, kb_,
                                 (bf16_t*)(ws + WS_OC) + (size_t)(b * SEQ + qt * 256) * CW + h * CHD, 4, 0, nullptr, (LAS char*)(F.lds + RING_OFF));
        }
        __syncthreads();
        if (BOTH(7)) GRID_BAR();
    }
    if (IN(8)) {
        PHASE_WS();
        SchedTiles S{(const char*)(ws + WS_OC), (const char*)(ws + WS_WCO_T), 64, 8, CW, F.G, (int)blockIdx.x};
        EpiRes E{args.out, args.out, (bf16_t*)(ws + WS_XB), (float*)(ws + WS_SS) + (size_t)M * 32};
        gm::gemm_phase<EpiRes, SchedTiles, false>(F.tid, F.lds + RING_OFF, (const LAS int*)(F.lds + TAB_OFF), CW, S, E);
        if (BOTH(8)) GRID_BAR();
    }
    if (IN(9)) {
        PHASE_WS();
        int* tok_e = (int*)(ws + WS_TOK);
        router_rows(F, args.out, (const bf16_t*)(ws + WS_WR), args.in[20], args.in[22], (float*)(ws + WS_RS2), (int*)(ws + WS_CTL) + CW_CNT, (int*)(ws + WS_LIST), tok_e, tok_e + 2 * M, (float*)(tok_e + 4 * M));
        if (BOTH(9)) GRID_BAR();
    }
    if (IN(10)) {
        PHASE_WS();
        LAS int* mt = (LAS int*)(F.lds + MOE_OFF); LAS int* tab = (LAS int*)(F.lds + TAB_OFF);
        moe_tables(mt, (const int*)(ws + WS_CTL) + CW_CNT, F.tid);
        SchedMoE<true> S{mt, (const char*)(ws + WS_XB), (const char*)(ws + WS_WGU_T), F.G, F.vcu};
        { const int* list = (const int*)(ws + WS_LIST); gm::Unit u;
          for (int i = 0; i < 8 && S.next(i, u); ++i) if (F.tid < 256) { const int rg = u.pm * 256 + F.tid; tab[i * 256 + F.tid] = list[u.kind * M + (rg < mt[u.kind] ? rg : 0)]; } }
        VM_WAIT(); LDS_WAIT(); __syncthreads();
        EpiGU E{(bf16_t*)(ws + WS_HACT), (const float*)(ws + WS_RS2), mt, tab};
gm::gemm_phase<EpiGU, SchedMoE<true>, true>(F.tid, F.lds + RING_OFF, tab, DM, S, E);
        if constexpr (REP_MOE > 1) { __syncthreads(); gm::gemm_phase<EpiGU, SchedMoE<true>, true>(F.tid, F.lds + RING_OFF, tab, DM, S, E); }
        if (BOTH(10)) GRID_BAR();
    }
    if (IN(11)) {
        PHASE_WS();
        LAS int* mt = (LAS int*)(F.lds + MOE_OFF);
        moe_tables(mt, (const int*)(ws + WS_CTL) + CW_CNT, F.tid);
        SchedMoE<false> S{mt, (const char*)(ws + WS_HACT), (const char*)(ws + WS_WD_T), F.G, F.vcu};
        EpiDown E{(bf16_t*)(ws + WS_Y), mt};
gm::gemm_phase<EpiDown, SchedMoE<false>, false>(F.tid, F.lds + RING_OFF, (const LAS int*)(F.lds + TAB_OFF), DE, S, E);
        if constexpr (REP_MOE > 1) { __syncthreads(); gm::gemm_phase<EpiDown, SchedMoE<false>, false>(F.tid, F.lds + RING_OFF, (const LAS int*)(F.lds + TAB_OFF), DE, S, E); }
        if (BOTH(11)) GRID_BAR();
    }
    if (IN(12)) {
        PHASE_WS();
        LAS int* mt = (LAS int*)(F.lds + MOE_OFF);
        moe_tables(mt, (const int*)(ws + WS_CTL) + CW_CNT, F.tid);
        const int* tok_e = (const int*)(ws + WS_TOK);
        final_rows(F, args.out, (const bf16_t*)(ws + WS_Y), tok_e, tok_e + 2 * M, (const float*)(tok_e + 4 * M), args.in[26], mt);
    }
#undef IN
#undef BOTH
}
extern "C" void kernel_launch(void* const* d_in, const int* in_sizes, int n_in, void* d_out, int out_size, void* d_ws, size_t ws_size, hipStream_t stream) {
  static int grid = 0;
  static float rfv[16];
  if (grid == 0) {
    int dev = 0, cus = 0;
    if (hipGetDevice(&dev) != hipSuccess || hipDeviceGetAttribute(&cus, hipDeviceAttributeMultiprocessorCount, dev) != hipSuccess) { fprintf(stderr, "kernel_launch: device query failed\n"); grid = -1; return; }
    if (hipFuncSetAttribute((const void*)fwd, hipFuncAttributeMaxDynamicSharedMemorySize, LDS_BYTES) != hipSuccess) { fprintf(stderr, "kernel_launch: hipFuncSetAttribute failed\n"); grid = -1; return; }
    int per_cu = 0;
    if (hipOccupancyMaxActiveBlocksPerMultiprocessor(&per_cu, (const void*)fwd, NWAVES * 64, LDS_BYTES) != hipSuccess || per_cu < 1) fprintf(stderr, "kernel_launch: occupancy query says %d\n", per_cu);
    (void)hipGetLastError();
    for (int i = 0; i < 16; ++i) rfv[i] = (float)pow(500000.0, -(double)i / 16.0);
    grid = cus;
  }
  if (grid < 0) return;
  float* out = (float*)d_out;
  unsigned char* ws = (unsigned char*)d_ws;
  (void)hipMemsetAsync(ws + WS_CTL, 0, CTL_ZERO_BYTES, stream);
  Args a{};
  for (int i = 0; i < 27; ++i) a.in[i] = (const float*)d_in[i];
  a.out = out; a.ws = ws; for (int i = 0; i < 16; ++i) a.rf[i] = rfv[i];
  a.ph_lo = 0; a.ph_hi = 13; a.li = 0;
  hipLaunchKernelGGL(fwd, dim3(grid), dim3(NWAVES * 64), LDS_BYTES, stream, a);
}
```

```cpp
#include <hip/hip_runtime.h>
#include <stdint.h>
#include <math.h>
#include <cstdio>

constexpr int DM = 2048, BATCH = 8, SEQ = 2048, M = BATCH * SEQ, MEM = 256, MROWS = BATCH * MEM;
constexpr float EPS = 1e-6f;
constexpr int AH = 8, HD = 128, AW = 1024;
constexpr int MB = 256, NB = SEQ / MB;
constexpr int SW = 2048, SH = 32, SG = 4, SCONV = 4, CONVD = 3072;
constexpr int MIXW = 3072, INW = 8224, LDP = 8448;
constexpr int C_Q = 0, C_K = 1024, C_V = 2048, C_Z = 3072, C_XBC = 5120, C_DT = 8192;
constexpr int CH = 4, CHD = 128, CW = 512;
constexpr int NG = 4, EPG = 8, NE = 32, DE = 1024;

#define LAS __attribute__((address_space(3)))
#define GAS __attribute__((address_space(1)))
typedef unsigned short bf16_t;
typedef short bf16x8 __attribute__((ext_vector_type(8)));
typedef float f32x4 __attribute__((ext_vector_type(4)));
typedef float f32x2 __attribute__((ext_vector_type(2)));
typedef unsigned u32x4 __attribute__((ext_vector_type(4)));
typedef unsigned u32x2 __attribute__((ext_vector_type(2)));
#define LDS_WAIT() asm volatile("s_waitcnt lgkmcnt(0)" ::: "memory")
#define VM_WAIT() asm volatile("s_waitcnt vmcnt(0)" ::: "memory")

__device__ __forceinline__ unsigned cvt_pk_bf16(float lo, float hi) { unsigned r; asm volatile("v_cvt_pk_bf16_f32 %0, %1, %2" : "=v"(r) : "v"(lo), "v"(hi)); return r; }
__device__ __forceinline__ float bf2f(bf16_t b) { return __uint_as_float(((unsigned)b) << 16); }
__device__ __forceinline__ float bflo(unsigned w) { return __uint_as_float(w << 16); }
__device__ __forceinline__ float bfhi(unsigned w) { return __uint_as_float(w & 0xffff0000u); }
__device__ __forceinline__ void ld8bf(const bf16_t* p, float (&o)[8]) { const u32x4 w = *(const u32x4*)p; o[0] = bflo(w.x); o[1] = bfhi(w.x); o[2] = bflo(w.y); o[3] = bfhi(w.y); o[4] = bflo(w.z); o[5] = bfhi(w.z); o[6] = bflo(w.w); o[7] = bfhi(w.w); }
__device__ __forceinline__ float wave_sum(float v) {
#pragma unroll
  for (int o = 1; o < 64; o <<= 1) v += __shfl_xor(v, o);
  return v;
}
__device__ __forceinline__ float wave_max(float v) {
#pragma unroll
  for (int o = 1; o < 64; o <<= 1) v = fmaxf(v, __shfl_xor(v, o));
  return v;
}
__device__ __forceinline__ int lane_id_now() { int l; asm volatile("v_mbcnt_lo_u32_b32 %0, -1, 0\n\tv_mbcnt_hi_u32_b32 %0, -1, %0" : "=v"(l)); return l; }
__device__ __forceinline__ float silu_f(float x) { return x / (1.f + __expf(-x)); }

constexpr size_t MiB = 1u << 20;
constexpr size_t WS_CTL = 0, CTL_ZERO_BYTES = 1 * MiB;
constexpr int CW_BAR = 4096;
constexpr int CW_CNT = 65536;
constexpr size_t WS_WIN_T = 1 * MiB;
constexpr size_t WS_WOUT_T = 34 * MiB;
constexpr size_t WS_WCQ_T = 46 * MiB;
constexpr size_t WS_WCKV_T = 48 * MiB;
constexpr size_t WS_WCO_T = 52 * MiB;
constexpr size_t WS_WR = 54 * MiB;
constexpr size_t WS_SMALL = 55 * MiB;
constexpr size_t WS_ROPE = WS_SMALL, WS_RSX = WS_SMALL + 256 * 1024, WS_RSMEM = WS_RSX + 64 * 1024, WS_RS2 = WS_RSMEM + 64 * 1024, WS_KMEAN = WS_RS2 + 64 * 1024;
constexpr size_t WS_DTRAW = 56 * MiB;
constexpr size_t WS_SS = 58 * MiB;
constexpr size_t WS_MEMB = 62 * MiB;
constexpr size_t WS_XB = 70 * MiB;
constexpr size_t WS_PROJ = 134 * MiB;
constexpr size_t WS_MIXB = 398 * MiB;
constexpr size_t WS_QC = 494 * MiB, WS_OC = 510 * MiB;
constexpr size_t WS_KVC = 526 * MiB;
constexpr size_t WS_WGU_T = 530 * MiB;
constexpr size_t WS_WD_T = 786 * MiB;
constexpr size_t WS_LIST = 914 * MiB;
constexpr size_t WS_TOK = 916 * MiB;
constexpr size_t WS_HACT = WS_PROJ;
constexpr size_t WS_Y = WS_PROJ + 66 * MiB;
constexpr size_t WS_XBCC = 918 * MiB;
constexpr size_t WS_AFTER = 1014 * MiB;
#define XB_TMO      128
#define XB_XCNT(j)  (256  + 64 * (j))
#define XB_XSUB(j)  (1280 + 64 * (j))
#define XB_XGEN(j)  (2304 + 64 * (j))
#define XB_TOP      3328
#define XB_TOPGEN   3392
#define XCD_BAR_WORDS 3456
#define XB_SPIN_CAP (1u << 18)

__device__ __forceinline__ unsigned xb_ld(unsigned* p)              { return __hip_atomic_load(p, __ATOMIC_RELAXED, __HIP_MEMORY_SCOPE_AGENT); }
__device__ __forceinline__ unsigned xb_add(unsigned* p, unsigned v) { return __hip_atomic_fetch_add(p, v, __ATOMIC_RELAXED, __HIP_MEMORY_SCOPE_AGENT); }
__device__ __forceinline__ unsigned xb_xcc_id() { return (unsigned)__builtin_amdgcn_s_getreg((3 << 11) | 20) & 0xFu; }
#define XB_SPIN(cond, bar) do { unsigned _sp = 0; while (cond) { __builtin_amdgcn_s_sleep(1); \
    if ((++_sp & 255u) == 0u) { if (xb_ld(&(bar)[XB_TMO])) break; if (_sp > XB_SPIN_CAP) { atomicAdd(&(bar)[XB_TMO], 1u); break; } } } } while (0)

struct XcdBarrier {
    unsigned* bar; unsigned x;
    volatile LAS unsigned* st;
};

__device__ __forceinline__ XcdBarrier xcd_barrier_post(unsigned* bar, volatile LAS unsigned* st) {
    XcdBarrier b; b.bar = bar; b.x = xb_xcc_id(); b.st = st;
    if (threadIdx.x == 0) (void)xb_add(&bar[XB_XCNT(b.x)], 1u);
    return b;
}
__device__ __forceinline__ void xcd_barrier_complete(unsigned* bar, unsigned x, unsigned& nloc, unsigned& nx) {
    const unsigned G = gridDim.x * gridDim.y * gridDim.z;
    unsigned sum, cnt, mine, sp = 0u;
    for (;;) {
        sum = 0u; cnt = 0u; mine = 0u;
#pragma unroll
        for (unsigned j = 0; j < 16; ++j) { const unsigned c = xb_ld(&bar[XB_XCNT(j)]); sum += c; cnt += (c > 0u) ? 1u : 0u; mine = (j == x) ? c : mine; }
        if (sum == G) break;
        __builtin_amdgcn_s_sleep(1);
        if ((++sp & 255u) == 0u) { if (xb_ld(&bar[XB_TMO])) break; if (sp > XB_SPIN_CAP) { atomicAdd(&bar[XB_TMO], 1u); break; } }
    }
    nloc = mine > 0u ? mine : 1u; nx = cnt > 0u ? cnt : 1u;
}

__device__ __forceinline__ void xcd_barrier(const XcdBarrier& b, const int xb_tid) {
    asm volatile("s_waitcnt vmcnt(0)" ::: "memory");
    __syncthreads();
    if (xb_tid == 0) {
        unsigned* bar = b.bar;
        __builtin_amdgcn_s_waitcnt(0);
        unsigned nloc = b.st[0], nx = b.st[1];
        if (nloc == 0u) { xcd_barrier_complete(bar, b.x, nloc, nx); b.st[0] = nloc; b.st[1] = nx; }
        const unsigned old = xb_add(&bar[XB_XSUB(b.x)], 1u);
        const unsigned gen = old / nloc;
        if (old + 1u == (gen + 1u) * nloc) {
            __builtin_amdgcn_fence(__ATOMIC_RELEASE, "agent");
            asm volatile("s_waitcnt vmcnt(0)" ::: "memory");
            const unsigned og = xb_add(&bar[XB_TOP], 1u);
            const unsigned tg = og / nx;
            if (og + 1u == (tg + 1u) * nx) xb_add(&bar[XB_TOPGEN], 1u);
            else XB_SPIN(xb_ld(&bar[XB_TOPGEN]) == tg, bar);
            __builtin_amdgcn_fence(__ATOMIC_ACQUIRE, "agent");
            xb_add(&bar[XB_XGEN(b.x)], 1u);
            asm volatile("s_waitcnt vmcnt(0)" ::: "memory");
        } else {
            XB_SPIN(xb_ld(&bar[XB_XGEN(b.x)]) == gen, bar);
            __builtin_amdgcn_fence(__ATOMIC_ACQUIRE, "agent");
            asm volatile("s_waitcnt vmcnt(0)" ::: "memory");
        }
    }
    __syncthreads();
}

namespace gm {
constexpr int BM = 256, BK = 64, HALF = 128, HTB = HALF * BK * 2, STAGE_BYTES = 8 * HTB, NXCD = 8, WGM = 8;
__host__ __device__ __forceinline__ int lds_byte(int r, int c) { const int st = (r >> 4) * 2 + (c >> 5), rr = r & 15, cc = c & 31, ob = rr * 64 + cc * 2; return st * 1024 + (ob ^ (((ob >> 9) & 1) << 5)); }
__host__ __device__ __forceinline__ void stage_rc(int b, int& R, int& C) { const int st = b / 1024, sb = b % 1024, swz = sb ^ (((sb >> 9) & 1) << 5); R = (st >> 1) * 16 + swz / 64; C = (st & 1) * 32 + (swz % 64) / 2; }
__host__ __device__ __forceinline__ int perm32(int rho) { const int n = rho >> 4, i = rho & 15; return 8 * (i >> 2) + 4 * n + (i & 3); }

struct Unit { const char* a; const char* b; int pm, pn, kind, ti; };

__device__ __forceinline__ void tile_of(int L, int nM, int nN, int& pm, int& pn) {
    const int nwg = nM * nN; int wgid = L;
    { const int q = nwg / NXCD, r = nwg % NXCD, xcd = wgid % NXCD, off = wgid / NXCD; wgid = (xcd < r ? xcd * (q + 1) : r * (q + 1) + (xcd - r) * q) + off; }
    const int nig = WGM * nN, gid = wgid / nig, fm = gid * WGM, gsz = (nM - fm) < WGM ? (nM - fm) : WGM;
    pm = fm + ((wgid % nig) % gsz); pn = (wgid % nig) / gsz;
}

template <class Epi, class Sched, bool GATHER, bool BTILED = false>
__device__ __forceinline__ void gemm_phase(const int tid, LAS unsigned char* lds, const LAS int* tab, const int K, const Sched& S, const Epi& E) {
    const int wid = __builtin_amdgcn_readfirstlane(tid >> 6), lane = tid & 63, wr = wid >> 2, wc = wid & 3, fr = lane & 15, fq = lane >> 4;
    const int nt = K / BK;
    unsigned voffA0[2], voffA1[2], voffB[2];
    const size_t kstep = (size_t)(BK * 2);
    const size_t hstep = (size_t)HALF * K * 2;
    const size_t kstepB = BTILED ? (size_t)(BM * BK * 2) : kstep, hstepB = BTILED ? (size_t)(HALF * BK * 2) : hstep;
#pragma unroll
    for (int i = 0; i < 2; ++i) { int R, C; stage_rc(tid * 16 + i * 8192, R, C); const int Rb = (R & ~31) + perm32(R & 31);
        voffB[i] = BTILED ? (unsigned)(Rb * BK + C) * 2u : (unsigned)(Rb * K + C) * 2u; voffA0[i] = (unsigned)(R * K + C) * 2u; voffA1[i] = 0u; }
#define GM_SETVOFF(u) do { if constexpr (GATHER) { _Pragma("unroll") for (int _i = 0; _i < 2; ++_i) { int R_, C_; stage_rc(tid * 16 + _i * 8192, R_, C_); \
        const int r0_ = tab[(u).ti * 256 + R_], r1_ = tab[(u).ti * 256 + 128 + R_]; voffA0[_i] = (unsigned)(r0_ * K + C_) * 2u; voffA1[_i] = (unsigned)(r1_ * K + C_) * 2u; } } } while (0)
    const unsigned ldsw = (unsigned)wid * 1024u;
    const int aoff = lds_byte(wr * 64 + fr, fq * 8), boff = lds_byte(wc * 32 + fr, fq * 8);
#define PG8_SA(b, h) (((b) * 2 + (h)) * HTB)
#define PG8_SB(b, h) ((4 + (b) * 2 + (h)) * HTB)
#define PG8_STAGE(bufoff, gbase, voff) do { _Pragma("unroll") for (int _i = 0; _i < 2; ++_i) \
        __builtin_amdgcn_global_load_lds((const unsigned*)((const char*)(gbase) + (voff)[_i]), (LAS unsigned*)(lds + (bufoff) + ldsw + _i * 8192), 16, 0, 0); } while (0)
#define PG8_LDA(dst, b, h) do { _Pragma("unroll") for (int m = 0; m < 4; ++m) _Pragma("unroll") for (int k = 0; k < 2; ++k) dst[m][k] = *(const LAS bf16x8*)(lds + PG8_SA(b, h) + aoff + m * 2048 + k * 1024); } while (0)
#define PG8_LDB(dst, b, h) do { _Pragma("unroll") for (int n = 0; n < 2; ++n) _Pragma("unroll") for (int k = 0; k < 2; ++k) dst[n][k] = *(const LAS bf16x8*)(lds + PG8_SB(b, h) + boff + n * 2048 + k * 1024); } while (0)
#define PG8_MMA(ai, bj, At, Bt) do { __builtin_amdgcn_s_setprio(1); _Pragma("unroll") for (int m = 0; m < 4; ++m) _Pragma("unroll") for (int n = 0; n < 2; ++n) _Pragma("unroll") for (int k = 0; k < 2; ++k) \
        acc[ai][bj][m][n] = __builtin_amdgcn_mfma_f32_16x16x32_bf16(Bt[n][k], At[m][k], acc[ai][bj][m][n], 0, 0, 0); __builtin_amdgcn_s_setprio(0); } while (0)
#define GM_STAGE_A1(bufoff, gbase) do { if constexpr (GATHER) { PG8_STAGE(bufoff, gbase, voffA1); } else { PG8_STAGE(bufoff, (gbase) + hstep, voffA0); } } while (0)
#define PG8_WAIT_V(n) asm volatile("s_waitcnt vmcnt(" #n ")" ::: "memory")
#define PG8_WAIT_L(n) asm volatile("s_waitcnt lgkmcnt(" #n ")" ::: "memory")
#define PG8_BAR __builtin_amdgcn_s_barrier()
#define PG8_SCHED __builtin_amdgcn_sched_barrier(0)
    Unit cur, nxt; int ui = 0;
    if (!S.next(0, cur)) return;
    GM_SETVOFF(cur);
    f32x4 acc[2][2][4][2];
#pragma unroll
    for (int a = 0; a < 2; ++a)
#pragma unroll
        for (int b = 0; b < 2; ++b)
#pragma unroll
            for (int m = 0; m < 4; ++m)
#pragma unroll
                for (int n = 0; n < 2; ++n) acc[a][b][m][n] = (f32x4){0.f, 0.f, 0.f, 0.f};
    bf16x8 At[4][2], B0[2][2], B1[2][2];
    const char* cA = cur.a; const char* cB = cur.b;
    PG8_STAGE(PG8_SB(0, 0), cB, voffB); PG8_STAGE(PG8_SB(0, 1), cB + hstepB, voffB); PG8_STAGE(PG8_SA(0, 0), cA, voffA0); GM_STAGE_A1(PG8_SA(0, 1), cA);
    if (wr == 1) PG8_BAR;
    PG8_WAIT_V(2); PG8_BAR;
    PG8_STAGE(PG8_SB(1, 0), cB + kstepB, voffB); PG8_STAGE(PG8_SA(1, 0), cA + kstep, voffA0); PG8_STAGE(PG8_SB(1, 1), cB + hstepB + kstepB, voffB);
    PG8_WAIT_V(6); PG8_BAR;
    for (;;) {
        const bool has_next = S.next(ui + 1, nxt);
        const char* nA = has_next ? nxt.a : cA; const char* nB = has_next ? nxt.b : cB;
        for (int t = 0; t < nt; t += 2) {
            const bool last = (t == nt - 2);
            const char* a1 = cA + (size_t)(t + 1) * kstep;
            const char* a2 = last ? nA : cA + (size_t)(t + 2) * kstep; const char* b2 = last ? nB : cB + (size_t)(t + 2) * kstepB;
            const char* a3 = a2 + kstep; const char* b3 = b2 + kstepB;
            PG8_LDB(B0, 0, 0); PG8_LDB(B1, 0, 1); PG8_SCHED; PG8_LDA(At, 0, 0); GM_STAGE_A1(PG8_SA(1, 1), a1);
            PG8_WAIT_V(8); PG8_WAIT_L(0); PG8_BAR; PG8_MMA(0, 0, At, B0); PG8_MMA(0, 1, At, B1); PG8_BAR; PG8_SCHED;
            if constexpr (GATHER) { if (last && has_next) { GM_SETVOFF(nxt); } }
            PG8_LDA(At, 0, 1); PG8_STAGE(PG8_SB(0, 0), b2, voffB); PG8_STAGE(PG8_SB(0, 1), b2 + hstepB, voffB); PG8_STAGE(PG8_SA(0, 0), a2, voffA0);
            PG8_WAIT_V(8); PG8_WAIT_L(0); PG8_BAR; PG8_MMA(1, 0, At, B0); PG8_MMA(1, 1, At, B1); PG8_BAR; PG8_SCHED;
            PG8_LDB(B0, 1, 0); PG8_LDB(B1, 1, 1); PG8_SCHED; PG8_LDA(At, 1, 0); GM_STAGE_A1(PG8_SA(0, 1), a2);
            PG8_WAIT_V(8); PG8_WAIT_L(0); PG8_BAR; PG8_MMA(0, 0, At, B0); PG8_MMA(0, 1, At, B1); PG8_BAR; PG8_SCHED;
            PG8_LDA(At, 1, 1); PG8_STAGE(PG8_SB(1, 0), b3, voffB); PG8_STAGE(PG8_SB(1, 1), b3 + hstepB, voffB); PG8_STAGE(PG8_SA(1, 0), a3, voffA0);
            PG8_WAIT_V(8); PG8_WAIT_L(0); PG8_BAR; PG8_MMA(1, 0, At, B0); PG8_MMA(1, 1, At, B1); PG8_BAR; PG8_SCHED;
        }
        if (wr == 0) PG8_BAR;
        E(acc, cur, wr, wc, fr, fq);
        if (!has_next) break;
#pragma unroll
        for (int a = 0; a < 2; ++a)
#pragma unroll
            for (int b = 0; b < 2; ++b)
#pragma unroll
                for (int m = 0; m < 4; ++m)
#pragma unroll
                    for (int n = 0; n < 2; ++n) acc[a][b][m][n] = (f32x4){0.f, 0.f, 0.f, 0.f};
        cur = nxt; cA = nA; cB = nB; ++ui;
        if (wr == 1) PG8_BAR;
    }
    PG8_WAIT_V(0);
    PG8_BAR;
#undef GM_SETVOFF
#undef GM_STAGE_A1
#undef PG8_SA
#undef PG8_SB
#undef PG8_STAGE
#undef PG8_LDA
#undef PG8_LDB
#undef PG8_MMA
#undef PG8_WAIT_V
#undef PG8_WAIT_L
#undef PG8_BAR
#undef PG8_SCHED
}
}
namespace at {
using f32x16 = __attribute__((ext_vector_type(16))) float;
using s16x4 = __attribute__((ext_vector_type(4))) short;
constexpr int D = 128, NW = 8, QBLK = 32, KVBLK = 64;
constexpr float SCALE = 0.088388347648318440f;
constexpr float THR = 8.f;
constexpr int SHM_V = KVBLK * D * 2, SHM_K = KVBLK * D * 2, SHM_ATTN = 2 * SHM_V + 2 * SHM_K + NW * 64 * 4;
constexpr int KM_OFF = SHM_ATTN;
constexpr int QL_OFF = KM_OFF + 4096;
#define KSWZ(row, colB) ((row) * 256 + ((colB) ^ (((row) & 7) << 4)))
#define SBAR() __builtin_amdgcn_sched_barrier(0)
__device__ __forceinline__ int crow(int r, int hi) { return (r & 3) + 8 * (r >> 2) + 4 * hi; }

__device__ __forceinline__ void partialSM(f32x16& p0, f32x16& p1, float& m_reg, float& mn, float& alpha, bool dead) {
  constexpr float C = SCALE * 1.4426950408889634f;
  float pmax = p0[0];
#pragma unroll
  for (int r = 1; r < 16; ++r) pmax = fmaxf(pmax, p0[r]);
#pragma unroll
  for (int r = 0; r < 16; ++r) pmax = fmaxf(pmax, p1[r]);
  { auto rr = __builtin_amdgcn_permlane32_swap(__float_as_uint(pmax), __float_as_uint(pmax), false, false);
    pmax = fmaxf(__uint_as_float(rr[0]), __uint_as_float(rr[1])); }
  if (dead) pmax = -1e30f;
  if (__builtin_expect(__all(pmax - m_reg <= THR / SCALE), 1)) { mn = m_reg; alpha = 1.f; }
  else { mn = fmaxf(m_reg, pmax); alpha = __builtin_amdgcn_exp2f((m_reg - mn) * C); m_reg = mn; }
  const float mnC = dead ? -INFINITY : -mn * C;
#pragma unroll
  for (int r = 0; r < 16; ++r) p0[r] = fmaf(p0[r], C, mnC);
#pragma unroll
  for (int r = 0; r < 16; ++r) p1[r] = fmaf(p1[r], C, mnC);
#pragma unroll
  for (int r = 0; r < 16; ++r) p0[r] = __builtin_amdgcn_exp2f(p0[r]);
}
__device__ __forceinline__ void finishSM(f32x16& p0, f32x16& p1, float alpha, float& l_reg, bf16x8& pa0, bf16x8& pa1, bf16x8& pa2, bf16x8& pa3) {
#pragma unroll
  for (int r = 0; r < 16; ++r) p1[r] = __builtin_amdgcn_exp2f(p1[r]);
  float ps = 0;
#pragma unroll
  for (int r = 0; r < 16; ++r) ps += p0[r];
#pragma unroll
  for (int r = 0; r < 16; ++r) ps += p1[r];
  { auto rr = __builtin_amdgcn_permlane32_swap(__float_as_uint(ps), __float_as_uint(ps), false, false);
    ps = __uint_as_float(rr[0]) + __uint_as_float(rr[1]); }
  l_reg = l_reg * alpha + ps;
#define PK4(P, BASE, OUT) do { unsigned a0 = cvt_pk_bf16(P[BASE + 0], P[BASE + 1]), a1 = cvt_pk_bf16(P[BASE + 2], P[BASE + 3]);   \
    unsigned b0 = cvt_pk_bf16(P[BASE + 4], P[BASE + 5]), b1 = cvt_pk_bf16(P[BASE + 6], P[BASE + 7]);                              \
    auto r0 = __builtin_amdgcn_permlane32_swap(a0, b0, false, false); auto r1 = __builtin_amdgcn_permlane32_swap(a1, b1, false, false); \
    u32x4 w = {r0[0], r1[0], r0[1], r1[1]}; OUT = *reinterpret_cast<bf16x8*>(&w); } while (0)
  PK4(p0, 0, pa0); PK4(p0, 8, pa1); PK4(p1, 0, pa2); PK4(p1, 8, pa3);
#undef PK4
}
template <bool QLDS>
__device__ __forceinline__ void qkt(f32x16& p0, f32x16& p1, const LAS char* Ks, const bf16x8* qr, const LAS char* ql, int r32, int hi) {
  p0 = f32x16{}; p1 = f32x16{};
#pragma unroll
  for (int d0 = 0; d0 < 8; ++d0) { int cb = (d0 * 16 + hi * 8) * 2;
    bf16x8 b0 = *(const LAS bf16x8*)(Ks + KSWZ(r32, cb));
    bf16x8 b1 = *(const LAS bf16x8*)(Ks + KSWZ(32 + r32, cb));
    bf16x8 q; if constexpr (QLDS) q = *(const LAS bf16x8*)(ql + d0 * 8192); else q = qr[d0];
    p0 = __builtin_amdgcn_mfma_f32_32x32x16_bf16(b0, q, p0, 0, 0, 0);
    p1 = __builtin_amdgcn_mfma_f32_32x32x16_bf16(b1, q, p1, 0, 0, 0); }
}
__device__ __forceinline__ int v_st(int k, int c) { const int kk = (k & ~0xC) | ((k & 4) << 1) | ((k & 8) >> 1); return ((kk >> 3) * 4 + (c >> 5)) * 512 + ((kk & 7) * 32 + (c & 31)) * 2; }
__device__ __forceinline__ int v_rd_base(int lane) { return ((lane & 3) << 3) | (((lane >> 2) & 3) << 6) | (((lane >> 4) & 1) << 5) | (((lane >> 5) & 1) << 8); }
constexpr int v_rd_off(int d0, int ks, int half) { return d0 * 512 + ks * 4096 + half * 2048; }
template <int OFF> __device__ __forceinline__ s16x4 tr_read(int vb) {
  s16x4 r; asm volatile("ds_read_b64_tr_b16 %0, %1 offset:%2" : "=&v"(r) : "v"(vb), "i"(OFF) : "memory"); return r;
}
template <int D0> __device__ __forceinline__ void pv_one(f32x16& od, int vb, bf16x8 pa0, bf16x8 pa1, bf16x8 pa2, bf16x8 pa3) {
  const s16x4 l0 = tr_read<v_rd_off(D0, 0, 0)>(vb), h0 = tr_read<v_rd_off(D0, 0, 1)>(vb), l1 = tr_read<v_rd_off(D0, 1, 0)>(vb), h1 = tr_read<v_rd_off(D0, 1, 1)>(vb);
  const s16x4 l2 = tr_read<v_rd_off(D0, 2, 0)>(vb), h2 = tr_read<v_rd_off(D0, 2, 1)>(vb), l3 = tr_read<v_rd_off(D0, 3, 0)>(vb), h3 = tr_read<v_rd_off(D0, 3, 1)>(vb);
  asm volatile("s_waitcnt lgkmcnt(0)" ::: "memory"); SBAR();
#define PK(L, H) (bf16x8){L[0], L[1], L[2], L[3], H[0], H[1], H[2], H[3]}
  od = __builtin_amdgcn_mfma_f32_32x32x16_bf16(pa0, PK(l0, h0), od, 0, 0, 0);
  od = __builtin_amdgcn_mfma_f32_32x32x16_bf16(pa1, PK(l1, h1), od, 0, 0, 0);
  od = __builtin_amdgcn_mfma_f32_32x32x16_bf16(pa2, PK(l2, h2), od, 0, 0, 0);
  od = __builtin_amdgcn_mfma_f32_32x32x16_bf16(pa3, PK(l3, h3), od, 0, 0, 0);
#undef PK
}
__device__ __forceinline__ void pv_d0(f32x16* o, int vb, bf16x8 pa0, bf16x8 pa1, bf16x8 pa2, bf16x8 pa3) {
  pv_one<0>(o[0], vb, pa0, pa1, pa2, pa3); pv_one<1>(o[1], vb, pa0, pa1, pa2, pa3); pv_one<2>(o[2], vb, pa0, pa1, pa2, pa3); pv_one<3>(o[3], vb, pa0, pa1, pa2, pa3);
}

template <bool MOBA>
__device__ __forceinline__ void attn_unit(const int tid, const bf16_t* __restrict__ Qb, const bf16_t* __restrict__ Kh, bf16_t* __restrict__ Ob, int NT, int jb, const float* __restrict__ kmean_bh, LAS char* lds) {
  constexpr int ldq = MOBA ? LDP : CW, ldk = MOBA ? LDP : 2 * CW, ldo = MOBA ? MIXW : CW, VOFF = MOBA ? (C_V - C_K) : CW;
  const bf16_t* __restrict__ Vh = Kh + VOFF;
  const int wid = __builtin_amdgcn_readfirstlane(tid >> 6), lane = tid & 63, r32 = lane & 31, hi = lane >> 5;
  LAS char* V_lds = lds; LAS char* K_lds = lds + 2 * SHM_V;
  LAS float* wsf = (LAS float*)(lds + 2 * SHM_V + 2 * SHM_K) + wid * 64; LAS float* li_l = wsf; LAS float* al_l = wsf + 32;
  float m_reg = -1e30f, l_reg = 0; f32x16 o[4] = {}; bf16x8 qr[8];
  const bf16_t* Qw = Qb + (long)(wid * QBLK + r32) * ldq + hi * 8;
#pragma unroll
  for (int d0 = 0; d0 < 8; ++d0) qr[d0] = *reinterpret_cast<const bf16x8*>(Qw + d0 * 16);
  unsigned selmask = 0;
  if constexpr (MOBA) {
    LAS float* kml = (LAS float*)(lds + KM_OFF);
    __syncthreads();
    for (int i = tid; i < 8 * 128; i += NW * 64) kml[i] = kmean_bh[(i >> 7) * 1024 + (i & 127)];
    __syncthreads();
    float gate[8];
#pragma unroll
    for (int kb = 0; kb < 8; ++kb) {
      float g = 0.f;
      if (kb < jb) {
#pragma unroll
        for (int d0 = 0; d0 < 8; ++d0) { const f32x4 k0 = *(const LAS f32x4*)(kml + kb * 128 + d0 * 16 + hi * 8), k1 = *(const LAS f32x4*)(kml + kb * 128 + d0 * 16 + hi * 8 + 4);
          const u32x4 qw = *reinterpret_cast<const u32x4*>(&qr[d0]);
          g += bflo(qw.x) * k0[0] + bfhi(qw.x) * k0[1] + bflo(qw.y) * k0[2] + bfhi(qw.y) * k0[3] + bflo(qw.z) * k1[0] + bfhi(qw.z) * k1[1] + bflo(qw.w) * k1[2] + bfhi(qw.w) * k1[3]; }
        g += __shfl_xor(g, 32);
      }
      gate[kb] = g;
    }
#pragma unroll
    for (int r = 0; r < 3; ++r) { float best = -INFINITY; int bi = -1;
#pragma unroll
      for (int kb = 0; kb < 8; ++kb) { const bool ok = (kb < jb) && !((selmask >> kb) & 1u) && (gate[kb] > best || bi < 0); if (ok) { best = gate[kb]; bi = kb; } }
      if (bi >= 0) selmask |= 1u << bi; }
  }
  const LAS char* ql = lds + QL_OFF + tid * 16;
  if constexpr (MOBA) {
#pragma unroll
    for (int d0 = 0; d0 < 8; ++d0) *(LAS bf16x8*)(lds + QL_OFF + tid * 16 + d0 * 8192) = qr[d0];
  }
  const int rowb = wid * QBLK + r32;
#define MASK(P0, P1, T, DEAD) do { DEAD = false; if constexpr (MOBA) { const int kb_ = (T) >> 2; \
    if (kb_ < jb) { DEAD = !((selmask >> kb_) & 1u); } \
    else { const int lim_ = rowb - 64 * ((T) - 4 * jb); \
      if (!__all(lim_ >= 63)) { const int lh_ = lim_ - 4 * hi;     \
        _Pragma("unroll") for (int r_ = 0; r_ < 16; ++r_) { if ((r_ & 3) + 8 * (r_ >> 2) > lh_) P0[r_] = -INFINITY; if (32 + (r_ & 3) + 8 * (r_ >> 2) > lh_) P1[r_] = -INFINITY; } } } } } while (0)
  const int sr = tid >> 4, sc = (tid & 15) * 8, vst0 = v_st(sr, sc), vst1 = v_st(32 + sr, sc);
  const int vb0 = (int)(size_t)V_lds + v_rd_base(lane);
  constexpr int SDEPTH = MOBA ? 1 : 2;
  struct { bf16x8 vs0, vs1, ks0, ks1; } sr_[SDEPTH];
#define SLOAD(i, k0) do { sr_[i].vs0 = *reinterpret_cast<const bf16x8*>(&Vh[(long)((k0) + sr) * ldk + sc]); sr_[i].vs1 = *reinterpret_cast<const bf16x8*>(&Vh[(long)((k0) + 32 + sr) * ldk + sc]); \
    sr_[i].ks0 = *reinterpret_cast<const bf16x8*>(&Kh[(long)((k0) + sr) * ldk + sc]); sr_[i].ks1 = *reinterpret_cast<const bf16x8*>(&Kh[(long)((k0) + 32 + sr) * ldk + sc]); } while (0)
#define SWRITE(b, i) do { *(LAS bf16x8*)(V_lds + (b) * SHM_V + vst0) = sr_[i].vs0;          \
    *(LAS bf16x8*)(V_lds + (b) * SHM_V + vst1) = sr_[i].vs1; int kc = sc * 2;               \
    *(LAS bf16x8*)(K_lds + (b) * SHM_K + KSWZ(sr, kc)) = sr_[i].ks0;                       \
    *(LAS bf16x8*)(K_lds + (b) * SHM_K + KSWZ(32 + sr, kc)) = sr_[i].ks1; } while (0)
#define SWAIT() do { if constexpr (SDEPTH == 2) asm volatile("s_waitcnt vmcnt(4)" ::: "memory"); else asm volatile("s_waitcnt vmcnt(0)" ::: "memory"); } while (0)
#define RESC(a) do { if (__any((a) < 1.f)) { if (hi == 0) al_l[r32] = (a); asm volatile("s_waitcnt lgkmcnt(0)" ::: "memory"); \
    _Pragma("unroll") for (int d = 0; d < 4; ++d) _Pragma("unroll") for (int r = 0; r < 16; ++r) o[d][r] *= al_l[crow(r, hi)]; } } while (0)
  f32x16 pA0, pA1, pB0, pB1; float mnA, mnB, alA, alB; bf16x8 pa0, pa1, pa2, pa3; bool deadA, deadB;
  constexpr int SE = 0, SO = SDEPTH - 1;
  if constexpr (!MOBA) __syncthreads();
  SLOAD(SE, 0); asm volatile("s_waitcnt vmcnt(0)" ::: "memory"); SWRITE(0, SE); __syncthreads();
  qkt<MOBA>(pA0, pA1, K_lds, qr, ql, r32, hi); MASK(pA0, pA1, 0, deadA); partialSM(pA0, pA1, m_reg, mnA, alA, deadA);
  SLOAD(SO, KVBLK); if constexpr (SDEPTH == 2) { if (2 < NT) SLOAD(SE, 2 * KVBLK); }
  SWAIT(); SWRITE(1, SO); __syncthreads();
  for (int j = 1; j + 1 < NT; j += 2) {
    SBAR(); qkt<MOBA>(pB0, pB1, K_lds + SHM_K, qr, ql, r32, hi);
    finishSM(pA0, pA1, alA, l_reg, pa0, pa1, pa2, pa3); SBAR();
    SLOAD(SO, (j + SDEPTH) * KVBLK); SBAR();
    pv_d0(o, vb0, pa0, pa1, pa2, pa3); MASK(pB0, pB1, j, deadB); partialSM(pB0, pB1, m_reg, mnB, alB, deadB);
    __syncthreads(); SWAIT(); SWRITE(0, SE);
    RESC(alB); __syncthreads();
    SBAR(); qkt<MOBA>(pA0, pA1, K_lds, qr, ql, r32, hi);
    finishSM(pB0, pB1, alB, l_reg, pa0, pa1, pa2, pa3); SBAR();
    if (SDEPTH == 1 || j + 3 < NT) SLOAD(SE, (j + 1 + SDEPTH) * KVBLK); SBAR();
    pv_d0(o, vb0 + SHM_V, pa0, pa1, pa2, pa3); MASK(pA0, pA1, j + 1, deadA); partialSM(pA0, pA1, m_reg, mnA, alA, deadA);
    __syncthreads(); SWAIT(); SWRITE(1, SO);
    RESC(alA); __syncthreads();
  }
  SBAR(); qkt<MOBA>(pB0, pB1, K_lds + SHM_K, qr, ql, r32, hi);
  finishSM(pA0, pA1, alA, l_reg, pa0, pa1, pa2, pa3); SBAR();
  pv_d0(o, vb0, pa0, pa1, pa2, pa3); MASK(pB0, pB1, NT - 1, deadB); partialSM(pB0, pB1, m_reg, mnB, alB, deadB);
  __syncthreads(); RESC(alB);
  finishSM(pB0, pB1, alB, l_reg, pa0, pa1, pa2, pa3); SBAR();
  pv_d0(o, vb0 + SHM_V, pa0, pa1, pa2, pa3);
  if (hi == 0) li_l[r32] = l_reg; asm volatile("s_waitcnt lgkmcnt(0)" ::: "memory");
  float rli[16];
#pragma unroll
  for (int r = 0; r < 16; ++r) rli[r] = __builtin_amdgcn_rcpf(li_l[crow(r, hi)]);
  if constexpr (MOBA) {
#pragma unroll
    for (int r = 0; r < 16; ++r) {
      float q = 0.f;
#pragma unroll
      for (int d0 = 0; d0 < 4; ++d0) { const float v = o[d0][r] * rli[r]; q += v * v; }
      q += __shfl_xor(q, 1); q += __shfl_xor(q, 2); q += __shfl_xor(q, 4); q += __shfl_xor(q, 8); q += __shfl_xor(q, 16);
      rli[r] *= rsqrtf(q * (1.f / 128.f) + EPS);
    }
  }
  bf16_t* Ow = Ob + (long)(wid * QBLK) * ldo;
#pragma unroll
  for (int r = 0; r < 16; ++r) { const int orow = crow(r, hi);
#pragma unroll
    for (int d0 = 0; d0 < 4; ++d0) Ow[(long)orow * ldo + d0 * 32 + r32] = (bf16_t)(cvt_pk_bf16(o[d0][r] * rli[r], 0.f) & 0xffffu); }
#undef MASK
#undef SLOAD
#undef SWRITE
#undef SWAIT
#undef RESC
}
#undef KSWZ
#undef SBAR
}
namespace sd {
using f32x16 = __attribute__((ext_vector_type(16))) float;
typedef short v4i16_t __attribute__((ext_vector_type(4)));
constexpr int IMG_C = 0, IMG_B = 32768, IMG_X = 65536, IMG_S = 98304, TBL = 114688;
__device__ __forceinline__ unsigned off_b(unsigned row, unsigned ch) { return 256u * row + 16u * (ch ^ (((row & 3) << 2) | ((row >> 2) & 3))); }
__device__ __forceinline__ unsigned row_read_addr(unsigned lane, unsigned s) { return off_b(lane & 31, 2 * s + (lane >> 5)); }
__device__ __forceinline__ unsigned tr_read_addr(unsigned lane, unsigned c, unsigned ks, unsigned t) {
  const unsigned h = lane >> 5, blk = (lane >> 4) & 1, q = (lane & 15) >> 2, p = lane & 3;
  return off_b(16 * ks + 8 * h + 4 * t + q, 4 * c + 2 * blk + (p >> 1)) + 8 * (p & 1);
}
__device__ __forceinline__ unsigned elem_addr(unsigned row, unsigned col) { return (row >> 5) * 8192u + off_b(row & 31, col >> 3) + (col & 7) * 2u; }
__device__ __forceinline__ bf16x8 tr_frag(const LAS char* img, unsigned a0, unsigned a1) {
  const v4i16_t l = __builtin_amdgcn_ds_read_tr16_b64_v4i16((LAS v4i16_t*)(img + a0)), h = __builtin_amdgcn_ds_read_tr16_b64_v4i16((LAS v4i16_t*)(img + a1));
  return (bf16x8){l[0], l[1], l[2], l[3], h[0], h[1], h[2], h[3]};
}
__device__ __forceinline__ int crow(int r, int hi) { return (r & 3) + 8 * (r >> 2) + 4 * hi; }
__device__ __forceinline__ float softplus_f(float r) { return fmaxf(r, 0.f) + log1pf(__expf(-fabsf(r))); }

__device__ __forceinline__ void conv_prepass(const int gtid, const int nthr, const bf16_t* __restrict__ proj, const float* __restrict__ conv_w, const float* __restrict__ conv_b, bf16_t* __restrict__ xbcc) {
  constexpr int NITEM = (CONVD / 8) * (M / 16);
#pragma unroll 1
  for (int it = gtid; it < NITEM; it += nthr) {
    const int cgp = it % (CONVD / 8), run = it / (CONVD / 8), tok0 = run * 16, T0 = tok0 & (SEQ - 1), ch = 8 * cgp;
    const bf16_t* rawp = proj + (size_t)(tok0 - T0) * LDP + C_XBC + ch;
    u32x4 raw[19];
#pragma unroll
    for (int j = 0; j < 19; ++j) { const int T = T0 - 3 + j; raw[j] = (T >= 0) ? *(const u32x4*)(rawp + (size_t)T * LDP) : (u32x4){0u, 0u, 0u, 0u}; }
    f32x4 w[5][2];
#pragma unroll
    for (int tp = 0; tp < 4; ++tp) { w[tp][0] = *(const f32x4*)(conv_w + tp * CONVD + ch); w[tp][1] = *(const f32x4*)(conv_w + tp * CONVD + ch + 4); }
    w[4][0] = *(const f32x4*)(conv_b + ch); w[4][1] = *(const f32x4*)(conv_b + ch + 4);
    float ac[4][8];
#pragma unroll
    for (int j = 0; j < 19; ++j) {
      const u32x4 rw = raw[j];
      const float x[8] = {bflo(rw.x), bfhi(rw.x), bflo(rw.y), bfhi(rw.y), bflo(rw.z), bfhi(rw.z), bflo(rw.w), bfhi(rw.w)};
#pragma unroll
      for (int tp = 0; tp < 4; ++tp) {
        const int i = j - tp;
        if (i >= 0 && i < 16) { const int sl = i & 3;
#pragma unroll
          for (int e = 0; e < 8; ++e) ac[sl][e] = (tp == 0 ? w[4][e >> 2][e & 3] : ac[sl][e]) + w[tp][e >> 2][e & 3] * x[e]; }
      }
      if (j >= 3) {
        const int sl = (j - 3) & 3; float o8[8];
#pragma unroll
        for (int e = 0; e < 8; ++e) o8[e] = ac[sl][e] * __builtin_amdgcn_rcpf(1.f + __expf(-ac[sl][e]));
        u32x4 o; o.x = cvt_pk_bf16(o8[0], o8[1]); o.y = cvt_pk_bf16(o8[2], o8[3]); o.z = cvt_pk_bf16(o8[4], o8[5]); o.w = cvt_pk_bf16(o8[6], o8[7]);
        *(u32x4*)(xbcc + (size_t)(tok0 + j - 3) * CONVD + ch) = o;
      }
    }
  }
}

__device__ __forceinline__ void ssd_unit(const int tid, const int b, const int h, const bf16_t* __restrict__ proj, const bf16_t* __restrict__ xbcc, const float* __restrict__ dtraw,
                                         const float* __restrict__ dt_bias, const float* __restrict__ a_log, const float* __restrict__ d_skip,
                                         bf16_t* __restrict__ mixb, float* __restrict__ ssq, LAS char* lds) {
  const int wid = __builtin_amdgcn_readfirstlane(tid >> 6), lane = tid & 63, r32 = lane & 31, hi = lane >> 5;
  const int rb = wid >> 1, ph = wid & 1;
  LAS char* IC = lds + IMG_C; LAS char* IB = lds + IMG_B; LAS char* IX = lds + IMG_X; LAS char* IS = lds + IMG_S;
  LAS float* Tdt = (LAS float*)(lds + TBL); LAS float* Tacs = Tdt + 2048;
  const int grp = h >> 3;
  const float a = -__expf(a_log[h]), dtb = dt_bias[h], Dh = d_skip[h];
  __syncthreads();
  { const u32x4 z = {0u, 0u, 0u, 0u}; *(LAS u32x4*)(IS + tid * 32) = z; *(LAS u32x4*)(IS + tid * 32 + 16) = z; }
#pragma unroll 1
  for (int cc = 0; cc < 2; ++cc) {
    const int t0 = (wid * 2 + cc) * 128 + 2 * lane;
    const float d0 = softplus_f(dtraw[(size_t)(b * SEQ + t0) * 32 + h] + dtb), d1 = softplus_f(dtraw[(size_t)(b * SEQ + t0 + 1) * 32 + h] + dtb);
    const float v0 = d0 * a, ps = v0 + d1 * a;
    float sc = ps;
#pragma unroll
    for (int o = 1; o < 64; o <<= 1) { const float n = __shfl_up(sc, o); if (lane >= o) sc += n; }
    const float a0 = (sc - ps) + v0, a1 = sc, tot = __shfl(sc, 63);
    Tdt[t0] = d0; Tdt[t0 + 1] = d1; Tacs[t0] = a0; Tacs[t0 + 1] = a1;
  }
  f32x16 S = {};
  const unsigned xr = ((r32 & 3) << 2) | ((r32 >> 2) & 3);
#define RROW(k) (256u * r32 + 16u * ((2u * (k) + hi) ^ xr))
#pragma unroll 1
  for (int c = 0; c < 16; ++c) {
    int tq_ = tid; asm volatile("" : "+v"(tq_));
    const bf16_t* xsrc = xbcc + (size_t)(b * SEQ + c * 128) * CONVD;
    u32x4 rx[2], rB[4], rC[4];
#pragma unroll
    for (int i = 0; i < 2; ++i) rx[i] = *(const u32x4*)(xsrc + (size_t)((tq_ >> 3) + 64 * i) * CONVD + h * 64 + 8 * (tq_ & 7));
#pragma unroll
    for (int i = 0; i < 4; ++i) { rB[i] = *(const u32x4*)(xsrc + (size_t)((tq_ >> 4) + 32 * i) * CONVD + 2048 + grp * 128 + 8 * (tq_ & 15));
      rC[i] = *(const u32x4*)(xsrc + (size_t)((tq_ >> 4) + 32 * i) * CONVD + 2560 + grp * 128 + 8 * (tq_ & 15)); }
    __syncthreads();
    if (c > 0) {
      int lq_ = lane; asm volatile("" : "+v"(lq_)); const int r32 = lq_ & 31, hi = lq_ >> 5;
#pragma unroll
      for (int r = 0; r < 16; ++r) *(LAS bf16_t*)(IS + elem_addr(32 * ph + crow(r, hi), 32 * rb + r32)) = (bf16_t)(cvt_pk_bf16(S[r], 0.f) & 0xffffu);
    }
    {
      const float ace = Tacs[c * 128 + 127];
#pragma unroll
      for (int i = 0; i < 2; ++i) { const unsigned tk = (unsigned)(tq_ >> 3) + 64u * i, trow = tk & 31, xo = ((trow & 3) << 2) | ((trow >> 2) & 3), rowb = IMG_X + (tk >> 5) * 8192u + 256u * trow, cch = tq_ & 7;
        *(LAS u32x4*)(lds + rowb + 16u * (cch ^ xo)) = rx[i];
        const float w2 = Tdt[c * 128 + tk] * __expf(ace - Tacs[c * 128 + tk]);
        u32x4 v; v.x = cvt_pk_bf16(bflo(rx[i].x) * w2, bfhi(rx[i].x) * w2); v.y = cvt_pk_bf16(bflo(rx[i].y) * w2, bfhi(rx[i].y) * w2); v.z = cvt_pk_bf16(bflo(rx[i].z) * w2, bfhi(rx[i].z) * w2); v.w = cvt_pk_bf16(bflo(rx[i].w) * w2, bfhi(rx[i].w) * w2);
        *(LAS u32x4*)(lds + rowb + 16u * ((8u + cch) ^ xo)) = v; }
#pragma unroll
      for (int i = 0; i < 4; ++i) { const unsigned tk = (unsigned)(tq_ >> 4) + 32u * i, trow = tk & 31, xo = ((trow & 3) << 2) | ((trow >> 2) & 3), ro = (tk >> 5) * 8192u + 256u * trow + 16u * ((unsigned)(tq_ & 15) ^ xo);
        *(LAS u32x4*)(lds + IMG_B + ro) = rB[i]; *(LAS u32x4*)(lds + IMG_C + ro) = rC[i]; }
    }
    __syncthreads();
    int lq_ = lane; asm volatile("" : "+v"(lq_));
    const int lane = lq_, r32 = lane & 31, hi = lane >> 5; const unsigned xr = ((r32 & 3) << 2) | ((r32 >> 2) & 3);
    const LAS float* acs = Tacs + c * 128; const LAS float* dts = Tdt + c * 128;
    f32x16 Y = {};
    const float acl = acs[32 * rb + r32];
#pragma unroll 1
    for (int st = 0; st <= rb; ++st) {
      f32x16 Dm = {};
#pragma unroll
      for (int k = 0; k < 8; ++k) { const bf16x8 af = *(const LAS bf16x8*)(IB + st * 8192 + RROW(k)), bq = *(const LAS bf16x8*)(IC + rb * 8192 + RROW(k));
        Dm = __builtin_amdgcn_mfma_f32_32x32x16_bf16(af, bq, Dm, 0, 0, 0); }
#pragma unroll
      for (int q4 = 0; q4 < 4; ++q4) { const f32x4 as4 = *(const LAS f32x4*)(acs + 32 * st + 8 * q4 + 4 * hi), dt4 = *(const LAS f32x4*)(dts + 32 * st + 8 * q4 + 4 * hi);
#pragma unroll
        for (int e = 0; e < 4; ++e) { const int r = 4 * q4 + e; const bool dead = (st == rb) && (8 * q4 + 4 * hi + e > r32);
          const float f = dead ? 0.f : __expf(acl - as4[e]) * dt4[e]; Dm[r] *= f; } }
      bf16x8 pa0, pa1;
#define PK4(P, BASE, OUT) do { unsigned a0_ = cvt_pk_bf16(P[BASE + 0], P[BASE + 1]), a1_ = cvt_pk_bf16(P[BASE + 2], P[BASE + 3]);   \
    unsigned b0_ = cvt_pk_bf16(P[BASE + 4], P[BASE + 5]), b1_ = cvt_pk_bf16(P[BASE + 6], P[BASE + 7]);                              \
    auto r0_ = __builtin_amdgcn_permlane32_swap(a0_, b0_, false, false); auto r1_ = __builtin_amdgcn_permlane32_swap(a1_, b1_, false, false); \
    u32x4 w_ = {r0_[0], r1_[0], r0_[1], r1_[1]}; OUT = *reinterpret_cast<bf16x8*>(&w_); } while (0)
      PK4(Dm, 0, pa0); PK4(Dm, 8, pa1);
#undef PK4
      Y = __builtin_amdgcn_mfma_f32_32x32x16_bf16(pa0, tr_frag(IX + st * 8192, tr_read_addr(lane, ph, 0, 0), tr_read_addr(lane, ph, 0, 1)), Y, 0, 0, 0);
      Y = __builtin_amdgcn_mfma_f32_32x32x16_bf16(pa1, tr_frag(IX + st * 8192, tr_read_addr(lane, ph, 1, 0), tr_read_addr(lane, ph, 1, 1)), Y, 0, 0, 0);
    }
    {
      f32x16 CS = {};
#pragma unroll
      for (int k = 0; k < 8; ++k) { const bf16x8 af = *(const LAS bf16x8*)(IC + rb * 8192 + RROW(k)), bq = *(const LAS bf16x8*)(IS + ph * 8192 + RROW(k));
        CS = __builtin_amdgcn_mfma_f32_32x32x16_bf16(af, bq, CS, 0, 0, 0); }
#pragma unroll
      for (int q4 = 0; q4 < 4; ++q4) { const f32x4 as4 = *(const LAS f32x4*)(acs + 32 * rb + 8 * q4 + 4 * hi);
#pragma unroll
        for (int e = 0; e < 4; ++e) Y[4 * q4 + e] += CS[4 * q4 + e] * __expf(as4[e]); }
    }
    {
      const float dec = __expf(acs[127]);
#pragma unroll
      for (int r = 0; r < 16; ++r) S[r] *= dec;
#pragma unroll
      for (int st = 0; st < 4; ++st)
#pragma unroll
        for (int ks = 0; ks < 2; ++ks) {
          const bf16x8 af = tr_frag(IX + st * 8192, tr_read_addr(lane, 2 + ph, ks, 0), tr_read_addr(lane, 2 + ph, ks, 1));
          const bf16x8 bq = tr_frag(IB + st * 8192, tr_read_addr(lane, rb, ks, 0), tr_read_addr(lane, rb, ks, 1));
          S = __builtin_amdgcn_mfma_f32_32x32x16_bf16(af, bq, S, 0, 0, 0);
        }
    }
    {
      const int p = 32 * ph + r32;
#pragma unroll
      for (int r = 0; r < 16; ++r) {
        const int l = 32 * rb + crow(r, hi); const size_t tok = (size_t)(b * SEQ + c * 128 + l);
        const float xv = bf2f(*(const LAS bf16_t*)(IX + elem_addr(l, p)));
        const float z = bf2f(proj[tok * LDP + C_Z + h * 64 + p]);
        const float yg = (Y[r] + xv * Dh) * (z * __builtin_amdgcn_rcpf(1.f + __expf(-z)));
        mixb[tok * MIXW + AW + h * 64 + p] = (bf16_t)(cvt_pk_bf16(yg, 0.f) & 0xffffu);
        float q = yg * yg;
        q += __shfl_xor(q, 1); q += __shfl_xor(q, 2); q += __shfl_xor(q, 4); q += __shfl_xor(q, 8); q += __shfl_xor(q, 16);
        if (r32 == 0) ssq[tok * 64 + h * 2 + ph] = q;
      }
    }
  }
#undef RROW
  __syncthreads();
}
}
constexpr int RING_OFF = 0, RING_BYTES = 131072;
constexpr int TAB_OFF = RING_BYTES;
constexpr int RSL_OFF = TAB_OFF + 8192;
constexpr int MOE_OFF = RSL_OFF + 1024;
constexpr int LDSCTL_OFF = MOE_OFF + 512;
constexpr int MISC_OFF = LDSCTL_OFF + 320;
constexpr int LDS_BYTES = 147456;
static_assert(MISC_OFF + 128 <= LDS_BYTES, "LDS map");
constexpr int NWAVES = 8;

struct Args { const float* in[27]; float* out; unsigned char* ws; float rf[16]; int ph_lo, ph_hi, li, pad; };

struct Frame {
    LAS unsigned char* lds;
    volatile LAS unsigned* MISC;
    int tid, lane, wave, vcu, G;
};

__device__ __forceinline__ void row_to_bf16_rs(const float* xrow, bf16_t* orow, float* rs_out, int lane) {
    const f32x4* xr = (const f32x4*)xrow + lane;
    f32x4 v[8]; float s = 0.f;
#pragma unroll
    for (int j = 0; j < 8; ++j) { v[j] = xr[64 * j]; s += (v[j].x * v[j].x + v[j].y * v[j].y) + (v[j].z * v[j].z + v[j].w * v[j].w); }
    s = wave_sum(s);
    if (lane == 0) *rs_out = rsqrtf(s * (1.f / DM) + EPS);
    u32x2* o8 = (u32x2*)orow + lane;
#pragma unroll
    for (int j = 0; j < 8; ++j) { u32x2 w; w.x = cvt_pk_bf16(v[j].x, v[j].y); w.y = cvt_pk_bf16(v[j].z, v[j].w); o8[64 * j] = w; }
}
struct P0Item { const float* W; const float* sc; bf16_t* dst; int ldw, k0, dK, kd; };
__device__ __forceinline__ void p0_item_load(const P0Item& I, f32x4 (&v)[8], f32x4 (&sv)[2], int lane) {
#pragma unroll
    for (int j = 0; j < 8; ++j) v[j] = __builtin_nontemporal_load((const f32x4*)(I.W + (size_t)(I.k0 + 8 * j + (lane >> 3)) * I.ldw + 4 * (lane & 7)));
    if (I.sc) { sv[0] = *(const f32x4*)(I.sc + I.k0 + 8 * (lane & 7)); sv[1] = *(const f32x4*)(I.sc + I.k0 + 8 * (lane & 7) + 4); }
    else { sv[0] = (f32x4){1.f, 1.f, 1.f, 1.f}; sv[1] = sv[0]; }
}
__device__ __forceinline__ void p0_item_store(const P0Item& I, const f32x4 (&v)[8], const f32x4 (&sv)[2], LAS float* scr, int lane, bool live) {
#pragma unroll
    for (int j = 0; j < 8; ++j) *(LAS f32x4*)(scr + (8 * j + (lane >> 3)) * 36 + 4 * (lane & 7)) = v[j];
    LDS_WAIT(); asm volatile("" ::: "memory");
    const int c = lane & 7;
#pragma unroll
    for (int j = 0; j < 4; ++j) { const int n = (lane >> 3) + 8 * j; const LAS float* s = scr + (8 * c) * 36 + n;
        u32x4 o; o.x = cvt_pk_bf16(s[0 * 36] * sv[0][0], s[1 * 36] * sv[0][1]); o.y = cvt_pk_bf16(s[2 * 36] * sv[0][2], s[3 * 36] * sv[0][3]);
        o.z = cvt_pk_bf16(s[4 * 36] * sv[1][0], s[5 * 36] * sv[1][1]); o.w = cvt_pk_bf16(s[6 * 36] * sv[1][2], s[7 * 36] * sv[1][3]);
        if (live) __builtin_nontemporal_store(o, (u32x4*)(I.dst + (size_t)n * I.dK + I.kd + 8 * c)); }
    LDS_WAIT(); asm volatile("" ::: "memory");
}
template <class Dec> __device__ __forceinline__ void p0_items(const Dec& D, const int first, const int stride, const int nitems, LAS float* scr, const int lane) {
#pragma unroll 1
    for (int base = first; base < nitems; base += 4 * stride) {
        P0Item I0, I1, I2, I3; f32x4 v0[8], v1[8], v2[8], v3[8]; f32x4 s0[2], s1[2], s2[2], s3[2];
        const int i1 = base + stride, i2 = base + 2 * stride, i3 = base + 3 * stride;
        const bool h1 = i1 < nitems, h2 = i2 < nitems, h3 = i3 < nitems;
        D(base, I0); D(h1 ? i1 : 0, I1); D(h2 ? i2 : 0, I2); D(h3 ? i3 : 0, I3);
        p0_item_load(I0, v0, s0, lane); p0_item_load(I1, v1, s1, lane); p0_item_load(I2, v2, s2, lane); p0_item_load(I3, v3, s3, lane);
        p0_item_store(I0, v0, s0, scr, lane, true); p0_item_store(I1, v1, s1, scr, lane, h1); p0_item_store(I2, v2, s2, scr, lane, h2); p0_item_store(I3, v3, s3, scr, lane, h3);
    }
}
struct DecIn {
    const float* w_in; const float* nmw; bf16_t* dst;
    __device__ __forceinline__ bool operator()(int r, P0Item& I) const {
        if (r >= 32 * 257) return false;
        const int kb = r / 257, nb = r - kb * 257; I.W = w_in + 32 * nb; I.ldw = INW; I.k0 = 64 * kb; I.sc = nmw; I.dst = dst + (size_t)(32 * nb) * DM; I.dK = DM; I.kd = I.k0; return true;
    }
};
struct DecRest {
    const Args* a; unsigned char* ws;
    __device__ __forceinline__ bool operator()(int r, P0Item& I) const {
        constexpr int I_OUT = 48 * 64, I_CQ = 32 * 16, I_CO = 8 * 64, I_GU = 32 * 32 * 32, I_DN = 32 * 16 * 64;
        const float* const* in = a->in;
        if (r < I_OUT) { const int kb = r / 64, nb = r % 64; I.W = in[11] + 32 * nb; I.ldw = DM; I.k0 = 64 * kb; I.sc = (kb < 16) ? in[9] : (in[10] - AW); I.dst = (bf16_t*)(ws + WS_WOUT_T) + (size_t)(32 * nb) * MIXW; I.dK = MIXW; I.kd = I.k0; return true; } r -= I_OUT;
        if (r < 3 * I_CQ) { const int m = r / I_CQ, q = r - m * I_CQ, kb = q / 16, nb = q % 16; I.W = in[14 + m] + 32 * nb; I.ldw = CW; I.k0 = 64 * kb; I.sc = m == 0 ? in[12] : in[13];
            I.dst = (m == 0 ? (bf16_t*)(ws + WS_WCQ_T) : (bf16_t*)(ws + WS_WCKV_T) + (size_t)(m - 1) * CW * DM) + (size_t)(32 * nb) * DM; I.dK = DM; I.kd = I.k0; return true; } r -= 3 * I_CQ;
        if (r < I_CO) { const int kb = r / 64, nb = r % 64; I.W = in[17] + 32 * nb; I.ldw = DM; I.k0 = 64 * kb; I.sc = nullptr; I.dst = (bf16_t*)(ws + WS_WCO_T) + (size_t)(32 * nb) * CW; I.dK = CW; I.kd = I.k0; return true; } r -= I_CO;
        if (r < 2 * I_GU) { const int up = r >= I_GU; if (up) r -= I_GU; const int e = r >> 10, kb = (r >> 5) & 31, nb = r & 31, n0 = 32 * nb;
            I.W = in[up ? 24 : 23] + (size_t)e * DM * DE + n0; I.ldw = DE; I.k0 = 64 * kb; I.sc = in[18]; I.dst = (bf16_t*)(ws + WS_WGU_T) + (size_t)e * 2048 * DM + ((size_t)(((n0 >> 7) * 32 + kb) * 256 + up * 128 + (n0 & 127))) * 64; I.dK = 64; I.kd = 0; return true; } r -= 2 * I_GU;
        if (r < I_DN) { const int e = r >> 10, kb = (r >> 6) & 15, nb = r & 63; I.W = in[25] + (size_t)e * DE * DM + 32 * nb; I.ldw = DM; I.k0 = 64 * kb; I.sc = nullptr; I.dst = (bf16_t*)(ws + WS_WD_T) + (size_t)e * 2048 * DE + ((size_t)((((32 * nb) >> 8) * 16 + kb) * 256 + ((32 * nb) & 255))) * 64; I.dK = 64; I.kd = 0; return true; }
        return false;
    }
};
__device__ __forceinline__ void p0a_prologue(Frame& F, const Args& args) {
    LAS float* scr = (LAS float*)(F.lds + RING_OFF + F.wave * 16384);
    const int gw = F.vcu * NWAVES + F.wave, NGW = F.G * NWAVES, lane = F.lane;
    GAS unsigned char* wsg_ = (GAS unsigned char*)args.ws; asm volatile("" : "+s"(wsg_)); unsigned char* ws = (unsigned char*)wsg_;
    { DecIn D{args.in[3], args.in[2], (bf16_t*)(ws + WS_WIN_T)}; p0_items(D, gw, NGW, 32 * 257, scr, lane); }
    { u32x4* z = (u32x4*)((bf16_t*)(ws + WS_WIN_T) + (size_t)INW * DM); const int n16 = (LDP - INW) * DM * 2 / 16;
      for (int i = (F.vcu * NWAVES * 64) + F.tid; i < n16; i += F.G * NWAVES * 64) z[i] = (u32x4){0u, 0u, 0u, 0u}; }
    { float* km = (float*)(ws + WS_KMEAN); for (int i = (F.vcu * NWAVES * 64) + F.tid; i < BATCH * NB * 1024; i += F.G * NWAVES * 64) km[i] = 0.f; }
    { float* tab = (float*)(ws + WS_ROPE);
      for (int i = (F.vcu * NWAVES * 64) + F.tid; i < SEQ * 16; i += F.G * NWAVES * 64) { const int pos = i >> 4, f = i & 15;
        const float ang = (float)pos * args.rf[f]; double r = (double)ang * 0.15915494309189533577; r -= rint(r); const float th = (float)(r * 6.283185307179586477);
        tab[pos * 32 + f] = cosf(th); tab[pos * 32 + 16 + f] = sinf(th); } }
    for (int m = gw; m < M; m += NGW) row_to_bf16_rs(args.in[0] + (size_t)m * DM, (bf16_t*)(ws + WS_XB) + (size_t)m * DM, (float*)(ws + WS_RSX) + m, lane);
}
__device__ __forceinline__ void p0b_share(Frame& F, const Args& args) {
    LAS float* scr = (LAS float*)(F.lds + RING_OFF + F.wave * 16384);
    const int gw = F.vcu * NWAVES + F.wave, NGW = F.G * NWAVES, lane = F.lane;
    GAS unsigned char* wsg_ = (GAS unsigned char*)args.ws; asm volatile("" : "+s"(wsg_)); unsigned char* ws = (unsigned char*)wsg_;
    { DecRest D{&args, ws}; p0_items(D, gw, NGW, 48 * 64 + 3 * 32 * 16 + 8 * 64 + 2 * 32 * 32 * 32 + 32 * 16 * 64, scr, lane); }
    { bf16_t* wh = (bf16_t*)(ws + WS_WR); bf16_t* wl = wh + 48 * DM; const float* nfw = args.in[18];
      for (int i = (F.vcu * NWAVES * 64) + F.tid; i < 48 * DM; i += F.G * NWAVES * 64) { const int n = i >> 11, k = i & (DM - 1);
        const float v = n < NG ? args.in[19][k * NG + n] * nfw[k] : (n < 36 ? args.in[21][k * NE + (n - NG)] * nfw[k] : 0.f);
        const unsigned hb = cvt_pk_bf16(v, 0.f) & 0xffffu; wh[i] = (bf16_t)hb; wl[i] = (bf16_t)(cvt_pk_bf16(v - __uint_as_float(hb << 16), 0.f) & 0xffffu); } }
    for (int m = gw; m < MROWS; m += NGW) row_to_bf16_rs(args.in[1] + (size_t)m * DM, (bf16_t*)(ws + WS_MEMB) + (size_t)m * DM, (float*)(ws + WS_RSMEM) + m, lane);
}

struct SchedG1 {
    const char* A; const char* Bt; int G, c, i0, i1;
    __device__ __forceinline__ bool next(int i, gm::Unit& u) const {
        i += i0; if (i >= i1) return false;
        const int L = i * G + c; if (L >= 64 * 32) return false;
        int pm, pn; gm::tile_of(L, 64, 32, pm, pn);
        u.pm = pm; u.pn = pn; u.kind = 0; u.ti = 0; u.a = A + (size_t)pm * 256 * DM * 2; u.b = Bt + (size_t)pn * 256 * DM * 2; return true;
    }
};
struct EpiG1 {
    bf16_t* proj; float* dtraw; const float* rsx; const float* ropetab; float* kmean;
    __device__ __forceinline__ void operator()(const f32x4 (&acc)[2][2][4][2], const gm::Unit& u, int wr, int wc, int fr, int fq) const {
        const int row0 = u.pm * 256 + wr * 64 + fr;
        const bool rope = (u.pn < 8) && (wc == 0), dtt = (u.pn == 32), ktile = (u.pn >= 4) && (u.pn < 8);
        const float sgn = (fq < 2) ? -1.f : 1.f;
        f32x4 ks[2][2] = {{{0.f, 0.f, 0.f, 0.f}, {0.f, 0.f, 0.f, 0.f}}, {{0.f, 0.f, 0.f, 0.f}, {0.f, 0.f, 0.f, 0.f}}};
#pragma unroll
        for (int ai = 0; ai < 2; ++ai)
#pragma unroll
            for (int m = 0; m < 4; ++m) {
                const int row = row0 + ai * 128 + m * 16; const float rs = rsx[row];
                f32x4 c0 = {1.f, 1.f, 1.f, 1.f}, c1 = c0, s0 = {0.f, 0.f, 0.f, 0.f}, s1 = s0;
                if (rope) { const float* rt = ropetab + (row & (SEQ - 1)) * 32 + 8 * (fq & 1); c0 = *(const f32x4*)rt; c1 = *(const f32x4*)(rt + 4); s0 = *(const f32x4*)(rt + 16); s1 = *(const f32x4*)(rt + 20); }
#pragma unroll
                for (int bj = 0; bj < 2; ++bj) {
                    f32x4 v0 = acc[ai][bj][m][0] * rs, v1 = acc[ai][bj][m][1] * rs;
                    if (rope) {
                        f32x4 p0, p1;
#pragma unroll
                        for (int e = 0; e < 4; ++e) { p0[e] = __shfl_xor(v0[e], 32); p1[e] = __shfl_xor(v1[e], 32); }
                        v0 = v0 * c0 + (p0 * s0) * sgn; v1 = v1 * c1 + (p1 * s1) * sgn;
                    }
                    ks[bj][0] += v0; ks[bj][1] += v1;
                    if (!dtt) { u32x4 w; w.x = cvt_pk_bf16(v0[0], v0[1]); w.y = cvt_pk_bf16(v0[2], v0[3]); w.z = cvt_pk_bf16(v1[0], v1[1]); w.w = cvt_pk_bf16(v1[2], v1[3]);
                        *(u32x4*)(proj + (size_t)row * LDP + u.pn * 256 + bj * 128 + wc * 32 + 8 * fq) = w; }
                    else if (bj == 0 && wc == 0) { float* d = dtraw + (size_t)row * 32 + 8 * fq; *(f32x4*)d = v0; *(f32x4*)(d + 4) = v1; }
                }
                asm volatile("" ::: "memory");
            }
        if (ktile) {
#pragma unroll
            for (int bj = 0; bj < 2; ++bj)
#pragma unroll
                for (int n = 0; n < 2; ++n)
#pragma unroll
                    for (int e = 0; e < 4; ++e) { float s = ks[bj][n][e]; s += __shfl_xor(s, 1); s += __shfl_xor(s, 2); s += __shfl_xor(s, 4); s += __shfl_xor(s, 8);
                        if (fr == 0) atomicAdd(kmean + (size_t)u.pm * 1024 + (u.pn - 4) * 256 + bj * 128 + wc * 32 + 8 * fq + 4 * n + e, s * (1.f / MB)); }
        }
    }
};

struct SchedTiles {
    const char* A; const char* Bt; int nM, nN, K, G, c;
    __device__ __forceinline__ bool next(int i, gm::Unit& u) const {
        const int L = i * G + c; if (L >= nM * nN) return false;
        int pm, pn; gm::tile_of(L, nM, nN, pm, pn);
        u.pm = pm; u.pn = pn; u.kind = 0; u.ti = 0; u.a = A + (size_t)pm * 256 * K * 2; u.b = Bt + (size_t)pn * 256 * K * 2; return true;
    }
};
struct EpiRes {
    const float* base; float* outf; bf16_t* hb; float* ss;
    __device__ __forceinline__ void operator()(const f32x4 (&acc)[2][2][4][2], const gm::Unit& u, int wr, int wc, int fr, int fq) const {
        const int row0 = u.pm * 256 + wr * 64 + fr;
#pragma unroll
        for (int ai = 0; ai < 2; ++ai)
#pragma unroll
            for (int m = 0; m < 4; ++m) {
                const int row = row0 + ai * 128 + m * 16; float q = 0.f;
#pragma unroll
                for (int bj = 0; bj < 2; ++bj) {
                    const size_t o = (size_t)row * DM + u.pn * 256 + bj * 128 + wc * 32 + 8 * fq;
                    const f32x4 v0 = acc[ai][bj][m][0] + *(const f32x4*)(base + o), v1 = acc[ai][bj][m][1] + *(const f32x4*)(base + o + 4);
                    *(f32x4*)(outf + o) = v0; *(f32x4*)(outf + o + 4) = v1;
                    u32x4 w; w.x = cvt_pk_bf16(v0[0], v0[1]); w.y = cvt_pk_bf16(v0[2], v0[3]); w.z = cvt_pk_bf16(v1[0], v1[1]); w.w = cvt_pk_bf16(v1[2], v1[3]);
                    *(u32x4*)(hb + o) = w;
                    q += (v0[0] * v0[0] + v0[1] * v0[1]) + (v0[2] * v0[2] + v0[3] * v0[3]) + (v1[0] * v1[0] + v1[1] * v1[1]) + (v1[2] * v1[2] + v1[3] * v1[3]);
                }
                q += __shfl_xor(q, 16); q += __shfl_xor(q, 32);
                if (fq == 0) ss[(size_t)row * 32 + u.pn * 4 + wc] = q;
                asm volatile("" ::: "memory");
            }
    }
};
struct SchedQKV {
    const char* A0; const char* B0; const char* A1; const char* B1; int G, c;
    __device__ __forceinline__ bool next(int i, gm::Unit& u) const {
        const int L = i * G + c; int pm, pn;
        if (L < 128) { gm::tile_of(L, 64, 2, pm, pn); u.kind = 0; u.a = A0 + (size_t)pm * 256 * DM * 2; u.b = B0 + (size_t)pn * 256 * DM * 2; }
        else if (L < 160) { gm::tile_of(L - 128, 8, 4, pm, pn); u.kind = 1; u.a = A1 + (size_t)pm * 256 * DM * 2; u.b = B1 + (size_t)pn * 256 * DM * 2; }
        else return false;
        u.pm = pm; u.pn = pn; u.ti = 0; return true;
    }
};
struct EpiScale {
    bf16_t* O0; bf16_t* O1; int ld0, ld1; const LAS float* rsl;
    __device__ __forceinline__ void operator()(const f32x4 (&acc)[2][2][4][2], const gm::Unit& u, int wr, int wc, int fr, int fq) const {
        bf16_t* O = u.kind ? O1 : O0; const int ld = u.kind ? ld1 : ld0;
#pragma unroll
        for (int ai = 0; ai < 2; ++ai)
#pragma unroll
            for (int m = 0; m < 4; ++m) {
                const int r = ai * 128 + wr * 64 + m * 16 + fr; const float rs = rsl[r];
#pragma unroll
                for (int bj = 0; bj < 2; ++bj) {
                    const f32x4 v0 = acc[ai][bj][m][0] * rs, v1 = acc[ai][bj][m][1] * rs;
                    u32x4 w; w.x = cvt_pk_bf16(v0[0], v0[1]); w.y = cvt_pk_bf16(v0[2], v0[3]); w.z = cvt_pk_bf16(v1[0], v1[1]); w.w = cvt_pk_bf16(v1[2], v1[3]);
                    *(u32x4*)(O + (size_t)(u.pm * 256 + r) * ld + u.pn * 256 + bj * 128 + wc * 32 + 8 * fq) = w;
                }
            }
    }
};

__device__ __forceinline__ void moe_tables(LAS int* mt, const int* cnt_g, int tid) {
    if (tid < 32) mt[tid] = cnt_g[tid];
    LDS_WAIT(); __syncthreads();
    if (tid == 0) { int p = 0, o = 0; for (int e = 0; e < NE; ++e) { mt[32 + e] = p; mt[65 + e] = o; const int c = mt[e]; p += 8 * ((c + 255) >> 8); o += c; } mt[32 + NE] = p; mt[65 + NE] = o; }
    LDS_WAIT(); __syncthreads();
}
template <bool GU> struct SchedMoE {
    const LAS int* mt; const char* A; const char* Bt; int G, c;
    __device__ __forceinline__ bool next(int i, gm::Unit& u) const {
        const int L = i * G + c; if (L >= mt[32 + NE]) return false;
        int e = 0;
#pragma unroll 1
        for (int k = 1; k < NE; ++k) if (L >= mt[32 + k]) e = k;
        const int rem = L - mt[32 + e], te = (mt[e] + 255) >> 8, pn = rem / te, mtile = rem - pn * te;
        u.pm = mtile; u.pn = pn; u.kind = e; u.ti = i;
        if (GU) { u.a = A; u.b = Bt + ((size_t)e * 2048 + pn * 256) * DM * 2; }
        else { u.a = A + (size_t)(mt[65 + e] + mtile * 256) * DE * 2; u.b = Bt + ((size_t)e * 2048 + pn * 256) * DE * 2; }
        return true;
    }
};
struct EpiGU {
    bf16_t* Hact; const float* rs2; const LAS int* mt; const LAS int* tab;
    __device__ __forceinline__ void operator()(const f32x4 (&acc)[2][2][4][2], const gm::Unit& u, int wr, int wc, int fr, int fq) const {
        const int e = u.kind, valid = mt[e] - u.pm * 256, slot0 = mt[65 + e] + u.pm * 256;
#pragma unroll
        for (int ai = 0; ai < 2; ++ai)
#pragma unroll
            for (int m = 0; m < 4; ++m) {
                const int r = ai * 128 + wr * 64 + m * 16 + fr;
                if (r < valid) {
                    const float rs = rs2[tab[u.ti * 256 + r]];
                    const f32x4 g0 = acc[ai][0][m][0] * rs, g1 = acc[ai][0][m][1] * rs, u0 = acc[ai][1][m][0] * rs, u1 = acc[ai][1][m][1] * rs;
                    float o[8];
#pragma unroll
                    for (int j = 0; j < 4; ++j) { o[j] = g0[j] * __builtin_amdgcn_rcpf(1.f + __expf(-g0[j])) * u0[j]; o[4 + j] = g1[j] * __builtin_amdgcn_rcpf(1.f + __expf(-g1[j])) * u1[j]; }
                    u32x4 w; w.x = cvt_pk_bf16(o[0], o[1]); w.y = cvt_pk_bf16(o[2], o[3]); w.z = cvt_pk_bf16(o[4], o[5]); w.w = cvt_pk_bf16(o[6], o[7]);
                    *(u32x4*)(Hact + (size_t)(slot0 + r) * DE + u.pn * 128 + wc * 32 + 8 * fq) = w;
                }
            }
    }
};
struct EpiDown {
    bf16_t* Y; const LAS int* mt;
    __device__ __forceinline__ void operator()(const f32x4 (&acc)[2][2][4][2], const gm::Unit& u, int wr, int wc, int fr, int fq) const {
        const int e = u.kind, valid = mt[e] - u.pm * 256, slot0 = mt[65 + e] + u.pm * 256;
#pragma unroll
        for (int ai = 0; ai < 2; ++ai)
#pragma unroll
            for (int m = 0; m < 4; ++m) {
                const int r = ai * 128 + wr * 64 + m * 16 + fr;
                if (r < valid) {
#pragma unroll
                    for (int bj = 0; bj < 2; ++bj) { const f32x4 v0 = acc[ai][bj][m][0], v1 = acc[ai][bj][m][1];
                        u32x4 w; w.x = cvt_pk_bf16(v0[0], v0[1]); w.y = cvt_pk_bf16(v0[2], v0[3]); w.z = cvt_pk_bf16(v1[0], v1[1]); w.w = cvt_pk_bf16(v1[2], v1[3]);
                        *(u32x4*)(Y + (size_t)(slot0 + r) * DM + u.pn * 256 + bj * 128 + wc * 32 + 8 * fq) = w; }
                }
            }
    }
};
__device__ __forceinline__ void final_rows(Frame& F, float* hio, const bf16_t* Y, const int* tok_e, const int* tok_pos, const float* tok_w, const float* fw, const LAS int* mt) {
    const int gw = F.vcu * NWAVES + F.wave, NGW = F.G * NWAVES, lane = F.lane;
    for (int t = gw; t < M; t += NGW) {
        const int e1 = tok_e[2 * t], e2 = tok_e[2 * t + 1];
        const size_t s1 = (size_t)(mt[65 + e1] + tok_pos[2 * t]), s2 = (size_t)(mt[65 + e2] + tok_pos[2 * t + 1]);
        const float w1 = tok_w[2 * t], w2 = tok_w[2 * t + 1];
        f32x4* hr = (f32x4*)(hio + (size_t)t * DM) + 2 * lane;
        const u32x4* y1 = (const u32x4*)(Y + s1 * DM) + lane; const u32x4* y2 = (const u32x4*)(Y + s2 * DM) + lane;
        float v[4][8]; float ss = 0.f;
#pragma unroll
        for (int j = 0; j < 4; ++j) {
            const f32x4 a0 = hr[128 * j], a1 = hr[128 * j + 1]; const u32x4 p = y1[64 * j], q = y2[64 * j];
            const float pa[8] = {bflo(p.x), bfhi(p.x), bflo(p.y), bfhi(p.y), bflo(p.z), bfhi(p.z), bflo(p.w), bfhi(p.w)};
            const float qa[8] = {bflo(q.x), bfhi(q.x), bflo(q.y), bfhi(q.y), bflo(q.z), bfhi(q.z), bflo(q.w), bfhi(q.w)};
            const float ha[8] = {a0[0], a0[1], a0[2], a0[3], a1[0], a1[1], a1[2], a1[3]};
#pragma unroll
            for (int k = 0; k < 8; ++k) { v[j][k] = ha[k] + (w1 * pa[k] + w2 * qa[k]); ss += v[j][k] * v[j][k]; }
        }
        ss = wave_sum(ss);
        const float rs = rsqrtf(ss * (1.f / DM) + EPS);
#pragma unroll
        for (int j = 0; j < 4; ++j) {
            const f32x4 g0 = *((const f32x4*)fw + 2 * lane + 128 * j), g1 = *((const f32x4*)fw + 2 * lane + 128 * j + 1);
            hr[128 * j] = (f32x4){v[j][0] * rs * g0[0], v[j][1] * rs * g0[1], v[j][2] * rs * g0[2], v[j][3] * rs * g0[3]};
            hr[128 * j + 1] = (f32x4){v[j][4] * rs * g1[0], v[j][5] * rs * g1[1], v[j][6] * rs * g1[2], v[j][7] * rs * g1[3]};
        }
    }
}

__device__ __forceinline__ void router_rows(Frame& F, const float* h2, const bf16_t* wrh, const float* b_rg, const float* b_re, float* rs2, int* cnt, int* list, int* tok_e, int* tok_pos, float* tok_w) {
    const int lane = F.lane, tid = F.tid, w = F.wave, ti = lane & 15, kg = lane >> 4;
    LAS float* part = (LAS float*)(F.lds + RING_OFF);
    LAS float* sqp = part + 8 * 16 * 48;
    LAS float* lgt = sqp + 8 * 16;
    const bf16_t* wrl = wrh + 48 * DM;
    for (int g = F.vcu; g < M / 16; g += F.G) {
        const float* hr = h2 + (size_t)(g * 16 + ti) * DM + w * 256 + 8 * kg;
        f32x4 acc[3] = {{0.f, 0.f, 0.f, 0.f}, {0.f, 0.f, 0.f, 0.f}, {0.f, 0.f, 0.f, 0.f}}; float sq = 0.f;
#pragma unroll 2
        for (int s = 0; s < 8; ++s) {
            const f32x4 x0 = *(const f32x4*)(hr + 32 * s), x1 = *(const f32x4*)(hr + 32 * s + 4);
            bf16x8 bh[3], bl[3];
#pragma unroll
            for (int nt = 0; nt < 3; ++nt) { const size_t o = (size_t)(16 * nt + ti) * DM + w * 256 + 32 * s + 8 * kg; bh[nt] = *(const bf16x8*)(wrh + o); bl[nt] = *(const bf16x8*)(wrl + o); }
            sq += (x0[0] * x0[0] + x0[1] * x0[1]) + (x0[2] * x0[2] + x0[3] * x0[3]) + (x1[0] * x1[0] + x1[1] * x1[1]) + (x1[2] * x1[2] + x1[3] * x1[3]);
            u32x4 hw, lw;
            hw.x = cvt_pk_bf16(x0[0], x0[1]); hw.y = cvt_pk_bf16(x0[2], x0[3]); hw.z = cvt_pk_bf16(x1[0], x1[1]); hw.w = cvt_pk_bf16(x1[2], x1[3]);
            lw.x = cvt_pk_bf16(x0[0] - bflo(hw.x), x0[1] - bfhi(hw.x)); lw.y = cvt_pk_bf16(x0[2] - bflo(hw.y), x0[3] - bfhi(hw.y));
            lw.z = cvt_pk_bf16(x1[0] - bflo(hw.z), x1[1] - bfhi(hw.z)); lw.w = cvt_pk_bf16(x1[2] - bflo(hw.w), x1[3] - bfhi(hw.w));
            const bf16x8 ah = *reinterpret_cast<const bf16x8*>(&hw), al = *reinterpret_cast<const bf16x8*>(&lw);
#pragma unroll
            for (int nt = 0; nt < 3; ++nt) { acc[nt] = __builtin_amdgcn_mfma_f32_16x16x32_bf16(ah, bh[nt], acc[nt], 0, 0, 0); acc[nt] = __builtin_amdgcn_mfma_f32_16x16x32_bf16(ah, bl[nt], acc[nt], 0, 0, 0);
                acc[nt] = __builtin_amdgcn_mfma_f32_16x16x32_bf16(al, bh[nt], acc[nt], 0, 0, 0); }
        }
        sq += __shfl_xor(sq, 16); sq += __shfl_xor(sq, 32);
        __syncthreads();
#pragma unroll
        for (int nt = 0; nt < 3; ++nt)
#pragma unroll
            for (int r = 0; r < 4; ++r) part[(w * 16 + 4 * kg + r) * 48 + 16 * nt + ti] = acc[nt][r];
        if (kg == 0) sqp[w * 16 + ti] = sq;
        __syncthreads();
        for (int i = tid; i < 16 * 48 + 16; i += NWAVES * 64) { float s = 0.f;
            if (i < 16 * 48) {
#pragma unroll
                for (int ww = 0; ww < 8; ++ww) s += part[ww * 16 * 48 + i]; }
            else {
#pragma unroll
                for (int ww = 0; ww < 8; ++ww) s += sqp[ww * 16 + (i - 16 * 48)]; }
            lgt[i] = s; }
        __syncthreads();
        if (tid < 16) {
            const int tt = g * 16 + tid; const LAS float* lg = lgt + tid * 48;
            const float rs = rsqrtf(lgt[16 * 48 + tid] * (1.f / DM) + EPS);
            float gm_ = -INFINITY; int gi = 0; float gv[4];
#pragma unroll
            for (int i = 0; i < 4; ++i) { gv[i] = lg[i] * rs + b_rg[i]; if (gv[i] > gm_) { gm_ = gv[i]; gi = i; } }
            float gs = 0.f;
#pragma unroll
            for (int i = 0; i < 4; ++i) gs += __expf(gv[i] - gm_);
            const float gwt = 1.f / gs;
            float e1 = -INFINITY, e2 = -INFINITY; int i1 = 0, i2 = 0;
#pragma unroll
            for (int i = 0; i < 8; ++i) { const float vv = lg[4 + gi * 8 + i] * rs + b_re[gi * 8 + i]; if (vv > e1) { e2 = e1; i2 = i1; e1 = vv; i1 = i; } else if (vv > e2) { e2 = vv; i2 = i; } }
            const float p2 = 1.f / (1.f + __expf(e1 - e2)), p1 = 1.f - p2;
            const int ea = gi * 8 + i1, eb = gi * 8 + i2;
            const int pa = atomicAdd(&cnt[ea], 1), pb = atomicAdd(&cnt[eb], 1);
            list[ea * M + pa] = tt; list[eb * M + pb] = tt;
            tok_e[tt * 2] = ea; tok_e[tt * 2 + 1] = eb; tok_pos[tt * 2] = pa; tok_pos[tt * 2 + 1] = pb; tok_w[tt * 2] = gwt * p1; tok_w[tt * 2 + 1] = gwt * p2; rs2[tt] = rs;
        }
    }
    __syncthreads();
}

__device__ __forceinline__ void dt_rows(Frame& F, const bf16_t* xb, const bf16_t* wdt, const float* rsx, float* dtraw) {
    const int lane = F.lane, tid = F.tid, w = F.wave, ti = lane & 15, kg = lane >> 4;
    LAS float* part = (LAS float*)(F.lds + RING_OFF);
    for (int g = F.vcu; g < M / 16; g += F.G) {
        const bf16_t* ar = xb + (size_t)(g * 16 + ti) * DM + w * 256 + 8 * kg;
        f32x4 acc[2] = {{0.f, 0.f, 0.f, 0.f}, {0.f, 0.f, 0.f, 0.f}};
        bf16x8 af[8], b0[8], b1[8];
#pragma unroll
        for (int s = 0; s < 8; ++s) { af[s] = *(const bf16x8*)(ar + 32 * s); b0[s] = *(const bf16x8*)(wdt + (size_t)ti * DM + w * 256 + 32 * s + 8 * kg); b1[s] = *(const bf16x8*)(wdt + (size_t)(16 + ti) * DM + w * 256 + 32 * s + 8 * kg); }
#pragma unroll
        for (int s = 0; s < 8; ++s) { acc[0] = __builtin_amdgcn_mfma_f32_16x16x32_bf16(af[s], b0[s], acc[0], 0, 0, 0); acc[1] = __builtin_amdgcn_mfma_f32_16x16x32_bf16(af[s], b1[s], acc[1], 0, 0, 0); }
        __syncthreads();
#pragma unroll
        for (int nt = 0; nt < 2; ++nt)
#pragma unroll
            for (int r = 0; r < 4; ++r) part[(w * 16 + 4 * kg + r) * 32 + 16 * nt + ti] = acc[nt][r];
        __syncthreads();
        { float s = 0.f;
#pragma unroll
          for (int ww = 0; ww < 8; ++ww) s += part[ww * 512 + tid];
          const int tok = g * 16 + (tid >> 5); dtraw[(size_t)tok * 32 + (tid & 31)] = s * rsx[tok]; }
    }
    __syncthreads();
}

__device__ __forceinline__ void gnorm_rows(Frame& F, const float* ssq, bf16_t* mixb) {
    const int gw = F.vcu * NWAVES + F.wave, NGW = F.G * NWAVES, lane = F.lane;
#pragma unroll 2
    for (int tok = gw; tok < M; tok += NGW) {
        float part = ssq[(size_t)tok * 64 + lane];
        part += __shfl_xor(part, 1); part += __shfl_xor(part, 2); part += __shfl_xor(part, 4); part += __shfl_xor(part, 8);
        const float rsl = rsqrtf(part * (1.f / 512.f) + EPS);
        u32x4* p = (u32x4*)(mixb + (size_t)tok * MIXW + AW) + lane;
        u32x4 w[4];
#pragma unroll
        for (int g = 0; g < 4; ++g) w[g] = p[64 * g];
#pragma unroll
        for (int g = 0; g < 4; ++g) { const float rs = __shfl(rsl, 16 * g); u32x4 o;
            o.x = cvt_pk_bf16(bflo(w[g].x) * rs, bfhi(w[g].x) * rs); o.y = cvt_pk_bf16(bflo(w[g].y) * rs, bfhi(w[g].y) * rs); o.z = cvt_pk_bf16(bflo(w[g].z) * rs, bfhi(w[g].z) * rs); o.w = cvt_pk_bf16(bflo(w[g].w) * rs, bfhi(w[g].w) * rs);
            p[64 * g] = o; }
    }
}

#ifndef REP_P0
#define REP_P0 1
#endif
#ifndef REP_P0B
#define REP_P0B 1
#endif
#ifndef REP_G1
#define REP_G1 1
#endif
#ifndef REP_SSD
#define REP_SSD 1
#endif
#ifndef REP_MOE
#define REP_MOE 1
#endif
#ifndef REP_ATT
#define REP_ATT 1
#endif
#ifndef REP_G2
#define REP_G2 1
#endif
__global__ void __launch_bounds__(NWAVES * 64, 2) fwd(Args args) {
    extern __shared__ __attribute__((aligned(16))) unsigned char lds_raw[];
    Frame F;
    F.lds = (LAS unsigned char*)lds_raw;
    F.MISC = (volatile LAS unsigned*)(F.lds + MISC_OFF);
    F.tid = threadIdx.x; F.lane = F.tid & 63; F.wave = __builtin_amdgcn_readfirstlane(F.tid >> 6);
    F.G = gridDim.x; { const int bx = blockIdx.x; F.vcu = (F.G % 8 == 0) ? (bx % 8) * (F.G / 8) + bx / 8 : bx; }
    for (int u = F.tid; u < (LDS_BYTES - LDSCTL_OFF) / 4; u += NWAVES * 64) ((LAS unsigned*)(F.lds + LDSCTL_OFF))[u] = 0u;
    __syncthreads();
    (void)xcd_barrier_post((unsigned*)(args.ws + WS_CTL) + CW_BAR + args.li * XCD_BAR_WORDS, F.MISC + 8);
#define GRID_BAR() do { GAS unsigned char* wb_ = (GAS unsigned char*)args.ws; asm volatile("" : "+s"(wb_)); XcdBarrier b_; \
        b_.bar = (unsigned*)((unsigned char*)wb_ + WS_CTL) + CW_BAR + args.li * XCD_BAR_WORDS; b_.x = xb_xcc_id(); b_.st = F.MISC + 8; xcd_barrier(b_, F.wave * 64 + lane_id_now()); } while (0)
    const int lo = args.ph_lo, hi = args.ph_hi;
#define IN(k) (lo <= (k) && (k) < hi)
#define BOTH(k) (IN(k) && IN((k) + 1))
#define PHASE_WS() F.lane = lane_id_now(); F.tid = F.wave * 64 + F.lane; GAS unsigned char* wsg_ = (GAS unsigned char*)args.ws; asm volatile("" : "+s"(wsg_)); unsigned char* ws = (unsigned char*)wsg_
    if (IN(0)) { F.lane = lane_id_now(); F.tid = F.wave * 64 + F.lane;
p0a_prologue(F, args); if constexpr (REP_P0 > 1) p0a_prologue(F, args); if (BOTH(0)) GRID_BAR(); }
    if (IN(1)) {
        PHASE_WS();
        const int rsplit = (F.vcu >> 5) & 7;
        EpiG1 E{(bf16_t*)(ws + WS_PROJ), (float*)(ws + WS_DTRAW), (const float*)(ws + WS_RSX), (const float*)(ws + WS_ROPE), (float*)(ws + WS_KMEAN)};
        { SchedG1 S{(const char*)(ws + WS_XB), (const char*)(ws + WS_WIN_T), F.G, (int)blockIdx.x, 0, rsplit};
          gm::gemm_phase<EpiG1, SchedG1, false>(F.tid, F.lds + RING_OFF, (const LAS int*)(F.lds + TAB_OFF), DM, S, E); }
        __syncthreads();
        p0b_share(F, args);
        if constexpr (REP_P0B > 1) { __syncthreads(); p0b_share(F, args); }
        __syncthreads();
        { F.lane = lane_id_now(); F.tid = F.wave * 64 + F.lane;
          SchedG1 S{(const char*)(ws + WS_XB), (const char*)(ws + WS_WIN_T), F.G, (int)blockIdx.x, rsplit, 1 << 20};
          gm::gemm_phase<EpiG1, SchedG1, false>(F.tid, F.lds + RING_OFF, (const LAS int*)(F.lds + TAB_OFF), DM, S, E); }
        if (BOTH(1)) GRID_BAR();
    }
    if (IN(2)) {
        PHASE_WS();
        dt_rows(F, (const bf16_t*)(ws + WS_XB), (const bf16_t*)(ws + WS_WIN_T) + (size_t)C_DT * DM, (const float*)(ws + WS_RSX), (float*)(ws + WS_DTRAW));
        sd::conv_prepass(F.vcu * NWAVES * 64 + F.tid, F.G * NWAVES * 64, (const bf16_t*)(ws + WS_PROJ), args.in[4], args.in[5], (bf16_t*)(ws + WS_XBCC));
        if (BOTH(2)) GRID_BAR();
    }
    if (IN(3)) {
        PHASE_WS();
        for (int L = F.vcu; L < BATCH * SH; L += F.G)
            sd::ssd_unit(F.tid, L / SH, L % SH, (const bf16_t*)(ws + WS_PROJ), (const bf16_t*)(ws + WS_XBCC), (const float*)(ws + WS_DTRAW), args.in[6], args.in[7], args.in[8],
                         (bf16_t*)(ws + WS_MIXB), (float*)(ws + WS_SS), (LAS char*)(F.lds + RING_OFF));
        if constexpr (REP_SSD > 1) {
        for (int L = F.vcu; L < BATCH * SH; L += F.G)
            sd::ssd_unit(F.tid, L / SH, L % SH, (const bf16_t*)(ws + WS_PROJ), (const bf16_t*)(ws + WS_XBCC), (const float*)(ws + WS_DTRAW), args.in[6], args.in[7], args.in[8],
                         (bf16_t*)(ws + WS_MIXB), (float*)(ws + WS_SS), (LAS char*)(F.lds + RING_OFF));
        }
        if (BOTH(3)) GRID_BAR();
    }
    if (IN(4)) {
        PHASE_WS();
        for (int L = F.vcu; L < BATCH * AH * 4; L += F.G) {
            const int b = L >> 5, h = (L >> 2) & 7, pi = L & 3;
            const bf16_t* pb = (const bf16_t*)(ws + WS_PROJ) + (size_t)b * SEQ * LDP + h * HD;
#pragma unroll 1
            for (int k = 0; k < 2; ++k) { const int jb = k ? pi : 7 - pi;
                at::attn_unit<true>(F.tid, pb + (size_t)jb * MB * LDP + C_Q, pb + C_K, (bf16_t*)(ws + WS_MIXB) + (size_t)(b * SEQ + jb * MB) * MIXW + h * HD,
                                    4 * (jb + 1), jb, (const float*)(ws + WS_KMEAN) + (size_t)b * NB * 1024 + h * HD, (LAS char*)(F.lds + RING_OFF)); }
        }
        if constexpr (REP_ATT > 1) {
        for (int L = F.vcu; L < BATCH * AH * 4; L += F.G) {
            const int b = L >> 5, h = (L >> 2) & 7, pi = L & 3;
            const bf16_t* pb = (const bf16_t*)(ws + WS_PROJ) + (size_t)b * SEQ * LDP + h * HD;
#pragma unroll 1
            for (int k = 0; k < 2; ++k) { const int jb = k ? pi : 7 - pi;
                at::attn_unit<true>(F.tid, pb + (size_t)jb * MB * LDP + C_Q, pb + C_K, (bf16_t*)(ws + WS_MIXB) + (size_t)(b * SEQ + jb * MB) * MIXW + h * HD,
                                    4 * (jb + 1), jb, (const float*)(ws + WS_KMEAN) + (size_t)b * NB * 1024 + h * HD, (LAS char*)(F.lds + RING_OFF)); }
        }
        }
        __syncthreads();
        gnorm_rows(F, (const float*)(ws + WS_SS), (bf16_t*)(ws + WS_MIXB));
        if (BOTH(4)) GRID_BAR();
    }
    if (IN(5)) {
        PHASE_WS();
        SchedTiles S{(const char*)(ws + WS_MIXB), (const char*)(ws + WS_WOUT_T), 64, 8, MIXW, F.G, (int)blockIdx.x};
        EpiRes E{args.in[0], args.out, (bf16_t*)(ws + WS_XB), (float*)(ws + WS_SS)};
        gm::gemm_phase<EpiRes, SchedTiles, false>(F.tid, F.lds + RING_OFF, (const LAS int*)(F.lds + TAB_OFF), MIXW, S, E);
        if constexpr (REP_G2 > 1) { __syncthreads(); gm::gemm_phase<EpiRes, SchedTiles, false>(F.tid, F.lds + RING_OFF, (const LAS int*)(F.lds + TAB_OFF), MIXW, S, E); }
        if (BOTH(5)) GRID_BAR();
    }
    if (IN(6)) {
        PHASE_WS();
        SchedQKV S{(const char*)(ws + WS_XB), (const char*)(ws + WS_WCQ_T), (const char*)(ws + WS_MEMB), (const char*)(ws + WS_WCKV_T), F.G, (int)blockIdx.x};
        gm::Unit u0; LAS float* rsl = (LAS float*)(F.lds + RSL_OFF);
        if (S.next(0, u0) && F.tid < 256) {
            const int row = u0.pm * 256 + F.tid;
            if (u0.kind == 0) { const f32x4* p = (const f32x4*)((const float*)(ws + WS_SS) + (size_t)row * 32); float q = 0.f;
#pragma unroll
                for (int j = 0; j < 8; ++j) { const f32x4 v = p[j]; q += (v[0] + v[1]) + (v[2] + v[3]); }
                rsl[F.tid] = rsqrtf(q * (1.f / DM) + EPS); }
            else rsl[F.tid] = ((const float*)(ws + WS_RSMEM))[row];
        }
        VM_WAIT(); LDS_WAIT(); __syncthreads();
        EpiScale E{(bf16_t*)(ws + WS_QC), (bf16_t*)(ws + WS_KVC), CW, 2 * CW, rsl};
        gm::gemm_phase<EpiScale, SchedQKV, false>(F.tid, F.lds + RING_OFF, (const LAS int*)(F.lds + TAB_OFF), DM, S, E);
        if (BOTH(6)) GRID_BAR();
    }
    if (IN(7)) {
        PHASE_WS();
        for (int L = F.vcu; L < BATCH * CH * 8; L += F.G) {
            const int b = L >> 5, h = (L >> 3) & 3, qt = L & 7;
            const bf16_t* kb_ = (const bf16_t*)(ws + WS_KVC) + (size_t)b * MEM * (2 * CW) + h * CHD;
            at::attn_unit<false>(F.tid, (const bf16_t*)(ws + WS_QC) + (size_t)(b * SEQ + qt * 256) * CW + h * CHD, kb_,
                                 (bf16_t*)(ws + WS_OC) + (size_t)(b * SEQ + qt * 256) * CW + h * CHD, 4, 0, nullptr, (LAS char*)(F.lds + RING_OFF));
        }
        __syncthreads();
        if (BOTH(7)) GRID_BAR();
    }
    if (IN(8)) {
        PHASE_WS();
        SchedTiles S{(const char*)(ws + WS_OC), (const char*)(ws + WS_WCO_T), 64, 8, CW, F.G, (int)blockIdx.x};
        EpiRes E{args.out, args.out, (bf16_t*)(ws + WS_XB), (float*)(ws + WS_SS) + (size_t)M * 32};
        gm::gemm_phase<EpiRes, SchedTiles, false>(F.tid, F.lds + RING_OFF, (const LAS int*)(F.lds + TAB_OFF), CW, S, E);
        if (BOTH(8)) GRID_BAR();
    }
    if (IN(9)) {
        PHASE_WS();
        int* tok_e = (int*)(ws + WS_TOK);
        router_rows(F, args.out, (const bf16_t*)(ws + WS_WR), args.in[20], args.in[22], (float*)(ws + WS_RS2), (int*)(ws + WS_CTL) + CW_CNT, (int*)(ws + WS_LIST), tok_e, tok_e + 2 * M, (float*)(tok_e + 4 * M));
        if (BOTH(9)) GRID_BAR();
    }
    if (IN(10)) {
        PHASE_WS();
        LAS int* mt = (LAS int*)(F.lds + MOE_OFF); LAS int* tab = (LAS int*)(F.lds + TAB_OFF);
        moe_tables(mt, (const int*)(ws + WS_CTL) + CW_CNT, F.tid);
        SchedMoE<true> S{mt, (const char*)(ws + WS_XB), (const char*)(ws + WS_WGU_T), F.G, F.vcu};
        { const int* list = (const int*)(ws + WS_LIST); gm::Unit u;
          for (int i = 0; i < 8 && S.next(i, u); ++i) if (F.tid < 256) { const int rg = u.pm * 256 + F.tid; tab[i * 256 + F.tid] = list[u.kind * M + (rg < mt[u.kind] ? rg : 0)]; } }
        VM_WAIT(); LDS_WAIT(); __syncthreads();
        EpiGU E{(bf16_t*)(ws + WS_HACT), (const float*)(ws + WS_RS2), mt, tab};
gm::gemm_phase<EpiGU, SchedMoE<true>, true, true>(F.tid, F.lds + RING_OFF, tab, DM, S, E);
        if constexpr (REP_MOE > 1) { __syncthreads(); gm::gemm_phase<EpiGU, SchedMoE<true>, true, true>(F.tid, F.lds + RING_OFF, tab, DM, S, E); }
        if (BOTH(10)) GRID_BAR();
    }
    if (IN(11)) {
        PHASE_WS();
        LAS int* mt = (LAS int*)(F.lds + MOE_OFF);
        moe_tables(mt, (const int*)(ws + WS_CTL) + CW_CNT, F.tid);
        SchedMoE<false> S{mt, (const char*)(ws + WS_HACT), (const char*)(ws + WS_WD_T), F.G, F.vcu};
        EpiDown E{(bf16_t*)(ws + WS_Y), mt};
gm::gemm_phase<EpiDown, SchedMoE<false>, false, true>(F.tid, F.lds + RING_OFF, (const LAS int*)(F.lds + TAB_OFF), DE, S, E);
        if constexpr (REP_MOE > 1) { __syncthreads(); gm::gemm_phase<EpiDown, SchedMoE<false>, false, true>(F.tid, F.lds + RING_OFF, (const LAS int*)(F.lds + TAB_OFF), DE, S, E); }
        if (BOTH(11)) GRID_BAR();
    }
    if (IN(12)) {
        PHASE_WS();
        LAS int* mt = (LAS int*)(F.lds + MOE_OFF);
        moe_tables(mt, (const int*)(ws + WS_CTL) + CW_CNT, F.tid);
        const int* tok_e = (const int*)(ws + WS_TOK);
        final_rows(F, args.out, (const bf16_t*)(ws + WS_Y), tok_e, tok_e + 2 * M, (const float*)(tok_e + 4 * M), args.in[26], mt);
    }
#undef IN
#undef BOTH
}
extern "C" void kernel_launch(void* const* d_in, const int* in_sizes, int n_in, void* d_out, int out_size, void* d_ws, size_t ws_size, hipStream_t stream) {
  static int grid = 0;
  static float rfv[16];
  if (grid == 0) {
    int dev = 0, cus = 0;
    if (hipGetDevice(&dev) != hipSuccess || hipDeviceGetAttribute(&cus, hipDeviceAttributeMultiprocessorCount, dev) != hipSuccess) { fprintf(stderr, "kernel_launch: device query failed\n"); grid = -1; return; }
    if (hipFuncSetAttribute((const void*)fwd, hipFuncAttributeMaxDynamicSharedMemorySize, LDS_BYTES) != hipSuccess) { fprintf(stderr, "kernel_launch: hipFuncSetAttribute failed\n"); grid = -1; return; }
    int per_cu = 0;
    if (hipOccupancyMaxActiveBlocksPerMultiprocessor(&per_cu, (const void*)fwd, NWAVES * 64, LDS_BYTES) != hipSuccess || per_cu < 1) fprintf(stderr, "kernel_launch: occupancy query says %d\n", per_cu);
    (void)hipGetLastError();
    for (int i = 0; i < 16; ++i) rfv[i] = (float)pow(500000.0, -(double)i / 16.0);
    grid = cus;
  }
  if (grid < 0) return;
  float* out = (float*)d_out;
  unsigned char* ws = (unsigned char*)d_ws;
  (void)hipMemsetAsync(ws + WS_CTL, 0, CTL_ZERO_BYTES, stream);
  Args a{};
  for (int i = 0; i < 27; ++i) a.in[i] = (const float*)d_in[i];
  a.out = out; a.ws = ws; for (int i = 0; i < 16; ++i) a.rf[i] = rfv[i];
  a.ph_lo = 0; a.ph_hi = 13; a.li = 0;
  hipLaunchKernelGGL(fwd, dim3(grid), dim3(NWAVES * 64), LDS_BYTES, stream, a);
}
```

```cpp
#include <hip/hip_runtime.h>
#include <stdint.h>
#include <math.h>
#include <cstdio>

constexpr int DM = 2048, BATCH = 8, SEQ = 2048, M = BATCH * SEQ, MEM = 256, MROWS = BATCH * MEM;
constexpr float EPS = 1e-6f;
constexpr int AH = 8, HD = 128, AW = 1024;
constexpr int MB = 256, NB = SEQ / MB;
constexpr int SW = 2048, SH = 32, SG = 4, SCONV = 4, CONVD = 3072;
constexpr int MIXW = 3072, INW = 8224, LDP = 8448;
constexpr int C_Q = 0, C_K = 1024, C_V = 2048, C_Z = 3072, C_XBC = 5120, C_DT = 8192;
constexpr int CH = 4, CHD = 128, CW = 512;
constexpr int NG = 4, EPG = 8, NE = 32, DE = 1024;

#define LAS __attribute__((address_space(3)))
#define GAS __attribute__((address_space(1)))
typedef unsigned short bf16_t;
typedef short bf16x8 __attribute__((ext_vector_type(8)));
typedef float f32x4 __attribute__((ext_vector_type(4)));
typedef float f32x2 __attribute__((ext_vector_type(2)));
typedef unsigned u32x4 __attribute__((ext_vector_type(4)));
typedef unsigned u32x2 __attribute__((ext_vector_type(2)));
typedef int i32x4 __attribute__((ext_vector_type(4)));
typedef int i32x8 __attribute__((ext_vector_type(8)));
typedef short s16x16 __attribute__((ext_vector_type(16)));
#define LDS_WAIT() asm volatile("s_waitcnt lgkmcnt(0)" ::: "memory")
#define VM_WAIT() asm volatile("s_waitcnt vmcnt(0)" ::: "memory")

__device__ __forceinline__ unsigned cvt_pk_bf16(float lo, float hi) { unsigned r; asm volatile("v_cvt_pk_bf16_f32 %0, %1, %2" : "=v"(r) : "v"(lo), "v"(hi)); return r; }
__device__ __forceinline__ unsigned pk4_fp8(float a, float b, float c, float d) {
  a = fminf(fmaxf(a, -448.f), 448.f); b = fminf(fmaxf(b, -448.f), 448.f); c = fminf(fmaxf(c, -448.f), 448.f); d = fminf(fmaxf(d, -448.f), 448.f);
  int w = 0; w = __builtin_amdgcn_cvt_pk_fp8_f32(a, b, w, false); w = __builtin_amdgcn_cvt_pk_fp8_f32(c, d, w, true); return (unsigned)w; }
__device__ __forceinline__ float bf2f(bf16_t b) { return __uint_as_float(((unsigned)b) << 16); }
__device__ __forceinline__ float bflo(unsigned w) { return __uint_as_float(w << 16); }
__device__ __forceinline__ float bfhi(unsigned w) { return __uint_as_float(w & 0xffff0000u); }
__device__ __forceinline__ void ld8bf(const bf16_t* p, float (&o)[8]) { const u32x4 w = *(const u32x4*)p; o[0] = bflo(w.x); o[1] = bfhi(w.x); o[2] = bflo(w.y); o[3] = bfhi(w.y); o[4] = bflo(w.z); o[5] = bfhi(w.z); o[6] = bflo(w.w); o[7] = bfhi(w.w); }
__device__ __forceinline__ float wave_sum(float v) {
#pragma unroll
  for (int o = 1; o < 64; o <<= 1) v += __shfl_xor(v, o);
  return v;
}
__device__ __forceinline__ float wave_max(float v) {
#pragma unroll
  for (int o = 1; o < 64; o <<= 1) v = fmaxf(v, __shfl_xor(v, o));
  return v;
}
__device__ __forceinline__ int lane_id_now() { int l; asm volatile("v_mbcnt_lo_u32_b32 %0, -1, 0\n\tv_mbcnt_hi_u32_b32 %0, -1, %0" : "=v"(l)); return l; }
__device__ __forceinline__ float silu_f(float x) { return x / (1.f + __expf(-x)); }

constexpr size_t MiB = 1u << 20;
constexpr size_t WS_CTL = 0, CTL_ZERO_BYTES = 1 * MiB;
constexpr int CW_BAR = 4096;
constexpr int CW_CNT = 65536;
constexpr size_t WS_WIN_T = 1 * MiB;
constexpr size_t WS_WOUT_T = 34 * MiB;
constexpr size_t WS_WCQ_T = 46 * MiB;
constexpr size_t WS_WCKV_T = 48 * MiB;
constexpr size_t WS_WCO_T = 52 * MiB;
constexpr size_t WS_WR = 54 * MiB;
constexpr size_t WS_SMALL = 55 * MiB;
constexpr size_t WS_ROPE = WS_SMALL, WS_RSX = WS_SMALL + 256 * 1024, WS_RSMEM = WS_RSX + 64 * 1024, WS_RS2 = WS_RSMEM + 64 * 1024, WS_KMEAN = WS_RS2 + 64 * 1024;
constexpr size_t WS_DTRAW = 56 * MiB;
constexpr size_t WS_SS = 58 * MiB;
constexpr size_t WS_MEMB = 62 * MiB;
constexpr size_t WS_XB = 70 * MiB;
constexpr size_t WS_PROJ = 134 * MiB;
constexpr size_t WS_MIXB = 398 * MiB;
constexpr size_t WS_QC = 494 * MiB, WS_OC = 510 * MiB;
constexpr size_t WS_KVC = 526 * MiB;
constexpr size_t WS_WGU_T = 530 * MiB;
constexpr size_t WS_WD_T = 786 * MiB;
constexpr size_t WS_LIST = 914 * MiB;
constexpr size_t WS_TOK = 916 * MiB;
constexpr size_t WS_HACT = WS_PROJ;
constexpr size_t WS_Y = WS_PROJ + 66 * MiB;
constexpr size_t WS_XBCC = 918 * MiB;
constexpr size_t WS_AFTER = 1014 * MiB;
#define XB_TMO      128
#define XB_XCNT(j)  (256  + 64 * (j))
#define XB_XSUB(j)  (1280 + 64 * (j))
#define XB_XGEN(j)  (2304 + 64 * (j))
#define XB_TOP      3328
#define XB_TOPGEN   3392
#define XCD_BAR_WORDS 3456
#define XB_SPIN_CAP (1u << 18)

__device__ __forceinline__ unsigned xb_ld(unsigned* p)              { return __hip_atomic_load(p, __ATOMIC_RELAXED, __HIP_MEMORY_SCOPE_AGENT); }
__device__ __forceinline__ unsigned xb_add(unsigned* p, unsigned v) { return __hip_atomic_fetch_add(p, v, __ATOMIC_RELAXED, __HIP_MEMORY_SCOPE_AGENT); }
__device__ __forceinline__ unsigned xb_xcc_id() { return (unsigned)__builtin_amdgcn_s_getreg((3 << 11) | 20) & 0xFu; }
#define XB_SPIN(cond, bar) do { unsigned _sp = 0; while (cond) { __builtin_amdgcn_s_sleep(1); \
    if ((++_sp & 255u) == 0u) { if (xb_ld(&(bar)[XB_TMO])) break; if (_sp > XB_SPIN_CAP) { atomicAdd(&(bar)[XB_TMO], 1u); break; } } } } while (0)

struct XcdBarrier {
    unsigned* bar; unsigned x;
    volatile LAS unsigned* st;
};

__device__ __forceinline__ XcdBarrier xcd_barrier_post(unsigned* bar, volatile LAS unsigned* st) {
    XcdBarrier b; b.bar = bar; b.x = xb_xcc_id(); b.st = st;
    if (threadIdx.x == 0) (void)xb_add(&bar[XB_XCNT(b.x)], 1u);
    return b;
}
__device__ __forceinline__ void xcd_barrier_complete(unsigned* bar, unsigned x, unsigned& nloc, unsigned& nx) {
    const unsigned G = gridDim.x * gridDim.y * gridDim.z;
    unsigned sum, cnt, mine, sp = 0u;
    for (;;) {
        sum = 0u; cnt = 0u; mine = 0u;
#pragma unroll
        for (unsigned j = 0; j < 16; ++j) { const unsigned c = xb_ld(&bar[XB_XCNT(j)]); sum += c; cnt += (c > 0u) ? 1u : 0u; mine = (j == x) ? c : mine; }
        if (sum == G) break;
        __builtin_amdgcn_s_sleep(1);
        if ((++sp & 255u) == 0u) { if (xb_ld(&bar[XB_TMO])) break; if (sp > XB_SPIN_CAP) { atomicAdd(&bar[XB_TMO], 1u); break; } }
    }
    nloc = mine > 0u ? mine : 1u; nx = cnt > 0u ? cnt : 1u;
}

__device__ __forceinline__ void xcd_barrier(const XcdBarrier& b, const int xb_tid) {
    asm volatile("s_waitcnt vmcnt(0)" ::: "memory");
    __syncthreads();
    if (xb_tid == 0) {
        unsigned* bar = b.bar;
        __builtin_amdgcn_s_waitcnt(0);
        unsigned nloc = b.st[0], nx = b.st[1];
        if (nloc == 0u) { xcd_barrier_complete(bar, b.x, nloc, nx); b.st[0] = nloc; b.st[1] = nx; }
        const unsigned old = xb_add(&bar[XB_XSUB(b.x)], 1u);
        const unsigned gen = old / nloc;
        if (old + 1u == (gen + 1u) * nloc) {
            __builtin_amdgcn_fence(__ATOMIC_RELEASE, "agent");
            asm volatile("s_waitcnt vmcnt(0)" ::: "memory");
            const unsigned og = xb_add(&bar[XB_TOP], 1u);
            const unsigned tg = og / nx;
            if (og + 1u == (tg + 1u) * nx) xb_add(&bar[XB_TOPGEN], 1u);
            else XB_SPIN(xb_ld(&bar[XB_TOPGEN]) == tg, bar);
            __builtin_amdgcn_fence(__ATOMIC_ACQUIRE, "agent");
            xb_add(&bar[XB_XGEN(b.x)], 1u);
            asm volatile("s_waitcnt vmcnt(0)" ::: "memory");
        } else {
            XB_SPIN(xb_ld(&bar[XB_XGEN(b.x)]) == gen, bar);
            __builtin_amdgcn_fence(__ATOMIC_ACQUIRE, "agent");
            asm volatile("s_waitcnt vmcnt(0)" ::: "memory");
        }
    }
    __syncthreads();
}

namespace gm {
constexpr int BM = 256, BK = 64, HALF = 128, HTB = HALF * BK * 2, STAGE_BYTES = 8 * HTB, NXCD = 8, WGM = 8;
__host__ __device__ __forceinline__ int lds_byte(int r, int c) { const int st = (r >> 4) * 2 + (c >> 5), rr = r & 15, cc = c & 31, ob = rr * 64 + cc * 2; return st * 1024 + (ob ^ (((ob >> 9) & 1) << 5)); }
__host__ __device__ __forceinline__ void stage_rc(int b, int& R, int& C) { const int st = b / 1024, sb = b % 1024, swz = sb ^ (((sb >> 9) & 1) << 5); R = (st >> 1) * 16 + swz / 64; C = (st & 1) * 32 + (swz % 64) / 2; }
__host__ __device__ __forceinline__ int perm32(int rho) { const int n = rho >> 4, i = rho & 15; return 8 * (i >> 2) + 4 * n + (i & 3); }

struct Unit { const char* a; const char* b; int pm, pn, kind, ti; };

__device__ __forceinline__ void tile_of(int L, int nM, int nN, int& pm, int& pn) {
    const int nwg = nM * nN; int wgid = L;
    { const int q = nwg / NXCD, r = nwg % NXCD, xcd = wgid % NXCD, off = wgid / NXCD; wgid = (xcd < r ? xcd * (q + 1) : r * (q + 1) + (xcd - r) * q) + off; }
    const int nig = WGM * nN, gid = wgid / nig, fm = gid * WGM, gsz = (nM - fm) < WGM ? (nM - fm) : WGM;
    pm = fm + ((wgid % nig) % gsz); pn = (wgid % nig) / gsz;
}

template <class Epi, class Sched, bool GATHER, bool BTILED = false, bool F8 = false>
__device__ __forceinline__ void gemm_phase(const int tid, LAS unsigned char* lds, const LAS int* tab, const int K, const Sched& S, const Epi& E) {
    const int wid = __builtin_amdgcn_readfirstlane(tid >> 6), lane = tid & 63, wr = wid >> 2, wc = wid & 3, fr = lane & 15, fq = lane >> 4;
    const int nt = K / BK;
    unsigned voffA0[2], voffA1[2], voffB[2];
    const size_t kstep = (size_t)(BK * 2);
    const size_t hstep = (size_t)HALF * K * 2;
    const size_t kstepB = BTILED ? (size_t)(BM * BK * 2) : kstep, hstepB = BTILED ? (size_t)(HALF * BK * 2) : hstep;
#pragma unroll
    for (int i = 0; i < 2; ++i) { int R, C; stage_rc(tid * 16 + i * 8192, R, C); const int Rb = (R & ~31) + perm32(R & 31);
        voffB[i] = BTILED ? (unsigned)(Rb * BK + C) * 2u : (unsigned)(Rb * K + C) * 2u; voffA0[i] = (unsigned)(R * K + C) * 2u; voffA1[i] = 0u; }
#define GM_SETVOFF(u) do { if constexpr (GATHER) { _Pragma("unroll") for (int _i = 0; _i < 2; ++_i) { int R_, C_; stage_rc(tid * 16 + _i * 8192, R_, C_); \
        const int r0_ = tab[(u).ti * 256 + R_], r1_ = tab[(u).ti * 256 + 128 + R_]; voffA0[_i] = (unsigned)(r0_ * K + C_) * 2u; voffA1[_i] = (unsigned)(r1_ * K + C_) * 2u; } } } while (0)
    const unsigned ldsw = (unsigned)wid * 1024u;
    const int aoff = F8 ? lds_byte(wr * 64 + fr, fq * 16) : lds_byte(wr * 64 + fr, fq * 8), boff = F8 ? lds_byte(wc * 32 + fr, fq * 16) : lds_byte(wc * 32 + fr, fq * 8);
#define PG8_SA(b, h) (((b) * 2 + (h)) * HTB)
#define PG8_SB(b, h) ((4 + (b) * 2 + (h)) * HTB)
#define PG8_STAGE(bufoff, gbase, voff) do { _Pragma("unroll") for (int _i = 0; _i < 2; ++_i) \
        __builtin_amdgcn_global_load_lds((const unsigned*)((const char*)(gbase) + (voff)[_i]), (LAS unsigned*)(lds + (bufoff) + ldsw + _i * 8192), 16, 0, 0); } while (0)
#define PG8_LDA8(dst, b, h) do { _Pragma("unroll") for (int m = 0; m < 4; ++m) { const bf16x8 lo_ = *(const LAS bf16x8*)(lds + PG8_SA(b, h) + aoff + m * 2048), hi_ = *(const LAS bf16x8*)(lds + PG8_SA(b, h) + aoff + m * 2048 + 16); \
        dst[m] = __builtin_shufflevector(__builtin_bit_cast(i32x4, lo_), __builtin_bit_cast(i32x4, hi_), 0, 1, 2, 3, 4, 5, 6, 7); } } while (0)
#define PG8_LDB8(dst, b, h) do { _Pragma("unroll") for (int n = 0; n < 2; ++n) { const bf16x8 lo_ = *(const LAS bf16x8*)(lds + PG8_SB(b, h) + boff + n * 2048), hi_ = *(const LAS bf16x8*)(lds + PG8_SB(b, h) + boff + n * 2048 + 16); \
        dst[n] = __builtin_shufflevector(__builtin_bit_cast(i32x4, lo_), __builtin_bit_cast(i32x4, hi_), 0, 1, 2, 3, 4, 5, 6, 7); } } while (0)
#define PG8_MMA8(ai, bj, At, Bt) do { __builtin_amdgcn_s_setprio(1); _Pragma("unroll") for (int m = 0; m < 4; ++m) _Pragma("unroll") for (int n = 0; n < 2; ++n) \
        acc[ai][bj][m][n] = __builtin_amdgcn_mfma_scale_f32_16x16x128_f8f6f4(Bt[n], At[m], acc[ai][bj][m][n], 0, 0, 0, 0, 0, 0); __builtin_amdgcn_s_setprio(0); } while (0)
#define PG8_LDA(dst, b, h) do { _Pragma("unroll") for (int m = 0; m < 4; ++m) _Pragma("unroll") for (int k = 0; k < 2; ++k) dst[m][k] = *(const LAS bf16x8*)(lds + PG8_SA(b, h) + aoff + m * 2048 + k * 1024); } while (0)
#define PG8_LDB(dst, b, h) do { _Pragma("unroll") for (int n = 0; n < 2; ++n) _Pragma("unroll") for (int k = 0; k < 2; ++k) dst[n][k] = *(const LAS bf16x8*)(lds + PG8_SB(b, h) + boff + n * 2048 + k * 1024); } while (0)
#define PG8_MMA(ai, bj, At, Bt) do { __builtin_amdgcn_s_setprio(1); _Pragma("unroll") for (int m = 0; m < 4; ++m) _Pragma("unroll") for (int n = 0; n < 2; ++n) _Pragma("unroll") for (int k = 0; k < 2; ++k) \
        acc[ai][bj][m][n] = __builtin_amdgcn_mfma_f32_16x16x32_bf16(Bt[n][k], At[m][k], acc[ai][bj][m][n], 0, 0, 0); __builtin_amdgcn_s_setprio(0); } while (0)
#define GM_STAGE_A1(bufoff, gbase) do { if constexpr (GATHER) { PG8_STAGE(bufoff, gbase, voffA1); } else { PG8_STAGE(bufoff, (gbase) + hstep, voffA0); } } while (0)
#define PG8_WAIT_V(n) asm volatile("s_waitcnt vmcnt(" #n ")" ::: "memory")
#define PG8_WAIT_L(n) asm volatile("s_waitcnt lgkmcnt(" #n ")" ::: "memory")
#define PG8_BAR __builtin_amdgcn_s_barrier()
#define PG8_SCHED __builtin_amdgcn_sched_barrier(0)
    Unit cur, nxt; int ui = 0;
    if (!S.next(0, cur)) return;
    GM_SETVOFF(cur);
    f32x4 acc[2][2][4][2];
#pragma unroll
    for (int a = 0; a < 2; ++a)
#pragma unroll
        for (int b = 0; b < 2; ++b)
#pragma unroll
            for (int m = 0; m < 4; ++m)
#pragma unroll
                for (int n = 0; n < 2; ++n) acc[a][b][m][n] = (f32x4){0.f, 0.f, 0.f, 0.f};
    bf16x8 At[4][2], B0[2][2], B1[2][2]; i32x8 At8[4], B08[2], B18[2];
    const char* cA = cur.a; const char* cB = cur.b;
    PG8_STAGE(PG8_SB(0, 0), cB, voffB); PG8_STAGE(PG8_SB(0, 1), cB + hstepB, voffB); PG8_STAGE(PG8_SA(0, 0), cA, voffA0); GM_STAGE_A1(PG8_SA(0, 1), cA);
    if (wr == 1) PG8_BAR;
    PG8_WAIT_V(2); PG8_BAR;
    PG8_STAGE(PG8_SB(1, 0), cB + kstepB, voffB); PG8_STAGE(PG8_SA(1, 0), cA + kstep, voffA0); PG8_STAGE(PG8_SB(1, 1), cB + hstepB + kstepB, voffB);
    PG8_WAIT_V(6); PG8_BAR;
    for (;;) {
        const bool has_next = S.next(ui + 1, nxt);
        const char* nA = has_next ? nxt.a : cA; const char* nB = has_next ? nxt.b : cB;
#pragma unroll 1
        for (int t = 0; t < nt; t += 2) {
            const bool last = (t == nt - 2);
            const char* a1 = cA + (size_t)(t + 1) * kstep;
            const char* a2 = last ? nA : cA + (size_t)(t + 2) * kstep; const char* b2 = last ? nB : cB + (size_t)(t + 2) * kstepB;
            const char* a3 = a2 + kstep; const char* b3 = b2 + kstepB;
            if constexpr (F8) {
            PG8_LDB8(B08, 0, 0); PG8_LDB8(B18, 0, 1); PG8_SCHED; PG8_LDA8(At8, 0, 0); GM_STAGE_A1(PG8_SA(1, 1), a1);
            PG8_WAIT_V(8); PG8_WAIT_L(0); PG8_BAR; PG8_MMA8(0, 0, At8, B08); PG8_MMA8(0, 1, At8, B18); PG8_BAR; PG8_SCHED;
            if constexpr (GATHER) { if (last && has_next) { GM_SETVOFF(nxt); } }
            PG8_LDA8(At8, 0, 1); PG8_STAGE(PG8_SB(0, 0), b2, voffB); PG8_STAGE(PG8_SB(0, 1), b2 + hstepB, voffB); PG8_STAGE(PG8_SA(0, 0), a2, voffA0);
            PG8_WAIT_V(8); PG8_WAIT_L(0); PG8_BAR; PG8_MMA8(1, 0, At8, B08); PG8_MMA8(1, 1, At8, B18); PG8_BAR; PG8_SCHED;
            PG8_LDB8(B08, 1, 0); PG8_LDB8(B18, 1, 1); PG8_SCHED; PG8_LDA8(At8, 1, 0); GM_STAGE_A1(PG8_SA(0, 1), a2);
            PG8_WAIT_V(8); PG8_WAIT_L(0); PG8_BAR; PG8_MMA8(0, 0, At8, B08); PG8_MMA8(0, 1, At8, B18); PG8_BAR; PG8_SCHED;
            PG8_LDA8(At8, 1, 1); PG8_STAGE(PG8_SB(1, 0), b3, voffB); PG8_STAGE(PG8_SB(1, 1), b3 + hstepB, voffB); PG8_STAGE(PG8_SA(1, 0), a3, voffA0);
            PG8_WAIT_V(8); PG8_WAIT_L(0); PG8_BAR; PG8_MMA8(1, 0, At8, B08); PG8_MMA8(1, 1, At8, B18); PG8_BAR; PG8_SCHED;
            } else {
            PG8_LDB(B0, 0, 0); PG8_LDB(B1, 0, 1); PG8_SCHED; PG8_LDA(At, 0, 0); GM_STAGE_A1(PG8_SA(1, 1), a1);
            PG8_WAIT_V(8); PG8_WAIT_L(0); PG8_BAR; PG8_MMA(0, 0, At, B0); PG8_MMA(0, 1, At, B1); PG8_BAR; PG8_SCHED;
            if constexpr (GATHER) { if (last && has_next) { GM_SETVOFF(nxt); } }
            PG8_LDA(At, 0, 1); PG8_STAGE(PG8_SB(0, 0), b2, voffB); PG8_STAGE(PG8_SB(0, 1), b2 + hstepB, voffB); PG8_STAGE(PG8_SA(0, 0), a2, voffA0);
            PG8_WAIT_V(8); PG8_WAIT_L(0); PG8_BAR; PG8_MMA(1, 0, At, B0); PG8_MMA(1, 1, At, B1); PG8_BAR; PG8_SCHED;
            PG8_LDB(B0, 1, 0); PG8_LDB(B1, 1, 1); PG8_SCHED; PG8_LDA(At, 1, 0); GM_STAGE_A1(PG8_SA(0, 1), a2);
            PG8_WAIT_V(8); PG8_WAIT_L(0); PG8_BAR; PG8_MMA(0, 0, At, B0); PG8_MMA(0, 1, At, B1); PG8_BAR; PG8_SCHED;
            PG8_LDA(At, 1, 1); PG8_STAGE(PG8_SB(1, 0), b3, voffB); PG8_STAGE(PG8_SB(1, 1), b3 + hstepB, voffB); PG8_STAGE(PG8_SA(1, 0), a3, voffA0);
            PG8_WAIT_V(8); PG8_WAIT_L(0); PG8_BAR; PG8_MMA(1, 0, At, B0); PG8_MMA(1, 1, At, B1); PG8_BAR; PG8_SCHED;
            }
        }
        if (wr == 0) PG8_BAR;
        { int fr_ = fr, fq_ = fq; asm volatile("" : "+v"(fr_), "+v"(fq_));
          E(acc, cur, wr, wc, fr_, fq_); }
        if (!has_next) break;
#pragma unroll
        for (int a = 0; a < 2; ++a)
#pragma unroll
            for (int b = 0; b < 2; ++b)
#pragma unroll
                for (int m = 0; m < 4; ++m)
#pragma unroll
                    for (int n = 0; n < 2; ++n) acc[a][b][m][n] = (f32x4){0.f, 0.f, 0.f, 0.f};
        cur = nxt; cA = nA; cB = nB; ++ui;
        if (wr == 1) PG8_BAR;
    }
    PG8_WAIT_V(0);
    PG8_BAR;
#undef GM_SETVOFF
#undef GM_STAGE_A1
#undef PG8_SA
#undef PG8_SB
#undef PG8_STAGE
#undef PG8_LDA
#undef PG8_LDA8
#undef PG8_LDB8
#undef PG8_MMA8
#undef PG8_LDB
#undef PG8_MMA
#undef PG8_WAIT_V
#undef PG8_WAIT_L
#undef PG8_BAR
#undef PG8_SCHED
}
}
namespace at {
using f32x16 = __attribute__((ext_vector_type(16))) float;
using s16x4 = __attribute__((ext_vector_type(4))) short;
constexpr int D = 128, NW = 8, QBLK = 32, KVBLK = 64;
constexpr float SCALE = 0.088388347648318440f;
constexpr float THR = 8.f;
constexpr int SHM_V = KVBLK * D * 2, SHM_K = KVBLK * D * 2, SHM_ATTN = 2 * SHM_V + 2 * SHM_K + NW * 64 * 4;
constexpr int KM_OFF = SHM_ATTN;
constexpr int QL_OFF = KM_OFF + 4096;
#define KSWZ(row, colB) ((row) * 256 + ((colB) ^ (((row) & 7) << 4)))
#define SBAR() __builtin_amdgcn_sched_barrier(0)
__device__ __forceinline__ int crow(int r, int hi) { return (r & 3) + 8 * (r >> 2) + 4 * hi; }

__device__ __forceinline__ void partialSM(f32x16& p0, f32x16& p1, float& m_reg, float& mn, float& alpha, bool dead) {
  constexpr float C = SCALE * 1.4426950408889634f;
  float pmax = p0[0];
#pragma unroll
  for (int r = 1; r < 16; ++r) pmax = fmaxf(pmax, p0[r]);
#pragma unroll
  for (int r = 0; r < 16; ++r) pmax = fmaxf(pmax, p1[r]);
  { auto rr = __builtin_amdgcn_permlane32_swap(__float_as_uint(pmax), __float_as_uint(pmax), false, false);
    pmax = fmaxf(__uint_as_float(rr[0]), __uint_as_float(rr[1])); }
  if (dead) pmax = -1e30f;
  if (__builtin_expect(__all(pmax - m_reg <= THR / SCALE), 1)) { mn = m_reg; alpha = 1.f; }
  else { mn = fmaxf(m_reg, pmax); alpha = __builtin_amdgcn_exp2f((m_reg - mn) * C); m_reg = mn; }
  const float mnC = dead ? -INFINITY : -mn * C;
#pragma unroll
  for (int r = 0; r < 16; ++r) p0[r] = fmaf(p0[r], C, mnC);
#pragma unroll
  for (int r = 0; r < 16; ++r) p1[r] = fmaf(p1[r], C, mnC);
#pragma unroll
  for (int r = 0; r < 16; ++r) p0[r] = __builtin_amdgcn_exp2f(p0[r]);
}
__device__ __forceinline__ void finishSM(f32x16& p0, f32x16& p1, float alpha, float& l_reg, bf16x8& pa0, bf16x8& pa1, bf16x8& pa2, bf16x8& pa3) {
#pragma unroll
  for (int r = 0; r < 16; ++r) p1[r] = __builtin_amdgcn_exp2f(p1[r]);
  float ps = 0;
#pragma unroll
  for (int r = 0; r < 16; ++r) ps += p0[r];
#pragma unroll
  for (int r = 0; r < 16; ++r) ps += p1[r];
  { auto rr = __builtin_amdgcn_permlane32_swap(__float_as_uint(ps), __float_as_uint(ps), false, false);
    ps = __uint_as_float(rr[0]) + __uint_as_float(rr[1]); }
  l_reg = l_reg * alpha + ps;
#define PK4(P, BASE, OUT) do { unsigned a0 = cvt_pk_bf16(P[BASE + 0], P[BASE + 1]), a1 = cvt_pk_bf16(P[BASE + 2], P[BASE + 3]);   \
    unsigned b0 = cvt_pk_bf16(P[BASE + 4], P[BASE + 5]), b1 = cvt_pk_bf16(P[BASE + 6], P[BASE + 7]);                              \
    auto r0 = __builtin_amdgcn_permlane32_swap(a0, b0, false, false); auto r1 = __builtin_amdgcn_permlane32_swap(a1, b1, false, false); \
    u32x4 w = {r0[0], r1[0], r0[1], r1[1]}; OUT = *reinterpret_cast<bf16x8*>(&w); } while (0)
  PK4(p0, 0, pa0); PK4(p0, 8, pa1); PK4(p1, 0, pa2); PK4(p1, 8, pa3);
#undef PK4
}
template <bool QLDS>
__device__ __forceinline__ void qkt(f32x16& p0, f32x16& p1, const LAS char* Ks, const bf16x8* qr, const LAS char* ql, int r32, int hi) {
  p0 = f32x16{}; p1 = f32x16{};
#pragma unroll
  for (int d0 = 0; d0 < 8; ++d0) { int cb = (d0 * 16 + hi * 8) * 2;
    bf16x8 b0 = *(const LAS bf16x8*)(Ks + KSWZ(r32, cb));
    bf16x8 b1 = *(const LAS bf16x8*)(Ks + KSWZ(32 + r32, cb));
    bf16x8 q; if constexpr (QLDS) q = *(const LAS bf16x8*)(ql + d0 * 8192); else q = qr[d0];
    p0 = __builtin_amdgcn_mfma_f32_32x32x16_bf16(b0, q, p0, 0, 0, 0);
    p1 = __builtin_amdgcn_mfma_f32_32x32x16_bf16(b1, q, p1, 0, 0, 0); }
}
__device__ __forceinline__ int v_st(int k, int c) { const int kk = (k & ~0xC) | ((k & 4) << 1) | ((k & 8) >> 1); return ((kk >> 3) * 4 + (c >> 5)) * 512 + ((kk & 7) * 32 + (c & 31)) * 2; }
__device__ __forceinline__ int v_rd_base(int lane) { return ((lane & 3) << 3) | (((lane >> 2) & 3) << 6) | (((lane >> 4) & 1) << 5) | (((lane >> 5) & 1) << 8); }
constexpr int v_rd_off(int d0, int ks, int half) { return d0 * 512 + ks * 4096 + half * 2048; }
template <int OFF> __device__ __forceinline__ s16x4 tr_read(int vb) {
  s16x4 r; asm volatile("ds_read_b64_tr_b16 %0, %1 offset:%2" : "=&v"(r) : "v"(vb), "i"(OFF) : "memory"); return r;
}
template <int D0> __device__ __forceinline__ void pv_one(f32x16& od, int vb, bf16x8 pa0, bf16x8 pa1, bf16x8 pa2, bf16x8 pa3) {
  const s16x4 l0 = tr_read<v_rd_off(D0, 0, 0)>(vb), h0 = tr_read<v_rd_off(D0, 0, 1)>(vb), l1 = tr_read<v_rd_off(D0, 1, 0)>(vb), h1 = tr_read<v_rd_off(D0, 1, 1)>(vb);
  const s16x4 l2 = tr_read<v_rd_off(D0, 2, 0)>(vb), h2 = tr_read<v_rd_off(D0, 2, 1)>(vb), l3 = tr_read<v_rd_off(D0, 3, 0)>(vb), h3 = tr_read<v_rd_off(D0, 3, 1)>(vb);
  asm volatile("s_waitcnt lgkmcnt(0)" ::: "memory"); SBAR();
#define PK(L, H) (bf16x8){L[0], L[1], L[2], L[3], H[0], H[1], H[2], H[3]}
  od = __builtin_amdgcn_mfma_f32_32x32x16_bf16(pa0, PK(l0, h0), od, 0, 0, 0);
  od = __builtin_amdgcn_mfma_f32_32x32x16_bf16(pa1, PK(l1, h1), od, 0, 0, 0);
  od = __builtin_amdgcn_mfma_f32_32x32x16_bf16(pa2, PK(l2, h2), od, 0, 0, 0);
  od = __builtin_amdgcn_mfma_f32_32x32x16_bf16(pa3, PK(l3, h3), od, 0, 0, 0);
#undef PK
}
__device__ __forceinline__ void pv_d0(f32x16* o, int vb, bf16x8 pa0, bf16x8 pa1, bf16x8 pa2, bf16x8 pa3) {
  pv_one<0>(o[0], vb, pa0, pa1, pa2, pa3); pv_one<1>(o[1], vb, pa0, pa1, pa2, pa3); pv_one<2>(o[2], vb, pa0, pa1, pa2, pa3); pv_one<3>(o[3], vb, pa0, pa1, pa2, pa3);
}

template <bool MOBA>
__device__ __forceinline__ void attn_unit(const int tid, const bf16_t* __restrict__ Qb, const bf16_t* __restrict__ Kh, bf16_t* __restrict__ Ob, int NT, int jb, const float* __restrict__ kmean_bh, LAS char* lds) {
  constexpr int ldq = MOBA ? LDP : CW, ldk = MOBA ? LDP : 2 * CW, ldo = MOBA ? MIXW : CW, VOFF = MOBA ? (C_V - C_K) : CW;
  const bf16_t* __restrict__ Vh = Kh + VOFF;
  const int wid = __builtin_amdgcn_readfirstlane(tid >> 6), lane = tid & 63, r32 = lane & 31, hi = lane >> 5;
  LAS char* V_lds = lds; LAS char* K_lds = lds + 2 * SHM_V;
  LAS float* wsf = (LAS float*)(lds + 2 * SHM_V + 2 * SHM_K) + wid * 64; LAS float* li_l = wsf; LAS float* al_l = wsf + 32;
  float m_reg = -1e30f, l_reg = 0; f32x16 o[4] = {}; bf16x8 qr[8];
  const bf16_t* Qw = Qb + (long)(wid * QBLK + r32) * ldq + hi * 8;
#pragma unroll
  for (int d0 = 0; d0 < 8; ++d0) qr[d0] = *reinterpret_cast<const bf16x8*>(Qw + d0 * 16);
  unsigned selmask = 0;
  if constexpr (MOBA) {
    LAS float* kml = (LAS float*)(lds + KM_OFF);
    __syncthreads();
    for (int i = tid; i < 8 * 128; i += NW * 64) kml[i] = kmean_bh[(i >> 7) * 1024 + (i & 127)];
    __syncthreads();
    float gate[8];
#pragma unroll
    for (int kb = 0; kb < 8; ++kb) {
      float g = 0.f;
      if (kb < jb) {
#pragma unroll
        for (int d0 = 0; d0 < 8; ++d0) { const f32x4 k0 = *(const LAS f32x4*)(kml + kb * 128 + d0 * 16 + hi * 8), k1 = *(const LAS f32x4*)(kml + kb * 128 + d0 * 16 + hi * 8 + 4);
          const u32x4 qw = *reinterpret_cast<const u32x4*>(&qr[d0]);
          g += bflo(qw.x) * k0[0] + bfhi(qw.x) * k0[1] + bflo(qw.y) * k0[2] + bfhi(qw.y) * k0[3] + bflo(qw.z) * k1[0] + bfhi(qw.z) * k1[1] + bflo(qw.w) * k1[2] + bfhi(qw.w) * k1[3]; }
        g += __shfl_xor(g, 32);
      }
      gate[kb] = g;
    }
#pragma unroll
    for (int r = 0; r < 3; ++r) { float best = -INFINITY; int bi = -1;
#pragma unroll
      for (int kb = 0; kb < 8; ++kb) { const bool ok = (kb < jb) && !((selmask >> kb) & 1u) && (gate[kb] > best || bi < 0); if (ok) { best = gate[kb]; bi = kb; } }
      if (bi >= 0) selmask |= 1u << bi; }
  }
  const LAS char* ql = lds + QL_OFF + tid * 16;
  if constexpr (MOBA) {
#pragma unroll
    for (int d0 = 0; d0 < 8; ++d0) *(LAS bf16x8*)(lds + QL_OFF + tid * 16 + d0 * 8192) = qr[d0];
  }
  const int rowb = wid * QBLK + r32;
#define MASK(P0, P1, T, DEAD) do { DEAD = false; if constexpr (MOBA) { const int kb_ = (T) >> 2; \
    if (kb_ < jb) { DEAD = !((selmask >> kb_) & 1u); } \
    else { const int lim_ = rowb - 64 * ((T) - 4 * jb); \
      if (!__all(lim_ >= 63)) { const int lh_ = lim_ - 4 * hi;     \
        _Pragma("unroll") for (int r_ = 0; r_ < 16; ++r_) { if ((r_ & 3) + 8 * (r_ >> 2) > lh_) P0[r_] = -INFINITY; if (32 + (r_ & 3) + 8 * (r_ >> 2) > lh_) P1[r_] = -INFINITY; } } } } } while (0)
  const int sr = tid >> 4, sc = (tid & 15) * 8, vst0 = v_st(sr, sc), vst1 = v_st(32 + sr, sc);
  const int vb0 = (int)(size_t)V_lds + v_rd_base(lane);
  constexpr int SDEPTH = MOBA ? 1 : 2;
  struct { bf16x8 vs0, vs1, ks0, ks1; } sr_[SDEPTH];
#define SLOAD(i, k0) do { sr_[i].vs0 = *reinterpret_cast<const bf16x8*>(&Vh[(long)((k0) + sr) * ldk + sc]); sr_[i].vs1 = *reinterpret_cast<const bf16x8*>(&Vh[(long)((k0) + 32 + sr) * ldk + sc]); \
    sr_[i].ks0 = *reinterpret_cast<const bf16x8*>(&Kh[(long)((k0) + sr) * ldk + sc]); sr_[i].ks1 = *reinterpret_cast<const bf16x8*>(&Kh[(long)((k0) + 32 + sr) * ldk + sc]); } while (0)
#define SWRITE(b, i) do { *(LAS bf16x8*)(V_lds + (b) * SHM_V + vst0) = sr_[i].vs0;          \
    *(LAS bf16x8*)(V_lds + (b) * SHM_V + vst1) = sr_[i].vs1; int kc = sc * 2;               \
    *(LAS bf16x8*)(K_lds + (b) * SHM_K + KSWZ(sr, kc)) = sr_[i].ks0;                       \
    *(LAS bf16x8*)(K_lds + (b) * SHM_K + KSWZ(32 + sr, kc)) = sr_[i].ks1; } while (0)
#define SWAIT() do { if constexpr (SDEPTH == 2) asm volatile("s_waitcnt vmcnt(4)" ::: "memory"); else asm volatile("s_waitcnt vmcnt(0)" ::: "memory"); } while (0)
#define RESC(a) do { if (__any((a) < 1.f)) { if (hi == 0) al_l[r32] = (a); asm volatile("s_waitcnt lgkmcnt(0)" ::: "memory"); \
    _Pragma("unroll") for (int d = 0; d < 4; ++d) _Pragma("unroll") for (int r = 0; r < 16; ++r) o[d][r] *= al_l[crow(r, hi)]; } } while (0)
  f32x16 pA0, pA1, pB0, pB1; float mnA, mnB, alA, alB; bf16x8 pa0, pa1, pa2, pa3; bool deadA, deadB;
  constexpr int SE = 0, SO = SDEPTH - 1;
  if constexpr (!MOBA) __syncthreads();
  SLOAD(SE, 0); asm volatile("s_waitcnt vmcnt(0)" ::: "memory"); SWRITE(0, SE); __syncthreads();
  qkt<MOBA>(pA0, pA1, K_lds, qr, ql, r32, hi); MASK(pA0, pA1, 0, deadA); partialSM(pA0, pA1, m_reg, mnA, alA, deadA);
  SLOAD(SO, KVBLK); if constexpr (SDEPTH == 2) { if (2 < NT) SLOAD(SE, 2 * KVBLK); }
  SWAIT(); SWRITE(1, SO); __syncthreads();
  for (int j = 1; j + 1 < NT; j += 2) {
    SBAR(); qkt<MOBA>(pB0, pB1, K_lds + SHM_K, qr, ql, r32, hi);
    finishSM(pA0, pA1, alA, l_reg, pa0, pa1, pa2, pa3); SBAR();
    SLOAD(SO, (j + SDEPTH) * KVBLK); SBAR();
    pv_d0(o, vb0, pa0, pa1, pa2, pa3); MASK(pB0, pB1, j, deadB); partialSM(pB0, pB1, m_reg, mnB, alB, deadB);
    __syncthreads(); SWAIT(); SWRITE(0, SE);
    RESC(alB); __syncthreads();
    SBAR(); qkt<MOBA>(pA0, pA1, K_lds, qr, ql, r32, hi);
    finishSM(pB0, pB1, alB, l_reg, pa0, pa1, pa2, pa3); SBAR();
    if (SDEPTH == 1 || j + 3 < NT) SLOAD(SE, (j + 1 + SDEPTH) * KVBLK); SBAR();
    pv_d0(o, vb0 + SHM_V, pa0, pa1, pa2, pa3); MASK(pA0, pA1, j + 1, deadA); partialSM(pA0, pA1, m_reg, mnA, alA, deadA);
    __syncthreads(); SWAIT(); SWRITE(1, SO);
    RESC(alA); __syncthreads();
  }
  SBAR(); qkt<MOBA>(pB0, pB1, K_lds + SHM_K, qr, ql, r32, hi);
  finishSM(pA0, pA1, alA, l_reg, pa0, pa1, pa2, pa3); SBAR();
  pv_d0(o, vb0, pa0, pa1, pa2, pa3); MASK(pB0, pB1, NT - 1, deadB); partialSM(pB0, pB1, m_reg, mnB, alB, deadB);
  __syncthreads(); RESC(alB);
  finishSM(pB0, pB1, alB, l_reg, pa0, pa1, pa2, pa3); SBAR();
  pv_d0(o, vb0 + SHM_V, pa0, pa1, pa2, pa3);
  if (hi == 0) li_l[r32] = l_reg; asm volatile("s_waitcnt lgkmcnt(0)" ::: "memory");
  float rli[16];
#pragma unroll
  for (int r = 0; r < 16; ++r) rli[r] = __builtin_amdgcn_rcpf(li_l[crow(r, hi)]);
  if constexpr (MOBA) {
#pragma unroll
    for (int r = 0; r < 16; ++r) {
      float q = 0.f;
#pragma unroll
      for (int d0 = 0; d0 < 4; ++d0) { const float v = o[d0][r] * rli[r]; q += v * v; }
      q += __shfl_xor(q, 1); q += __shfl_xor(q, 2); q += __shfl_xor(q, 4); q += __shfl_xor(q, 8); q += __shfl_xor(q, 16);
      rli[r] *= rsqrtf(q * (1.f / 128.f) + EPS);
    }
  }
  bf16_t* Ow = Ob + (long)(wid * QBLK) * ldo;
#pragma unroll
  for (int r = 0; r < 16; ++r) { const int orow = crow(r, hi);
#pragma unroll
    for (int d0 = 0; d0 < 4; ++d0) Ow[(long)orow * ldo + d0 * 32 + r32] = (bf16_t)(cvt_pk_bf16(o[d0][r] * rli[r], 0.f) & 0xffffu); }
#undef MASK
#undef SLOAD
#undef SWRITE
#undef SWAIT
#undef RESC
}
#undef KSWZ
#undef SBAR
}
namespace sd {
using f32x16 = __attribute__((ext_vector_type(16))) float;
typedef short v4i16_t __attribute__((ext_vector_type(4)));
constexpr int IMG_C = 0, IMG_B = 32768, IMG_X = 65536, IMG_S = 98304, TBL = 114688;
__device__ __forceinline__ unsigned off_b(unsigned row, unsigned ch) { return 256u * row + 16u * (ch ^ (((row & 3) << 2) | ((row >> 2) & 3))); }
__device__ __forceinline__ unsigned row_read_addr(unsigned lane, unsigned s) { return off_b(lane & 31, 2 * s + (lane >> 5)); }
__device__ __forceinline__ unsigned tr_read_addr(unsigned lane, unsigned c, unsigned ks, unsigned t) {
  const unsigned h = lane >> 5, blk = (lane >> 4) & 1, q = (lane & 15) >> 2, p = lane & 3;
  return off_b(16 * ks + 8 * h + 4 * t + q, 4 * c + 2 * blk + (p >> 1)) + 8 * (p & 1);
}
__device__ __forceinline__ unsigned elem_addr(unsigned row, unsigned col) { return (row >> 5) * 8192u + off_b(row & 31, col >> 3) + (col & 7) * 2u; }
__device__ __forceinline__ bf16x8 tr_frag(const LAS char* img, unsigned a0, unsigned a1) {
  const v4i16_t l = __builtin_amdgcn_ds_read_tr16_b64_v4i16((LAS v4i16_t*)(img + a0)), h = __builtin_amdgcn_ds_read_tr16_b64_v4i16((LAS v4i16_t*)(img + a1));
  return (bf16x8){l[0], l[1], l[2], l[3], h[0], h[1], h[2], h[3]};
}
__device__ __forceinline__ int crow(int r, int hi) { return (r & 3) + 8 * (r >> 2) + 4 * hi; }
__device__ __forceinline__ float softplus_f(float r) { return fmaxf(r, 0.f) + log1pf(__expf(-fabsf(r))); }

__device__ __forceinline__ void conv_prepass(const int gtid, const int nthr, const bf16_t* __restrict__ proj, const float* __restrict__ conv_w, const float* __restrict__ conv_b, bf16_t* __restrict__ xbcc) {
  constexpr int NITEM = (CONVD / 8) * (M / 16);
#pragma unroll 1
  for (int it = gtid; it < NITEM; it += nthr) {
    const int cgp = it % (CONVD / 8), run = it / (CONVD / 8), tok0 = run * 16, T0 = tok0 & (SEQ - 1), ch = 8 * cgp;
    const bf16_t* rawp = proj + (size_t)(tok0 - T0) * LDP + C_XBC + ch;
    u32x4 raw[19];
#pragma unroll
    for (int j = 0; j < 19; ++j) { const int T = T0 - 3 + j; raw[j] = (T >= 0) ? *(const u32x4*)(rawp + (size_t)T * LDP) : (u32x4){0u, 0u, 0u, 0u}; }
    f32x4 w[5][2];
#pragma unroll
    for (int tp = 0; tp < 4; ++tp) { w[tp][0] = *(const f32x4*)(conv_w + tp * CONVD + ch); w[tp][1] = *(const f32x4*)(conv_w + tp * CONVD + ch + 4); }
    w[4][0] = *(const f32x4*)(conv_b + ch); w[4][1] = *(const f32x4*)(conv_b + ch + 4);
    float ac[4][8];
#pragma unroll
    for (int j = 0; j < 19; ++j) {
      const u32x4 rw = raw[j];
      const float x[8] = {bflo(rw.x), bfhi(rw.x), bflo(rw.y), bfhi(rw.y), bflo(rw.z), bfhi(rw.z), bflo(rw.w), bfhi(rw.w)};
#pragma unroll
      for (int tp = 0; tp < 4; ++tp) {
        const int i = j - tp;
        if (i >= 0 && i < 16) { const int sl = i & 3;
#pragma unroll
          for (int e = 0; e < 8; ++e) ac[sl][e] = (tp == 0 ? w[4][e >> 2][e & 3] : ac[sl][e]) + w[tp][e >> 2][e & 3] * x[e]; }
      }
      if (j >= 3) {
        const int sl = (j - 3) & 3; float o8[8];
#pragma unroll
        for (int e = 0; e < 8; ++e) o8[e] = ac[sl][e] * __builtin_amdgcn_rcpf(1.f + __expf(-ac[sl][e]));
        u32x4 o; o.x = cvt_pk_bf16(o8[0], o8[1]); o.y = cvt_pk_bf16(o8[2], o8[3]); o.z = cvt_pk_bf16(o8[4], o8[5]); o.w = cvt_pk_bf16(o8[6], o8[7]);
        *(u32x4*)(xbcc + (size_t)(tok0 + j - 3) * CONVD + ch) = o;
      }
    }
  }
}

__device__ __forceinline__ void ssd_unit(const int tid, const int b, const int h, const bf16_t* __restrict__ proj, const bf16_t* __restrict__ xbcc, const float* __restrict__ dtraw,
                                         const float* __restrict__ dt_bias, const float* __restrict__ a_log, const float* __restrict__ d_skip,
                                         bf16_t* __restrict__ mixb, LAS char* lds) {
  const int wid = __builtin_amdgcn_readfirstlane(tid >> 6), lane = tid & 63, r32 = lane & 31, hi = lane >> 5;
  const int ph = wid & 1, rb = wid < 4 ? 3 - (wid >> 1) : (wid >> 1) - 2;
  LAS char* IC = lds + IMG_C; LAS char* IB = lds + IMG_B; LAS char* IX = lds + IMG_X; LAS char* IS = lds + IMG_S;
  LAS float* Tdt = (LAS float*)(lds + TBL); LAS float* Tacs = Tdt + 2048;
  const int grp = h >> 3;
  const float a = -__expf(a_log[h]), dtb = dt_bias[h], Dh = d_skip[h];
  __syncthreads();
  { const u32x4 z = {0u, 0u, 0u, 0u}; *(LAS u32x4*)(IS + tid * 32) = z; *(LAS u32x4*)(IS + tid * 32 + 16) = z; }
#pragma unroll 1
  for (int cc = 0; cc < 2; ++cc) {
    const int t0 = (wid * 2 + cc) * 128 + 2 * lane;
    const float d0 = softplus_f(dtraw[(size_t)(b * SEQ + t0) * 32 + h] + dtb), d1 = softplus_f(dtraw[(size_t)(b * SEQ + t0 + 1) * 32 + h] + dtb);
    const float v0 = d0 * a, ps = v0 + d1 * a;
    float sc = ps;
#pragma unroll
    for (int o = 1; o < 64; o <<= 1) { const float n = __shfl_up(sc, o); if (lane >= o) sc += n; }
    const float a0 = (sc - ps) + v0, a1 = sc, tot = __shfl(sc, 63);
    Tdt[t0] = d0; Tdt[t0 + 1] = d1; Tacs[t0] = a0; Tacs[t0 + 1] = a1;
  }
  f32x16 S = {};
  const unsigned xr = ((r32 & 3) << 2) | ((r32 >> 2) & 3);
#define RROW(k) (256u * r32 + 16u * ((2u * (k) + hi) ^ xr))
#pragma unroll 1
  for (int c = 0; c < 16; ++c) {
    int tq_ = tid; asm volatile("" : "+v"(tq_));
    const bf16_t* xsrc = xbcc + (size_t)(b * SEQ + c * 128) * CONVD;
    u32x4 rx[2], rB[4], rC[4];
#pragma unroll
    for (int i = 0; i < 2; ++i) rx[i] = *(const u32x4*)(xsrc + (size_t)((tq_ >> 3) + 64 * i) * CONVD + h * 64 + 8 * (tq_ & 7));
#pragma unroll
    for (int i = 0; i < 4; ++i) { rB[i] = *(const u32x4*)(xsrc + (size_t)((tq_ >> 4) + 32 * i) * CONVD + 2048 + grp * 128 + 8 * (tq_ & 15));
      rC[i] = *(const u32x4*)(xsrc + (size_t)((tq_ >> 4) + 32 * i) * CONVD + 2560 + grp * 128 + 8 * (tq_ & 15)); }
    __syncthreads();
    if (c > 0) {
      int lq_ = lane; asm volatile("" : "+v"(lq_)); const int r32 = lq_ & 31, hi = lq_ >> 5;
#pragma unroll
      for (int r = 0; r < 16; ++r) *(LAS bf16_t*)(IS + elem_addr(32 * ph + crow(r, hi), 32 * rb + r32)) = (bf16_t)(cvt_pk_bf16(S[r], 0.f) & 0xffffu);
    }
    {
      const float ace = Tacs[c * 128 + 127];
#pragma unroll
      for (int i = 0; i < 2; ++i) { const unsigned tk = (unsigned)(tq_ >> 3) + 64u * i, trow = tk & 31, xo = ((trow & 3) << 2) | ((trow >> 2) & 3), rowb = IMG_X + (tk >> 5) * 8192u + 256u * trow, cch = tq_ & 7;
        *(LAS u32x4*)(lds + rowb + 16u * (cch ^ xo)) = rx[i];
        const float w2 = Tdt[c * 128 + tk] * __expf(ace - Tacs[c * 128 + tk]);
        u32x4 v; v.x = cvt_pk_bf16(bflo(rx[i].x) * w2, bfhi(rx[i].x) * w2); v.y = cvt_pk_bf16(bflo(rx[i].y) * w2, bfhi(rx[i].y) * w2); v.z = cvt_pk_bf16(bflo(rx[i].z) * w2, bfhi(rx[i].z) * w2); v.w = cvt_pk_bf16(bflo(rx[i].w) * w2, bfhi(rx[i].w) * w2);
        *(LAS u32x4*)(lds + rowb + 16u * ((8u + cch) ^ xo)) = v; }
#pragma unroll
      for (int i = 0; i < 4; ++i) { const unsigned tk = (unsigned)(tq_ >> 4) + 32u * i, trow = tk & 31, xo = ((trow & 3) << 2) | ((trow >> 2) & 3), ro = (tk >> 5) * 8192u + 256u * trow + 16u * ((unsigned)(tq_ & 15) ^ xo);
        *(LAS u32x4*)(lds + IMG_B + ro) = rB[i]; *(LAS u32x4*)(lds + IMG_C + ro) = rC[i]; }
    }
    __syncthreads();
    int lq_ = lane; asm volatile("" : "+v"(lq_));
    const int lane = lq_, r32 = lane & 31, hi = lane >> 5; const unsigned xr = ((r32 & 3) << 2) | ((r32 >> 2) & 3);
    const LAS float* acs = Tacs + c * 128; const LAS float* dts = Tdt + c * 128;
    f32x16 Y = {};
    const float acl = acs[32 * rb + r32];
#pragma unroll 1
    for (int st = 0; st <= rb; ++st) {
      f32x16 Dm = {};
#pragma unroll
      for (int k = 0; k < 8; ++k) { const bf16x8 af = *(const LAS bf16x8*)(IB + st * 8192 + RROW(k)), bq = *(const LAS bf16x8*)(IC + rb * 8192 + RROW(k));
        Dm = __builtin_amdgcn_mfma_f32_32x32x16_bf16(af, bq, Dm, 0, 0, 0); }
#pragma unroll
      for (int q4 = 0; q4 < 4; ++q4) { const f32x4 as4 = *(const LAS f32x4*)(acs + 32 * st + 8 * q4 + 4 * hi), dt4 = *(const LAS f32x4*)(dts + 32 * st + 8 * q4 + 4 * hi);
#pragma unroll
        for (int e = 0; e < 4; ++e) { const int r = 4 * q4 + e; const bool dead = (st == rb) && (8 * q4 + 4 * hi + e > r32);
          const float f = dead ? 0.f : __expf(acl - as4[e]) * dt4[e]; Dm[r] *= f; } }
      bf16x8 pa0, pa1;
#define PK4(P, BASE, OUT) do { unsigned a0_ = cvt_pk_bf16(P[BASE + 0], P[BASE + 1]), a1_ = cvt_pk_bf16(P[BASE + 2], P[BASE + 3]);   \
    unsigned b0_ = cvt_pk_bf16(P[BASE + 4], P[BASE + 5]), b1_ = cvt_pk_bf16(P[BASE + 6], P[BASE + 7]);                              \
    auto r0_ = __builtin_amdgcn_permlane32_swap(a0_, b0_, false, false); auto r1_ = __builtin_amdgcn_permlane32_swap(a1_, b1_, false, false); \
    u32x4 w_ = {r0_[0], r1_[0], r0_[1], r1_[1]}; OUT = *reinterpret_cast<bf16x8*>(&w_); } while (0)
      PK4(Dm, 0, pa0); PK4(Dm, 8, pa1);
#undef PK4
      Y = __builtin_amdgcn_mfma_f32_32x32x16_bf16(pa0, tr_frag(IX + st * 8192, tr_read_addr(lane, ph, 0, 0), tr_read_addr(lane, ph, 0, 1)), Y, 0, 0, 0);
      Y = __builtin_amdgcn_mfma_f32_32x32x16_bf16(pa1, tr_frag(IX + st * 8192, tr_read_addr(lane, ph, 1, 0), tr_read_addr(lane, ph, 1, 1)), Y, 0, 0, 0);
    }
    {
      f32x16 CS = {};
#pragma unroll
      for (int k = 0; k < 8; ++k) { const bf16x8 af = *(const LAS bf16x8*)(IC + rb * 8192 + RROW(k)), bq = *(const LAS bf16x8*)(IS + ph * 8192 + RROW(k));
        CS = __builtin_amdgcn_mfma_f32_32x32x16_bf16(af, bq, CS, 0, 0, 0); }
#pragma unroll
      for (int q4 = 0; q4 < 4; ++q4) { const f32x4 as4 = *(const LAS f32x4*)(acs + 32 * rb + 8 * q4 + 4 * hi);
#pragma unroll
        for (int e = 0; e < 4; ++e) Y[4 * q4 + e] += CS[4 * q4 + e] * __expf(as4[e]); }
    }
    {
      const float dec = __expf(acs[127]);
#pragma unroll
      for (int r = 0; r < 16; ++r) S[r] *= dec;
#pragma unroll
      for (int st = 0; st < 4; ++st)
#pragma unroll
        for (int ks = 0; ks < 2; ++ks) {
          const bf16x8 af = tr_frag(IX + st * 8192, tr_read_addr(lane, 2 + ph, ks, 0), tr_read_addr(lane, 2 + ph, ks, 1));
          const bf16x8 bq = tr_frag(IB + st * 8192, tr_read_addr(lane, rb, ks, 0), tr_read_addr(lane, rb, ks, 1));
          S = __builtin_amdgcn_mfma_f32_32x32x16_bf16(af, bq, S, 0, 0, 0);
        }
    }
    {
      const int p = 32 * ph + r32;
#pragma unroll
      for (int r = 0; r < 16; ++r) {
        const int l = 32 * rb + crow(r, hi); const size_t tok = (size_t)(b * SEQ + c * 128 + l);
        const float xv = bf2f(*(const LAS bf16_t*)(IX + elem_addr(l, p)));
        const float yg = Y[r] + xv * Dh;
        mixb[tok * MIXW + AW + h * 64 + p] = (bf16_t)(cvt_pk_bf16(yg, 0.f) & 0xffffu);
      }
    }
  }
#undef RROW
  __syncthreads();
}
}
constexpr int RING_OFF = 0, RING_BYTES = 131072;
constexpr int TAB_OFF = RING_BYTES;
constexpr int RSL_OFF = TAB_OFF + 8192;
constexpr int MOE_OFF = RSL_OFF + 1024;
constexpr int LDSCTL_OFF = MOE_OFF + 512;
constexpr int MISC_OFF = LDSCTL_OFF + 320;
constexpr int LDS_BYTES = 147456;
static_assert(MISC_OFF + 128 <= LDS_BYTES, "LDS map");
constexpr int NWAVES = 8;

struct Args { const float* in[27]; float* out; unsigned char* ws; float rf[16]; int ph_lo, ph_hi, li, pad; };

struct Frame {
    LAS unsigned char* lds;
    volatile LAS unsigned* MISC;
    int tid, lane, wave, vcu, G;
};

__device__ __forceinline__ void row_to_bf16_rs(const float* xrow, bf16_t* orow, float* rs_out, int lane) {
    const f32x4* xr = (const f32x4*)xrow + lane;
    f32x4 v[8]; float s = 0.f;
#pragma unroll
    for (int j = 0; j < 8; ++j) { v[j] = xr[64 * j]; s += (v[j].x * v[j].x + v[j].y * v[j].y) + (v[j].z * v[j].z + v[j].w * v[j].w); }
    s = wave_sum(s);
    if (lane == 0) *rs_out = rsqrtf(s * (1.f / DM) + EPS);
    u32x2* o8 = (u32x2*)orow + lane;
#pragma unroll
    for (int j = 0; j < 8; ++j) { u32x2 w; w.x = cvt_pk_bf16(v[j].x, v[j].y); w.y = cvt_pk_bf16(v[j].z, v[j].w); o8[64 * j] = w; }
}
struct P0Item { const float* W; const float* sc; bf16_t* dst; int ldw, k0, dK, kd, f8; };
__device__ __forceinline__ void p0_item_load(const P0Item& I, f32x4 (&v)[8], f32x4 (&sv)[2], int lane) {
#pragma unroll
    for (int j = 0; j < 8; ++j) v[j] = __builtin_nontemporal_load((const f32x4*)(I.W + (size_t)(I.k0 + 8 * j + (lane >> 3)) * I.ldw + 4 * (lane & 7)));
    if (I.sc) { sv[0] = *(const f32x4*)(I.sc + I.k0 + 8 * (lane & 7)); sv[1] = *(const f32x4*)(I.sc + I.k0 + 8 * (lane & 7) + 4); }
    else { sv[0] = (f32x4){1.f, 1.f, 1.f, 1.f}; sv[1] = sv[0]; }
}
__device__ __forceinline__ void p0_item_store(const P0Item& I, const f32x4 (&v)[8], const f32x4 (&sv)[2], LAS float* scr, int lane, bool live) {
#pragma unroll
    for (int j = 0; j < 8; ++j) *(LAS f32x4*)(scr + (8 * j + (lane >> 3)) * 36 + 4 * (lane & 7)) = v[j];
    LDS_WAIT(); asm volatile("" ::: "memory");
    const int c = lane & 7;
#pragma unroll
    for (int j = 0; j < 4; ++j) { const int n = (lane >> 3) + 8 * j; const LAS float* s = scr + (8 * c) * 36 + n;
        u32x4 o; o.x = cvt_pk_bf16(s[0 * 36] * sv[0][0], s[1 * 36] * sv[0][1]); o.y = cvt_pk_bf16(s[2 * 36] * sv[0][2], s[3 * 36] * sv[0][3]);
        o.z = cvt_pk_bf16(s[4 * 36] * sv[1][0], s[5 * 36] * sv[1][1]); o.w = cvt_pk_bf16(s[6 * 36] * sv[1][2], s[7 * 36] * sv[1][3]);
        if (I.f8) { u32x2 q; q.x = pk4_fp8(256.f * s[0 * 36] * sv[0][0], 256.f * s[1 * 36] * sv[0][1], 256.f * s[2 * 36] * sv[0][2], 256.f * s[3 * 36] * sv[0][3]);
            q.y = pk4_fp8(256.f * s[4 * 36] * sv[1][0], 256.f * s[5 * 36] * sv[1][1], 256.f * s[6 * 36] * sv[1][2], 256.f * s[7 * 36] * sv[1][3]);
            if (live) __builtin_nontemporal_store(q, (u32x2*)((unsigned char*)I.dst + (size_t)n * I.dK + I.kd + 8 * c)); }
        else if (live) __builtin_nontemporal_store(o, (u32x4*)(I.dst + (size_t)n * I.dK + I.kd + 8 * c)); }
    LDS_WAIT(); asm volatile("" ::: "memory");
}
template <class Dec> __device__ __forceinline__ void p0_items(const Dec& D, const int first, const int stride, const int nitems, LAS float* scr, const int lane) {
#pragma unroll 1
    for (int base = first; base < nitems; base += 4 * stride) {
        P0Item I0, I1, I2, I3; f32x4 v0[8], v1[8], v2[8], v3[8]; f32x4 s0[2], s1[2], s2[2], s3[2];
        const int i1 = base + stride, i2 = base + 2 * stride, i3 = base + 3 * stride;
        const bool h1 = i1 < nitems, h2 = i2 < nitems, h3 = i3 < nitems;
        D(base, I0); D(h1 ? i1 : 0, I1); D(h2 ? i2 : 0, I2); D(h3 ? i3 : 0, I3);
        p0_item_load(I0, v0, s0, lane); p0_item_load(I1, v1, s1, lane); p0_item_load(I2, v2, s2, lane); p0_item_load(I3, v3, s3, lane);
        p0_item_store(I0, v0, s0, scr, lane, true); p0_item_store(I1, v1, s1, scr, lane, h1); p0_item_store(I2, v2, s2, scr, lane, h2); p0_item_store(I3, v3, s3, scr, lane, h3);
    }
}
struct DecIn {
    const float* w_in; const float* nmw; bf16_t* dst;
    __device__ __forceinline__ bool operator()(int r, P0Item& I) const {
        if (r >= 32 * 257) return false;
        const int kb = r / 257, nb = r - kb * 257; I.W = w_in + 32 * nb; I.ldw = INW; I.k0 = 64 * kb; I.sc = nmw; I.dst = dst + (size_t)(32 * nb) * DM; I.dK = DM; I.kd = I.k0; I.f8 = 0; return true;
    }
};
struct DecRest {
    const Args* a; unsigned char* ws;
    __device__ __forceinline__ bool operator()(int r, P0Item& I) const {
        constexpr int I_OUT = 48 * 64, I_CQ = 32 * 16, I_CO = 8 * 64, I_GU = 32 * 32 * 32, I_DN = 32 * 16 * 64;
        const float* const* in = a->in;
        if (r < I_OUT) { const int kb = r / 64, nb = r % 64; I.W = in[11] + 32 * nb; I.ldw = DM; I.k0 = 64 * kb; I.sc = (kb < 16) ? in[9] : (in[10] - AW); I.dst = (bf16_t*)(ws + WS_WOUT_T) + (size_t)(32 * nb) * MIXW; I.dK = MIXW; I.kd = I.k0; I.f8 = 0; return true; } r -= I_OUT;
        if (r < 3 * I_CQ) { const int m = r / I_CQ, q = r - m * I_CQ, kb = q / 16, nb = q % 16; I.W = in[14 + m] + 32 * nb; I.ldw = CW; I.k0 = 64 * kb; I.sc = m == 0 ? in[12] : in[13];
            I.dst = (m == 0 ? (bf16_t*)(ws + WS_WCQ_T) : (bf16_t*)(ws + WS_WCKV_T) + (size_t)(m - 1) * CW * DM) + (size_t)(32 * nb) * DM; I.dK = DM; I.kd = I.k0; I.f8 = 0; return true; } r -= 3 * I_CQ;
        if (r < I_CO) { const int kb = r / 64, nb = r % 64; I.W = in[17] + 32 * nb; I.ldw = DM; I.k0 = 64 * kb; I.sc = nullptr; I.dst = (bf16_t*)(ws + WS_WCO_T) + (size_t)(32 * nb) * CW; I.dK = CW; I.kd = I.k0; I.f8 = 0; return true; } r -= I_CO;
        if (r < 2 * I_GU) { const int up = r >= I_GU; if (up) r -= I_GU; const int e = r >> 10, kb = (r >> 5) & 31, nb = r & 31, n0 = 32 * nb;
            I.W = in[up ? 24 : 23] + (size_t)e * DM * DE + n0; I.ldw = DE; I.k0 = 64 * kb; I.sc = in[18]; I.dst = (bf16_t*)(ws + WS_WGU_T + (size_t)e * 2048 * DM + ((size_t)(((n0 >> 7) * 16 + (kb >> 1)) * 256 + up * 128 + (n0 & 127))) * 128 + (kb & 1) * 64); I.dK = 128; I.kd = 0; I.f8 = 1; return true; } r -= 2 * I_GU;
        if (r < I_DN) { const int e = r >> 10, kb = (r >> 6) & 15, nb = r & 63; I.W = in[25] + (size_t)e * DE * DM + 32 * nb; I.ldw = DM; I.k0 = 64 * kb; I.sc = nullptr; I.dst = (bf16_t*)(ws + WS_WD_T + (size_t)e * 2048 * DE + ((size_t)((((32 * nb) >> 8) * 8 + (kb >> 1)) * 256 + ((32 * nb) & 255))) * 128 + (kb & 1) * 64); I.dK = 128; I.kd = 0; I.f8 = 1; return true; }
        return false;
    }
};
__device__ __forceinline__ void p0a_prologue(Frame& F, const Args& args) {
    LAS float* scr = (LAS float*)(F.lds + RING_OFF + F.wave * 16384);
    const int gw = F.vcu * NWAVES + F.wave, NGW = F.G * NWAVES, lane = F.lane;
    GAS unsigned char* wsg_ = (GAS unsigned char*)args.ws; asm volatile("" : "+s"(wsg_)); unsigned char* ws = (unsigned char*)wsg_;
    { DecIn D{args.in[3], args.in[2], (bf16_t*)(ws + WS_WIN_T)}; p0_items(D, gw, NGW, 32 * 257, scr, lane); }
    { u32x4* z = (u32x4*)((bf16_t*)(ws + WS_WIN_T) + (size_t)INW * DM); const int n16 = (LDP - INW) * DM * 2 / 16;
      for (int i = (F.vcu * NWAVES * 64) + F.tid; i < n16; i += F.G * NWAVES * 64) z[i] = (u32x4){0u, 0u, 0u, 0u}; }
    { float* km = (float*)(ws + WS_KMEAN); for (int i = (F.vcu * NWAVES * 64) + F.tid; i < BATCH * NB * 1024; i += F.G * NWAVES * 64) km[i] = 0.f; }
    { float* tab = (float*)(ws + WS_ROPE);
      for (int i = (F.vcu * NWAVES * 64) + F.tid; i < SEQ * 16; i += F.G * NWAVES * 64) { const int pos = i >> 4, f = i & 15;
        const float ang = (float)pos * args.rf[f]; double r = (double)ang * 0.15915494309189533577; r -= rint(r); const float th = (float)(r * 6.283185307179586477);
        tab[pos * 32 + f] = cosf(th); tab[pos * 32 + 16 + f] = sinf(th); } }
    for (int m = gw; m < M; m += NGW) row_to_bf16_rs(args.in[0] + (size_t)m * DM, (bf16_t*)(ws + WS_XB) + (size_t)m * DM, (float*)(ws + WS_RSX) + m, lane);
}
__device__ __forceinline__ void p0b_share(Frame& F, const Args& args) {
    LAS float* scr = (LAS float*)(F.lds + RING_OFF + F.wave * 16384);
    const int gw = F.vcu * NWAVES + F.wave, NGW = F.G * NWAVES, lane = F.lane;
    GAS unsigned char* wsg_ = (GAS unsigned char*)args.ws; asm volatile("" : "+s"(wsg_)); unsigned char* ws = (unsigned char*)wsg_;
    { DecRest D{&args, ws}; p0_items(D, gw, NGW, 48 * 64 + 3 * 32 * 16 + 8 * 64 + 2 * 32 * 32 * 32 + 32 * 16 * 64, scr, lane); }
    { bf16_t* wh = (bf16_t*)(ws + WS_WR); bf16_t* wl = wh + 48 * DM; const float* nfw = args.in[18];
      for (int i = (F.vcu * NWAVES * 64) + F.tid; i < 48 * DM; i += F.G * NWAVES * 64) { const int n = i >> 11, k = i & (DM - 1);
        const float v = n < NG ? args.in[19][k * NG + n] * nfw[k] : (n < 36 ? args.in[21][k * NE + (n - NG)] * nfw[k] : 0.f);
        const unsigned hb = cvt_pk_bf16(v, 0.f) & 0xffffu; wh[i] = (bf16_t)hb; wl[i] = (bf16_t)(cvt_pk_bf16(v - __uint_as_float(hb << 16), 0.f) & 0xffffu); } }
    for (int m = gw; m < MROWS; m += NGW) row_to_bf16_rs(args.in[1] + (size_t)m * DM, (bf16_t*)(ws + WS_MEMB) + (size_t)m * DM, (float*)(ws + WS_RSMEM) + m, lane);
}

struct SchedG1 {
    const char* A; const char* Bt; int G, c, i0, i1;
    __device__ __forceinline__ bool next(int i, gm::Unit& u) const {
        i += i0; if (i >= i1) return false;
        const int L = i * G + c; if (L >= 64 * 32) return false;
        int pm, pn; gm::tile_of(L, 64, 32, pm, pn);
        u.pm = pm; u.pn = pn; u.kind = 0; u.ti = 0; u.a = A + (size_t)pm * 256 * DM * 2; u.b = Bt + (size_t)pn * 256 * DM * 2; return true;
    }
};
struct EpiG1 {
    bf16_t* proj; float* dtraw; const float* rsx; const float* ropetab; float* kmean;
    __device__ __forceinline__ void operator()(const f32x4 (&acc)[2][2][4][2], const gm::Unit& u, int wr, int wc, int fr, int fq) const {
        const int row0 = u.pm * 256 + wr * 64 + fr;
        const bool rope = (u.pn < 8) && (wc == 0), dtt = (u.pn == 32), ktile = (u.pn >= 4) && (u.pn < 8);
        const float sgn = (fq < 2) ? -1.f : 1.f;
        f32x4 ks[2][2] = {{{0.f, 0.f, 0.f, 0.f}, {0.f, 0.f, 0.f, 0.f}}, {{0.f, 0.f, 0.f, 0.f}, {0.f, 0.f, 0.f, 0.f}}};
#pragma unroll
        for (int ai = 0; ai < 2; ++ai)
#pragma unroll
            for (int m = 0; m < 4; ++m) {
                const int row = row0 + ai * 128 + m * 16; const float rs = rsx[row];
                f32x4 c0 = {1.f, 1.f, 1.f, 1.f}, c1 = c0, s0 = {0.f, 0.f, 0.f, 0.f}, s1 = s0;
                if (rope) { const float* rt = ropetab + (row & (SEQ - 1)) * 32 + 8 * (fq & 1); c0 = *(const f32x4*)rt; c1 = *(const f32x4*)(rt + 4); s0 = *(const f32x4*)(rt + 16); s1 = *(const f32x4*)(rt + 20); }
#pragma unroll
                for (int bj = 0; bj < 2; ++bj) {
                    f32x4 v0 = acc[ai][bj][m][0] * rs, v1 = acc[ai][bj][m][1] * rs;
                    if (rope) {
                        f32x4 p0, p1;
#pragma unroll
                        for (int e = 0; e < 4; ++e) { p0[e] = __shfl_xor(v0[e], 32); p1[e] = __shfl_xor(v1[e], 32); }
                        v0 = v0 * c0 + (p0 * s0) * sgn; v1 = v1 * c1 + (p1 * s1) * sgn;
                    }
                    ks[bj][0] += v0; ks[bj][1] += v1;
                    if (!dtt) { u32x4 w; w.x = cvt_pk_bf16(v0[0], v0[1]); w.y = cvt_pk_bf16(v0[2], v0[3]); w.z = cvt_pk_bf16(v1[0], v1[1]); w.w = cvt_pk_bf16(v1[2], v1[3]);
                        *(u32x4*)(proj + (size_t)row * LDP + u.pn * 256 + bj * 128 + wc * 32 + 8 * fq) = w; }
                    else if (bj == 0 && wc == 0) { float* d = dtraw + (size_t)row * 32 + 8 * fq; *(f32x4*)d = v0; *(f32x4*)(d + 4) = v1; }
                }
                asm volatile("" ::: "memory");
            }
        if (ktile) {
#pragma unroll
            for (int bj = 0; bj < 2; ++bj)
#pragma unroll
                for (int n = 0; n < 2; ++n)
#pragma unroll
                    for (int e = 0; e < 4; ++e) { float s = ks[bj][n][e]; s += __shfl_xor(s, 1); s += __shfl_xor(s, 2); s += __shfl_xor(s, 4); s += __shfl_xor(s, 8);
                        if (fr == 0) atomicAdd(kmean + (size_t)u.pm * 1024 + (u.pn - 4) * 256 + bj * 128 + wc * 32 + 8 * fq + 4 * n + e, s * (1.f / MB)); }
        }
    }
};

struct SchedTiles {
    const char* A; const char* Bt; int nM, nN, K, G, c;
    __device__ __forceinline__ bool next(int i, gm::Unit& u) const {
        const int L = i * G + c; if (L >= nM * nN) return false;
        int pm, pn; gm::tile_of(L, nM, nN, pm, pn);
        u.pm = pm; u.pn = pn; u.kind = 0; u.ti = 0; u.a = A + (size_t)pm * 256 * K * 2; u.b = Bt + (size_t)pn * 256 * K * 2; return true;
    }
};
template <bool Q8> struct EpiRes {
    const float* base; float* outf; bf16_t* hb; float* ss;
    __device__ __forceinline__ void operator()(const f32x4 (&acc)[2][2][4][2], const gm::Unit& u, int wr, int wc, int fr, int fq) const {
        const int row0 = u.pm * 256 + wr * 64 + fr;
#pragma unroll
        for (int ai = 0; ai < 2; ++ai)
#pragma unroll
            for (int m = 0; m < 4; ++m) {
                const int row = row0 + ai * 128 + m * 16; float q = 0.f;
#pragma unroll
                for (int bj = 0; bj < 2; ++bj) {
                    const size_t o = (size_t)row * DM + u.pn * 256 + bj * 128 + wc * 32 + 8 * fq;
                    const f32x4 v0 = acc[ai][bj][m][0] + *(const f32x4*)(base + o), v1 = acc[ai][bj][m][1] + *(const f32x4*)(base + o + 4);
                    *(f32x4*)(outf + o) = v0; *(f32x4*)(outf + o + 4) = v1;
                    if constexpr (Q8) { u32x2 w8; w8.x = pk4_fp8(v0[0], v0[1], v0[2], v0[3]); w8.y = pk4_fp8(v1[0], v1[1], v1[2], v1[3]); *(u32x2*)((unsigned char*)hb + o) = w8; }
                    else { u32x4 w; w.x = cvt_pk_bf16(v0[0], v0[1]); w.y = cvt_pk_bf16(v0[2], v0[3]); w.z = cvt_pk_bf16(v1[0], v1[1]); w.w = cvt_pk_bf16(v1[2], v1[3]); *(u32x4*)(hb + o) = w; }
                    q += (v0[0] * v0[0] + v0[1] * v0[1]) + (v0[2] * v0[2] + v0[3] * v0[3]) + (v1[0] * v1[0] + v1[1] * v1[1]) + (v1[2] * v1[2] + v1[3] * v1[3]);
                }
                q += __shfl_xor(q, 16); q += __shfl_xor(q, 32);
                if (fq == 0) ss[(size_t)row * 32 + u.pn * 4 + wc] = q;
                asm volatile("" ::: "memory");
            }
    }
};
struct SchedQKV {
    const char* A0; const char* B0; const char* A1; const char* B1; int G, c;
    __device__ __forceinline__ bool next(int i, gm::Unit& u) const {
        const int L = i * G + c; int pm, pn;
        if (L < 128) { gm::tile_of(L, 64, 2, pm, pn); u.kind = 0; u.a = A0 + (size_t)pm * 256 * DM * 2; u.b = B0 + (size_t)pn * 256 * DM * 2; }
        else if (L < 160) { gm::tile_of(L - 128, 8, 4, pm, pn); u.kind = 1; u.a = A1 + (size_t)pm * 256 * DM * 2; u.b = B1 + (size_t)pn * 256 * DM * 2; }
        else return false;
        u.pm = pm; u.pn = pn; u.ti = 0; return true;
    }
};
struct EpiScale {
    bf16_t* O0; bf16_t* O1; int ld0, ld1; const LAS float* rsl;
    __device__ __forceinline__ void operator()(const f32x4 (&acc)[2][2][4][2], const gm::Unit& u, int wr, int wc, int fr, int fq) const {
        bf16_t* O = u.kind ? O1 : O0; const int ld = u.kind ? ld1 : ld0;
#pragma unroll
        for (int ai = 0; ai < 2; ++ai)
#pragma unroll
            for (int m = 0; m < 4; ++m) {
                const int r = ai * 128 + wr * 64 + m * 16 + fr; const float rs = rsl[r];
#pragma unroll
                for (int bj = 0; bj < 2; ++bj) {
                    const f32x4 v0 = acc[ai][bj][m][0] * rs, v1 = acc[ai][bj][m][1] * rs;
                    u32x4 w; w.x = cvt_pk_bf16(v0[0], v0[1]); w.y = cvt_pk_bf16(v0[2], v0[3]); w.z = cvt_pk_bf16(v1[0], v1[1]); w.w = cvt_pk_bf16(v1[2], v1[3]);
                    *(u32x4*)(O + (size_t)(u.pm * 256 + r) * ld + u.pn * 256 + bj * 128 + wc * 32 + 8 * fq) = w;
                }
            }
    }
};

__device__ __forceinline__ void moe_tables(LAS int* mt, const int* cnt_g, int tid) {
    if (tid < 32) mt[tid] = cnt_g[tid];
    LDS_WAIT(); __syncthreads();
    if (tid == 0) { int p = 0, o = 0; for (int e = 0; e < NE; ++e) { mt[32 + e] = p; mt[65 + e] = o; const int c = mt[e]; p += 8 * ((c + 255) >> 8); o += c; } mt[32 + NE] = p; mt[65 + NE] = o; }
    LDS_WAIT(); __syncthreads();
}
template <bool GU> struct SchedMoE {
    const LAS int* mt; const char* A; const char* Bt; int G, c;
    __device__ __forceinline__ bool next(int i, gm::Unit& u) const {
        const int L = i * G + c; if (L >= __builtin_amdgcn_readfirstlane(mt[32 + NE])) return false;
        int e = 0;
#pragma unroll 1
        for (int k = 1; k < NE; ++k) if (L >= __builtin_amdgcn_readfirstlane(mt[32 + k])) e = k;
        const int rem = L - __builtin_amdgcn_readfirstlane(mt[32 + e]), te = (__builtin_amdgcn_readfirstlane(mt[e]) + 255) >> 8, pn = rem / te, mtile = rem - pn * te;
        const int slot0 = __builtin_amdgcn_readfirstlane(mt[65 + e]) + mtile * 256;
        u.pm = mtile; u.pn = pn; u.kind = e; u.ti = i;
        if (GU) { u.a = A; u.b = Bt + ((size_t)e * 2048 + pn * 256) * DM; }
        else { u.a = A; u.b = Bt + ((size_t)e * 2048 + pn * 256) * DE; (void)slot0; }
        return true;
    }
};
struct EpiGU {
    bf16_t* Hact; const float* rs2; const LAS int* mt; const LAS int* tab;
    __device__ __forceinline__ void operator()(const f32x4 (&acc)[2][2][4][2], const gm::Unit& u, int wr, int wc, int fr, int fq) const {
        const int e = u.kind, valid = mt[e] - u.pm * 256, slot0 = mt[65 + e] + u.pm * 256;
#pragma unroll
        for (int ai = 0; ai < 2; ++ai)
#pragma unroll
            for (int m = 0; m < 4; ++m) {
                const int r = ai * 128 + wr * 64 + m * 16 + fr;
                if (r < valid) {
                    const float rs = rs2[tab[u.ti * 256 + r]] * (1.f / 256.f);
                    const f32x4 g0 = acc[ai][0][m][0] * rs, g1 = acc[ai][0][m][1] * rs, u0 = acc[ai][1][m][0] * rs, u1 = acc[ai][1][m][1] * rs;
                    float o[8];
#pragma unroll
                    for (int j = 0; j < 4; ++j) { o[j] = g0[j] * __builtin_amdgcn_rcpf(1.f + __expf(-g0[j])) * u0[j]; o[4 + j] = g1[j] * __builtin_amdgcn_rcpf(1.f + __expf(-g1[j])) * u1[j]; }
                    u32x2 w; w.x = pk4_fp8(16.f * o[0], 16.f * o[1], 16.f * o[2], 16.f * o[3]); w.y = pk4_fp8(16.f * o[4], 16.f * o[5], 16.f * o[6], 16.f * o[7]);
                    *(u32x2*)((unsigned char*)Hact + (size_t)(slot0 + r) * DE + u.pn * 128 + wc * 32 + 8 * fq) = w;
                }
            }
    }
};
struct EpiDown {
    bf16_t* Y; const LAS int* mt;
    __device__ __forceinline__ void operator()(const f32x4 (&acc)[2][2][4][2], const gm::Unit& u, int wr, int wc, int fr, int fq) const {
        const int e = u.kind, valid = mt[e] - u.pm * 256, slot0 = mt[65 + e] + u.pm * 256;
#pragma unroll
        for (int ai = 0; ai < 2; ++ai)
#pragma unroll
            for (int m = 0; m < 4; ++m) {
                const int r = ai * 128 + wr * 64 + m * 16 + fr;
                if (r < valid) {
#pragma unroll
                    for (int bj = 0; bj < 2; ++bj) { const f32x4 v0 = acc[ai][bj][m][0] * (1.f / 4096.f), v1 = acc[ai][bj][m][1] * (1.f / 4096.f);
                        u32x4 w; w.x = cvt_pk_bf16(v0[0], v0[1]); w.y = cvt_pk_bf16(v0[2], v0[3]); w.z = cvt_pk_bf16(v1[0], v1[1]); w.w = cvt_pk_bf16(v1[2], v1[3]);
                        *(u32x4*)(Y + (size_t)(slot0 + r) * DM + u.pn * 256 + bj * 128 + wc * 32 + 8 * fq) = w; }
                }
            }
    }
};
__device__ __forceinline__ void final_rows(Frame& F, float* hio, const bf16_t* Y, const int* tok_e, const int* tok_pos, const float* tok_w, const float* fw, const LAS int* mt) {
    const int gw = F.vcu * NWAVES + F.wave, NGW = F.G * NWAVES, lane = F.lane;
    for (int t = gw; t < M; t += NGW) {
        const int e1 = tok_e[2 * t], e2 = tok_e[2 * t + 1];
        const size_t s1 = (size_t)(mt[65 + e1] + tok_pos[2 * t]), s2 = (size_t)(mt[65 + e2] + tok_pos[2 * t + 1]);
        const float w1 = tok_w[2 * t], w2 = tok_w[2 * t + 1];
        f32x4* hr = (f32x4*)(hio + (size_t)t * DM) + 2 * lane;
        const u32x4* y1 = (const u32x4*)(Y + s1 * DM) + lane; const u32x4* y2 = (const u32x4*)(Y + s2 * DM) + lane;
        float v[4][8]; float ss = 0.f;
#pragma unroll
        for (int j = 0; j < 4; ++j) {
            const f32x4 a0 = hr[128 * j], a1 = hr[128 * j + 1]; const u32x4 p = y1[64 * j], q = y2[64 * j];
            const float pa[8] = {bflo(p.x), bfhi(p.x), bflo(p.y), bfhi(p.y), bflo(p.z), bfhi(p.z), bflo(p.w), bfhi(p.w)};
            const float qa[8] = {bflo(q.x), bfhi(q.x), bflo(q.y), bfhi(q.y), bflo(q.z), bfhi(q.z), bflo(q.w), bfhi(q.w)};
            const float ha[8] = {a0[0], a0[1], a0[2], a0[3], a1[0], a1[1], a1[2], a1[3]};
#pragma unroll
            for (int k = 0; k < 8; ++k) { v[j][k] = ha[k] + (w1 * pa[k] + w2 * qa[k]); ss += v[j][k] * v[j][k]; }
        }
        ss = wave_sum(ss);
        const float rs = rsqrtf(ss * (1.f / DM) + EPS);
#pragma unroll
        for (int j = 0; j < 4; ++j) {
            const f32x4 g0 = *((const f32x4*)fw + 2 * lane + 128 * j), g1 = *((const f32x4*)fw + 2 * lane + 128 * j + 1);
            hr[128 * j] = (f32x4){v[j][0] * rs * g0[0], v[j][1] * rs * g0[1], v[j][2] * rs * g0[2], v[j][3] * rs * g0[3]};
            hr[128 * j + 1] = (f32x4){v[j][4] * rs * g1[0], v[j][5] * rs * g1[1], v[j][6] * rs * g1[2], v[j][7] * rs * g1[3]};
        }
    }
}

__device__ __forceinline__ void router_rows(Frame& F, const float* h2, const bf16_t* wrh, const float* b_rg, const float* b_re, float* rs2, int* cnt, int* list, int* tok_e, int* tok_pos, float* tok_w) {
    const int lane = F.lane, tid = F.tid, w = F.wave, ti = lane & 15, kg = lane >> 4;
    LAS float* part = (LAS float*)(F.lds + RING_OFF);
    LAS float* sqp = part + 8 * 16 * 48;
    LAS float* lgt = sqp + 8 * 16;
    const bf16_t* wrl = wrh + 48 * DM;
    for (int g = F.vcu; g < M / 16; g += F.G) {
        const float* hr = h2 + (size_t)(g * 16 + ti) * DM + w * 256 + 8 * kg;
        f32x4 acc[3] = {{0.f, 0.f, 0.f, 0.f}, {0.f, 0.f, 0.f, 0.f}, {0.f, 0.f, 0.f, 0.f}}; float sq = 0.f;
#pragma unroll 2
        for (int s = 0; s < 8; ++s) {
            const f32x4 x0 = *(const f32x4*)(hr + 32 * s), x1 = *(const f32x4*)(hr + 32 * s + 4);
            bf16x8 bh[3], bl[3];
#pragma unroll
            for (int nt = 0; nt < 3; ++nt) { const size_t o = (size_t)(16 * nt + ti) * DM + w * 256 + 32 * s + 8 * kg; bh[nt] = *(const bf16x8*)(wrh + o); bl[nt] = *(const bf16x8*)(wrl + o); }
            sq += (x0[0] * x0[0] + x0[1] * x0[1]) + (x0[2] * x0[2] + x0[3] * x0[3]) + (x1[0] * x1[0] + x1[1] * x1[1]) + (x1[2] * x1[2] + x1[3] * x1[3]);
            u32x4 hw, lw;
            hw.x = cvt_pk_bf16(x0[0], x0[1]); hw.y = cvt_pk_bf16(x0[2], x0[3]); hw.z = cvt_pk_bf16(x1[0], x1[1]); hw.w = cvt_pk_bf16(x1[2], x1[3]);
            lw.x = cvt_pk_bf16(x0[0] - bflo(hw.x), x0[1] - bfhi(hw.x)); lw.y = cvt_pk_bf16(x0[2] - bflo(hw.y), x0[3] - bfhi(hw.y));
            lw.z = cvt_pk_bf16(x1[0] - bflo(hw.z), x1[1] - bfhi(hw.z)); lw.w = cvt_pk_bf16(x1[2] - bflo(hw.w), x1[3] - bfhi(hw.w));
            const bf16x8 ah = *reinterpret_cast<const bf16x8*>(&hw), al = *reinterpret_cast<const bf16x8*>(&lw);
#pragma unroll
            for (int nt = 0; nt < 3; ++nt) { acc[nt] = __builtin_amdgcn_mfma_f32_16x16x32_bf16(ah, bh[nt], acc[nt], 0, 0, 0); acc[nt] = __builtin_amdgcn_mfma_f32_16x16x32_bf16(ah, bl[nt], acc[nt], 0, 0, 0);
                acc[nt] = __builtin_amdgcn_mfma_f32_16x16x32_bf16(al, bh[nt], acc[nt], 0, 0, 0); }
        }
        sq += __shfl_xor(sq, 16); sq += __shfl_xor(sq, 32);
        __syncthreads();
#pragma unroll
        for (int nt = 0; nt < 3; ++nt)
#pragma unroll
            for (int r = 0; r < 4; ++r) part[(w * 16 + 4 * kg + r) * 48 + 16 * nt + ti] = acc[nt][r];
        if (kg == 0) sqp[w * 16 + ti] = sq;
        __syncthreads();
        for (int i = tid; i < 16 * 48 + 16; i += NWAVES * 64) { float s = 0.f;
            if (i < 16 * 48) {
#pragma unroll
                for (int ww = 0; ww < 8; ++ww) s += part[ww * 16 * 48 + i]; }
            else {
#pragma unroll
                for (int ww = 0; ww < 8; ++ww) s += sqp[ww * 16 + (i - 16 * 48)]; }
            lgt[i] = s; }
        __syncthreads();
        if (tid < 16) {
            const int tt = g * 16 + tid; const LAS float* lg = lgt + tid * 48;
            const float rs = rsqrtf(lgt[16 * 48 + tid] * (1.f / DM) + EPS);
            float gm_ = -INFINITY; int gi = 0; float gv[4];
#pragma unroll
            for (int i = 0; i < 4; ++i) { gv[i] = lg[i] * rs + b_rg[i]; if (gv[i] > gm_) { gm_ = gv[i]; gi = i; } }
            float gs = 0.f;
#pragma unroll
            for (int i = 0; i < 4; ++i) gs += __expf(gv[i] - gm_);
            const float gwt = 1.f / gs;
            float e1 = -INFINITY, e2 = -INFINITY; int i1 = 0, i2 = 0;
#pragma unroll
            for (int i = 0; i < 8; ++i) { const float vv = lg[4 + gi * 8 + i] * rs + b_re[gi * 8 + i]; if (vv > e1) { e2 = e1; i2 = i1; e1 = vv; i1 = i; } else if (vv > e2) { e2 = vv; i2 = i; } }
            const float p2 = 1.f / (1.f + __expf(e1 - e2)), p1 = 1.f - p2;
            const int ea = gi * 8 + i1, eb = gi * 8 + i2;
            const int pa = atomicAdd(&cnt[ea], 1), pb = atomicAdd(&cnt[eb], 1);
            list[ea * M + pa] = tt; list[eb * M + pb] = tt;
            tok_e[tt * 2] = ea; tok_e[tt * 2 + 1] = eb; tok_pos[tt * 2] = pa; tok_pos[tt * 2 + 1] = pb; tok_w[tt * 2] = gwt * p1; tok_w[tt * 2 + 1] = gwt * p2; rs2[tt] = rs;
        }
    }
    __syncthreads();
}

__device__ __forceinline__ void dt_rows(Frame& F, const bf16_t* xb, const bf16_t* wdt, const float* rsx, float* dtraw) {
    const int lane = F.lane, tid = F.tid, w = F.wave, ti = lane & 15, kg = lane >> 4;
    LAS float* part = (LAS float*)(F.lds + RING_OFF);
    for (int g = F.vcu; g < M / 16; g += F.G) {
        const bf16_t* ar = xb + (size_t)(g * 16 + ti) * DM + w * 256 + 8 * kg;
        f32x4 acc[2] = {{0.f, 0.f, 0.f, 0.f}, {0.f, 0.f, 0.f, 0.f}};
        bf16x8 af[8], b0[8], b1[8];
#pragma unroll
        for (int s = 0; s < 8; ++s) { af[s] = *(const bf16x8*)(ar + 32 * s); b0[s] = *(const bf16x8*)(wdt + (size_t)ti * DM + w * 256 + 32 * s + 8 * kg); b1[s] = *(const bf16x8*)(wdt + (size_t)(16 + ti) * DM + w * 256 + 32 * s + 8 * kg); }
#pragma unroll
        for (int s = 0; s < 8; ++s) { acc[0] = __builtin_amdgcn_mfma_f32_16x16x32_bf16(af[s], b0[s], acc[0], 0, 0, 0); acc[1] = __builtin_amdgcn_mfma_f32_16x16x32_bf16(af[s], b1[s], acc[1], 0, 0, 0); }
        __syncthreads();
#pragma unroll
        for (int nt = 0; nt < 2; ++nt)
#pragma unroll
            for (int r = 0; r < 4; ++r) part[(w * 16 + 4 * kg + r) * 32 + 16 * nt + ti] = acc[nt][r];
        __syncthreads();
        { float s = 0.f;
#pragma unroll
          for (int ww = 0; ww < 8; ++ww) s += part[ww * 512 + tid];
          const int tok = g * 16 + (tid >> 5); dtraw[(size_t)tok * 32 + (tid & 31)] = s * rsx[tok]; }
    }
    __syncthreads();
}

__device__ __forceinline__ void gnorm_rows(Frame& F, bf16_t* mixb, const bf16_t* proj) {
    const int gw = F.vcu * NWAVES + F.wave, NGW = F.G * NWAVES, lane = F.lane;
#pragma unroll 2
    for (int tok = gw; tok < M; tok += NGW) {
        u32x4* p = (u32x4*)(mixb + (size_t)tok * MIXW + AW) + lane; const u32x4* zp = (const u32x4*)(proj + (size_t)tok * LDP + C_Z) + lane;
        u32x4 w[4], zw[4]; float v[4][8]; float q[4];
#pragma unroll
        for (int g = 0; g < 4; ++g) { w[g] = p[64 * g]; zw[g] = zp[64 * g]; }
#pragma unroll
        for (int g = 0; g < 4; ++g) { float z[8] = {bflo(zw[g].x), bfhi(zw[g].x), bflo(zw[g].y), bfhi(zw[g].y), bflo(zw[g].z), bfhi(zw[g].z), bflo(zw[g].w), bfhi(zw[g].w)};
#pragma unroll
            for (int e = 0; e < 8; ++e) z[e] = z[e] * __builtin_amdgcn_rcpf(1.f + __expf(-z[e]));
            v[g][0] = bflo(w[g].x) * z[0]; v[g][1] = bfhi(w[g].x) * z[1]; v[g][2] = bflo(w[g].y) * z[2]; v[g][3] = bfhi(w[g].y) * z[3]; v[g][4] = bflo(w[g].z) * z[4]; v[g][5] = bfhi(w[g].z) * z[5]; v[g][6] = bflo(w[g].w) * z[6]; v[g][7] = bfhi(w[g].w) * z[7];
            q[g] = (v[g][0] * v[g][0] + v[g][1] * v[g][1]) + (v[g][2] * v[g][2] + v[g][3] * v[g][3]) + (v[g][4] * v[g][4] + v[g][5] * v[g][5]) + (v[g][6] * v[g][6] + v[g][7] * v[g][7]); }
#pragma unroll
        for (int o = 1; o < 64; o <<= 1) {
#pragma unroll
            for (int g = 0; g < 4; ++g) q[g] += __shfl_xor(q[g], o); }
#pragma unroll
        for (int g = 0; g < 4; ++g) { const float rs = rsqrtf(q[g] * (1.f / 512.f) + EPS); u32x4 o;
            o.x = cvt_pk_bf16(v[g][0] * rs, v[g][1] * rs); o.y = cvt_pk_bf16(v[g][2] * rs, v[g][3] * rs); o.z = cvt_pk_bf16(v[g][4] * rs, v[g][5] * rs); o.w = cvt_pk_bf16(v[g][6] * rs, v[g][7] * rs);
            p[64 * g] = o; }
    }
}

#ifndef REP_P0
#define REP_P0 1
#endif
#ifndef REP_P0B
#define REP_P0B 1
#endif
#ifndef REP_G1
#define REP_G1 1
#endif
#ifndef REP_SSD
#define REP_SSD 1
#endif
#ifndef REP_MOE
#define REP_MOE 1
#endif
#ifndef REP_ATT
#define REP_ATT 1
#endif
#ifndef REP_G2
#define REP_G2 1
#endif
__global__ void __launch_bounds__(NWAVES * 64, 2) fwd(Args args) {
    extern __shared__ __attribute__((aligned(16))) unsigned char lds_raw[];
    Frame F;
    F.lds = (LAS unsigned char*)lds_raw;
    F.MISC = (volatile LAS unsigned*)(F.lds + MISC_OFF);
    F.tid = threadIdx.x; F.lane = F.tid & 63; F.wave = __builtin_amdgcn_readfirstlane(F.tid >> 6);
    F.G = gridDim.x; { const int bx = blockIdx.x; F.vcu = (F.G % 8 == 0) ? (bx % 8) * (F.G / 8) + bx / 8 : bx; }
    for (int u = F.tid; u < (LDS_BYTES - LDSCTL_OFF) / 4; u += NWAVES * 64) ((LAS unsigned*)(F.lds + LDSCTL_OFF))[u] = 0u;
    __syncthreads();
    (void)xcd_barrier_post((unsigned*)(args.ws + WS_CTL) + CW_BAR + args.li * XCD_BAR_WORDS, F.MISC + 8);
#define GRID_BAR() do { GAS unsigned char* wb_ = (GAS unsigned char*)args.ws; asm volatile("" : "+s"(wb_)); XcdBarrier b_; \
        b_.bar = (unsigned*)((unsigned char*)wb_ + WS_CTL) + CW_BAR + args.li * XCD_BAR_WORDS; b_.x = xb_xcc_id(); b_.st = F.MISC + 8; xcd_barrier(b_, F.wave * 64 + lane_id_now()); } while (0)
    const int lo = args.ph_lo, hi = args.ph_hi;
#define IN(k) (lo <= (k) && (k) < hi)
#define BOTH(k) (IN(k) && IN((k) + 1))
#define PHASE_WS() F.lane = lane_id_now(); F.tid = F.wave * 64 + F.lane; GAS unsigned char* wsg_ = (GAS unsigned char*)args.ws; asm volatile("" : "+s"(wsg_)); unsigned char* ws = (unsigned char*)wsg_
    if (IN(0)) { F.lane = lane_id_now(); F.tid = F.wave * 64 + F.lane;
p0a_prologue(F, args); if constexpr (REP_P0 > 1) p0a_prologue(F, args); if (BOTH(0)) GRID_BAR(); }
    if (IN(1)) {
        PHASE_WS();
        const int rsplit = (F.vcu >> 5) & 7;
        EpiG1 E{(bf16_t*)(ws + WS_PROJ), (float*)(ws + WS_DTRAW), (const float*)(ws + WS_RSX), (const float*)(ws + WS_ROPE), (float*)(ws + WS_KMEAN)};
        { SchedG1 S{(const char*)(ws + WS_XB), (const char*)(ws + WS_WIN_T), F.G, (int)blockIdx.x, 0, rsplit};
          gm::gemm_phase<EpiG1, SchedG1, false>(F.tid, F.lds + RING_OFF, (const LAS int*)(F.lds + TAB_OFF), DM, S, E); }
        __syncthreads();
        p0b_share(F, args);
        if constexpr (REP_P0B > 1) { __syncthreads(); p0b_share(F, args); }
        __syncthreads();
        { F.lane = lane_id_now(); F.tid = F.wave * 64 + F.lane;
          SchedG1 S{(const char*)(ws + WS_XB), (const char*)(ws + WS_WIN_T), F.G, (int)blockIdx.x, rsplit, 1 << 20};
          gm::gemm_phase<EpiG1, SchedG1, false>(F.tid, F.lds + RING_OFF, (const LAS int*)(F.lds + TAB_OFF), DM, S, E); }
        if (BOTH(1)) GRID_BAR();
    }
    if (IN(2)) {
        PHASE_WS();
        dt_rows(F, (const bf16_t*)(ws + WS_XB), (const bf16_t*)(ws + WS_WIN_T) + (size_t)C_DT * DM, (const float*)(ws + WS_RSX), (float*)(ws + WS_DTRAW));
        sd::conv_prepass(F.vcu * NWAVES * 64 + F.tid, F.G * NWAVES * 64, (const bf16_t*)(ws + WS_PROJ), args.in[4], args.in[5], (bf16_t*)(ws + WS_XBCC));
        if (BOTH(2)) GRID_BAR();
    }
    if (IN(3)) {
        PHASE_WS();
        for (int L = F.vcu; L < BATCH * SH; L += F.G)
            sd::ssd_unit(F.tid, L / SH, L % SH, (const bf16_t*)(ws + WS_PROJ), (const bf16_t*)(ws + WS_XBCC), (const float*)(ws + WS_DTRAW), args.in[6], args.in[7], args.in[8],
                         (bf16_t*)(ws + WS_MIXB), (LAS char*)(F.lds + RING_OFF));
        if constexpr (REP_SSD > 1) {
        for (int L = F.vcu; L < BATCH * SH; L += F.G)
            sd::ssd_unit(F.tid, L / SH, L % SH, (const bf16_t*)(ws + WS_PROJ), (const bf16_t*)(ws + WS_XBCC), (const float*)(ws + WS_DTRAW), args.in[6], args.in[7], args.in[8],
                         (bf16_t*)(ws + WS_MIXB), (LAS char*)(F.lds + RING_OFF));
        }
        if (BOTH(3)) GRID_BAR();
    }
    if (IN(4)) {
        PHASE_WS();
        for (int L = F.vcu; L < BATCH * AH * 4; L += F.G) {
            const int b = L >> 5, h = (L >> 2) & 7, pi = L & 3;
            const bf16_t* pb = (const bf16_t*)(ws + WS_PROJ) + (size_t)b * SEQ * LDP + h * HD;
#pragma unroll 1
            for (int k = 0; k < 2; ++k) { const int jb = k ? pi : 7 - pi;
                at::attn_unit<true>(F.tid, pb + (size_t)jb * MB * LDP + C_Q, pb + C_K, (bf16_t*)(ws + WS_MIXB) + (size_t)(b * SEQ + jb * MB) * MIXW + h * HD,
                                    4 * (jb + 1), jb, (const float*)(ws + WS_KMEAN) + (size_t)b * NB * 1024 + h * HD, (LAS char*)(F.lds + RING_OFF)); }
        }
        if constexpr (REP_ATT > 1) {
        for (int L = F.vcu; L < BATCH * AH * 4; L += F.G) {
            const int b = L >> 5, h = (L >> 2) & 7, pi = L & 3;
            const bf16_t* pb = (const bf16_t*)(ws + WS_PROJ) + (size_t)b * SEQ * LDP + h * HD;
#pragma unroll 1
            for (int k = 0; k < 2; ++k) { const int jb = k ? pi : 7 - pi;
                at::attn_unit<true>(F.tid, pb + (size_t)jb * MB * LDP + C_Q, pb + C_K, (bf16_t*)(ws + WS_MIXB) + (size_t)(b * SEQ + jb * MB) * MIXW + h * HD,
                                    4 * (jb + 1), jb, (const float*)(ws + WS_KMEAN) + (size_t)b * NB * 1024 + h * HD, (LAS char*)(F.lds + RING_OFF)); }
        }
        }
        __syncthreads();
        gnorm_rows(F, (bf16_t*)(ws + WS_MIXB), (const bf16_t*)(ws + WS_PROJ));
        if (BOTH(4)) GRID_BAR();
    }
    if (IN(5)) {
        PHASE_WS();
        SchedTiles S{(const char*)(ws + WS_MIXB), (const char*)(ws + WS_WOUT_T), 64, 8, MIXW, F.G, (int)blockIdx.x};
        EpiRes<false> E{args.in[0], args.out, (bf16_t*)(ws + WS_XB), (float*)(ws + WS_SS)};
        gm::gemm_phase<EpiRes<false>, SchedTiles, false>(F.tid, F.lds + RING_OFF, (const LAS int*)(F.lds + TAB_OFF), MIXW, S, E);
        if constexpr (REP_G2 > 1) { __syncthreads(); gm::gemm_phase<EpiRes<false>, SchedTiles, false>(F.tid, F.lds + RING_OFF, (const LAS int*)(F.lds + TAB_OFF), MIXW, S, E); }
        if (BOTH(5)) GRID_BAR();
    }
    if (IN(6)) {
        PHASE_WS();
        SchedQKV S{(const char*)(ws + WS_XB), (const char*)(ws + WS_WCQ_T), (const char*)(ws + WS_MEMB), (const char*)(ws + WS_WCKV_T), F.G, (int)blockIdx.x};
        gm::Unit u0; LAS float* rsl = (LAS float*)(F.lds + RSL_OFF);
        if (S.next(0, u0) && F.tid < 256) {
            const int row = u0.pm * 256 + F.tid;
            if (u0.kind == 0) { const f32x4* p = (const f32x4*)((const float*)(ws + WS_SS) + (size_t)row * 32); float q = 0.f;
#pragma unroll
                for (int j = 0; j < 8; ++j) { const f32x4 v = p[j]; q += (v[0] + v[1]) + (v[2] + v[3]); }
                rsl[F.tid] = rsqrtf(q * (1.f / DM) + EPS); }
            else rsl[F.tid] = ((const float*)(ws + WS_RSMEM))[row];
        }
        VM_WAIT(); LDS_WAIT(); __syncthreads();
        EpiScale E{(bf16_t*)(ws + WS_QC), (bf16_t*)(ws + WS_KVC), CW, 2 * CW, rsl};
        gm::gemm_phase<EpiScale, SchedQKV, false>(F.tid, F.lds + RING_OFF, (const LAS int*)(F.lds + TAB_OFF), DM, S, E);
        if (BOTH(6)) GRID_BAR();
    }
    if (IN(7)) {
        PHASE_WS();
        for (int L = F.vcu; L < BATCH * CH * 8; L += F.G) {
            const int b = L >> 5, h = (L >> 3) & 3, qt = L & 7;
            const bf16_t* kb_ = (const bf16_t*)(ws + WS_KVC) + (size_t)b * MEM * (2 * CW) + h * CHD;
            at::attn_unit<false>(F.tid, (const bf16_t*)(ws + WS_QC) + (size_t)(b * SEQ + qt * 256) * CW + h * CHD, kb_,
                                 (bf16_t*)(ws + WS_OC) + (size_t)(b * SEQ + qt * 256) * CW + h * CHD, 4, 0, nullptr, (LAS char*)(F.lds + RING_OFF));
        }
        __syncthreads();
        if (BOTH(7)) GRID_BAR();
    }
    if (IN(8)) {
        PHASE_WS();
        SchedTiles S{(const char*)(ws + WS_OC), (const char*)(ws + WS_WCO_T), 64, 8, CW, F.G, (int)blockIdx.x};
        EpiRes<true> E{args.out, args.out, (bf16_t*)(ws + WS_XB), (float*)(ws + WS_SS) + (size_t)M * 32};
        gm::gemm_phase<EpiRes<true>, SchedTiles, false>(F.tid, F.lds + RING_OFF, (const LAS int*)(F.lds + TAB_OFF), CW, S, E);
        if (BOTH(8)) GRID_BAR();
    }
    if (IN(9)) {
        PHASE_WS();
        int* tok_e = (int*)(ws + WS_TOK);
        router_rows(F, args.out, (const bf16_t*)(ws + WS_WR), args.in[20], args.in[22], (float*)(ws + WS_RS2), (int*)(ws + WS_CTL) + CW_CNT, (int*)(ws + WS_LIST), tok_e, tok_e + 2 * M, (float*)(tok_e + 4 * M));
        if (BOTH(9)) GRID_BAR();
    }
    if (IN(10)) {
        PHASE_WS();
        LAS int* mt = (LAS int*)(F.lds + MOE_OFF); LAS int* tab = (LAS int*)(F.lds + TAB_OFF);
        moe_tables(mt, (const int*)(ws + WS_CTL) + CW_CNT, F.tid);
        SchedMoE<true> S{mt, (const char*)(ws + WS_XB), (const char*)(ws + WS_WGU_T), F.G, F.vcu};
        { const int* list = (const int*)(ws + WS_LIST); gm::Unit u;
          for (int i = 0; i < 8 && S.next(i, u); ++i) if (F.tid < 256) { const int rg = u.pm * 256 + F.tid; tab[i * 256 + F.tid] = list[u.kind * M + (rg < mt[u.kind] ? rg : 0)]; } }
        VM_WAIT(); LDS_WAIT(); __syncthreads();
        EpiGU E{(bf16_t*)(ws + WS_HACT), (const float*)(ws + WS_RS2), mt, tab};
gm::gemm_phase<EpiGU, SchedMoE<true>, true, true, true>(F.tid, F.lds + RING_OFF, tab, DM / 2, S, E);
        if constexpr (REP_MOE > 1) { __syncthreads(); gm::gemm_phase<EpiGU, SchedMoE<true>, true, true, true>(F.tid, F.lds + RING_OFF, tab, DM / 2, S, E); }
        if (BOTH(10)) GRID_BAR();
    }
    if (IN(11)) {
        PHASE_WS();
        LAS int* mt = (LAS int*)(F.lds + MOE_OFF);
        moe_tables(mt, (const int*)(ws + WS_CTL) + CW_CNT, F.tid);
        LAS int* tab = (LAS int*)(F.lds + TAB_OFF);
        SchedMoE<false> S{mt, (const char*)(ws + WS_HACT), (const char*)(ws + WS_WD_T), F.G, F.vcu};
        { gm::Unit u;
          for (int i = 0; i < 8 && S.next(i, u); ++i) if (F.tid < 256) tab[i * 256 + F.tid] = mt[65 + u.kind] + u.pm * 256 + F.tid; }
        LDS_WAIT(); __syncthreads();
        EpiDown E{(bf16_t*)(ws + WS_Y), mt};
        gm::gemm_phase<EpiDown, SchedMoE<false>, true, true, true>(F.tid, F.lds + RING_OFF, tab, DE / 2, S, E);
        if constexpr (REP_MOE > 1) { __syncthreads(); gm::gemm_phase<EpiDown, SchedMoE<false>, true, true, true>(F.tid, F.lds + RING_OFF, tab, DE / 2, S, E); }
        if (BOTH(11)) GRID_BAR();
    }
    if (IN(12)) {
        PHASE_WS();
        LAS int* mt = (LAS int*)(F.lds + MOE_OFF);
        moe_tables(mt, (const int*)(ws + WS_CTL) + CW_CNT, F.tid);
        const int* tok_e = (const int*)(ws + WS_TOK);
        final_rows(F, args.out, (const bf16_t*)(ws + WS_Y), tok_e, tok_e + 2 * M, (const float*)(tok_e + 4 * M), args.in[26], mt);
    }
#undef IN
#undef BOTH
}
extern "C" void kernel_launch(void* const* d_in, const int* in_sizes, int n_in, void* d_out, int out_size, void* d_ws, size_t ws_size, hipStream_t stream) {
  static int grid = 0;
  static float rfv[16];
  if (grid == 0) {
    int dev = 0, cus = 0;
    if (hipGetDevice(&dev) != hipSuccess || hipDeviceGetAttribute(&cus, hipDeviceAttributeMultiprocessorCount, dev) != hipSuccess) { fprintf(stderr, "kernel_launch: device query failed\n"); grid = -1; return; }
    if (hipFuncSetAttribute((const void*)fwd, hipFuncAttributeMaxDynamicSharedMemorySize, LDS_BYTES) != hipSuccess) { fprintf(stderr, "kernel_launch: hipFuncSetAttribute failed\n"); grid = -1; return; }
    int per_cu = 0;
    if (hipOccupancyMaxActiveBlocksPerMultiprocessor(&per_cu, (const void*)fwd, NWAVES * 64, LDS_BYTES) != hipSuccess || per_cu < 1) fprintf(stderr, "kernel_launch: occupancy query says %d\n", per_cu);
    (void)hipGetLastError();
    for (int i = 0; i < 16; ++i) rfv[i] = (float)pow(500000.0, -(double)i / 16.0);
    grid = cus;
  }
  if (grid < 0) return;
  float* out = (float*)d_out;
  unsigned char* ws = (unsigned char*)d_ws;
  (void)hipMemsetAsync(ws + WS_CTL, 0, CTL_ZERO_BYTES, stream);
  Args a{};
  for (int i = 0; i < 27; ++i) a.in[i] = (const float*)d_in[i];
  a.out = out; a.ws = ws; for (int i = 0; i < 16; ++i) a.rf[i] = rfv[i];
  a.ph_lo = 0; a.ph_hi = 13; a.li = 0;
  hipLaunchKernelGGL(fwd, dim3(grid), dim3(NWAVES * 64), LDS_BYTES, stream, a);
}
```

```cpp
#include <hip/hip_runtime.h>
#include <stdint.h>
#include <math.h>
#include <cstdio>

constexpr int DM = 2048, BATCH = 8, SEQ = 2048, M = BATCH * SEQ, MEM = 256, MROWS = BATCH * MEM;
constexpr float EPS = 1e-6f;
constexpr int AH = 8, HD = 128, AW = 1024;
constexpr int MB = 256, NB = SEQ / MB;
constexpr int SW = 2048, SH = 32, SG = 4, SCONV = 4, CONVD = 3072;
constexpr int MIXW = 3072, INW = 8224, LDP = 8448;
constexpr int C_Q = 0, C_K = 1024, C_V = 2048, C_Z = 3072, C_XBC = 5120, C_DT = 8192;
constexpr int CH = 4, CHD = 128, CW = 512;
constexpr int NG = 4, EPG = 8, NE = 32, DE = 1024;

#define LAS __attribute__((address_space(3)))
#define GAS __attribute__((address_space(1)))
typedef unsigned short bf16_t;
typedef short bf16x8 __attribute__((ext_vector_type(8)));
typedef float f32x4 __attribute__((ext_vector_type(4)));
typedef float f32x2 __attribute__((ext_vector_type(2)));
typedef unsigned u32x4 __attribute__((ext_vector_type(4)));
typedef unsigned u32x2 __attribute__((ext_vector_type(2)));
typedef int i32x4 __attribute__((ext_vector_type(4)));
typedef int i32x8 __attribute__((ext_vector_type(8)));
typedef short s16x16 __attribute__((ext_vector_type(16)));
#define LDS_WAIT() asm volatile("s_waitcnt lgkmcnt(0)" ::: "memory")
#define VM_WAIT() asm volatile("s_waitcnt vmcnt(0)" ::: "memory")

__device__ __forceinline__ unsigned cvt_pk_bf16(float lo, float hi) { unsigned r; asm volatile("v_cvt_pk_bf16_f32 %0, %1, %2" : "=v"(r) : "v"(lo), "v"(hi)); return r; }
__device__ __forceinline__ unsigned pk4_fp8(float a, float b, float c, float d) {
  a = fminf(fmaxf(a, -448.f), 448.f); b = fminf(fmaxf(b, -448.f), 448.f); c = fminf(fmaxf(c, -448.f), 448.f); d = fminf(fmaxf(d, -448.f), 448.f);
  int w = 0; w = __builtin_amdgcn_cvt_pk_fp8_f32(a, b, w, false); w = __builtin_amdgcn_cvt_pk_fp8_f32(c, d, w, true); return (unsigned)w; }
__device__ __forceinline__ float bf2f(bf16_t b) { return __uint_as_float(((unsigned)b) << 16); }
__device__ __forceinline__ float bflo(unsigned w) { return __uint_as_float(w << 16); }
__device__ __forceinline__ float bfhi(unsigned w) { return __uint_as_float(w & 0xffff0000u); }
__device__ __forceinline__ void ld8bf(const bf16_t* p, float (&o)[8]) { const u32x4 w = *(const u32x4*)p; o[0] = bflo(w.x); o[1] = bfhi(w.x); o[2] = bflo(w.y); o[3] = bfhi(w.y); o[4] = bflo(w.z); o[5] = bfhi(w.z); o[6] = bflo(w.w); o[7] = bfhi(w.w); }
__device__ __forceinline__ float wave_sum(float v) {
#pragma unroll
  for (int o = 1; o < 64; o <<= 1) v += __shfl_xor(v, o);
  return v;
}
__device__ __forceinline__ float wave_max(float v) {
#pragma unroll
  for (int o = 1; o < 64; o <<= 1) v = fmaxf(v, __shfl_xor(v, o));
  return v;
}
__device__ __forceinline__ int lane_id_now() { int l; asm volatile("v_mbcnt_lo_u32_b32 %0, -1, 0\n\tv_mbcnt_hi_u32_b32 %0, -1, %0" : "=v"(l)); return l; }
__device__ __forceinline__ float silu_f(float x) { return x / (1.f + __expf(-x)); }

constexpr size_t MiB = 1u << 20;
constexpr size_t WS_CTL = 0, CTL_ZERO_BYTES = 1 * MiB;
constexpr int CW_BAR = 4096;
constexpr int CW_CNT = 65536;
constexpr size_t WS_WIN_T = 1 * MiB;
constexpr size_t WS_WOUT_T = 34 * MiB;
constexpr size_t WS_WCQ_T = 46 * MiB;
constexpr size_t WS_WCKV_T = 48 * MiB;
constexpr size_t WS_WCO_T = 52 * MiB;
constexpr size_t WS_WR = 54 * MiB;
constexpr size_t WS_SMALL = 55 * MiB;
constexpr size_t WS_ROPE = WS_SMALL, WS_RSX = WS_SMALL + 256 * 1024, WS_RSMEM = WS_RSX + 64 * 1024, WS_RS2 = WS_RSMEM + 64 * 1024, WS_KMEAN = WS_RS2 + 64 * 1024;
constexpr size_t WS_DTRAW = 56 * MiB;
constexpr size_t WS_SS = 58 * MiB;
constexpr size_t WS_MEMB = 62 * MiB;
constexpr size_t WS_XB = 70 * MiB;
constexpr size_t WS_PROJ = 134 * MiB;
constexpr size_t WS_MIXB = 398 * MiB;
constexpr size_t WS_QC = 494 * MiB, WS_OC = 510 * MiB;
constexpr size_t WS_KVC = 526 * MiB;
constexpr size_t WS_WGU_T = 530 * MiB;
constexpr size_t WS_WD_T = 786 * MiB;
constexpr size_t WS_LIST = 914 * MiB;
constexpr size_t WS_TOK = 916 * MiB;
constexpr size_t WS_HACT = WS_PROJ;
constexpr size_t WS_Y = WS_PROJ + 66 * MiB;
constexpr size_t WS_XBCC = 918 * MiB;
constexpr size_t WS_AFTER = 1014 * MiB;
#define XB_TMO      128
#define XB_XCNT(j)  (256  + 64 * (j))
#define XB_XSUB(j)  (1280 + 64 * (j))
#define XB_XGEN(j)  (2304 + 64 * (j))
#define XB_TOP      3328
#define XB_TOPGEN   3392
#define XCD_BAR_WORDS 3456
#define XB_SPIN_CAP (1u << 18)

__device__ __forceinline__ unsigned xb_ld(unsigned* p)              { return __hip_atomic_load(p, __ATOMIC_RELAXED, __HIP_MEMORY_SCOPE_AGENT); }
__device__ __forceinline__ unsigned xb_add(unsigned* p, unsigned v) { return __hip_atomic_fetch_add(p, v, __ATOMIC_RELAXED, __HIP_MEMORY_SCOPE_AGENT); }
__device__ __forceinline__ unsigned xb_xcc_id() { return (unsigned)__builtin_amdgcn_s_getreg((3 << 11) | 20) & 0xFu; }
#define XB_SPIN(cond, bar) do { unsigned _sp = 0; while (cond) { __builtin_amdgcn_s_sleep(1); \
    if ((++_sp & 255u) == 0u) { if (xb_ld(&(bar)[XB_TMO])) break; if (_sp > XB_SPIN_CAP) { atomicAdd(&(bar)[XB_TMO], 1u); break; } } } } while (0)

struct XcdBarrier {
    unsigned* bar; unsigned x;
    volatile LAS unsigned* st;
};

__device__ __forceinline__ XcdBarrier xcd_barrier_post(unsigned* bar, volatile LAS unsigned* st) {
    XcdBarrier b; b.bar = bar; b.x = xb_xcc_id(); b.st = st;
    if (threadIdx.x == 0) (void)xb_add(&bar[XB_XCNT(b.x)], 1u);
    return b;
}
__device__ __forceinline__ void xcd_barrier_complete(unsigned* bar, unsigned x, unsigned& nloc, unsigned& nx) {
    const unsigned G = gridDim.x * gridDim.y * gridDim.z;
    unsigned sum, cnt, mine, sp = 0u;
    for (;;) {
        sum = 0u; cnt = 0u; mine = 0u;
#pragma unroll
        for (unsigned j = 0; j < 16; ++j) { const unsigned c = xb_ld(&bar[XB_XCNT(j)]); sum += c; cnt += (c > 0u) ? 1u : 0u; mine = (j == x) ? c : mine; }
        if (sum == G) break;
        __builtin_amdgcn_s_sleep(1);
        if ((++sp & 255u) == 0u) { if (xb_ld(&bar[XB_TMO])) break; if (sp > XB_SPIN_CAP) { atomicAdd(&bar[XB_TMO], 1u); break; } }
    }
    nloc = mine > 0u ? mine : 1u; nx = cnt > 0u ? cnt : 1u;
}

__device__ __forceinline__ void xcd_barrier(const XcdBarrier& b, const int xb_tid) {
    asm volatile("s_waitcnt vmcnt(0)" ::: "memory");
    __syncthreads();
    if (xb_tid == 0) {
        unsigned* bar = b.bar;
        __builtin_amdgcn_s_waitcnt(0);
        unsigned nloc = b.st[0], nx = b.st[1];
        if (nloc == 0u) { xcd_barrier_complete(bar, b.x, nloc, nx); b.st[0] = nloc; b.st[1] = nx; }
        const unsigned old = xb_add(&bar[XB_XSUB(b.x)], 1u);
        const unsigned gen = old / nloc;
        if (old + 1u == (gen + 1u) * nloc) {
            __builtin_amdgcn_fence(__ATOMIC_RELEASE, "agent");
            asm volatile("s_waitcnt vmcnt(0)" ::: "memory");
            const unsigned og = xb_add(&bar[XB_TOP], 1u);
            const unsigned tg = og / nx;
            if (og + 1u == (tg + 1u) * nx) xb_add(&bar[XB_TOPGEN], 1u);
            else XB_SPIN(xb_ld(&bar[XB_TOPGEN]) == tg, bar);
            __builtin_amdgcn_fence(__ATOMIC_ACQUIRE, "agent");
            xb_add(&bar[XB_XGEN(b.x)], 1u);
            asm volatile("s_waitcnt vmcnt(0)" ::: "memory");
        } else {
            XB_SPIN(xb_ld(&bar[XB_XGEN(b.x)]) == gen, bar);
            __builtin_amdgcn_fence(__ATOMIC_ACQUIRE, "agent");
            asm volatile("s_waitcnt vmcnt(0)" ::: "memory");
        }
    }
    __syncthreads();
}

namespace gm {
constexpr int BM = 256, BK = 64, HALF = 128, HTB = HALF * BK * 2, STAGE_BYTES = 8 * HTB, NXCD = 8, WGM = 8;
__host__ __device__ __forceinline__ int lds_byte(int r, int c) { const int st = (r >> 4) * 2 + (c >> 5), rr = r & 15, cc = c & 31, ob = rr * 64 + cc * 2; return st * 1024 + (ob ^ (((ob >> 9) & 1) << 5)); }
__host__ __device__ __forceinline__ void stage_rc(int b, int& R, int& C) { const int st = b / 1024, sb = b % 1024, swz = sb ^ (((sb >> 9) & 1) << 5); R = (st >> 1) * 16 + swz / 64; C = (st & 1) * 32 + (swz % 64) / 2; }
__host__ __device__ __forceinline__ int perm32(int rho) { const int n = rho >> 4, i = rho & 15; return 8 * (i >> 2) + 4 * n + (i & 3); }

struct Unit { const char* a; const char* b; int pm, pn, kind, ti; };

__device__ __forceinline__ void tile_of(int L, int nM, int nN, int& pm, int& pn) {
    const int nwg = nM * nN; int wgid = L;
    { const int q = nwg / NXCD, r = nwg % NXCD, xcd = wgid % NXCD, off = wgid / NXCD; wgid = (xcd < r ? xcd * (q + 1) : r * (q + 1) + (xcd - r) * q) + off; }
    const int nig = WGM * nN, gid = wgid / nig, fm = gid * WGM, gsz = (nM - fm) < WGM ? (nM - fm) : WGM;
    pm = fm + ((wgid % nig) % gsz); pn = (wgid % nig) / gsz;
}

template <class Epi, class Sched, bool GATHER, bool BTILED = false, bool F8 = false>
__device__ __forceinline__ void gemm_phase(const int tid, LAS unsigned char* lds, const LAS int* tab, const int K, const Sched& S, const Epi& E) {
    const int wid = __builtin_amdgcn_readfirstlane(tid >> 6), lane = tid & 63, wr = wid >> 2, wc = wid & 3, fr = lane & 15, fq = lane >> 4;
    const int nt = K / BK;
    unsigned voffA0[2], voffA1[2], voffB[2];
    const size_t kstep = (size_t)(BK * 2);
    const size_t hstep = (size_t)HALF * K * 2;
    const size_t kstepB = BTILED ? (size_t)(BM * BK * 2) : kstep, hstepB = BTILED ? (size_t)(HALF * BK * 2) : hstep;
#pragma unroll
    for (int i = 0; i < 2; ++i) { int R, C; stage_rc(tid * 16 + i * 8192, R, C); const int Rb = (R & ~31) + perm32(R & 31);
        voffB[i] = BTILED ? (unsigned)(Rb * BK + C) * 2u : (unsigned)(Rb * K + C) * 2u; voffA0[i] = (unsigned)(R * K + C) * 2u; voffA1[i] = 0u; }
#define GM_SETVOFF(u) do { if constexpr (GATHER) { _Pragma("unroll") for (int _i = 0; _i < 2; ++_i) { int R_, C_; stage_rc(tid * 16 + _i * 8192, R_, C_); \
        const int r0_ = tab[(u).ti * 256 + R_], r1_ = tab[(u).ti * 256 + 128 + R_]; voffA0[_i] = (unsigned)(r0_ * K + C_) * 2u; voffA1[_i] = (unsigned)(r1_ * K + C_) * 2u; } } } while (0)
    const unsigned ldsw = (unsigned)wid * 1024u;
    const int aoff = F8 ? lds_byte(wr * 64 + fr, fq * 16) : lds_byte(wr * 64 + fr, fq * 8), boff = F8 ? lds_byte(wc * 32 + fr, fq * 16) : lds_byte(wc * 32 + fr, fq * 8);
#define PG8_SA(b, h) (((b) * 2 + (h)) * HTB)
#define PG8_SB(b, h) ((4 + (b) * 2 + (h)) * HTB)
#define PG8_STAGE(bufoff, gbase, voff) do { _Pragma("unroll") for (int _i = 0; _i < 2; ++_i) \
        __builtin_amdgcn_global_load_lds((const unsigned*)((const char*)(gbase) + (voff)[_i]), (LAS unsigned*)(lds + (bufoff) + ldsw + _i * 8192), 16, 0, 0); } while (0)
#define PG8_LDA8(dst, b, h) do { _Pragma("unroll") for (int m = 0; m < 4; ++m) { const bf16x8 lo_ = *(const LAS bf16x8*)(lds + PG8_SA(b, h) + aoff + m * 2048), hi_ = *(const LAS bf16x8*)(lds + PG8_SA(b, h) + aoff + m * 2048 + 16); \
        dst[m] = __builtin_shufflevector(__builtin_bit_cast(i32x4, lo_), __builtin_bit_cast(i32x4, hi_), 0, 1, 2, 3, 4, 5, 6, 7); } } while (0)
#define PG8_LDB8(dst, b, h) do { _Pragma("unroll") for (int n = 0; n < 2; ++n) { const bf16x8 lo_ = *(const LAS bf16x8*)(lds + PG8_SB(b, h) + boff + n * 2048), hi_ = *(const LAS bf16x8*)(lds + PG8_SB(b, h) + boff + n * 2048 + 16); \
        dst[n] = __builtin_shufflevector(__builtin_bit_cast(i32x4, lo_), __builtin_bit_cast(i32x4, hi_), 0, 1, 2, 3, 4, 5, 6, 7); } } while (0)
#define PG8_MMA8(ai, bj, At, Bt) do { __builtin_amdgcn_s_setprio(1); _Pragma("unroll") for (int m = 0; m < 4; ++m) _Pragma("unroll") for (int n = 0; n < 2; ++n) \
        acc[ai][bj][m][n] = __builtin_amdgcn_mfma_scale_f32_16x16x128_f8f6f4(Bt[n], At[m], acc[ai][bj][m][n], 0, 0, 0, 0, 0, 0); __builtin_amdgcn_s_setprio(0); } while (0)
#define PG8_LDA(dst, b, h) do { _Pragma("unroll") for (int m = 0; m < 4; ++m) _Pragma("unroll") for (int k = 0; k < 2; ++k) dst[m][k] = *(const LAS bf16x8*)(lds + PG8_SA(b, h) + aoff + m * 2048 + k * 1024); } while (0)
#define PG8_LDB(dst, b, h) do { _Pragma("unroll") for (int n = 0; n < 2; ++n) _Pragma("unroll") for (int k = 0; k < 2; ++k) dst[n][k] = *(const LAS bf16x8*)(lds + PG8_SB(b, h) + boff + n * 2048 + k * 1024); } while (0)
#define PG8_MMA(ai, bj, At, Bt) do { __builtin_amdgcn_s_setprio(1); _Pragma("unroll") for (int m = 0; m < 4; ++m) _Pragma("unroll") for (int n = 0; n < 2; ++n) _Pragma("unroll") for (int k = 0; k < 2; ++k) \
        acc[ai][bj][m][n] = __builtin_amdgcn_mfma_f32_16x16x32_bf16(Bt[n][k], At[m][k], acc[ai][bj][m][n], 0, 0, 0); __builtin_amdgcn_s_setprio(0); } while (0)
#define GM_STAGE_A1(bufoff, gbase) do { if constexpr (GATHER) { PG8_STAGE(bufoff, gbase, voffA1); } else { PG8_STAGE(bufoff, (gbase) + hstep, voffA0); } } while (0)
#define PG8_WAIT_V(n) asm volatile("s_waitcnt vmcnt(" #n ")" ::: "memory")
#define PG8_WAIT_L(n) asm volatile("s_waitcnt lgkmcnt(" #n ")" ::: "memory")
#define PG8_BAR __builtin_amdgcn_s_barrier()
#define PG8_SCHED __builtin_amdgcn_sched_barrier(0)
    Unit cur, nxt; int ui = 0;
    if (!S.next(0, cur)) return;
    GM_SETVOFF(cur);
    f32x4 acc[2][2][4][2];
#pragma unroll
    for (int a = 0; a < 2; ++a)
#pragma unroll
        for (int b = 0; b < 2; ++b)
#pragma unroll
            for (int m = 0; m < 4; ++m)
#pragma unroll
                for (int n = 0; n < 2; ++n) acc[a][b][m][n] = (f32x4){0.f, 0.f, 0.f, 0.f};
    bf16x8 At[4][2], B0[2][2], B1[2][2]; i32x8 At8[4], B08[2], B18[2];
    const char* cA = cur.a; const char* cB = cur.b;
    PG8_STAGE(PG8_SB(0, 0), cB, voffB); PG8_STAGE(PG8_SB(0, 1), cB + hstepB, voffB); PG8_STAGE(PG8_SA(0, 0), cA, voffA0); GM_STAGE_A1(PG8_SA(0, 1), cA);
    if (wr == 1) PG8_BAR;
    PG8_WAIT_V(2); PG8_BAR;
    PG8_STAGE(PG8_SB(1, 0), cB + kstepB, voffB); PG8_STAGE(PG8_SA(1, 0), cA + kstep, voffA0); PG8_STAGE(PG8_SB(1, 1), cB + hstepB + kstepB, voffB);
    PG8_WAIT_V(6); PG8_BAR;
    for (;;) {
        const bool has_next = S.next(ui + 1, nxt);
        const char* nA = has_next ? nxt.a : cA; const char* nB = has_next ? nxt.b : cB;
#pragma unroll 1
        for (int t = 0; t < nt; t += 2) {
            const bool last = (t == nt - 2);
            const char* a1 = cA + (size_t)(t + 1) * kstep;
            const char* a2 = last ? nA : cA + (size_t)(t + 2) * kstep; const char* b2 = last ? nB : cB + (size_t)(t + 2) * kstepB;
            const char* a3 = a2 + kstep; const char* b3 = b2 + kstepB;
            if constexpr (F8) {
            PG8_LDB8(B08, 0, 0); PG8_LDB8(B18, 0, 1); PG8_SCHED; PG8_LDA8(At8, 0, 0); GM_STAGE_A1(PG8_SA(1, 1), a1);
            PG8_WAIT_V(8); PG8_WAIT_L(0); PG8_BAR; PG8_MMA8(0, 0, At8, B08); PG8_MMA8(0, 1, At8, B18); PG8_BAR; PG8_SCHED;
            if constexpr (GATHER) { if (last && has_next) { GM_SETVOFF(nxt); } }
            PG8_LDA8(At8, 0, 1); PG8_STAGE(PG8_SB(0, 0), b2, voffB); PG8_STAGE(PG8_SB(0, 1), b2 + hstepB, voffB); PG8_STAGE(PG8_SA(0, 0), a2, voffA0);
            PG8_WAIT_V(8); PG8_WAIT_L(0); PG8_BAR; PG8_MMA8(1, 0, At8, B08); PG8_MMA8(1, 1, At8, B18); PG8_BAR; PG8_SCHED;
            PG8_LDB8(B08, 1, 0); PG8_LDB8(B18, 1, 1); PG8_SCHED; PG8_LDA8(At8, 1, 0); GM_STAGE_A1(PG8_SA(0, 1), a2);
            PG8_WAIT_V(8); PG8_WAIT_L(0); PG8_BAR; PG8_MMA8(0, 0, At8, B08); PG8_MMA8(0, 1, At8, B18); PG8_BAR; PG8_SCHED;
            PG8_LDA8(At8, 1, 1); PG8_STAGE(PG8_SB(1, 0), b3, voffB); PG8_STAGE(PG8_SB(1, 1), b3 + hstepB, voffB); PG8_STAGE(PG8_SA(1, 0), a3, voffA0);
            PG8_WAIT_V(8); PG8_WAIT_L(0); PG8_BAR; PG8_MMA8(1, 0, At8, B08); PG8_MMA8(1, 1, At8, B18); PG8_BAR; PG8_SCHED;
            } else {
            PG8_LDB(B0, 0, 0); PG8_LDB(B1, 0, 1); PG8_SCHED; PG8_LDA(At, 0, 0); GM_STAGE_A1(PG8_SA(1, 1), a1);
            PG8_WAIT_V(8); PG8_WAIT_L(0); PG8_BAR; PG8_MMA(0, 0, At, B0); PG8_MMA(0, 1, At, B1); PG8_BAR; PG8_SCHED;
            if constexpr (GATHER) { if (last && has_next) { GM_SETVOFF(nxt); } }
            PG8_LDA(At, 0, 1); PG8_STAGE(PG8_SB(0, 0), b2, voffB); PG8_STAGE(PG8_SB(0, 1), b2 + hstepB, voffB); PG8_STAGE(PG8_SA(0, 0), a2, voffA0);
            PG8_WAIT_V(8); PG8_WAIT_L(0); PG8_BAR; PG8_MMA(1, 0, At, B0); PG8_MMA(1, 1, At, B1); PG8_BAR; PG8_SCHED;
            PG8_LDB(B0, 1, 0); PG8_LDB(B1, 1, 1); PG8_SCHED; PG8_LDA(At, 1, 0); GM_STAGE_A1(PG8_SA(0, 1), a2);
            PG8_WAIT_V(8); PG8_WAIT_L(0); PG8_BAR; PG8_MMA(0, 0, At, B0); PG8_MMA(0, 1, At, B1); PG8_BAR; PG8_SCHED;
            PG8_LDA(At, 1, 1); PG8_STAGE(PG8_SB(1, 0), b3, voffB); PG8_STAGE(PG8_SB(1, 1), b3 + hstepB, voffB); PG8_STAGE(PG8_SA(1, 0), a3, voffA0);
            PG8_WAIT_V(8); PG8_WAIT_L(0); PG8_BAR; PG8_MMA(1, 0, At, B0); PG8_MMA(1, 1, At, B1); PG8_BAR; PG8_SCHED;
            }
        }
        if (wr == 0) PG8_BAR;
        { int fr_ = fr, fq_ = fq; asm volatile("" : "+v"(fr_), "+v"(fq_));
          E(acc, cur, wr, wc, fr_, fq_); }
        if (!has_next) break;
#pragma unroll
        for (int a = 0; a < 2; ++a)
#pragma unroll
            for (int b = 0; b < 2; ++b)
#pragma unroll
                for (int m = 0; m < 4; ++m)
#pragma unroll
                    for (int n = 0; n < 2; ++n) acc[a][b][m][n] = (f32x4){0.f, 0.f, 0.f, 0.f};
        cur = nxt; cA = nA; cB = nB; ++ui;
        if (wr == 1) PG8_BAR;
    }
    PG8_WAIT_V(0);
    PG8_BAR;
#undef GM_SETVOFF
#undef GM_STAGE_A1
#undef PG8_SA
#undef PG8_SB
#undef PG8_STAGE
#undef PG8_LDA
#undef PG8_LDA8
#undef PG8_LDB8
#undef PG8_MMA8
#undef PG8_LDB
#undef PG8_MMA
#undef PG8_WAIT_V
#undef PG8_WAIT_L
#undef PG8_BAR
#undef PG8_SCHED
}
}
namespace at {
using f32x16 = __attribute__((ext_vector_type(16))) float;
using s16x4 = __attribute__((ext_vector_type(4))) short;
constexpr int D = 128, NW = 8, QBLK = 32, KVBLK = 64;
constexpr float SCALE = 0.088388347648318440f;
constexpr float THR = 8.f;
constexpr int SHM_V = KVBLK * D * 2, SHM_K = KVBLK * D * 2, SHM_ATTN = 2 * SHM_V + 2 * SHM_K + NW * 64 * 4;
constexpr int KM_OFF = SHM_ATTN;
constexpr int QL_OFF = KM_OFF + 4096;
#define KSWZ(row, colB) ((row) * 256 + ((colB) ^ (((row) & 7) << 4)))
#define SBAR() __builtin_amdgcn_sched_barrier(0)
__device__ __forceinline__ int crow(int r, int hi) { return (r & 3) + 8 * (r >> 2) + 4 * hi; }

__device__ __forceinline__ void partialSM(f32x16& p0, f32x16& p1, float& m_reg, float& mn, float& alpha, bool dead) {
  constexpr float C = SCALE * 1.4426950408889634f;
  float pmax = p0[0];
#pragma unroll
  for (int r = 1; r < 16; ++r) pmax = fmaxf(pmax, p0[r]);
#pragma unroll
  for (int r = 0; r < 16; ++r) pmax = fmaxf(pmax, p1[r]);
  { auto rr = __builtin_amdgcn_permlane32_swap(__float_as_uint(pmax), __float_as_uint(pmax), false, false);
    pmax = fmaxf(__uint_as_float(rr[0]), __uint_as_float(rr[1])); }
  if (dead) pmax = -1e30f;
  if (__builtin_expect(__all(pmax - m_reg <= THR / SCALE), 1)) { mn = m_reg; alpha = 1.f; }
  else { mn = fmaxf(m_reg, pmax); alpha = __builtin_amdgcn_exp2f((m_reg - mn) * C); m_reg = mn; }
  const float mnC = dead ? -INFINITY : -mn * C;
#pragma unroll
  for (int r = 0; r < 16; ++r) p0[r] = fmaf(p0[r], C, mnC);
#pragma unroll
  for (int r = 0; r < 16; ++r) p1[r] = fmaf(p1[r], C, mnC);
#pragma unroll
  for (int r = 0; r < 16; ++r) p0[r] = __builtin_amdgcn_exp2f(p0[r]);
}
__device__ __forceinline__ void finishSM(f32x16& p0, f32x16& p1, float alpha, float& l_reg, bf16x8& pa0, bf16x8& pa1, bf16x8& pa2, bf16x8& pa3) {
#pragma unroll
  for (int r = 0; r < 16; ++r) p1[r] = __builtin_amdgcn_exp2f(p1[r]);
  float ps = 0;
#pragma unroll
  for (int r = 0; r < 16; ++r) ps += p0[r];
#pragma unroll
  for (int r = 0; r < 16; ++r) ps += p1[r];
  { auto rr = __builtin_amdgcn_permlane32_swap(__float_as_uint(ps), __float_as_uint(ps), false, false);
    ps = __uint_as_float(rr[0]) + __uint_as_float(rr[1]); }
  l_reg = l_reg * alpha + ps;
#define PK4(P, BASE, OUT) do { unsigned a0 = cvt_pk_bf16(P[BASE + 0], P[BASE + 1]), a1 = cvt_pk_bf16(P[BASE + 2], P[BASE + 3]);   \
    unsigned b0 = cvt_pk_bf16(P[BASE + 4], P[BASE + 5]), b1 = cvt_pk_bf16(P[BASE + 6], P[BASE + 7]);                              \
    auto r0 = __builtin_amdgcn_permlane32_swap(a0, b0, false, false); auto r1 = __builtin_amdgcn_permlane32_swap(a1, b1, false, false); \
    u32x4 w = {r0[0], r1[0], r0[1], r1[1]}; OUT = *reinterpret_cast<bf16x8*>(&w); } while (0)
  PK4(p0, 0, pa0); PK4(p0, 8, pa1); PK4(p1, 0, pa2); PK4(p1, 8, pa3);
#undef PK4
}
template <bool QLDS>
__device__ __forceinline__ void qkt(f32x16& p0, f32x16& p1, const LAS char* Ks, const bf16x8* qr, const LAS char* ql, int r32, int hi) {
  p0 = f32x16{}; p1 = f32x16{};
#pragma unroll
  for (int d0 = 0; d0 < 8; ++d0) { int cb = (d0 * 16 + hi * 8) * 2;
    bf16x8 b0 = *(const LAS bf16x8*)(Ks + KSWZ(r32, cb));
    bf16x8 b1 = *(const LAS bf16x8*)(Ks + KSWZ(32 + r32, cb));
    bf16x8 q; if constexpr (QLDS) q = *(const LAS bf16x8*)(ql + d0 * 8192); else q = qr[d0];
    p0 = __builtin_amdgcn_mfma_f32_32x32x16_bf16(b0, q, p0, 0, 0, 0);
    p1 = __builtin_amdgcn_mfma_f32_32x32x16_bf16(b1, q, p1, 0, 0, 0); }
}
__device__ __forceinline__ int v_st(int k, int c) { const int kk = (k & ~0xC) | ((k & 4) << 1) | ((k & 8) >> 1); return ((kk >> 3) * 4 + (c >> 5)) * 512 + ((kk & 7) * 32 + (c & 31)) * 2; }
__device__ __forceinline__ int v_rd_base(int lane) { return ((lane & 3) << 3) | (((lane >> 2) & 3) << 6) | (((lane >> 4) & 1) << 5) | (((lane >> 5) & 1) << 8); }
constexpr int v_rd_off(int d0, int ks, int half) { return d0 * 512 + ks * 4096 + half * 2048; }
template <int OFF> __device__ __forceinline__ s16x4 tr_read(int vb) {
  s16x4 r; asm volatile("ds_read_b64_tr_b16 %0, %1 offset:%2" : "=&v"(r) : "v"(vb), "i"(OFF) : "memory"); return r;
}
template <int D0> __device__ __forceinline__ void pv_one(f32x16& od, int vb, bf16x8 pa0, bf16x8 pa1, bf16x8 pa2, bf16x8 pa3) {
  const s16x4 l0 = tr_read<v_rd_off(D0, 0, 0)>(vb), h0 = tr_read<v_rd_off(D0, 0, 1)>(vb), l1 = tr_read<v_rd_off(D0, 1, 0)>(vb), h1 = tr_read<v_rd_off(D0, 1, 1)>(vb);
  const s16x4 l2 = tr_read<v_rd_off(D0, 2, 0)>(vb), h2 = tr_read<v_rd_off(D0, 2, 1)>(vb), l3 = tr_read<v_rd_off(D0, 3, 0)>(vb), h3 = tr_read<v_rd_off(D0, 3, 1)>(vb);
  asm volatile("s_waitcnt lgkmcnt(0)" ::: "memory"); SBAR();
#define PK(L, H) (bf16x8){L[0], L[1], L[2], L[3], H[0], H[1], H[2], H[3]}
  od = __builtin_amdgcn_mfma_f32_32x32x16_bf16(pa0, PK(l0, h0), od, 0, 0, 0);
  od = __builtin_amdgcn_mfma_f32_32x32x16_bf16(pa1, PK(l1, h1), od, 0, 0, 0);
  od = __builtin_amdgcn_mfma_f32_32x32x16_bf16(pa2, PK(l2, h2), od, 0, 0, 0);
  od = __builtin_amdgcn_mfma_f32_32x32x16_bf16(pa3, PK(l3, h3), od, 0, 0, 0);
#undef PK
}
__device__ __forceinline__ void pv_d0(f32x16* o, int vb, bf16x8 pa0, bf16x8 pa1, bf16x8 pa2, bf16x8 pa3) {
  pv_one<0>(o[0], vb, pa0, pa1, pa2, pa3); pv_one<1>(o[1], vb, pa0, pa1, pa2, pa3); pv_one<2>(o[2], vb, pa0, pa1, pa2, pa3); pv_one<3>(o[3], vb, pa0, pa1, pa2, pa3);
}

template <bool MOBA>
__device__ __forceinline__ void attn_unit(const int tid, const bf16_t* __restrict__ Qb, const bf16_t* __restrict__ Kh, bf16_t* __restrict__ Ob, int NT, int jb, const float* __restrict__ kmean_bh, LAS char* lds) {
  constexpr int ldq = MOBA ? LDP : CW, ldk = MOBA ? LDP : 2 * CW, ldo = MOBA ? MIXW : CW, VOFF = MOBA ? (C_V - C_K) : CW;
  const bf16_t* __restrict__ Vh = Kh + VOFF;
  const int wid = __builtin_amdgcn_readfirstlane(tid >> 6), lane = tid & 63, r32 = lane & 31, hi = lane >> 5;
  LAS char* V_lds = lds; LAS char* K_lds = lds + 2 * SHM_V;
  LAS float* wsf = (LAS float*)(lds + 2 * SHM_V + 2 * SHM_K) + wid * 64; LAS float* li_l = wsf; LAS float* al_l = wsf + 32;
  float m_reg = -1e30f, l_reg = 0; f32x16 o[4] = {}; bf16x8 qr[8];
  const bf16_t* Qw = Qb + (long)(wid * QBLK + r32) * ldq + hi * 8;
#pragma unroll
  for (int d0 = 0; d0 < 8; ++d0) qr[d0] = *reinterpret_cast<const bf16x8*>(Qw + d0 * 16);
  unsigned selmask = 0;
  if constexpr (MOBA) {
    LAS float* kml = (LAS float*)(lds + KM_OFF);
    __syncthreads();
    for (int i = tid; i < 8 * 128; i += NW * 64) kml[i] = kmean_bh[(i >> 7) * 1024 + (i & 127)];
    __syncthreads();
    float gate[8];
#pragma unroll
    for (int kb = 0; kb < 8; ++kb) {
      float g = 0.f;
      if (kb < jb) {
#pragma unroll
        for (int d0 = 0; d0 < 8; ++d0) { const f32x4 k0 = *(const LAS f32x4*)(kml + kb * 128 + d0 * 16 + hi * 8), k1 = *(const LAS f32x4*)(kml + kb * 128 + d0 * 16 + hi * 8 + 4);
          const u32x4 qw = *reinterpret_cast<const u32x4*>(&qr[d0]);
          g += bflo(qw.x) * k0[0] + bfhi(qw.x) * k0[1] + bflo(qw.y) * k0[2] + bfhi(qw.y) * k0[3] + bflo(qw.z) * k1[0] + bfhi(qw.z) * k1[1] + bflo(qw.w) * k1[2] + bfhi(qw.w) * k1[3]; }
        g += __shfl_xor(g, 32);
      }
      gate[kb] = g;
    }
#pragma unroll
    for (int r = 0; r < 3; ++r) { float best = -INFINITY; int bi = -1;
#pragma unroll
      for (int kb = 0; kb < 8; ++kb) { const bool ok = (kb < jb) && !((selmask >> kb) & 1u) && (gate[kb] > best || bi < 0); if (ok) { best = gate[kb]; bi = kb; } }
      if (bi >= 0) selmask |= 1u << bi; }
  }
  const LAS char* ql = lds + QL_OFF + tid * 16;
  if constexpr (MOBA) {
#pragma unroll
    for (int d0 = 0; d0 < 8; ++d0) *(LAS bf16x8*)(lds + QL_OFF + tid * 16 + d0 * 8192) = qr[d0];
  }
  const int rowb = wid * QBLK + r32;
#define MASK(P0, P1, T, DEAD) do { DEAD = false; if constexpr (MOBA) { const int kb_ = (T) >> 2; \
    if (kb_ < jb) { DEAD = !((selmask >> kb_) & 1u); } \
    else { const int lim_ = rowb - 64 * ((T) - 4 * jb); \
      if (!__all(lim_ >= 63)) { const int lh_ = lim_ - 4 * hi;     \
        _Pragma("unroll") for (int r_ = 0; r_ < 16; ++r_) { if ((r_ & 3) + 8 * (r_ >> 2) > lh_) P0[r_] = -INFINITY; if (32 + (r_ & 3) + 8 * (r_ >> 2) > lh_) P1[r_] = -INFINITY; } } } } } while (0)
  const int sr = tid >> 4, sc = (tid & 15) * 8, vst0 = v_st(sr, sc), vst1 = v_st(32 + sr, sc);
  const int vb0 = (int)(size_t)V_lds + v_rd_base(lane);
  constexpr int SDEPTH = MOBA ? 1 : 2;
  struct { bf16x8 vs0, vs1, ks0, ks1; } sr_[SDEPTH];
#define SLOAD(i, k0) do { sr_[i].vs0 = *reinterpret_cast<const bf16x8*>(&Vh[(long)((k0) + sr) * ldk + sc]); sr_[i].vs1 = *reinterpret_cast<const bf16x8*>(&Vh[(long)((k0) + 32 + sr) * ldk + sc]); \
    sr_[i].ks0 = *reinterpret_cast<const bf16x8*>(&Kh[(long)((k0) + sr) * ldk + sc]); sr_[i].ks1 = *reinterpret_cast<const bf16x8*>(&Kh[(long)((k0) + 32 + sr) * ldk + sc]); } while (0)
#define SWRITE(b, i) do { *(LAS bf16x8*)(V_lds + (b) * SHM_V + vst0) = sr_[i].vs0;          \
    *(LAS bf16x8*)(V_lds + (b) * SHM_V + vst1) = sr_[i].vs1; int kc = sc * 2;               \
    *(LAS bf16x8*)(K_lds + (b) * SHM_K + KSWZ(sr, kc)) = sr_[i].ks0;                       \
    *(LAS bf16x8*)(K_lds + (b) * SHM_K + KSWZ(32 + sr, kc)) = sr_[i].ks1; } while (0)
#define SWAIT() do { if constexpr (SDEPTH == 2) asm volatile("s_waitcnt vmcnt(4)" ::: "memory"); else asm volatile("s_waitcnt vmcnt(0)" ::: "memory"); } while (0)
#define RESC(a) do { if (__any((a) < 1.f)) { if (hi == 0) al_l[r32] = (a); asm volatile("s_waitcnt lgkmcnt(0)" ::: "memory"); \
    _Pragma("unroll") for (int d = 0; d < 4; ++d) _Pragma("unroll") for (int r = 0; r < 16; ++r) o[d][r] *= al_l[crow(r, hi)]; } } while (0)
  f32x16 pA0, pA1, pB0, pB1; float mnA, mnB, alA, alB; bf16x8 pa0, pa1, pa2, pa3; bool deadA, deadB;
  constexpr int SE = 0, SO = SDEPTH - 1;
  if constexpr (!MOBA) __syncthreads();
  SLOAD(SE, 0); asm volatile("s_waitcnt vmcnt(0)" ::: "memory"); SWRITE(0, SE); __syncthreads();
  qkt<MOBA>(pA0, pA1, K_lds, qr, ql, r32, hi); MASK(pA0, pA1, 0, deadA); partialSM(pA0, pA1, m_reg, mnA, alA, deadA);
  SLOAD(SO, KVBLK); if constexpr (SDEPTH == 2) { if (2 < NT) SLOAD(SE, 2 * KVBLK); }
  SWAIT(); SWRITE(1, SO); __syncthreads();
  for (int j = 1; j + 1 < NT; j += 2) {
    SBAR(); qkt<MOBA>(pB0, pB1, K_lds + SHM_K, qr, ql, r32, hi);
    finishSM(pA0, pA1, alA, l_reg, pa0, pa1, pa2, pa3); SBAR();
    SLOAD(SO, (j + SDEPTH) * KVBLK); SBAR();
    pv_d0(o, vb0, pa0, pa1, pa2, pa3); MASK(pB0, pB1, j, deadB); partialSM(pB0, pB1, m_reg, mnB, alB, deadB);
    __syncthreads(); SWAIT(); SWRITE(0, SE);
    RESC(alB); __syncthreads();
    SBAR(); qkt<MOBA>(pA0, pA1, K_lds, qr, ql, r32, hi);
    finishSM(pB0, pB1, alB, l_reg, pa0, pa1, pa2, pa3); SBAR();
    if (SDEPTH == 1 || j + 3 < NT) SLOAD(SE, (j + 1 + SDEPTH) * KVBLK); SBAR();
    pv_d0(o, vb0 + SHM_V, pa0, pa1, pa2, pa3); MASK(pA0, pA1, j + 1, deadA); partialSM(pA0, pA1, m_reg, mnA, alA, deadA);
    __syncthreads(); SWAIT(); SWRITE(1, SO);
    RESC(alA); __syncthreads();
  }
  SBAR(); qkt<MOBA>(pB0, pB1, K_lds + SHM_K, qr, ql, r32, hi);
  finishSM(pA0, pA1, alA, l_reg, pa0, pa1, pa2, pa3); SBAR();
  pv_d0(o, vb0, pa0, pa1, pa2, pa3); MASK(pB0, pB1, NT - 1, deadB); partialSM(pB0, pB1, m_reg, mnB, alB, deadB);
  __syncthreads(); RESC(alB);
  finishSM(pB0, pB1, alB, l_reg, pa0, pa1, pa2, pa3); SBAR();
  pv_d0(o, vb0 + SHM_V, pa0, pa1, pa2, pa3);
  if (hi == 0) li_l[r32] = l_reg; asm volatile("s_waitcnt lgkmcnt(0)" ::: "memory");
  float rli[16];
#pragma unroll
  for (int r = 0; r < 16; ++r) rli[r] = __builtin_amdgcn_rcpf(li_l[crow(r, hi)]);
  if constexpr (MOBA) {
#pragma unroll
    for (int r = 0; r < 16; ++r) {
      float q = 0.f;
#pragma unroll
      for (int d0 = 0; d0 < 4; ++d0) { const float v = o[d0][r] * rli[r]; q += v * v; }
      q += __shfl_xor(q, 1); q += __shfl_xor(q, 2); q += __shfl_xor(q, 4); q += __shfl_xor(q, 8); q += __shfl_xor(q, 16);
      rli[r] *= rsqrtf(q * (1.f / 128.f) + EPS);
    }
  }
  bf16_t* Ow = Ob + (long)(wid * QBLK) * ldo;
#pragma unroll
  for (int r = 0; r < 16; ++r) { const int orow = crow(r, hi);
#pragma unroll
    for (int d0 = 0; d0 < 4; ++d0) Ow[(long)orow * ldo + d0 * 32 + r32] = (bf16_t)(cvt_pk_bf16(o[d0][r] * rli[r], 0.f) & 0xffffu); }
#undef MASK
#undef SLOAD
#undef SWRITE
#undef SWAIT
#undef RESC
}
#undef KSWZ
#undef SBAR
}
namespace sd {
using f32x16 = __attribute__((ext_vector_type(16))) float;
typedef short v4i16_t __attribute__((ext_vector_type(4)));
constexpr int IMG_C = 0, IMG_B = 32768, IMG_X = 65536, IMG_S = 98304, TBL = 114688;
__device__ __forceinline__ unsigned off_b(unsigned row, unsigned ch) { return 256u * row + 16u * (ch ^ (((row & 3) << 2) | ((row >> 2) & 3))); }
__device__ __forceinline__ unsigned row_read_addr(unsigned lane, unsigned s) { return off_b(lane & 31, 2 * s + (lane >> 5)); }
__device__ __forceinline__ unsigned tr_read_addr(unsigned lane, unsigned c, unsigned ks, unsigned t) {
  const unsigned h = lane >> 5, blk = (lane >> 4) & 1, q = (lane & 15) >> 2, p = lane & 3;
  return off_b(16 * ks + 8 * h + 4 * t + q, 4 * c + 2 * blk + (p >> 1)) + 8 * (p & 1);
}
__device__ __forceinline__ unsigned elem_addr(unsigned row, unsigned col) { return (row >> 5) * 8192u + off_b(row & 31, col >> 3) + (col & 7) * 2u; }
__device__ __forceinline__ bf16x8 tr_frag(const LAS char* img, unsigned a0, unsigned a1) {
  const v4i16_t l = __builtin_amdgcn_ds_read_tr16_b64_v4i16((LAS v4i16_t*)(img + a0)), h = __builtin_amdgcn_ds_read_tr16_b64_v4i16((LAS v4i16_t*)(img + a1));
  return (bf16x8){l[0], l[1], l[2], l[3], h[0], h[1], h[2], h[3]};
}
__device__ __forceinline__ int crow(int r, int hi) { return (r & 3) + 8 * (r >> 2) + 4 * hi; }
__device__ __forceinline__ float softplus_f(float r) { return fmaxf(r, 0.f) + log1pf(__expf(-fabsf(r))); }

__device__ __forceinline__ void conv_rows(const u32x4 (&raw)[11], const float* __restrict__ conv_w, const float* __restrict__ conv_b, bf16_t* __restrict__ xbcc, const int tok0, const int ch, const bool live) {
  f32x4 w[5][2];
#pragma unroll
  for (int tp = 0; tp < 4; ++tp) { w[tp][0] = *(const f32x4*)(conv_w + tp * CONVD + ch); w[tp][1] = *(const f32x4*)(conv_w + tp * CONVD + ch + 4); }
  w[4][0] = *(const f32x4*)(conv_b + ch); w[4][1] = *(const f32x4*)(conv_b + ch + 4);
  float ac[4][8];
#pragma unroll
  for (int j = 0; j < 11; ++j) {
    const u32x4 rw = raw[j];
    const float x[8] = {bflo(rw.x), bfhi(rw.x), bflo(rw.y), bfhi(rw.y), bflo(rw.z), bfhi(rw.z), bflo(rw.w), bfhi(rw.w)};
#pragma unroll
    for (int tp = 0; tp < 4; ++tp) {
      const int i = j - tp;
      if (i >= 0 && i < 8) { const int sl = i & 3;
#pragma unroll
        for (int e = 0; e < 8; ++e) ac[sl][e] = (tp == 0 ? w[4][e >> 2][e & 3] : ac[sl][e]) + w[tp][e >> 2][e & 3] * x[e]; }
    }
    if (j >= 3) {
      const int sl = (j - 3) & 3; float o8[8];
#pragma unroll
      for (int e = 0; e < 8; ++e) o8[e] = ac[sl][e] * __builtin_amdgcn_rcpf(1.f + __expf(-ac[sl][e]));
      u32x4 o; o.x = cvt_pk_bf16(o8[0], o8[1]); o.y = cvt_pk_bf16(o8[2], o8[3]); o.z = cvt_pk_bf16(o8[4], o8[5]); o.w = cvt_pk_bf16(o8[6], o8[7]);
      if (live) *(u32x4*)(xbcc + (size_t)(tok0 + j - 3) * CONVD + ch) = o;
    }
  }
}
__device__ __forceinline__ void conv_prepass(const int gtid, const int nthr, const bf16_t* __restrict__ proj, const float* __restrict__ conv_w, const float* __restrict__ conv_b, bf16_t* __restrict__ xbcc) {
  constexpr int NCG = CONVD / 8, NITEM = NCG * (M / 8);
#define CONV_LOADROWS(R, IT) do { const int cg_ = (IT) % NCG, t0_ = ((IT) / NCG) * 8, T0_ = t0_ & (SEQ - 1); const bf16_t* rp_ = proj + (size_t)(t0_ - T0_) * LDP + C_XBC + 8 * cg_; \
    _Pragma("unroll") for (int j_ = 0; j_ < 11; ++j_) { const int T_ = T0_ - 3 + j_; R[j_] = (T_ >= 0) ? *(const u32x4*)(rp_ + (size_t)T_ * LDP) : (u32x4){0u, 0u, 0u, 0u}; } } while (0)
  u32x4 ra[11], rb[11];
  int it = gtid;
  { const int i0 = it < NITEM ? it : NITEM - 1; CONV_LOADROWS(ra, i0); }
#pragma unroll 1
  for (; it < NITEM; it += 2 * nthr) {
    const int it2 = it + nthr, i2 = it2 < NITEM ? it2 : NITEM - 1, it3 = it2 + nthr, i3 = it3 < NITEM ? it3 : NITEM - 1;
    CONV_LOADROWS(rb, i2);
    conv_rows(ra, conv_w, conv_b, xbcc, (it / NCG) * 8, 8 * (it % NCG), true);
    CONV_LOADROWS(ra, i3);
    conv_rows(rb, conv_w, conv_b, xbcc, (i2 / NCG) * 8, 8 * (i2 % NCG), it2 < NITEM);
  }
#undef CONV_LOADROWS
}

__device__ __forceinline__ void ssd_unit(const int tid, const int b, const int h, const bf16_t* __restrict__ proj, const bf16_t* __restrict__ xbcc, const float* __restrict__ dtraw,
                                         const float* __restrict__ dt_bias, const float* __restrict__ a_log, const float* __restrict__ d_skip,
                                         bf16_t* __restrict__ mixb, LAS char* lds) {
  const int wid = __builtin_amdgcn_readfirstlane(tid >> 6), lane = tid & 63, r32 = lane & 31, hi = lane >> 5;
  const int ph = wid & 1, rb = wid < 4 ? 3 - (wid >> 1) : (wid >> 1) - 2;
  LAS char* IC = lds + IMG_C; LAS char* IB = lds + IMG_B; LAS char* IX = lds + IMG_X; LAS char* IS = lds + IMG_S;
  LAS float* Tdt = (LAS float*)(lds + TBL); LAS float* Tacs = Tdt + 2048;
  const int grp = h >> 3;
  const float a = -__expf(a_log[h]), dtb = dt_bias[h], Dh = d_skip[h];
  __syncthreads();
  { const u32x4 z = {0u, 0u, 0u, 0u}; *(LAS u32x4*)(IS + tid * 32) = z; *(LAS u32x4*)(IS + tid * 32 + 16) = z; }
#pragma unroll 1
  for (int cc = 0; cc < 2; ++cc) {
    const int t0 = (wid * 2 + cc) * 128 + 2 * lane;
    const float d0 = softplus_f(dtraw[(size_t)(b * SEQ + t0) * 32 + h] + dtb), d1 = softplus_f(dtraw[(size_t)(b * SEQ + t0 + 1) * 32 + h] + dtb);
    const float v0 = d0 * a, ps = v0 + d1 * a;
    float sc = ps;
#pragma unroll
    for (int o = 1; o < 64; o <<= 1) { const float n = __shfl_up(sc, o); if (lane >= o) sc += n; }
    const float a0 = (sc - ps) + v0, a1 = sc, tot = __shfl(sc, 63);
    Tdt[t0] = d0; Tdt[t0 + 1] = d1; Tacs[t0] = a0; Tacs[t0 + 1] = a1;
  }
  f32x16 S = {};
  const unsigned xr = ((r32 & 3) << 2) | ((r32 >> 2) & 3);
#define RROW(k) (256u * r32 + 16u * ((2u * (k) + hi) ^ xr))
#pragma unroll 1
  for (int c = 0; c < 16; ++c) {
    int tq_ = tid; asm volatile("" : "+v"(tq_));
    const bf16_t* xsrc = xbcc + (size_t)(b * SEQ + c * 128) * CONVD;
    u32x4 rx[2], rB[4], rC[4];
#pragma unroll
    for (int i = 0; i < 2; ++i) rx[i] = *(const u32x4*)(xsrc + (size_t)((tq_ >> 3) + 64 * i) * CONVD + h * 64 + 8 * (tq_ & 7));
#pragma unroll
    for (int i = 0; i < 4; ++i) { rB[i] = *(const u32x4*)(xsrc + (size_t)((tq_ >> 4) + 32 * i) * CONVD + 2048 + grp * 128 + 8 * (tq_ & 15));
      rC[i] = *(const u32x4*)(xsrc + (size_t)((tq_ >> 4) + 32 * i) * CONVD + 2560 + grp * 128 + 8 * (tq_ & 15)); }
    __syncthreads();
    if (c > 0) {
      int lq_ = lane; asm volatile("" : "+v"(lq_)); const int r32 = lq_ & 31, hi = lq_ >> 5;
#pragma unroll
      for (int r = 0; r < 16; ++r) *(LAS bf16_t*)(IS + elem_addr(32 * ph + crow(r, hi), 32 * rb + r32)) = (bf16_t)(cvt_pk_bf16(S[r], 0.f) & 0xffffu);
    }
    {
      const float ace = Tacs[c * 128 + 127];
#pragma unroll
      for (int i = 0; i < 2; ++i) { const unsigned tk = (unsigned)(tq_ >> 3) + 64u * i, trow = tk & 31, xo = ((trow & 3) << 2) | ((trow >> 2) & 3), rowb = IMG_X + (tk >> 5) * 8192u + 256u * trow, cch = tq_ & 7;
        *(LAS u32x4*)(lds + rowb + 16u * (cch ^ xo)) = rx[i];
        const float w2 = Tdt[c * 128 + tk] * __expf(ace - Tacs[c * 128 + tk]);
        u32x4 v; v.x = cvt_pk_bf16(bflo(rx[i].x) * w2, bfhi(rx[i].x) * w2); v.y = cvt_pk_bf16(bflo(rx[i].y) * w2, bfhi(rx[i].y) * w2); v.z = cvt_pk_bf16(bflo(rx[i].z) * w2, bfhi(rx[i].z) * w2); v.w = cvt_pk_bf16(bflo(rx[i].w) * w2, bfhi(rx[i].w) * w2);
        *(LAS u32x4*)(lds + rowb + 16u * ((8u + cch) ^ xo)) = v; }
#pragma unroll
      for (int i = 0; i < 4; ++i) { const unsigned tk = (unsigned)(tq_ >> 4) + 32u * i, trow = tk & 31, xo = ((trow & 3) << 2) | ((trow >> 2) & 3), ro = (tk >> 5) * 8192u + 256u * trow + 16u * ((unsigned)(tq_ & 15) ^ xo);
        *(LAS u32x4*)(lds + IMG_B + ro) = rB[i]; *(LAS u32x4*)(lds + IMG_C + ro) = rC[i]; }
    }
    __syncthreads();
    int lq_ = lane; asm volatile("" : "+v"(lq_));
    const int lane = lq_, r32 = lane & 31, hi = lane >> 5; const unsigned xr = ((r32 & 3) << 2) | ((r32 >> 2) & 3);
    const LAS float* acs = Tacs + c * 128; const LAS float* dts = Tdt + c * 128;
    f32x16 Y = {};
    const float acl = acs[32 * rb + r32];
#pragma unroll 1
    for (int st = 0; st <= rb; ++st) {
      f32x16 Dm = {};
#pragma unroll
      for (int k = 0; k < 8; ++k) { const bf16x8 af = *(const LAS bf16x8*)(IB + st * 8192 + RROW(k)), bq = *(const LAS bf16x8*)(IC + rb * 8192 + RROW(k));
        Dm = __builtin_amdgcn_mfma_f32_32x32x16_bf16(af, bq, Dm, 0, 0, 0); }
#pragma unroll
      for (int q4 = 0; q4 < 4; ++q4) { const f32x4 as4 = *(const LAS f32x4*)(acs + 32 * st + 8 * q4 + 4 * hi), dt4 = *(const LAS f32x4*)(dts + 32 * st + 8 * q4 + 4 * hi);
#pragma unroll
        for (int e = 0; e < 4; ++e) { const int r = 4 * q4 + e; const bool dead = (st == rb) && (8 * q4 + 4 * hi + e > r32);
          const float f = dead ? 0.f : __expf(acl - as4[e]) * dt4[e]; Dm[r] *= f; } }
      bf16x8 pa0, pa1;
#define PK4(P, BASE, OUT) do { unsigned a0_ = cvt_pk_bf16(P[BASE + 0], P[BASE + 1]), a1_ = cvt_pk_bf16(P[BASE + 2], P[BASE + 3]);   \
    unsigned b0_ = cvt_pk_bf16(P[BASE + 4], P[BASE + 5]), b1_ = cvt_pk_bf16(P[BASE + 6], P[BASE + 7]);                              \
    auto r0_ = __builtin_amdgcn_permlane32_swap(a0_, b0_, false, false); auto r1_ = __builtin_amdgcn_permlane32_swap(a1_, b1_, false, false); \
    u32x4 w_ = {r0_[0], r1_[0], r0_[1], r1_[1]}; OUT = *reinterpret_cast<bf16x8*>(&w_); } while (0)
      PK4(Dm, 0, pa0); PK4(Dm, 8, pa1);
#undef PK4
      Y = __builtin_amdgcn_mfma_f32_32x32x16_bf16(pa0, tr_frag(IX + st * 8192, tr_read_addr(lane, ph, 0, 0), tr_read_addr(lane, ph, 0, 1)), Y, 0, 0, 0);
      Y = __builtin_amdgcn_mfma_f32_32x32x16_bf16(pa1, tr_frag(IX + st * 8192, tr_read_addr(lane, ph, 1, 0), tr_read_addr(lane, ph, 1, 1)), Y, 0, 0, 0);
    }
    {
      f32x16 CS = {};
#pragma unroll
      for (int k = 0; k < 8; ++k) { const bf16x8 af = *(const LAS bf16x8*)(IC + rb * 8192 + RROW(k)), bq = *(const LAS bf16x8*)(IS + ph * 8192 + RROW(k));
        CS = __builtin_amdgcn_mfma_f32_32x32x16_bf16(af, bq, CS, 0, 0, 0); }
#pragma unroll
      for (int q4 = 0; q4 < 4; ++q4) { const f32x4 as4 = *(const LAS f32x4*)(acs + 32 * rb + 8 * q4 + 4 * hi);
#pragma unroll
        for (int e = 0; e < 4; ++e) Y[4 * q4 + e] += CS[4 * q4 + e] * __expf(as4[e]); }
    }
    {
      const float dec = __expf(acs[127]);
#pragma unroll
      for (int r = 0; r < 16; ++r) S[r] *= dec;
#pragma unroll
      for (int st = 0; st < 4; ++st)
#pragma unroll
        for (int ks = 0; ks < 2; ++ks) {
          const bf16x8 af = tr_frag(IX + st * 8192, tr_read_addr(lane, 2 + ph, ks, 0), tr_read_addr(lane, 2 + ph, ks, 1));
          const bf16x8 bq = tr_frag(IB + st * 8192, tr_read_addr(lane, rb, ks, 0), tr_read_addr(lane, rb, ks, 1));
          S = __builtin_amdgcn_mfma_f32_32x32x16_bf16(af, bq, S, 0, 0, 0);
        }
    }
    {
      const int p = 32 * ph + r32;
#pragma unroll
      for (int r = 0; r < 16; ++r) {
        const int l = 32 * rb + crow(r, hi); const size_t tok = (size_t)(b * SEQ + c * 128 + l);
        const float xv = bf2f(*(const LAS bf16_t*)(IX + elem_addr(l, p)));
        const float yg = Y[r] + xv * Dh;
        mixb[tok * MIXW + AW + h * 64 + p] = (bf16_t)(cvt_pk_bf16(yg, 0.f) & 0xffffu);
      }
    }
  }
#undef RROW
  __syncthreads();
}
}
constexpr int RING_OFF = 0, RING_BYTES = 131072;
constexpr int TAB_OFF = RING_BYTES;
constexpr int RSL_OFF = TAB_OFF + 8192;
constexpr int MOE_OFF = RSL_OFF + 1024;
constexpr int LDSCTL_OFF = MOE_OFF + 512;
constexpr int MISC_OFF = LDSCTL_OFF + 320;
constexpr int LDS_BYTES = 147456;
static_assert(MISC_OFF + 128 <= LDS_BYTES, "LDS map");
constexpr int NWAVES = 8;

struct Args { const float* in[27]; float* out; unsigned char* ws; float rf[16]; int ph_lo, ph_hi, li, pad; };

struct Frame {
    LAS unsigned char* lds;
    volatile LAS unsigned* MISC;
    int tid, lane, wave, vcu, G;
};

__device__ __forceinline__ void row_to_bf16_rs(const float* xrow, bf16_t* orow, float* rs_out, int lane) {
    const f32x4* xr = (const f32x4*)xrow + lane;
    f32x4 v[8]; float s = 0.f;
#pragma unroll
    for (int j = 0; j < 8; ++j) { v[j] = xr[64 * j]; s += (v[j].x * v[j].x + v[j].y * v[j].y) + (v[j].z * v[j].z + v[j].w * v[j].w); }
    s = wave_sum(s);
    if (lane == 0) *rs_out = rsqrtf(s * (1.f / DM) + EPS);
    u32x2* o8 = (u32x2*)orow + lane;
#pragma unroll
    for (int j = 0; j < 8; ++j) { u32x2 w; w.x = cvt_pk_bf16(v[j].x, v[j].y); w.y = cvt_pk_bf16(v[j].z, v[j].w); o8[64 * j] = w; }
}
struct P0Item { const float* W; const float* sc; bf16_t* dst; int ldw, k0, dK, kd, f8; };
__device__ __forceinline__ void p0_item_load(const P0Item& I, f32x4 (&v)[8], f32x4 (&sv)[2], int lane) {
#pragma unroll
    for (int j = 0; j < 8; ++j) v[j] = __builtin_nontemporal_load((const f32x4*)(I.W + (size_t)(I.k0 + 8 * j + (lane >> 3)) * I.ldw + 4 * (lane & 7)));
    if (I.sc) { sv[0] = *(const f32x4*)(I.sc + I.k0 + 8 * (lane & 7)); sv[1] = *(const f32x4*)(I.sc + I.k0 + 8 * (lane & 7) + 4); }
    else { sv[0] = (f32x4){1.f, 1.f, 1.f, 1.f}; sv[1] = sv[0]; }
}
__device__ __forceinline__ void p0_item_store(const P0Item& I, const f32x4 (&v)[8], const f32x4 (&sv)[2], LAS float* scr, int lane, bool live) {
#pragma unroll
    for (int j = 0; j < 8; ++j) *(LAS f32x4*)(scr + (8 * j + (lane >> 3)) * 36 + 4 * (lane & 7)) = v[j];
    LDS_WAIT(); asm volatile("" ::: "memory");
    const int c = lane & 7;
#pragma unroll
    for (int j = 0; j < 4; ++j) { const int n = (lane >> 3) + 8 * j; const LAS float* s = scr + (8 * c) * 36 + n;
        u32x4 o; o.x = cvt_pk_bf16(s[0 * 36] * sv[0][0], s[1 * 36] * sv[0][1]); o.y = cvt_pk_bf16(s[2 * 36] * sv[0][2], s[3 * 36] * sv[0][3]);
        o.z = cvt_pk_bf16(s[4 * 36] * sv[1][0], s[5 * 36] * sv[1][1]); o.w = cvt_pk_bf16(s[6 * 36] * sv[1][2], s[7 * 36] * sv[1][3]);
        if (I.f8) { u32x2 q; q.x = pk4_fp8(256.f * s[0 * 36] * sv[0][0], 256.f * s[1 * 36] * sv[0][1], 256.f * s[2 * 36] * sv[0][2], 256.f * s[3 * 36] * sv[0][3]);
            q.y = pk4_fp8(256.f * s[4 * 36] * sv[1][0], 256.f * s[5 * 36] * sv[1][1], 256.f * s[6 * 36] * sv[1][2], 256.f * s[7 * 36] * sv[1][3]);
            if (live) __builtin_nontemporal_store(q, (u32x2*)((unsigned char*)I.dst + (size_t)n * I.dK + I.kd + 8 * c)); }
        else if (live) __builtin_nontemporal_store(o, (u32x4*)(I.dst + (size_t)n * I.dK + I.kd + 8 * c)); }
    LDS_WAIT(); asm volatile("" ::: "memory");
}
template <class Dec> __device__ __forceinline__ void p0_items(const Dec& D, const int first, const int stride, const int nitems, LAS float* scr, const int lane) {
#pragma unroll 1
    for (int base = first; base < nitems; base += 4 * stride) {
        P0Item I0, I1, I2, I3; f32x4 v0[8], v1[8], v2[8], v3[8]; f32x4 s0[2], s1[2], s2[2], s3[2];
        const int i1 = base + stride, i2 = base + 2 * stride, i3 = base + 3 * stride;
        const bool h1 = i1 < nitems, h2 = i2 < nitems, h3 = i3 < nitems;
        D(base, I0); D(h1 ? i1 : 0, I1); D(h2 ? i2 : 0, I2); D(h3 ? i3 : 0, I3);
        p0_item_load(I0, v0, s0, lane); p0_item_load(I1, v1, s1, lane); p0_item_load(I2, v2, s2, lane); p0_item_load(I3, v3, s3, lane);
        p0_item_store(I0, v0, s0, scr, lane, true); p0_item_store(I1, v1, s1, scr, lane, h1); p0_item_store(I2, v2, s2, scr, lane, h2); p0_item_store(I3, v3, s3, scr, lane, h3);
    }
}
struct DecIn {
    const float* w_in; const float* nmw; bf16_t* dst;
    __device__ __forceinline__ bool operator()(int r, P0Item& I) const {
        if (r >= 32 * 257) return false;
        const int kb = r / 257, nb = r - kb * 257; I.W = w_in + 32 * nb; I.ldw = INW; I.k0 = 64 * kb; I.sc = nmw; I.dst = dst + (size_t)(32 * nb) * DM; I.dK = DM; I.kd = I.k0; I.f8 = 0; return true;
    }
};
struct DecRest {
    const Args* a; unsigned char* ws;
    __device__ __forceinline__ bool operator()(int r, P0Item& I) const {
        constexpr int I_OUT = 48 * 64, I_CQ = 32 * 16, I_CO = 8 * 64, I_GU = 32 * 32 * 32, I_DN = 32 * 16 * 64;
        const float* const* in = a->in;
        if (r < I_OUT) { const int kb = r / 64, nb = r % 64; I.W = in[11] + 32 * nb; I.ldw = DM; I.k0 = 64 * kb; I.sc = (kb < 16) ? in[9] : (in[10] - AW); I.dst = (bf16_t*)(ws + WS_WOUT_T) + (size_t)(32 * nb) * MIXW; I.dK = MIXW; I.kd = I.k0; I.f8 = 0; return true; } r -= I_OUT;
        if (r < 3 * I_CQ) { const int m = r / I_CQ, q = r - m * I_CQ, kb = q / 16, nb = q % 16; I.W = in[14 + m] + 32 * nb; I.ldw = CW; I.k0 = 64 * kb; I.sc = m == 0 ? in[12] : in[13];
            I.dst = (m == 0 ? (bf16_t*)(ws + WS_WCQ_T) : (bf16_t*)(ws + WS_WCKV_T) + (size_t)(m - 1) * CW * DM) + (size_t)(32 * nb) * DM; I.dK = DM; I.kd = I.k0; I.f8 = 0; return true; } r -= 3 * I_CQ;
        if (r < I_CO) { const int kb = r / 64, nb = r % 64; I.W = in[17] + 32 * nb; I.ldw = DM; I.k0 = 64 * kb; I.sc = nullptr; I.dst = (bf16_t*)(ws + WS_WCO_T) + (size_t)(32 * nb) * CW; I.dK = CW; I.kd = I.k0; I.f8 = 0; return true; } r -= I_CO;
        if (r < 2 * I_GU) { const int up = r >= I_GU; if (up) r -= I_GU; const int e = r >> 10, kb = (r >> 5) & 31, nb = r & 31, n0 = 32 * nb;
            I.W = in[up ? 24 : 23] + (size_t)e * DM * DE + n0; I.ldw = DE; I.k0 = 64 * kb; I.sc = in[18]; I.dst = (bf16_t*)(ws + WS_WGU_T + (size_t)e * 2048 * DM + ((size_t)(((n0 >> 7) * 16 + (kb >> 1)) * 256 + up * 128 + (n0 & 127))) * 128 + (kb & 1) * 64); I.dK = 128; I.kd = 0; I.f8 = 1; return true; } r -= 2 * I_GU;
        if (r < I_DN) { const int e = r >> 10, kb = (r >> 6) & 15, nb = r & 63; I.W = in[25] + (size_t)e * DE * DM + 32 * nb; I.ldw = DM; I.k0 = 64 * kb; I.sc = nullptr; I.dst = (bf16_t*)(ws + WS_WD_T + (size_t)e * 2048 * DE + ((size_t)((((32 * nb) >> 8) * 8 + (kb >> 1)) * 256 + ((32 * nb) & 255))) * 128 + (kb & 1) * 64); I.dK = 128; I.kd = 0; I.f8 = 1; return true; }
        return false;
    }
};
__device__ __forceinline__ void p0a_prologue(Frame& F, const Args& args) {
    LAS float* scr = (LAS float*)(F.lds + RING_OFF + F.wave * 16384);
    const int gw = F.vcu * NWAVES + F.wave, NGW = F.G * NWAVES, lane = F.lane;
    GAS unsigned char* wsg_ = (GAS unsigned char*)args.ws; asm volatile("" : "+s"(wsg_)); unsigned char* ws = (unsigned char*)wsg_;
    { DecIn D{args.in[3], args.in[2], (bf16_t*)(ws + WS_WIN_T)}; p0_items(D, gw, NGW, 32 * 257, scr, lane); }
    { u32x4* z = (u32x4*)((bf16_t*)(ws + WS_WIN_T) + (size_t)INW * DM); const int n16 = (LDP - INW) * DM * 2 / 16;
      for (int i = (F.vcu * NWAVES * 64) + F.tid; i < n16; i += F.G * NWAVES * 64) z[i] = (u32x4){0u, 0u, 0u, 0u}; }
    { float* km = (float*)(ws + WS_KMEAN); for (int i = (F.vcu * NWAVES * 64) + F.tid; i < BATCH * NB * 1024; i += F.G * NWAVES * 64) km[i] = 0.f; }
    { float* tab = (float*)(ws + WS_ROPE);
      for (int i = (F.vcu * NWAVES * 64) + F.tid; i < SEQ * 16; i += F.G * NWAVES * 64) { const int pos = i >> 4, f = i & 15;
        const float ang = (float)pos * args.rf[f]; double r = (double)ang * 0.15915494309189533577; r -= rint(r); const float th = (float)(r * 6.283185307179586477);
        tab[pos * 32 + f] = cosf(th); tab[pos * 32 + 16 + f] = sinf(th); } }
    for (int m = gw; m < M; m += NGW) row_to_bf16_rs(args.in[0] + (size_t)m * DM, (bf16_t*)(ws + WS_XB) + (size_t)m * DM, (float*)(ws + WS_RSX) + m, lane);
}
__device__ __forceinline__ void p0b_share(Frame& F, const Args& args) {
    LAS float* scr = (LAS float*)(F.lds + RING_OFF + F.wave * 16384);
    const int gw = F.vcu * NWAVES + F.wave, NGW = F.G * NWAVES, lane = F.lane;
    GAS unsigned char* wsg_ = (GAS unsigned char*)args.ws; asm volatile("" : "+s"(wsg_)); unsigned char* ws = (unsigned char*)wsg_;
    { DecRest D{&args, ws}; p0_items(D, gw, NGW, 48 * 64 + 3 * 32 * 16 + 8 * 64 + 2 * 32 * 32 * 32 + 32 * 16 * 64, scr, lane); }
    { bf16_t* wh = (bf16_t*)(ws + WS_WR); bf16_t* wl = wh + 48 * DM; const float* nfw = args.in[18];
      for (int i = (F.vcu * NWAVES * 64) + F.tid; i < 48 * DM; i += F.G * NWAVES * 64) { const int n = i >> 11, k = i & (DM - 1);
        const float v = n < NG ? args.in[19][k * NG + n] * nfw[k] : (n < 36 ? args.in[21][k * NE + (n - NG)] * nfw[k] : 0.f);
        const unsigned hb = cvt_pk_bf16(v, 0.f) & 0xffffu; wh[i] = (bf16_t)hb; wl[i] = (bf16_t)(cvt_pk_bf16(v - __uint_as_float(hb << 16), 0.f) & 0xffffu); } }
    for (int m = gw; m < MROWS; m += NGW) row_to_bf16_rs(args.in[1] + (size_t)m * DM, (bf16_t*)(ws + WS_MEMB) + (size_t)m * DM, (float*)(ws + WS_RSMEM) + m, lane);
}

struct SchedG1 {
    const char* A; const char* Bt; int G, c, i0, i1;
    __device__ __forceinline__ bool next(int i, gm::Unit& u) const {
        i += i0; if (i >= i1) return false;
        const int L = i * G + c; if (L >= 64 * 32) return false;
        int pm, pn; gm::tile_of(L, 64, 32, pm, pn);
        u.pm = pm; u.pn = pn; u.kind = 0; u.ti = 0; u.a = A + (size_t)pm * 256 * DM * 2; u.b = Bt + (size_t)pn * 256 * DM * 2; return true;
    }
};
struct EpiG1 {
    bf16_t* proj; float* dtraw; const float* rsx; const float* ropetab; float* kmean;
    __device__ __forceinline__ void operator()(const f32x4 (&acc)[2][2][4][2], const gm::Unit& u, int wr, int wc, int fr, int fq) const {
        const int row0 = u.pm * 256 + wr * 64 + fr;
        const bool rope = (u.pn < 8) && (wc == 0), dtt = (u.pn == 32), ktile = (u.pn >= 4) && (u.pn < 8);
        const float sgn = (fq < 2) ? -1.f : 1.f;
        f32x4 ks[2][2] = {{{0.f, 0.f, 0.f, 0.f}, {0.f, 0.f, 0.f, 0.f}}, {{0.f, 0.f, 0.f, 0.f}, {0.f, 0.f, 0.f, 0.f}}};
#pragma unroll
        for (int ai = 0; ai < 2; ++ai)
#pragma unroll
            for (int m = 0; m < 4; ++m) {
                const int row = row0 + ai * 128 + m * 16; const float rs = rsx[row];
                f32x4 c0 = {1.f, 1.f, 1.f, 1.f}, c1 = c0, s0 = {0.f, 0.f, 0.f, 0.f}, s1 = s0;
                if (rope) { const float* rt = ropetab + (row & (SEQ - 1)) * 32 + 8 * (fq & 1); c0 = *(const f32x4*)rt; c1 = *(const f32x4*)(rt + 4); s0 = *(const f32x4*)(rt + 16); s1 = *(const f32x4*)(rt + 20); }
#pragma unroll
                for (int bj = 0; bj < 2; ++bj) {
                    f32x4 v0 = acc[ai][bj][m][0] * rs, v1 = acc[ai][bj][m][1] * rs;
                    if (rope) {
                        f32x4 p0, p1;
#pragma unroll
                        for (int e = 0; e < 4; ++e) { p0[e] = __shfl_xor(v0[e], 32); p1[e] = __shfl_xor(v1[e], 32); }
                        v0 = v0 * c0 + (p0 * s0) * sgn; v1 = v1 * c1 + (p1 * s1) * sgn;
                    }
                    ks[bj][0] += v0; ks[bj][1] += v1;
                    if (!dtt) { u32x4 w; w.x = cvt_pk_bf16(v0[0], v0[1]); w.y = cvt_pk_bf16(v0[2], v0[3]); w.z = cvt_pk_bf16(v1[0], v1[1]); w.w = cvt_pk_bf16(v1[2], v1[3]);
                        *(u32x4*)(proj + (size_t)row * LDP + u.pn * 256 + bj * 128 + wc * 32 + 8 * fq) = w; }
                    else if (bj == 0 && wc == 0) { float* d = dtraw + (size_t)row * 32 + 8 * fq; *(f32x4*)d = v0; *(f32x4*)(d + 4) = v1; }
                }
                asm volatile("" ::: "memory");
            }
        if (ktile) {
#pragma unroll
            for (int bj = 0; bj < 2; ++bj)
#pragma unroll
                for (int n = 0; n < 2; ++n)
#pragma unroll
                    for (int e = 0; e < 4; ++e) { float s = ks[bj][n][e]; s += __shfl_xor(s, 1); s += __shfl_xor(s, 2); s += __shfl_xor(s, 4); s += __shfl_xor(s, 8);
                        if (fr == 0) atomicAdd(kmean + (size_t)u.pm * 1024 + (u.pn - 4) * 256 + bj * 128 + wc * 32 + 8 * fq + 4 * n + e, s * (1.f / MB)); }
        }
    }
};

struct SchedTiles {
    const char* A; const char* Bt; int nM, nN, K, G, c;
    __device__ __forceinline__ bool next(int i, gm::Unit& u) const {
        const int L = i * G + c; if (L >= nM * nN) return false;
        int pm, pn; gm::tile_of(L, nM, nN, pm, pn);
        u.pm = pm; u.pn = pn; u.kind = 0; u.ti = 0; u.a = A + (size_t)pm * 256 * K * 2; u.b = Bt + (size_t)pn * 256 * K * 2; return true;
    }
};
template <bool Q8> struct EpiRes {
    const float* base; float* outf; bf16_t* hb; float* ss;
    __device__ __forceinline__ void operator()(const f32x4 (&acc)[2][2][4][2], const gm::Unit& u, int wr, int wc, int fr, int fq) const {
        const int row0 = u.pm * 256 + wr * 64 + fr, colb = u.pn * 256 + wc * 32 + 8 * fq;
        f32x4 nb[2][2];
#pragma unroll
        for (int bj = 0; bj < 2; ++bj) { const size_t o = (size_t)row0 * DM + colb + bj * 128; nb[bj][0] = *(const f32x4*)(base + o); nb[bj][1] = *(const f32x4*)(base + o + 4); }
#pragma unroll
        for (int g = 0; g < 8; ++g) {
            const int row = row0 + (g >> 2) * 128 + (g & 3) * 16; float q = 0.f;
            f32x4 cb[2][2];
#pragma unroll
            for (int bj = 0; bj < 2; ++bj) { cb[bj][0] = nb[bj][0]; cb[bj][1] = nb[bj][1]; }
            if (g + 1 < 8) { const int rn = row0 + ((g + 1) >> 2) * 128 + ((g + 1) & 3) * 16;
#pragma unroll
                for (int bj = 0; bj < 2; ++bj) { const size_t o = (size_t)rn * DM + colb + bj * 128; nb[bj][0] = *(const f32x4*)(base + o); nb[bj][1] = *(const f32x4*)(base + o + 4); } }
            asm volatile("" ::: "memory");
#pragma unroll
            for (int bj = 0; bj < 2; ++bj) {
                const size_t o = (size_t)row * DM + colb + bj * 128;
                const f32x4 v0 = acc[g >> 2][bj][g & 3][0] + cb[bj][0], v1 = acc[g >> 2][bj][g & 3][1] + cb[bj][1];
                *(f32x4*)(outf + o) = v0; *(f32x4*)(outf + o + 4) = v1;
                if constexpr (Q8) { u32x2 w8; w8.x = pk4_fp8(v0[0], v0[1], v0[2], v0[3]); w8.y = pk4_fp8(v1[0], v1[1], v1[2], v1[3]); *(u32x2*)((unsigned char*)hb + o) = w8; }
                else { u32x4 w; w.x = cvt_pk_bf16(v0[0], v0[1]); w.y = cvt_pk_bf16(v0[2], v0[3]); w.z = cvt_pk_bf16(v1[0], v1[1]); w.w = cvt_pk_bf16(v1[2], v1[3]); *(u32x4*)(hb + o) = w; }
                q += (v0[0] * v0[0] + v0[1] * v0[1]) + (v0[2] * v0[2] + v0[3] * v0[3]) + (v1[0] * v1[0] + v1[1] * v1[1]) + (v1[2] * v1[2] + v1[3] * v1[3]);
            }
            if (ss) { q += __shfl_xor(q, 16); q += __shfl_xor(q, 32); if (fq == 0) ss[(size_t)row * 32 + u.pn * 4 + wc] = q; }
        }
    }
};
struct SchedQKV {
    const char* A0; const char* B0; const char* A1; const char* B1; int G, c;
    __device__ __forceinline__ bool next(int i, gm::Unit& u) const {
        const int L = i * G + c; int pm, pn;
        if (L < 128) { gm::tile_of(L, 64, 2, pm, pn); u.kind = 0; u.a = A0 + (size_t)pm * 256 * DM * 2; u.b = B0 + (size_t)pn * 256 * DM * 2; }
        else if (L < 160) { gm::tile_of(L - 128, 8, 4, pm, pn); u.kind = 1; u.a = A1 + (size_t)pm * 256 * DM * 2; u.b = B1 + (size_t)pn * 256 * DM * 2; }
        else return false;
        u.pm = pm; u.pn = pn; u.ti = 0; return true;
    }
};
struct EpiScale {
    bf16_t* O0; bf16_t* O1; int ld0, ld1; const LAS float* rsl;
    __device__ __forceinline__ void operator()(const f32x4 (&acc)[2][2][4][2], const gm::Unit& u, int wr, int wc, int fr, int fq) const {
        bf16_t* O = u.kind ? O1 : O0; const int ld = u.kind ? ld1 : ld0;
#pragma unroll
        for (int ai = 0; ai < 2; ++ai)
#pragma unroll
            for (int m = 0; m < 4; ++m) {
                const int r = ai * 128 + wr * 64 + m * 16 + fr; const float rs = rsl[r];
#pragma unroll
                for (int bj = 0; bj < 2; ++bj) {
                    const f32x4 v0 = acc[ai][bj][m][0] * rs, v1 = acc[ai][bj][m][1] * rs;
                    u32x4 w; w.x = cvt_pk_bf16(v0[0], v0[1]); w.y = cvt_pk_bf16(v0[2], v0[3]); w.z = cvt_pk_bf16(v1[0], v1[1]); w.w = cvt_pk_bf16(v1[2], v1[3]);
                    *(u32x4*)(O + (size_t)(u.pm * 256 + r) * ld + u.pn * 256 + bj * 128 + wc * 32 + 8 * fq) = w;
                }
            }
    }
};

__device__ __forceinline__ void moe_tables(LAS int* mt, const int* cnt_g, int tid) {
    if (tid < 32) mt[tid] = cnt_g[tid];
    LDS_WAIT(); __syncthreads();
    if (tid == 0) { int p = 0, o = 0; for (int e = 0; e < NE; ++e) { mt[32 + e] = p; mt[65 + e] = o; const int c = mt[e]; p += 8 * ((c + 255) >> 8); o += c; } mt[32 + NE] = p; mt[65 + NE] = o; }
    LDS_WAIT(); __syncthreads();
}
template <bool GU> struct SchedMoE {
    const LAS int* mt; const char* A; const char* Bt; int G, c;
    __device__ __forceinline__ bool next(int i, gm::Unit& u) const {
        const int L = i * G + c; if (L >= __builtin_amdgcn_readfirstlane(mt[32 + NE])) return false;
        int e = 0;
#pragma unroll 1
        for (int k = 1; k < NE; ++k) if (L >= __builtin_amdgcn_readfirstlane(mt[32 + k])) e = k;
        const int rem = L - __builtin_amdgcn_readfirstlane(mt[32 + e]), te = (__builtin_amdgcn_readfirstlane(mt[e]) + 255) >> 8, pn = rem / te, mtile = rem - pn * te;
        const int slot0 = __builtin_amdgcn_readfirstlane(mt[65 + e]) + mtile * 256;
        u.pm = mtile; u.pn = pn; u.kind = e; u.ti = i;
        if (GU) { u.a = A; u.b = Bt + ((size_t)e * 2048 + pn * 256) * DM; }
        else { u.a = A; u.b = Bt + ((size_t)e * 2048 + pn * 256) * DE; (void)slot0; }
        return true;
    }
};
struct EpiGU {
    bf16_t* Hact; const float* rs2; const LAS int* mt; const LAS int* tab;
    __device__ __forceinline__ void operator()(const f32x4 (&acc)[2][2][4][2], const gm::Unit& u, int wr, int wc, int fr, int fq) const {
        const int e = u.kind, valid = mt[e] - u.pm * 256, slot0 = mt[65 + e] + u.pm * 256;
        float rsv[8];
#pragma unroll
        for (int g = 0; g < 8; ++g) rsv[g] = rs2[tab[u.ti * 256 + (g >> 2) * 128 + wr * 64 + (g & 3) * 16 + fr]];
#pragma unroll
        for (int ai = 0; ai < 2; ++ai)
#pragma unroll
            for (int m = 0; m < 4; ++m) {
                const int r = ai * 128 + wr * 64 + m * 16 + fr;
                if (r < valid) {
                    const float rs = rsv[ai * 4 + m] * (1.f / 256.f);
                    const f32x4 g0 = acc[ai][0][m][0] * rs, g1 = acc[ai][0][m][1] * rs, u0 = acc[ai][1][m][0] * rs, u1 = acc[ai][1][m][1] * rs;
                    float o[8];
#pragma unroll
                    for (int j = 0; j < 4; ++j) { o[j] = g0[j] * __builtin_amdgcn_rcpf(1.f + __expf(-g0[j])) * u0[j]; o[4 + j] = g1[j] * __builtin_amdgcn_rcpf(1.f + __expf(-g1[j])) * u1[j]; }
                    u32x2 w; w.x = pk4_fp8(16.f * o[0], 16.f * o[1], 16.f * o[2], 16.f * o[3]); w.y = pk4_fp8(16.f * o[4], 16.f * o[5], 16.f * o[6], 16.f * o[7]);
                    *(u32x2*)((unsigned char*)Hact + (size_t)(slot0 + r) * DE + u.pn * 128 + wc * 32 + 8 * fq) = w;
                }
            }
    }
};
struct EpiDown {
    bf16_t* Y; const LAS int* mt;
    __device__ __forceinline__ void operator()(const f32x4 (&acc)[2][2][4][2], const gm::Unit& u, int wr, int wc, int fr, int fq) const {
        const int e = u.kind, valid = mt[e] - u.pm * 256, slot0 = mt[65 + e] + u.pm * 256;
#pragma unroll
        for (int ai = 0; ai < 2; ++ai)
#pragma unroll
            for (int m = 0; m < 4; ++m) {
                const int r = ai * 128 + wr * 64 + m * 16 + fr;
                if (r < valid) {
#pragma unroll
                    for (int bj = 0; bj < 2; ++bj) { const f32x4 v0 = acc[ai][bj][m][0] * (1.f / 4096.f), v1 = acc[ai][bj][m][1] * (1.f / 4096.f);
                        u32x4 w; w.x = cvt_pk_bf16(v0[0], v0[1]); w.y = cvt_pk_bf16(v0[2], v0[3]); w.z = cvt_pk_bf16(v1[0], v1[1]); w.w = cvt_pk_bf16(v1[2], v1[3]);
                        *(u32x4*)(Y + (size_t)(slot0 + r) * DM + u.pn * 256 + bj * 128 + wc * 32 + 8 * fq) = w; }
                }
            }
    }
};
__device__ __forceinline__ void final_rows(Frame& F, float* hio, const bf16_t* Y, const int* tok_e, const int* tok_pos, const float* tok_w, const float* fw, const LAS int* mt) {
    const int gw = F.vcu * NWAVES + F.wave, NGW = F.G * NWAVES, lane = F.lane;
    for (int t = gw; t < M; t += NGW) {
        const int e1 = tok_e[2 * t], e2 = tok_e[2 * t + 1];
        const size_t s1 = (size_t)(mt[65 + e1] + tok_pos[2 * t]), s2 = (size_t)(mt[65 + e2] + tok_pos[2 * t + 1]);
        const float w1 = tok_w[2 * t], w2 = tok_w[2 * t + 1];
        f32x4* hr = (f32x4*)(hio + (size_t)t * DM) + 2 * lane;
        const u32x4* y1 = (const u32x4*)(Y + s1 * DM) + lane; const u32x4* y2 = (const u32x4*)(Y + s2 * DM) + lane;
        float v[4][8]; float ss = 0.f;
#pragma unroll
        for (int j = 0; j < 4; ++j) {
            const f32x4 a0 = hr[128 * j], a1 = hr[128 * j + 1]; const u32x4 p = y1[64 * j], q = y2[64 * j];
            const float pa[8] = {bflo(p.x), bfhi(p.x), bflo(p.y), bfhi(p.y), bflo(p.z), bfhi(p.z), bflo(p.w), bfhi(p.w)};
            const float qa[8] = {bflo(q.x), bfhi(q.x), bflo(q.y), bfhi(q.y), bflo(q.z), bfhi(q.z), bflo(q.w), bfhi(q.w)};
            const float ha[8] = {a0[0], a0[1], a0[2], a0[3], a1[0], a1[1], a1[2], a1[3]};
#pragma unroll
            for (int k = 0; k < 8; ++k) { v[j][k] = ha[k] + (w1 * pa[k] + w2 * qa[k]); ss += v[j][k] * v[j][k]; }
        }
        ss = wave_sum(ss);
        const float rs = rsqrtf(ss * (1.f / DM) + EPS);
#pragma unroll
        for (int j = 0; j < 4; ++j) {
            const f32x4 g0 = *((const f32x4*)fw + 2 * lane + 128 * j), g1 = *((const f32x4*)fw + 2 * lane + 128 * j + 1);
            hr[128 * j] = (f32x4){v[j][0] * rs * g0[0], v[j][1] * rs * g0[1], v[j][2] * rs * g0[2], v[j][3] * rs * g0[3]};
            hr[128 * j + 1] = (f32x4){v[j][4] * rs * g1[0], v[j][5] * rs * g1[1], v[j][6] * rs * g1[2], v[j][7] * rs * g1[3]};
        }
    }
}

__device__ __forceinline__ void router_rows(Frame& F, const float* h2, const bf16_t* wrh, const float* b_rg, const float* b_re, float* rs2, int* cnt, int* list, int* tok_e, int* tok_pos, float* tok_w) {
    const int lane = F.lane, tid = F.tid, w = F.wave, ti = lane & 15, kg = lane >> 4;
    LAS float* part = (LAS float*)(F.lds + RING_OFF);
    LAS float* sqp = part + 8 * 16 * 48;
    LAS float* lgt = sqp + 8 * 16;
    const bf16_t* wrl = wrh + 48 * DM;
    for (int g = F.vcu; g < M / 16; g += F.G) {
        const float* hr = h2 + (size_t)(g * 16 + ti) * DM + w * 256 + 8 * kg;
        f32x4 acc[3] = {{0.f, 0.f, 0.f, 0.f}, {0.f, 0.f, 0.f, 0.f}, {0.f, 0.f, 0.f, 0.f}}; float sq = 0.f;
#pragma unroll 2
        for (int s = 0; s < 8; ++s) {
            const f32x4 x0 = *(const f32x4*)(hr + 32 * s), x1 = *(const f32x4*)(hr + 32 * s + 4);
            bf16x8 bh[3], bl[3];
#pragma unroll
            for (int nt = 0; nt < 3; ++nt) { const size_t o = (size_t)(16 * nt + ti) * DM + w * 256 + 32 * s + 8 * kg; bh[nt] = *(const bf16x8*)(wrh + o); bl[nt] = *(const bf16x8*)(wrl + o); }
            sq += (x0[0] * x0[0] + x0[1] * x0[1]) + (x0[2] * x0[2] + x0[3] * x0[3]) + (x1[0] * x1[0] + x1[1] * x1[1]) + (x1[2] * x1[2] + x1[3] * x1[3]);
            u32x4 hw, lw;
            hw.x = cvt_pk_bf16(x0[0], x0[1]); hw.y = cvt_pk_bf16(x0[2], x0[3]); hw.z = cvt_pk_bf16(x1[0], x1[1]); hw.w = cvt_pk_bf16(x1[2], x1[3]);
            lw.x = cvt_pk_bf16(x0[0] - bflo(hw.x), x0[1] - bfhi(hw.x)); lw.y = cvt_pk_bf16(x0[2] - bflo(hw.y), x0[3] - bfhi(hw.y));
            lw.z = cvt_pk_bf16(x1[0] - bflo(hw.z), x1[1] - bfhi(hw.z)); lw.w = cvt_pk_bf16(x1[2] - bflo(hw.w), x1[3] - bfhi(hw.w));
            const bf16x8 ah = *reinterpret_cast<const bf16x8*>(&hw), al = *reinterpret_cast<const bf16x8*>(&lw);
#pragma unroll
            for (int nt = 0; nt < 3; ++nt) { acc[nt] = __builtin_amdgcn_mfma_f32_16x16x32_bf16(ah, bh[nt], acc[nt], 0, 0, 0); acc[nt] = __builtin_amdgcn_mfma_f32_16x16x32_bf16(ah, bl[nt], acc[nt], 0, 0, 0);
                acc[nt] = __builtin_amdgcn_mfma_f32_16x16x32_bf16(al, bh[nt], acc[nt], 0, 0, 0); }
        }
        sq += __shfl_xor(sq, 16); sq += __shfl_xor(sq, 32);
        __syncthreads();
#pragma unroll
        for (int nt = 0; nt < 3; ++nt)
#pragma unroll
            for (int r = 0; r < 4; ++r) part[(w * 16 + 4 * kg + r) * 48 + 16 * nt + ti] = acc[nt][r];
        if (kg == 0) sqp[w * 16 + ti] = sq;
        __syncthreads();
        for (int i = tid; i < 16 * 48 + 16; i += NWAVES * 64) { float s = 0.f;
            if (i < 16 * 48) {
#pragma unroll
                for (int ww = 0; ww < 8; ++ww) s += part[ww * 16 * 48 + i]; }
            else {
#pragma unroll
                for (int ww = 0; ww < 8; ++ww) s += sqp[ww * 16 + (i - 16 * 48)]; }
            lgt[i] = s; }
        __syncthreads();
        if (tid < 16) {
            const int tt = g * 16 + tid; const LAS float* lg = lgt + tid * 48;
            const float rs = rsqrtf(lgt[16 * 48 + tid] * (1.f / DM) + EPS);
            float gm_ = -INFINITY; int gi = 0; float gv[4];
#pragma unroll
            for (int i = 0; i < 4; ++i) { gv[i] = lg[i] * rs + b_rg[i]; if (gv[i] > gm_) { gm_ = gv[i]; gi = i; } }
            float gs = 0.f;
#pragma unroll
            for (int i = 0; i < 4; ++i) gs += __expf(gv[i] - gm_);
            const float gwt = 1.f / gs;
            float e1 = -INFINITY, e2 = -INFINITY; int i1 = 0, i2 = 0;
#pragma unroll
            for (int i = 0; i < 8; ++i) { const float vv = lg[4 + gi * 8 + i] * rs + b_re[gi * 8 + i]; if (vv > e1) { e2 = e1; i2 = i1; e1 = vv; i1 = i; } else if (vv > e2) { e2 = vv; i2 = i; } }
            const float p2 = 1.f / (1.f + __expf(e1 - e2)), p1 = 1.f - p2;
            const int ea = gi * 8 + i1, eb = gi * 8 + i2;
            const int pa = atomicAdd(&cnt[ea], 1), pb = atomicAdd(&cnt[eb], 1);
            list[ea * M + pa] = tt; list[eb * M + pb] = tt;
            tok_e[tt * 2] = ea; tok_e[tt * 2 + 1] = eb; tok_pos[tt * 2] = pa; tok_pos[tt * 2 + 1] = pb; tok_w[tt * 2] = gwt * p1; tok_w[tt * 2 + 1] = gwt * p2; rs2[tt] = rs;
        }
    }
    __syncthreads();
}

__device__ __forceinline__ void dt_rows(Frame& F, const bf16_t* xb, const bf16_t* wdt, const float* rsx, float* dtraw) {
    const int lane = F.lane, tid = F.tid, w = F.wave, ti = lane & 15, kg = lane >> 4;
    LAS float* part = (LAS float*)(F.lds + RING_OFF);
    for (int g = F.vcu; g < M / 16; g += F.G) {
        const bf16_t* ar = xb + (size_t)(g * 16 + ti) * DM + w * 256 + 8 * kg;
        f32x4 acc[2] = {{0.f, 0.f, 0.f, 0.f}, {0.f, 0.f, 0.f, 0.f}};
        bf16x8 af[8], b0[8], b1[8];
#pragma unroll
        for (int s = 0; s < 8; ++s) { af[s] = *(const bf16x8*)(ar + 32 * s); b0[s] = *(const bf16x8*)(wdt + (size_t)ti * DM + w * 256 + 32 * s + 8 * kg); b1[s] = *(const bf16x8*)(wdt + (size_t)(16 + ti) * DM + w * 256 + 32 * s + 8 * kg); }
#pragma unroll
        for (int s = 0; s < 8; ++s) { acc[0] = __builtin_amdgcn_mfma_f32_16x16x32_bf16(af[s], b0[s], acc[0], 0, 0, 0); acc[1] = __builtin_amdgcn_mfma_f32_16x16x32_bf16(af[s], b1[s], acc[1], 0, 0, 0); }
        __syncthreads();
#pragma unroll
        for (int nt = 0; nt < 2; ++nt)
#pragma unroll
            for (int r = 0; r < 4; ++r) part[(w * 16 + 4 * kg + r) * 32 + 16 * nt + ti] = acc[nt][r];
        __syncthreads();
        { float s = 0.f;
#pragma unroll
          for (int ww = 0; ww < 8; ++ww) s += part[ww * 512 + tid];
          const int tok = g * 16 + (tid >> 5); dtraw[(size_t)tok * 32 + (tid & 31)] = s * rsx[tok]; }
    }
    __syncthreads();
}

__device__ __forceinline__ void gnorm_rows(Frame& F, bf16_t* mixb, const bf16_t* proj) {
    const int gw = F.vcu * NWAVES + F.wave, NGW = F.G * NWAVES, lane = F.lane;
#pragma unroll 2
    for (int tok = gw; tok < M; tok += NGW) {
        u32x4* p = (u32x4*)(mixb + (size_t)tok * MIXW + AW) + lane; const u32x4* zp = (const u32x4*)(proj + (size_t)tok * LDP + C_Z) + lane;
        u32x4 w[4], zw[4]; float v[4][8]; float q[4];
#pragma unroll
        for (int g = 0; g < 4; ++g) { w[g] = p[64 * g]; zw[g] = zp[64 * g]; }
#pragma unroll
        for (int g = 0; g < 4; ++g) { float z[8] = {bflo(zw[g].x), bfhi(zw[g].x), bflo(zw[g].y), bfhi(zw[g].y), bflo(zw[g].z), bfhi(zw[g].z), bflo(zw[g].w), bfhi(zw[g].w)};
#pragma unroll
            for (int e = 0; e < 8; ++e) z[e] = z[e] * __builtin_amdgcn_rcpf(1.f + __expf(-z[e]));
            v[g][0] = bflo(w[g].x) * z[0]; v[g][1] = bfhi(w[g].x) * z[1]; v[g][2] = bflo(w[g].y) * z[2]; v[g][3] = bfhi(w[g].y) * z[3]; v[g][4] = bflo(w[g].z) * z[4]; v[g][5] = bfhi(w[g].z) * z[5]; v[g][6] = bflo(w[g].w) * z[6]; v[g][7] = bfhi(w[g].w) * z[7];
            q[g] = (v[g][0] * v[g][0] + v[g][1] * v[g][1]) + (v[g][2] * v[g][2] + v[g][3] * v[g][3]) + (v[g][4] * v[g][4] + v[g][5] * v[g][5]) + (v[g][6] * v[g][6] + v[g][7] * v[g][7]); }
#pragma unroll
        for (int o = 1; o < 64; o <<= 1) {
#pragma unroll
            for (int g = 0; g < 4; ++g) q[g] += __shfl_xor(q[g], o); }
#pragma unroll
        for (int g = 0; g < 4; ++g) { const float rs = rsqrtf(q[g] * (1.f / 512.f) + EPS); u32x4 o;
            o.x = cvt_pk_bf16(v[g][0] * rs, v[g][1] * rs); o.y = cvt_pk_bf16(v[g][2] * rs, v[g][3] * rs); o.z = cvt_pk_bf16(v[g][4] * rs, v[g][5] * rs); o.w = cvt_pk_bf16(v[g][6] * rs, v[g][7] * rs);
            p[64 * g] = o; }
    }
}

#ifndef REP_P0
#define REP_P0 1
#endif
#ifndef REP_P0B
#define REP_P0B 1
#endif
#ifndef REP_G1
#define REP_G1 1
#endif
#ifndef REP_SSD
#define REP_SSD 1
#endif
#ifndef REP_MOE
#define REP_MOE 1
#endif
#ifndef REP_ATT
#define REP_ATT 1
#endif
#ifndef REP_G2
#define REP_G2 1
#endif
__global__ void __launch_bounds__(NWAVES * 64, 2) fwd(Args args) {
    extern __shared__ __attribute__((aligned(16))) unsigned char lds_raw[];
    Frame F;
    F.lds = (LAS unsigned char*)lds_raw;
    F.MISC = (volatile LAS unsigned*)(F.lds + MISC_OFF);
    F.tid = threadIdx.x; F.lane = F.tid & 63; F.wave = __builtin_amdgcn_readfirstlane(F.tid >> 6);
    F.G = gridDim.x; { const int bx = blockIdx.x; F.vcu = (F.G % 8 == 0) ? (bx % 8) * (F.G / 8) + bx / 8 : bx; }
    for (int u = F.tid; u < (LDS_BYTES - LDSCTL_OFF) / 4; u += NWAVES * 64) ((LAS unsigned*)(F.lds + LDSCTL_OFF))[u] = 0u;
    __syncthreads();
    (void)xcd_barrier_post((unsigned*)(args.ws + WS_CTL) + CW_BAR + args.li * XCD_BAR_WORDS, F.MISC + 8);
#define GRID_BAR() do { GAS unsigned char* wb_ = (GAS unsigned char*)args.ws; asm volatile("" : "+s"(wb_)); XcdBarrier b_; \
        b_.bar = (unsigned*)((unsigned char*)wb_ + WS_CTL) + CW_BAR + args.li * XCD_BAR_WORDS; b_.x = xb_xcc_id(); b_.st = F.MISC + 8; xcd_barrier(b_, F.wave * 64 + lane_id_now()); } while (0)
    const int lo = args.ph_lo, hi = args.ph_hi;
#define IN(k) (lo <= (k) && (k) < hi)
#define BOTH(k) (IN(k) && IN((k) + 1))
#define PHASE_WS() F.lane = lane_id_now(); F.tid = F.wave * 64 + F.lane; GAS unsigned char* wsg_ = (GAS unsigned char*)args.ws; asm volatile("" : "+s"(wsg_)); unsigned char* ws = (unsigned char*)wsg_
    if (IN(0)) { F.lane = lane_id_now(); F.tid = F.wave * 64 + F.lane;
p0a_prologue(F, args); if constexpr (REP_P0 > 1) p0a_prologue(F, args); if (BOTH(0)) GRID_BAR(); }
    if (IN(1)) {
        PHASE_WS();
        const int rsplit = (F.vcu >> 5) & 7;
        EpiG1 E{(bf16_t*)(ws + WS_PROJ), (float*)(ws + WS_DTRAW), (const float*)(ws + WS_RSX), (const float*)(ws + WS_ROPE), (float*)(ws + WS_KMEAN)};
        { SchedG1 S{(const char*)(ws + WS_XB), (const char*)(ws + WS_WIN_T), F.G, (int)blockIdx.x, 0, rsplit};
          gm::gemm_phase<EpiG1, SchedG1, false>(F.tid, F.lds + RING_OFF, (const LAS int*)(F.lds + TAB_OFF), DM, S, E); }
        __syncthreads();
        p0b_share(F, args);
        if constexpr (REP_P0B > 1) { __syncthreads(); p0b_share(F, args); }
        __syncthreads();
        { F.lane = lane_id_now(); F.tid = F.wave * 64 + F.lane;
          SchedG1 S{(const char*)(ws + WS_XB), (const char*)(ws + WS_WIN_T), F.G, (int)blockIdx.x, rsplit, 1 << 20};
          gm::gemm_phase<EpiG1, SchedG1, false>(F.tid, F.lds + RING_OFF, (const LAS int*)(F.lds + TAB_OFF), DM, S, E); }
        if (BOTH(1)) GRID_BAR();
    }
    if (IN(2)) {
        PHASE_WS();
        dt_rows(F, (const bf16_t*)(ws + WS_XB), (const bf16_t*)(ws + WS_WIN_T) + (size_t)C_DT * DM, (const float*)(ws + WS_RSX), (float*)(ws + WS_DTRAW));
        sd::conv_prepass(F.vcu * NWAVES * 64 + F.tid, F.G * NWAVES * 64, (const bf16_t*)(ws + WS_PROJ), args.in[4], args.in[5], (bf16_t*)(ws + WS_XBCC));
        if (BOTH(2)) GRID_BAR();
    }
    if (IN(3)) {
        PHASE_WS();
        for (int L = F.vcu; L < BATCH * SH; L += F.G)
            sd::ssd_unit(F.tid, L / SH, L % SH, (const bf16_t*)(ws + WS_PROJ), (const bf16_t*)(ws + WS_XBCC), (const float*)(ws + WS_DTRAW), args.in[6], args.in[7], args.in[8],
                         (bf16_t*)(ws + WS_MIXB), (LAS char*)(F.lds + RING_OFF));
        if constexpr (REP_SSD > 1) {
        for (int L = F.vcu; L < BATCH * SH; L += F.G)
            sd::ssd_unit(F.tid, L / SH, L % SH, (const bf16_t*)(ws + WS_PROJ), (const bf16_t*)(ws + WS_XBCC), (const float*)(ws + WS_DTRAW), args.in[6], args.in[7], args.in[8],
                         (bf16_t*)(ws + WS_MIXB), (LAS char*)(F.lds + RING_OFF));
        }
        if (BOTH(3)) GRID_BAR();
    }
    if (IN(4)) {
        PHASE_WS();
        for (int L = F.vcu; L < BATCH * AH * 4; L += F.G) {
            const int b = L >> 5, h = (L >> 2) & 7, pi = L & 3;
            const bf16_t* pb = (const bf16_t*)(ws + WS_PROJ) + (size_t)b * SEQ * LDP + h * HD;
#pragma unroll 1
            for (int k = 0; k < 2; ++k) { const int jb = k ? pi : 7 - pi;
                at::attn_unit<true>(F.tid, pb + (size_t)jb * MB * LDP + C_Q, pb + C_K, (bf16_t*)(ws + WS_MIXB) + (size_t)(b * SEQ + jb * MB) * MIXW + h * HD,
                                    4 * (jb + 1), jb, (const float*)(ws + WS_KMEAN) + (size_t)b * NB * 1024 + h * HD, (LAS char*)(F.lds + RING_OFF)); }
        }
        if constexpr (REP_ATT > 1) {
        for (int L = F.vcu; L < BATCH * AH * 4; L += F.G) {
            const int b = L >> 5, h = (L >> 2) & 7, pi = L & 3;
            const bf16_t* pb = (const bf16_t*)(ws + WS_PROJ) + (size_t)b * SEQ * LDP + h * HD;
#pragma unroll 1
            for (int k = 0; k < 2; ++k) { const int jb = k ? pi : 7 - pi;
                at::attn_unit<true>(F.tid, pb + (size_t)jb * MB * LDP + C_Q, pb + C_K, (bf16_t*)(ws + WS_MIXB) + (size_t)(b * SEQ + jb * MB) * MIXW + h * HD,
                                    4 * (jb + 1), jb, (const float*)(ws + WS_KMEAN) + (size_t)b * NB * 1024 + h * HD, (LAS char*)(F.lds + RING_OFF)); }
        }
        }
        __syncthreads();
        gnorm_rows(F, (bf16_t*)(ws + WS_MIXB), (const bf16_t*)(ws + WS_PROJ));
        if (BOTH(4)) GRID_BAR();
    }
    if (IN(5)) {
        PHASE_WS();
        SchedTiles S{(const char*)(ws + WS_MIXB), (const char*)(ws + WS_WOUT_T), 64, 8, MIXW, F.G, (int)blockIdx.x};
        EpiRes<false> E{args.in[0], args.out, (bf16_t*)(ws + WS_XB), (float*)(ws + WS_SS)};
        gm::gemm_phase<EpiRes<false>, SchedTiles, false>(F.tid, F.lds + RING_OFF, (const LAS int*)(F.lds + TAB_OFF), MIXW, S, E);
        if constexpr (REP_G2 > 1) { __syncthreads(); gm::gemm_phase<EpiRes<false>, SchedTiles, false>(F.tid, F.lds + RING_OFF, (const LAS int*)(F.lds + TAB_OFF), MIXW, S, E); }
        if (BOTH(5)) GRID_BAR();
    }
    if (IN(6)) {
        PHASE_WS();
        SchedQKV S{(const char*)(ws + WS_XB), (const char*)(ws + WS_WCQ_T), (const char*)(ws + WS_MEMB), (const char*)(ws + WS_WCKV_T), F.G, (int)blockIdx.x};
        gm::Unit u0; LAS float* rsl = (LAS float*)(F.lds + RSL_OFF);
        if (S.next(0, u0) && F.tid < 256) {
            const int row = u0.pm * 256 + F.tid;
            if (u0.kind == 0) { const f32x4* p = (const f32x4*)((const float*)(ws + WS_SS) + (size_t)row * 32); float q = 0.f;
#pragma unroll
                for (int j = 0; j < 8; ++j) { const f32x4 v = p[j]; q += (v[0] + v[1]) + (v[2] + v[3]); }
                rsl[F.tid] = rsqrtf(q * (1.f / DM) + EPS); }
            else rsl[F.tid] = ((const float*)(ws + WS_RSMEM))[row];
        }
        VM_WAIT(); LDS_WAIT(); __syncthreads();
        EpiScale E{(bf16_t*)(ws + WS_QC), (bf16_t*)(ws + WS_KVC), CW, 2 * CW, rsl};
        gm::gemm_phase<EpiScale, SchedQKV, false>(F.tid, F.lds + RING_OFF, (const LAS int*)(F.lds + TAB_OFF), DM, S, E);
        if (BOTH(6)) GRID_BAR();
    }
    if (IN(7)) {
        PHASE_WS();
        for (int L = F.vcu; L < BATCH * CH * 8; L += F.G) {
            const int b = L >> 5, h = (L >> 3) & 3, qt = L & 7;
            const bf16_t* kb_ = (const bf16_t*)(ws + WS_KVC) + (size_t)b * MEM * (2 * CW) + h * CHD;
            at::attn_unit<false>(F.tid, (const bf16_t*)(ws + WS_QC) + (size_t)(b * SEQ + qt * 256) * CW + h * CHD, kb_,
                                 (bf16_t*)(ws + WS_OC) + (size_t)(b * SEQ + qt * 256) * CW + h * CHD, 4, 0, nullptr, (LAS char*)(F.lds + RING_OFF));
        }
        __syncthreads();
        if (BOTH(7)) GRID_BAR();
    }
    if (IN(8)) {
        PHASE_WS();
        SchedTiles S{(const char*)(ws + WS_OC), (const char*)(ws + WS_WCO_T), 64, 8, CW, F.G, (int)blockIdx.x};
        EpiRes<true> E{args.out, args.out, (bf16_t*)(ws + WS_XB), nullptr};
        gm::gemm_phase<EpiRes<true>, SchedTiles, false>(F.tid, F.lds + RING_OFF, (const LAS int*)(F.lds + TAB_OFF), CW, S, E);
        if (BOTH(8)) GRID_BAR();
    }
    if (IN(9)) {
        PHASE_WS();
        int* tok_e = (int*)(ws + WS_TOK);
        router_rows(F, args.out, (const bf16_t*)(ws + WS_WR), args.in[20], args.in[22], (float*)(ws + WS_RS2), (int*)(ws + WS_CTL) + CW_CNT, (int*)(ws + WS_LIST), tok_e, tok_e + 2 * M, (float*)(tok_e + 4 * M));
        if (BOTH(9)) GRID_BAR();
    }
    if (IN(10)) {
        PHASE_WS();
        LAS int* mt = (LAS int*)(F.lds + MOE_OFF); LAS int* tab = (LAS int*)(F.lds + TAB_OFF);
        moe_tables(mt, (const int*)(ws + WS_CTL) + CW_CNT, F.tid);
        SchedMoE<true> S{mt, (const char*)(ws + WS_XB), (const char*)(ws + WS_WGU_T), F.G, F.vcu};
        { const int* list = (const int*)(ws + WS_LIST); gm::Unit u;
          for (int i = 0; i < 8 && S.next(i, u); ++i) if (F.tid < 256) { const int rg = u.pm * 256 + F.tid; tab[i * 256 + F.tid] = list[u.kind * M + (rg < mt[u.kind] ? rg : 0)]; } }
        VM_WAIT(); LDS_WAIT(); __syncthreads();
        EpiGU E{(bf16_t*)(ws + WS_HACT), (const float*)(ws + WS_RS2), mt, tab};
gm::gemm_phase<EpiGU, SchedMoE<true>, true, true, true>(F.tid, F.lds + RING_OFF, tab, DM / 2, S, E);
        if constexpr (REP_MOE > 1) { __syncthreads(); gm::gemm_phase<EpiGU, SchedMoE<true>, true, true, true>(F.tid, F.lds + RING_OFF, tab, DM / 2, S, E); }
        if (BOTH(10)) GRID_BAR();
    }
    if (IN(11)) {
        PHASE_WS();
        LAS int* mt = (LAS int*)(F.lds + MOE_OFF);
        moe_tables(mt, (const int*)(ws + WS_CTL) + CW_CNT, F.tid);
        LAS int* tab = (LAS int*)(F.lds + TAB_OFF);
        SchedMoE<false> S{mt, (const char*)(ws + WS_HACT), (const char*)(ws + WS_WD_T), F.G, F.vcu};
        { gm::Unit u;
          for (int i = 0; i < 8 && S.next(i, u); ++i) if (F.tid < 256) tab[i * 256 + F.tid] = mt[65 + u.kind] + u.pm * 256 + F.tid; }
        LDS_WAIT(); __syncthreads();
        EpiDown E{(bf16_t*)(ws + WS_Y), mt};
        gm::gemm_phase<EpiDown, SchedMoE<false>, true, true, true>(F.tid, F.lds + RING_OFF, tab, DE / 2, S, E);
        if constexpr (REP_MOE > 1) { __syncthreads(); gm::gemm_phase<EpiDown, SchedMoE<false>, true, true, true>(F.tid, F.lds + RING_OFF, tab, DE / 2, S, E); }
        if (BOTH(11)) GRID_BAR();
    }
    if (IN(12)) {
        PHASE_WS();
        LAS int* mt = (LAS int*)(F.lds + MOE_OFF);
        moe_tables(mt, (const int*)(ws + WS_CTL) + CW_CNT, F.tid);
        const int* tok_e = (const int*)(ws + WS_TOK);
        final_rows(F, args.out, (const bf16_t*)(ws + WS_Y), tok_e, tok_e + 2 * M, (const float*)(tok_e + 4 * M), args.in[26], mt);
    }
#undef IN
#undef BOTH
}
extern "C" void kernel_launch(void* const* d_in, const int* in_sizes, int n_in, void* d_out, int out_size, void* d_ws, size_t ws_size, hipStream_t stream) {
  static int grid = 0;
  static float rfv[16];
  if (grid == 0) {
    int dev = 0, cus = 0;
    if (hipGetDevice(&dev) != hipSuccess || hipDeviceGetAttribute(&cus, hipDeviceAttributeMultiprocessorCount, dev) != hipSuccess) { fprintf(stderr, "kernel_launch: device query failed\n"); grid = -1; return; }
    if (hipFuncSetAttribute((const void*)fwd, hipFuncAttributeMaxDynamicSharedMemorySize, LDS_BYTES) != hipSuccess) { fprintf(stderr, "kernel_launch: hipFuncSetAttribute failed\n"); grid = -1; return; }
    int per_cu = 0;
    if (hipOccupancyMaxActiveBlocksPerMultiprocessor(&per_cu, (const void*)fwd, NWAVES * 64, LDS_BYTES) != hipSuccess || per_cu < 1) fprintf(stderr, "kernel_launch: occupancy query says %d\n", per_cu);
    (void)hipGetLastError();
    for (int i = 0; i < 16; ++i) rfv[i] = (float)pow(500000.0, -(double)i / 16.0);
    grid = cus;
  }
  if (grid < 0) return;
  float* out = (float*)d_out;
  unsigned char* ws = (unsigned char*)d_ws;
  (void)hipMemsetAsync(ws + WS_CTL, 0, CTL_ZERO_BYTES, stream);
  Args a{};
  for (int i = 0; i < 27; ++i) a.in[i] = (const float*)d_in[i];
  a.out = out; a.ws = ws; for (int i = 0; i < 16; ++i) a.rf[i] = rfv[i];
  a.ph_lo = 0; a.ph_hi = 13; a.li = 0;
  hipLaunchKernelGGL(fwd, dim3(grid), dim3(NWAVES * 64), LDS_BYTES, stream, a);
}
```

```cpp
#include <hip/hip_runtime.h>
#include <stdint.h>
#include <math.h>
#include <cstdio>

constexpr int DM = 2048, BATCH = 8, SEQ = 2048, M = BATCH * SEQ, MEM = 256, MROWS = BATCH * MEM;
constexpr float EPS = 1e-6f;
constexpr int AH = 8, HD = 128, AW = 1024;
constexpr int MB = 256, NB = SEQ / MB;
constexpr int SW = 2048, SH = 32, SG = 4, SCONV = 4, CONVD = 3072;
constexpr int MIXW = 3072, INW = 8224, LDP = 8448;
constexpr int C_Q = 0, C_K = 1024, C_V = 2048, C_Z = 3072, C_XBC = 5120, C_DT = 8192;
constexpr int CH = 4, CHD = 128, CW = 512;
constexpr int NG = 4, EPG = 8, NE = 32, DE = 1024;

#define LAS __attribute__((address_space(3)))
#define GAS __attribute__((address_space(1)))
typedef unsigned short bf16_t;
typedef short bf16x8 __attribute__((ext_vector_type(8)));
typedef float f32x4 __attribute__((ext_vector_type(4)));
typedef float f32x2 __attribute__((ext_vector_type(2)));
typedef unsigned u32x4 __attribute__((ext_vector_type(4)));
typedef unsigned u32x2 __attribute__((ext_vector_type(2)));
typedef int i32x4 __attribute__((ext_vector_type(4)));
typedef int i32x8 __attribute__((ext_vector_type(8)));
typedef short s16x16 __attribute__((ext_vector_type(16)));
#define LDS_WAIT() asm volatile("s_waitcnt lgkmcnt(0)" ::: "memory")
#define VM_WAIT() asm volatile("s_waitcnt vmcnt(0)" ::: "memory")

__device__ __forceinline__ unsigned cvt_pk_bf16(float lo, float hi) { unsigned r; asm volatile("v_cvt_pk_bf16_f32 %0, %1, %2" : "=v"(r) : "v"(lo), "v"(hi)); return r; }
__device__ __forceinline__ unsigned pk4_fp8(float a, float b, float c, float d) {
  a = fminf(fmaxf(a, -448.f), 448.f); b = fminf(fmaxf(b, -448.f), 448.f); c = fminf(fmaxf(c, -448.f), 448.f); d = fminf(fmaxf(d, -448.f), 448.f);
  int w = 0; w = __builtin_amdgcn_cvt_pk_fp8_f32(a, b, w, false); w = __builtin_amdgcn_cvt_pk_fp8_f32(c, d, w, true); return (unsigned)w; }
__device__ __forceinline__ float bf2f(bf16_t b) { return __uint_as_float(((unsigned)b) << 16); }
__device__ __forceinline__ float bflo(unsigned w) { return __uint_as_float(w << 16); }
__device__ __forceinline__ float bfhi(unsigned w) { return __uint_as_float(w & 0xffff0000u); }
__device__ __forceinline__ void ld8bf(const bf16_t* p, float (&o)[8]) { const u32x4 w = *(const u32x4*)p; o[0] = bflo(w.x); o[1] = bfhi(w.x); o[2] = bflo(w.y); o[3] = bfhi(w.y); o[4] = bflo(w.z); o[5] = bfhi(w.z); o[6] = bflo(w.w); o[7] = bfhi(w.w); }
__device__ __forceinline__ float wave_sum(float v) {
#pragma unroll
  for (int o = 1; o < 64; o <<= 1) v += __shfl_xor(v, o);
  return v;
}
__device__ __forceinline__ float wave_max(float v) {
#pragma unroll
  for (int o = 1; o < 64; o <<= 1) v = fmaxf(v, __shfl_xor(v, o));
  return v;
}
__device__ __forceinline__ int lane_id_now() { int l; asm volatile("v_mbcnt_lo_u32_b32 %0, -1, 0\n\tv_mbcnt_hi_u32_b32 %0, -1, %0" : "=v"(l)); return l; }
__device__ __forceinline__ float silu_f(float x) { return x / (1.f + __expf(-x)); }

constexpr size_t MiB = 1u << 20;
constexpr size_t WS_CTL = 0, CTL_ZERO_BYTES = 1 * MiB;
constexpr int CW_BAR = 4096;
constexpr int CW_CNT = 65536;
constexpr size_t WS_WIN_T = 1 * MiB;
constexpr size_t WS_WOUT_T = 34 * MiB;
constexpr size_t WS_WCQ_T = 46 * MiB;
constexpr size_t WS_WCKV_T = 48 * MiB;
constexpr size_t WS_WCO_T = 52 * MiB;
constexpr size_t WS_WR = 54 * MiB;
constexpr size_t WS_SMALL = 55 * MiB;
constexpr size_t WS_ROPE = WS_SMALL, WS_RSX = WS_SMALL + 256 * 1024, WS_RSMEM = WS_RSX + 64 * 1024, WS_RS2 = WS_RSMEM + 64 * 1024, WS_KMEAN = WS_RS2 + 64 * 1024;
constexpr size_t WS_DTRAW = 56 * MiB;
constexpr size_t WS_SS = 58 * MiB;
constexpr size_t WS_MEMB = 62 * MiB;
constexpr size_t WS_XB = 70 * MiB;
constexpr size_t WS_PROJ = 134 * MiB;
constexpr size_t WS_MIXB = 398 * MiB;
constexpr size_t WS_QC = 494 * MiB, WS_OC = 510 * MiB;
constexpr size_t WS_KVC = 526 * MiB;
constexpr size_t WS_WGU_T = 530 * MiB;
constexpr size_t WS_WD_T = 786 * MiB;
constexpr size_t WS_LIST = 914 * MiB;
constexpr size_t WS_TOK = 916 * MiB;
constexpr size_t WS_HACT = WS_PROJ;
constexpr size_t WS_Y = WS_PROJ + 66 * MiB;
constexpr size_t WS_XBCC = 918 * MiB;
constexpr size_t WS_AFTER = 1014 * MiB;
#define XB_TMO      128
#define XB_XCNT(j)  (256  + 64 * (j))
#define XB_XSUB(j)  (1280 + 64 * (j))
#define XB_XGEN(j)  (2304 + 64 * (j))
#define XB_TOP      3328
#define XB_TOPGEN   3392
#define XCD_BAR_WORDS 3456
#define XB_SPIN_CAP (1u << 18)

__device__ __forceinline__ unsigned xb_ld(unsigned* p)              { return __hip_atomic_load(p, __ATOMIC_RELAXED, __HIP_MEMORY_SCOPE_AGENT); }
__device__ __forceinline__ unsigned xb_add(unsigned* p, unsigned v) { return __hip_atomic_fetch_add(p, v, __ATOMIC_RELAXED, __HIP_MEMORY_SCOPE_AGENT); }
__device__ __forceinline__ unsigned xb_xcc_id() { return (unsigned)__builtin_amdgcn_s_getreg((3 << 11) | 20) & 0xFu; }
#define XB_SPIN(cond, bar) do { unsigned _sp = 0; while (cond) { __builtin_amdgcn_s_sleep(1); \
    if ((++_sp & 255u) == 0u) { if (xb_ld(&(bar)[XB_TMO])) break; if (_sp > XB_SPIN_CAP) { atomicAdd(&(bar)[XB_TMO], 1u); break; } } } } while (0)

struct XcdBarrier {
    unsigned* bar; unsigned x;
    volatile LAS unsigned* st;
};

__device__ __forceinline__ XcdBarrier xcd_barrier_post(unsigned* bar, volatile LAS unsigned* st) {
    XcdBarrier b; b.bar = bar; b.x = xb_xcc_id(); b.st = st;
    if (threadIdx.x == 0) (void)xb_add(&bar[XB_XCNT(b.x)], 1u);
    return b;
}
__device__ __forceinline__ void xcd_barrier_complete(unsigned* bar, unsigned x, unsigned& nloc, unsigned& nx) {
    const unsigned G = gridDim.x * gridDim.y * gridDim.z;
    unsigned sum, cnt, mine, sp = 0u;
    for (;;) {
        sum = 0u; cnt = 0u; mine = 0u;
#pragma unroll
        for (unsigned j = 0; j < 16; ++j) { const unsigned c = xb_ld(&bar[XB_XCNT(j)]); sum += c; cnt += (c > 0u) ? 1u : 0u; mine = (j == x) ? c : mine; }
        if (sum == G) break;
        __builtin_amdgcn_s_sleep(1);
        if ((++sp & 255u) == 0u) { if (xb_ld(&bar[XB_TMO])) break; if (sp > XB_SPIN_CAP) { atomicAdd(&bar[XB_TMO], 1u); break; } }
    }
    nloc = mine > 0u ? mine : 1u; nx = cnt > 0u ? cnt : 1u;
}

__device__ __forceinline__ void xcd_barrier(const XcdBarrier& b, const int xb_tid) {
    asm volatile("s_waitcnt vmcnt(0)" ::: "memory");
    __syncthreads();
    if (xb_tid == 0) {
        unsigned* bar = b.bar;
        __builtin_amdgcn_s_waitcnt(0);
        unsigned nloc = b.st[0], nx = b.st[1];
        if (nloc == 0u) { xcd_barrier_complete(bar, b.x, nloc, nx); b.st[0] = nloc; b.st[1] = nx; }
        const unsigned old = xb_add(&bar[XB_XSUB(b.x)], 1u);
        const unsigned gen = old / nloc;
        if (old + 1u == (gen + 1u) * nloc) {
            __builtin_amdgcn_fence(__ATOMIC_RELEASE, "agent");
            asm volatile("s_waitcnt vmcnt(0)" ::: "memory");
            const unsigned og = xb_add(&bar[XB_TOP], 1u);
            const unsigned tg = og / nx;
            if (og + 1u == (tg + 1u) * nx) xb_add(&bar[XB_TOPGEN], 1u);
            else XB_SPIN(xb_ld(&bar[XB_TOPGEN]) == tg, bar);
            __builtin_amdgcn_fence(__ATOMIC_ACQUIRE, "agent");
            xb_add(&bar[XB_XGEN(b.x)], 1u);
            asm volatile("s_waitcnt vmcnt(0)" ::: "memory");
        } else {
            XB_SPIN(xb_ld(&bar[XB_XGEN(b.x)]) == gen, bar);
            __builtin_amdgcn_fence(__ATOMIC_ACQUIRE, "agent");
            asm volatile("s_waitcnt vmcnt(0)" ::: "memory");
        }
    }
    __syncthreads();
}

namespace gm {
constexpr int BM = 256, BK = 64, HALF = 128, HTB = HALF * BK * 2, STAGE_BYTES = 8 * HTB, NXCD = 8, WGM = 8;
__host__ __device__ __forceinline__ int lds_byte(int r, int c) { const int st = (r >> 4) * 2 + (c >> 5), rr = r & 15, cc = c & 31, ob = rr * 64 + cc * 2; return st * 1024 + (ob ^ (((ob >> 9) & 1) << 5)); }
__host__ __device__ __forceinline__ void stage_rc(int b, int& R, int& C) { const int st = b / 1024, sb = b % 1024, swz = sb ^ (((sb >> 9) & 1) << 5); R = (st >> 1) * 16 + swz / 64; C = (st & 1) * 32 + (swz % 64) / 2; }
__host__ __device__ __forceinline__ int perm32(int rho) { const int n = rho >> 4, i = rho & 15; return 8 * (i >> 2) + 4 * n + (i & 3); }

struct Unit { const char* a; const char* b; int pm, pn, kind, ti; };

__device__ __forceinline__ void tile_of(int L, int nM, int nN, int& pm, int& pn) {
    const int nwg = nM * nN; int wgid = L;
    { const int q = nwg / NXCD, r = nwg % NXCD, xcd = wgid % NXCD, off = wgid / NXCD; wgid = (xcd < r ? xcd * (q + 1) : r * (q + 1) + (xcd - r) * q) + off; }
    const int nig = WGM * nN, gid = wgid / nig, fm = gid * WGM, gsz = (nM - fm) < WGM ? (nM - fm) : WGM;
    pm = fm + ((wgid % nig) % gsz); pn = (wgid % nig) / gsz;
}

template <class Epi, class Sched, bool GATHER, bool BTILED = false, bool F8 = false>
__device__ __forceinline__ void gemm_phase(const int tid, LAS unsigned char* lds, const LAS int* tab, const int K, const Sched& S, const Epi& E) {
    const int wid = __builtin_amdgcn_readfirstlane(tid >> 6), lane = tid & 63, wr = wid >> 2, wc = wid & 3, fr = lane & 15, fq = lane >> 4;
    const int nt = K / BK;
    unsigned voffA0[2], voffA1[2], voffB[2];
    const size_t kstep = (size_t)(BK * 2);
    const size_t hstep = (size_t)HALF * K * 2;
    const size_t kstepB = BTILED ? (size_t)(BM * BK * 2) : kstep, hstepB = BTILED ? (size_t)(HALF * BK * 2) : hstep;
#pragma unroll
    for (int i = 0; i < 2; ++i) { int R, C; stage_rc(tid * 16 + i * 8192, R, C); const int Rb = (R & ~31) + perm32(R & 31);
        voffB[i] = BTILED ? (unsigned)(Rb * BK + C) * 2u : (unsigned)(Rb * K + C) * 2u; voffA0[i] = (unsigned)(R * K + C) * 2u; voffA1[i] = 0u; }
#define GM_SETVOFF(u) do { if constexpr (GATHER) { _Pragma("unroll") for (int _i = 0; _i < 2; ++_i) { int R_, C_; stage_rc(tid * 16 + _i * 8192, R_, C_); \
        const int r0_ = tab[(u).ti * 256 + R_], r1_ = tab[(u).ti * 256 + 128 + R_]; voffA0[_i] = (unsigned)(r0_ * K + C_) * 2u; voffA1[_i] = (unsigned)(r1_ * K + C_) * 2u; } } } while (0)
    const unsigned ldsw = (unsigned)wid * 1024u;
    const int aoff = F8 ? lds_byte(wr * 64 + fr, fq * 16) : lds_byte(wr * 64 + fr, fq * 8), boff = F8 ? lds_byte(wc * 32 + fr, fq * 16) : lds_byte(wc * 32 + fr, fq * 8);
#define PG8_SA(b, h) (((b) * 2 + (h)) * HTB)
#define PG8_SB(b, h) ((4 + (b) * 2 + (h)) * HTB)
#define PG8_STAGE(bufoff, gbase, voff) do { _Pragma("unroll") for (int _i = 0; _i < 2; ++_i) \
        __builtin_amdgcn_global_load_lds((const unsigned*)((const char*)(gbase) + (voff)[_i]), (LAS unsigned*)(lds + (bufoff) + ldsw + _i * 8192), 16, 0, 0); } while (0)
#define PG8_LDA8(dst, b, h) do { _Pragma("unroll") for (int m = 0; m < 4; ++m) { const bf16x8 lo_ = *(const LAS bf16x8*)(lds + PG8_SA(b, h) + aoff + m * 2048), hi_ = *(const LAS bf16x8*)(lds + PG8_SA(b, h) + aoff + m * 2048 + 16); \
        dst[m] = __builtin_shufflevector(__builtin_bit_cast(i32x4, lo_), __builtin_bit_cast(i32x4, hi_), 0, 1, 2, 3, 4, 5, 6, 7); } } while (0)
#define PG8_LDB8(dst, b, h) do { _Pragma("unroll") for (int n = 0; n < 2; ++n) { const bf16x8 lo_ = *(const LAS bf16x8*)(lds + PG8_SB(b, h) + boff + n * 2048), hi_ = *(const LAS bf16x8*)(lds + PG8_SB(b, h) + boff + n * 2048 + 16); \
        dst[n] = __builtin_shufflevector(__builtin_bit_cast(i32x4, lo_), __builtin_bit_cast(i32x4, hi_), 0, 1, 2, 3, 4, 5, 6, 7); } } while (0)
#define PG8_MMA8(ai, bj, At, Bt) do { __builtin_amdgcn_s_setprio(1); _Pragma("unroll") for (int m = 0; m < 4; ++m) _Pragma("unroll") for (int n = 0; n < 2; ++n) \
        acc[ai][bj][m][n] = __builtin_amdgcn_mfma_scale_f32_16x16x128_f8f6f4(Bt[n], At[m], acc[ai][bj][m][n], 0, 0, 0, 0, 0, 0); __builtin_amdgcn_s_setprio(0); } while (0)
#define PG8_LDA(dst, b, h) do { _Pragma("unroll") for (int m = 0; m < 4; ++m) _Pragma("unroll") for (int k = 0; k < 2; ++k) dst[m][k] = *(const LAS bf16x8*)(lds + PG8_SA(b, h) + aoff + m * 2048 + k * 1024); } while (0)
#define PG8_LDB(dst, b, h) do { _Pragma("unroll") for (int n = 0; n < 2; ++n) _Pragma("unroll") for (int k = 0; k < 2; ++k) dst[n][k] = *(const LAS bf16x8*)(lds + PG8_SB(b, h) + boff + n * 2048 + k * 1024); } while (0)
#define PG8_MMA(ai, bj, At, Bt) do { __builtin_amdgcn_s_setprio(1); _Pragma("unroll") for (int m = 0; m < 4; ++m) _Pragma("unroll") for (int n = 0; n < 2; ++n) _Pragma("unroll") for (int k = 0; k < 2; ++k) \
        acc[ai][bj][m][n] = __builtin_amdgcn_mfma_f32_16x16x32_bf16(Bt[n][k], At[m][k], acc[ai][bj][m][n], 0, 0, 0); __builtin_amdgcn_s_setprio(0); } while (0)
#define GM_STAGE_A1(bufoff, gbase) do { if constexpr (GATHER) { PG8_STAGE(bufoff, gbase, voffA1); } else { PG8_STAGE(bufoff, (gbase) + hstep, voffA0); } } while (0)
#define PG8_WAIT_V(n) asm volatile("s_waitcnt vmcnt(" #n ")" ::: "memory")
#define PG8_WAIT_L(n) asm volatile("s_waitcnt lgkmcnt(" #n ")" ::: "memory")
#define PG8_BAR __builtin_amdgcn_s_barrier()
#define PG8_SCHED __builtin_amdgcn_sched_barrier(0)
    Unit cur, nxt; int ui = 0;
    if (!S.next(0, cur)) return;
    GM_SETVOFF(cur);
    f32x4 acc[2][2][4][2];
#pragma unroll
    for (int a = 0; a < 2; ++a)
#pragma unroll
        for (int b = 0; b < 2; ++b)
#pragma unroll
            for (int m = 0; m < 4; ++m)
#pragma unroll
                for (int n = 0; n < 2; ++n) acc[a][b][m][n] = (f32x4){0.f, 0.f, 0.f, 0.f};
    bf16x8 At[4][2], B0[2][2], B1[2][2]; i32x8 At8[4], B08[2], B18[2];
    const char* cA = cur.a; const char* cB = cur.b;
    PG8_STAGE(PG8_SB(0, 0), cB, voffB); PG8_STAGE(PG8_SB(0, 1), cB + hstepB, voffB); PG8_STAGE(PG8_SA(0, 0), cA, voffA0); GM_STAGE_A1(PG8_SA(0, 1), cA);
    if (wr == 1) PG8_BAR;
    PG8_WAIT_V(2); PG8_BAR;
    PG8_STAGE(PG8_SB(1, 0), cB + kstepB, voffB); PG8_STAGE(PG8_SA(1, 0), cA + kstep, voffA0); PG8_STAGE(PG8_SB(1, 1), cB + hstepB + kstepB, voffB);
    PG8_WAIT_V(6); PG8_BAR;
    for (;;) {
        const bool has_next = S.next(ui + 1, nxt);
        const char* nA = has_next ? nxt.a : cA; const char* nB = has_next ? nxt.b : cB;
#pragma unroll 1
        for (int t = 0; t < nt; t += 2) {
            const bool last = (t == nt - 2);
            const char* a1 = cA + (size_t)(t + 1) * kstep;
            const char* a2 = last ? nA : cA + (size_t)(t + 2) * kstep; const char* b2 = last ? nB : cB + (size_t)(t + 2) * kstepB;
            const char* a3 = a2 + kstep; const char* b3 = b2 + kstepB;
            if constexpr (F8) {
            PG8_LDB8(B08, 0, 0); PG8_LDB8(B18, 0, 1); PG8_SCHED; PG8_LDA8(At8, 0, 0); GM_STAGE_A1(PG8_SA(1, 1), a1);
            PG8_WAIT_V(8); PG8_WAIT_L(0); PG8_BAR; PG8_MMA8(0, 0, At8, B08); PG8_MMA8(0, 1, At8, B18); PG8_BAR; PG8_SCHED;
            if constexpr (GATHER) { if (last && has_next) { GM_SETVOFF(nxt); } }
            PG8_LDA8(At8, 0, 1); PG8_STAGE(PG8_SB(0, 0), b2, voffB); PG8_STAGE(PG8_SB(0, 1), b2 + hstepB, voffB); PG8_STAGE(PG8_SA(0, 0), a2, voffA0);
            PG8_WAIT_V(8); PG8_WAIT_L(0); PG8_BAR; PG8_MMA8(1, 0, At8, B08); PG8_MMA8(1, 1, At8, B18); PG8_BAR; PG8_SCHED;
            PG8_LDB8(B08, 1, 0); PG8_LDB8(B18, 1, 1); PG8_SCHED; PG8_LDA8(At8, 1, 0); GM_STAGE_A1(PG8_SA(0, 1), a2);
            PG8_WAIT_V(8); PG8_WAIT_L(0); PG8_BAR; PG8_MMA8(0, 0, At8, B08); PG8_MMA8(0, 1, At8, B18); PG8_BAR; PG8_SCHED;
            PG8_LDA8(At8, 1, 1); PG8_STAGE(PG8_SB(1, 0), b3, voffB); PG8_STAGE(PG8_SB(1, 1), b3 + hstepB, voffB); PG8_STAGE(PG8_SA(1, 0), a3, voffA0);
            PG8_WAIT_V(8); PG8_WAIT_L(0); PG8_BAR; PG8_MMA8(1, 0, At8, B08); PG8_MMA8(1, 1, At8, B18); PG8_BAR; PG8_SCHED;
            } else {
            PG8_LDB(B0, 0, 0); PG8_LDB(B1, 0, 1); PG8_SCHED; PG8_LDA(At, 0, 0); GM_STAGE_A1(PG8_SA(1, 1), a1);
            PG8_WAIT_V(8); PG8_WAIT_L(0); PG8_BAR; PG8_MMA(0, 0, At, B0); PG8_MMA(0, 1, At, B1); PG8_BAR; PG8_SCHED;
            if constexpr (GATHER) { if (last && has_next) { GM_SETVOFF(nxt); } }
            PG8_LDA(At, 0, 1); PG8_STAGE(PG8_SB(0, 0), b2, voffB); PG8_STAGE(PG8_SB(0, 1), b2 + hstepB, voffB); PG8_STAGE(PG8_SA(0, 0), a2, voffA0);
            PG8_WAIT_V(8); PG8_WAIT_L(0); PG8_BAR; PG8_MMA(1, 0, At, B0); PG8_MMA(1, 1, At, B1); PG8_BAR; PG8_SCHED;
            PG8_LDB(B0, 1, 0); PG8_LDB(B1, 1, 1); PG8_SCHED; PG8_LDA(At, 1, 0); GM_STAGE_A1(PG8_SA(0, 1), a2);
            PG8_WAIT_V(8); PG8_WAIT_L(0); PG8_BAR; PG8_MMA(0, 0, At, B0); PG8_MMA(0, 1, At, B1); PG8_BAR; PG8_SCHED;
            PG8_LDA(At, 1, 1); PG8_STAGE(PG8_SB(1, 0), b3, voffB); PG8_STAGE(PG8_SB(1, 1), b3 + hstepB, voffB); PG8_STAGE(PG8_SA(1, 0), a3, voffA0);
            PG8_WAIT_V(8); PG8_WAIT_L(0); PG8_BAR; PG8_MMA(1, 0, At, B0); PG8_MMA(1, 1, At, B1); PG8_BAR; PG8_SCHED;
            }
        }
        if (wr == 0) PG8_BAR;
        { int fr_ = fr, fq_ = fq; asm volatile("" : "+v"(fr_), "+v"(fq_));
          E(acc, cur, wr, wc, fr_, fq_); }
        if (!has_next) break;
#pragma unroll
        for (int a = 0; a < 2; ++a)
#pragma unroll
            for (int b = 0; b < 2; ++b)
#pragma unroll
                for (int m = 0; m < 4; ++m)
#pragma unroll
                    for (int n = 0; n < 2; ++n) acc[a][b][m][n] = (f32x4){0.f, 0.f, 0.f, 0.f};
        cur = nxt; cA = nA; cB = nB; ++ui;
        if (wr == 1) PG8_BAR;
    }
    PG8_WAIT_V(0);
    PG8_BAR;
#undef GM_SETVOFF
#undef GM_STAGE_A1
#undef PG8_SA
#undef PG8_SB
#undef PG8_STAGE
#undef PG8_LDA
#undef PG8_LDA8
#undef PG8_LDB8
#undef PG8_MMA8
#undef PG8_LDB
#undef PG8_MMA
#undef PG8_WAIT_V
#undef PG8_WAIT_L
#undef PG8_BAR
#undef PG8_SCHED
}
}
namespace at {
using f32x16 = __attribute__((ext_vector_type(16))) float;
using s16x4 = __attribute__((ext_vector_type(4))) short;
constexpr int D = 128, NW = 8, QBLK = 32, KVBLK = 64;
constexpr float SCALE = 0.088388347648318440f;
constexpr float THR = 8.f;
constexpr int SHM_V = KVBLK * D * 2, SHM_K = KVBLK * D * 2, SHM_ATTN = 2 * SHM_V + 2 * SHM_K + NW * 64 * 4;
constexpr int KM_OFF = SHM_ATTN;
constexpr int QL_OFF = KM_OFF + 4096;
#define KSWZ(row, colB) ((row) * 256 + ((colB) ^ (((row) & 7) << 4)))
#define SBAR() __builtin_amdgcn_sched_barrier(0)
__device__ __forceinline__ int crow(int r, int hi) { return (r & 3) + 8 * (r >> 2) + 4 * hi; }

__device__ __forceinline__ void partialSM(f32x16& p0, f32x16& p1, float& m_reg, float& mn, float& alpha, bool dead) {
  constexpr float C = SCALE * 1.4426950408889634f;
  float pmax = p0[0];
#pragma unroll
  for (int r = 1; r < 16; ++r) pmax = fmaxf(pmax, p0[r]);
#pragma unroll
  for (int r = 0; r < 16; ++r) pmax = fmaxf(pmax, p1[r]);
  { auto rr = __builtin_amdgcn_permlane32_swap(__float_as_uint(pmax), __float_as_uint(pmax), false, false);
    pmax = fmaxf(__uint_as_float(rr[0]), __uint_as_float(rr[1])); }
  if (dead) pmax = -1e30f;
  if (__builtin_expect(__all(pmax - m_reg <= THR / SCALE), 1)) { mn = m_reg; alpha = 1.f; }
  else { mn = fmaxf(m_reg, pmax); alpha = __builtin_amdgcn_exp2f((m_reg - mn) * C); m_reg = mn; }
  const float mnC = dead ? -INFINITY : -mn * C;
#pragma unroll
  for (int r = 0; r < 16; ++r) p0[r] = fmaf(p0[r], C, mnC);
#pragma unroll
  for (int r = 0; r < 16; ++r) p1[r] = fmaf(p1[r], C, mnC);
#pragma unroll
  for (int r = 0; r < 16; ++r) p0[r] = __builtin_amdgcn_exp2f(p0[r]);
}
__device__ __forceinline__ void finishSM(f32x16& p0, f32x16& p1, float alpha, float& l_reg, bf16x8& pa0, bf16x8& pa1, bf16x8& pa2, bf16x8& pa3) {
#pragma unroll
  for (int r = 0; r < 16; ++r) p1[r] = __builtin_amdgcn_exp2f(p1[r]);
  float ps = 0;
#pragma unroll
  for (int r = 0; r < 16; ++r) ps += p0[r];
#pragma unroll
  for (int r = 0; r < 16; ++r) ps += p1[r];
  { auto rr = __builtin_amdgcn_permlane32_swap(__float_as_uint(ps), __float_as_uint(ps), false, false);
    ps = __uint_as_float(rr[0]) + __uint_as_float(rr[1]); }
  l_reg = l_reg * alpha + ps;
#define PK4(P, BASE, OUT) do { unsigned a0 = cvt_pk_bf16(P[BASE + 0], P[BASE + 1]), a1 = cvt_pk_bf16(P[BASE + 2], P[BASE + 3]);   \
    unsigned b0 = cvt_pk_bf16(P[BASE + 4], P[BASE + 5]), b1 = cvt_pk_bf16(P[BASE + 6], P[BASE + 7]);                              \
    auto r0 = __builtin_amdgcn_permlane32_swap(a0, b0, false, false); auto r1 = __builtin_amdgcn_permlane32_swap(a1, b1, false, false); \
    u32x4 w = {r0[0], r1[0], r0[1], r1[1]}; OUT = *reinterpret_cast<bf16x8*>(&w); } while (0)
  PK4(p0, 0, pa0); PK4(p0, 8, pa1); PK4(p1, 0, pa2); PK4(p1, 8, pa3);
#undef PK4
}
template <bool QLDS>
__device__ __forceinline__ void qkt(f32x16& p0, f32x16& p1, const LAS char* Ks, const bf16x8* qr, const LAS char* ql, int r32, int hi) {
  p0 = f32x16{}; p1 = f32x16{};
#pragma unroll
  for (int d0 = 0; d0 < 8; ++d0) { int cb = (d0 * 16 + hi * 8) * 2;
    bf16x8 b0 = *(const LAS bf16x8*)(Ks + KSWZ(r32, cb));
    bf16x8 b1 = *(const LAS bf16x8*)(Ks + KSWZ(32 + r32, cb));
    bf16x8 q; if constexpr (QLDS) q = *(const LAS bf16x8*)(ql + d0 * 8192); else q = qr[d0];
    p0 = __builtin_amdgcn_mfma_f32_32x32x16_bf16(b0, q, p0, 0, 0, 0);
    p1 = __builtin_amdgcn_mfma_f32_32x32x16_bf16(b1, q, p1, 0, 0, 0); }
}
__device__ __forceinline__ int v_st(int k, int c) { const int kk = (k & ~0xC) | ((k & 4) << 1) | ((k & 8) >> 1); return ((kk >> 3) * 4 + (c >> 5)) * 512 + ((kk & 7) * 32 + (c & 31)) * 2; }
__device__ __forceinline__ int v_rd_base(int lane) { return ((lane & 3) << 3) | (((lane >> 2) & 3) << 6) | (((lane >> 4) & 1) << 5) | (((lane >> 5) & 1) << 8); }
constexpr int v_rd_off(int d0, int ks, int half) { return d0 * 512 + ks * 4096 + half * 2048; }
template <int OFF> __device__ __forceinline__ s16x4 tr_read(int vb) {
  s16x4 r; asm volatile("ds_read_b64_tr_b16 %0, %1 offset:%2" : "=&v"(r) : "v"(vb), "i"(OFF) : "memory"); return r;
}
template <int D0> __device__ __forceinline__ void pv_one(f32x16& od, int vb, bf16x8 pa0, bf16x8 pa1, bf16x8 pa2, bf16x8 pa3) {
  const s16x4 l0 = tr_read<v_rd_off(D0, 0, 0)>(vb), h0 = tr_read<v_rd_off(D0, 0, 1)>(vb), l1 = tr_read<v_rd_off(D0, 1, 0)>(vb), h1 = tr_read<v_rd_off(D0, 1, 1)>(vb);
  const s16x4 l2 = tr_read<v_rd_off(D0, 2, 0)>(vb), h2 = tr_read<v_rd_off(D0, 2, 1)>(vb), l3 = tr_read<v_rd_off(D0, 3, 0)>(vb), h3 = tr_read<v_rd_off(D0, 3, 1)>(vb);
  asm volatile("s_waitcnt lgkmcnt(0)" ::: "memory"); SBAR();
#define PK(L, H) (bf16x8){L[0], L[1], L[2], L[3], H[0], H[1], H[2], H[3]}
  od = __builtin_amdgcn_mfma_f32_32x32x16_bf16(pa0, PK(l0, h0), od, 0, 0, 0);
  od = __builtin_amdgcn_mfma_f32_32x32x16_bf16(pa1, PK(l1, h1), od, 0, 0, 0);
  od = __builtin_amdgcn_mfma_f32_32x32x16_bf16(pa2, PK(l2, h2), od, 0, 0, 0);
  od = __builtin_amdgcn_mfma_f32_32x32x16_bf16(pa3, PK(l3, h3), od, 0, 0, 0);
#undef PK
}
__device__ __forceinline__ void pv_d0(f32x16* o, int vb, bf16x8 pa0, bf16x8 pa1, bf16x8 pa2, bf16x8 pa3) {
  pv_one<0>(o[0], vb, pa0, pa1, pa2, pa3); pv_one<1>(o[1], vb, pa0, pa1, pa2, pa3); pv_one<2>(o[2], vb, pa0, pa1, pa2, pa3); pv_one<3>(o[3], vb, pa0, pa1, pa2, pa3);
}

template <bool MOBA>
__device__ __forceinline__ void attn_unit(const int tid, const bf16_t* __restrict__ Qb, const bf16_t* __restrict__ Kh, bf16_t* __restrict__ Ob, int NT, int jb, const float* __restrict__ kmean_bh, LAS char* lds) {
  constexpr int ldq = MOBA ? LDP : CW, ldk = MOBA ? LDP : 2 * CW, ldo = MOBA ? MIXW : CW, VOFF = MOBA ? (C_V - C_K) : CW;
  const bf16_t* __restrict__ Vh = Kh + VOFF;
  const int wid = __builtin_amdgcn_readfirstlane(tid >> 6), lane = tid & 63, r32 = lane & 31, hi = lane >> 5;
  LAS char* V_lds = lds; LAS char* K_lds = lds + 2 * SHM_V;
  LAS float* wsf = (LAS float*)(lds + 2 * SHM_V + 2 * SHM_K) + wid * 64; LAS float* li_l = wsf; LAS float* al_l = wsf + 32;
  float m_reg = -1e30f, l_reg = 0; f32x16 o[4] = {}; bf16x8 qr[8];
  const bf16_t* Qw = Qb + (long)(wid * QBLK + r32) * ldq + hi * 8;
#pragma unroll
  for (int d0 = 0; d0 < 8; ++d0) qr[d0] = *reinterpret_cast<const bf16x8*>(Qw + d0 * 16);
  unsigned selmask = 0;
  if constexpr (MOBA) {
    LAS float* kml = (LAS float*)(lds + KM_OFF);
    __syncthreads();
    for (int i = tid; i < 8 * 128; i += NW * 64) kml[i] = kmean_bh[(i >> 7) * 1024 + (i & 127)];
    __syncthreads();
    float gate[8];
#pragma unroll
    for (int kb = 0; kb < 8; ++kb) {
      float g = 0.f;
      if (kb < jb) {
#pragma unroll
        for (int d0 = 0; d0 < 8; ++d0) { const f32x4 k0 = *(const LAS f32x4*)(kml + kb * 128 + d0 * 16 + hi * 8), k1 = *(const LAS f32x4*)(kml + kb * 128 + d0 * 16 + hi * 8 + 4);
          const u32x4 qw = *reinterpret_cast<const u32x4*>(&qr[d0]);
          g += bflo(qw.x) * k0[0] + bfhi(qw.x) * k0[1] + bflo(qw.y) * k0[2] + bfhi(qw.y) * k0[3] + bflo(qw.z) * k1[0] + bfhi(qw.z) * k1[1] + bflo(qw.w) * k1[2] + bfhi(qw.w) * k1[3]; }
        g += __shfl_xor(g, 32);
      }
      gate[kb] = g;
    }
#pragma unroll
    for (int r = 0; r < 3; ++r) { float best = -INFINITY; int bi = -1;
#pragma unroll
      for (int kb = 0; kb < 8; ++kb) { const bool ok = (kb < jb) && !((selmask >> kb) & 1u) && (gate[kb] > best || bi < 0); if (ok) { best = gate[kb]; bi = kb; } }
      if (bi >= 0) selmask |= 1u << bi; }
  }
  const LAS char* ql = lds + QL_OFF + tid * 16;
  if constexpr (MOBA) {
#pragma unroll
    for (int d0 = 0; d0 < 8; ++d0) *(LAS bf16x8*)(lds + QL_OFF + tid * 16 + d0 * 8192) = qr[d0];
  }
  const int rowb = wid * QBLK + r32;
#define MASK(P0, P1, T, DEAD) do { DEAD = false; if constexpr (MOBA) { const int kb_ = (T) >> 2; \
    if (kb_ < jb) { DEAD = !((selmask >> kb_) & 1u); } \
    else { const int lim_ = rowb - 64 * ((T) - 4 * jb); \
      if (!__all(lim_ >= 63)) { const int lh_ = lim_ - 4 * hi;     \
        _Pragma("unroll") for (int r_ = 0; r_ < 16; ++r_) { if ((r_ & 3) + 8 * (r_ >> 2) > lh_) P0[r_] = -INFINITY; if (32 + (r_ & 3) + 8 * (r_ >> 2) > lh_) P1[r_] = -INFINITY; } } } } } while (0)
  const int sr = tid >> 4, sc = (tid & 15) * 8, vst0 = v_st(sr, sc), vst1 = v_st(32 + sr, sc);
  const int vb0 = (int)(size_t)V_lds + v_rd_base(lane);
  constexpr int SDEPTH = MOBA ? 1 : 2;
  struct { bf16x8 vs0, vs1, ks0, ks1; } sr_[SDEPTH];
#define SLOAD(i, k0) do { sr_[i].vs0 = *reinterpret_cast<const bf16x8*>(&Vh[(long)((k0) + sr) * ldk + sc]); sr_[i].vs1 = *reinterpret_cast<const bf16x8*>(&Vh[(long)((k0) + 32 + sr) * ldk + sc]); \
    sr_[i].ks0 = *reinterpret_cast<const bf16x8*>(&Kh[(long)((k0) + sr) * ldk + sc]); sr_[i].ks1 = *reinterpret_cast<const bf16x8*>(&Kh[(long)((k0) + 32 + sr) * ldk + sc]); } while (0)
#define SWRITE(b, i) do { *(LAS bf16x8*)(V_lds + (b) * SHM_V + vst0) = sr_[i].vs0;          \
    *(LAS bf16x8*)(V_lds + (b) * SHM_V + vst1) = sr_[i].vs1; int kc = sc * 2;               \
    *(LAS bf16x8*)(K_lds + (b) * SHM_K + KSWZ(sr, kc)) = sr_[i].ks0;                       \
    *(LAS bf16x8*)(K_lds + (b) * SHM_K + KSWZ(32 + sr, kc)) = sr_[i].ks1; } while (0)
#define SWAIT() do { if constexpr (SDEPTH == 2) asm volatile("s_waitcnt vmcnt(4)" ::: "memory"); else asm volatile("s_waitcnt vmcnt(0)" ::: "memory"); } while (0)
#define RESC(a) do { if (__any((a) < 1.f)) { if (hi == 0) al_l[r32] = (a); asm volatile("s_waitcnt lgkmcnt(0)" ::: "memory"); \
    _Pragma("unroll") for (int d = 0; d < 4; ++d) _Pragma("unroll") for (int r = 0; r < 16; ++r) o[d][r] *= al_l[crow(r, hi)]; } } while (0)
  f32x16 pA0, pA1, pB0, pB1; float mnA, mnB, alA, alB; bf16x8 pa0, pa1, pa2, pa3; bool deadA, deadB;
  constexpr int SE = 0, SO = SDEPTH - 1;
  if constexpr (!MOBA) __syncthreads();
  SLOAD(SE, 0); asm volatile("s_waitcnt vmcnt(0)" ::: "memory"); SWRITE(0, SE); __syncthreads();
  qkt<MOBA>(pA0, pA1, K_lds, qr, ql, r32, hi); MASK(pA0, pA1, 0, deadA); partialSM(pA0, pA1, m_reg, mnA, alA, deadA);
  SLOAD(SO, KVBLK); if constexpr (SDEPTH == 2) { if (2 < NT) SLOAD(SE, 2 * KVBLK); }
  SWAIT(); SWRITE(1, SO); __syncthreads();
  for (int j = 1; j + 1 < NT; j += 2) {
    SBAR(); qkt<MOBA>(pB0, pB1, K_lds + SHM_K, qr, ql, r32, hi);
    finishSM(pA0, pA1, alA, l_reg, pa0, pa1, pa2, pa3); SBAR();
    SLOAD(SO, (j + SDEPTH) * KVBLK); SBAR();
    pv_d0(o, vb0, pa0, pa1, pa2, pa3); MASK(pB0, pB1, j, deadB); partialSM(pB0, pB1, m_reg, mnB, alB, deadB);
    __syncthreads(); SWAIT(); SWRITE(0, SE);
    RESC(alB); __syncthreads();
    SBAR(); qkt<MOBA>(pA0, pA1, K_lds, qr, ql, r32, hi);
    finishSM(pB0, pB1, alB, l_reg, pa0, pa1, pa2, pa3); SBAR();
    if (SDEPTH == 1 || j + 3 < NT) SLOAD(SE, (j + 1 + SDEPTH) * KVBLK); SBAR();
    pv_d0(o, vb0 + SHM_V, pa0, pa1, pa2, pa3); MASK(pA0, pA1, j + 1, deadA); partialSM(pA0, pA1, m_reg, mnA, alA, deadA);
    __syncthreads(); SWAIT(); SWRITE(1, SO);
    RESC(alA); __syncthreads();
  }
  SBAR(); qkt<MOBA>(pB0, pB1, K_lds + SHM_K, qr, ql, r32, hi);
  finishSM(pA0, pA1, alA, l_reg, pa0, pa1, pa2, pa3); SBAR();
  pv_d0(o, vb0, pa0, pa1, pa2, pa3); MASK(pB0, pB1, NT - 1, deadB); partialSM(pB0, pB1, m_reg, mnB, alB, deadB);
  __syncthreads(); RESC(alB);
  finishSM(pB0, pB1, alB, l_reg, pa0, pa1, pa2, pa3); SBAR();
  pv_d0(o, vb0 + SHM_V, pa0, pa1, pa2, pa3);
  if (hi == 0) li_l[r32] = l_reg; asm volatile("s_waitcnt lgkmcnt(0)" ::: "memory");
  float rli[16];
#pragma unroll
  for (int r = 0; r < 16; ++r) rli[r] = __builtin_amdgcn_rcpf(li_l[crow(r, hi)]);
  if constexpr (MOBA) {
#pragma unroll
    for (int r = 0; r < 16; ++r) {
      float q = 0.f;
#pragma unroll
      for (int d0 = 0; d0 < 4; ++d0) { const float v = o[d0][r] * rli[r]; q += v * v; }
      q += __shfl_xor(q, 1); q += __shfl_xor(q, 2); q += __shfl_xor(q, 4); q += __shfl_xor(q, 8); q += __shfl_xor(q, 16);
      rli[r] *= rsqrtf(q * (1.f / 128.f) + EPS);
    }
  }
  bf16_t* Ow = Ob + (long)(wid * QBLK) * ldo;
#pragma unroll
  for (int r = 0; r < 16; ++r) { const int orow = crow(r, hi);
#pragma unroll
    for (int d0 = 0; d0 < 4; ++d0) Ow[(long)orow * ldo + d0 * 32 + r32] = (bf16_t)(cvt_pk_bf16(o[d0][r] * rli[r], 0.f) & 0xffffu); }
#undef MASK
#undef SLOAD
#undef SWRITE
#undef SWAIT
#undef RESC
}
#undef KSWZ
#undef SBAR
}
namespace sd {
using f32x16 = __attribute__((ext_vector_type(16))) float;
typedef short v4i16_t __attribute__((ext_vector_type(4)));
constexpr int IMG_C = 0, IMG_B = 32768, IMG_X = 65536, IMG_S = 98304, TBL = 114688;
__device__ __forceinline__ unsigned off_b(unsigned row, unsigned ch) { return 256u * row + 16u * (ch ^ (((row & 3) << 2) | ((row >> 2) & 3))); }
__device__ __forceinline__ unsigned row_read_addr(unsigned lane, unsigned s) { return off_b(lane & 31, 2 * s + (lane >> 5)); }
__device__ __forceinline__ unsigned tr_read_addr(unsigned lane, unsigned c, unsigned ks, unsigned t) {
  const unsigned h = lane >> 5, blk = (lane >> 4) & 1, q = (lane & 15) >> 2, p = lane & 3;
  return off_b(16 * ks + 8 * h + 4 * t + q, 4 * c + 2 * blk + (p >> 1)) + 8 * (p & 1);
}
__device__ __forceinline__ unsigned elem_addr(unsigned row, unsigned col) { return (row >> 5) * 8192u + off_b(row & 31, col >> 3) + (col & 7) * 2u; }
__device__ __forceinline__ bf16x8 tr_frag(const LAS char* img, unsigned a0, unsigned a1) {
  const v4i16_t l = __builtin_amdgcn_ds_read_tr16_b64_v4i16((LAS v4i16_t*)(img + a0)), h = __builtin_amdgcn_ds_read_tr16_b64_v4i16((LAS v4i16_t*)(img + a1));
  return (bf16x8){l[0], l[1], l[2], l[3], h[0], h[1], h[2], h[3]};
}
__device__ __forceinline__ int crow(int r, int hi) { return (r & 3) + 8 * (r >> 2) + 4 * hi; }
__device__ __forceinline__ float softplus_f(float r) { return fmaxf(r, 0.f) + log1pf(__expf(-fabsf(r))); }

__device__ __forceinline__ void conv_rows(const u32x4 (&raw)[11], const float* __restrict__ conv_w, const float* __restrict__ conv_b, bf16_t* __restrict__ xbcc, const int tok0, const int ch, const bool live) {
  f32x4 w[5][2];
#pragma unroll
  for (int tp = 0; tp < 4; ++tp) { w[tp][0] = *(const f32x4*)(conv_w + tp * CONVD + ch); w[tp][1] = *(const f32x4*)(conv_w + tp * CONVD + ch + 4); }
  w[4][0] = *(const f32x4*)(conv_b + ch); w[4][1] = *(const f32x4*)(conv_b + ch + 4);
  float ac[4][8];
#pragma unroll
  for (int j = 0; j < 11; ++j) {
    const u32x4 rw = raw[j];
    const float x[8] = {bflo(rw.x), bfhi(rw.x), bflo(rw.y), bfhi(rw.y), bflo(rw.z), bfhi(rw.z), bflo(rw.w), bfhi(rw.w)};
#pragma unroll
    for (int tp = 0; tp < 4; ++tp) {
      const int i = j - tp;
      if (i >= 0 && i < 8) { const int sl = i & 3;
#pragma unroll
        for (int e = 0; e < 8; ++e) ac[sl][e] = (tp == 0 ? w[4][e >> 2][e & 3] : ac[sl][e]) + w[tp][e >> 2][e & 3] * x[e]; }
    }
    if (j >= 3) {
      const int sl = (j - 3) & 3; float o8[8];
#pragma unroll
      for (int e = 0; e < 8; ++e) o8[e] = ac[sl][e] * __builtin_amdgcn_rcpf(1.f + __expf(-ac[sl][e]));
      u32x4 o; o.x = cvt_pk_bf16(o8[0], o8[1]); o.y = cvt_pk_bf16(o8[2], o8[3]); o.z = cvt_pk_bf16(o8[4], o8[5]); o.w = cvt_pk_bf16(o8[6], o8[7]);
      if (live) *(u32x4*)(xbcc + (size_t)(tok0 + j - 3) * CONVD + ch) = o;
    }
  }
}
__device__ __forceinline__ void conv_prepass(const int gtid, const int nthr, const bf16_t* __restrict__ proj, const float* __restrict__ conv_w, const float* __restrict__ conv_b, bf16_t* __restrict__ xbcc) {
  constexpr int NCG = CONVD / 8, NITEM = NCG * (M / 8);
#define CONV_LOADROWS(R, IT) do { const int cg_ = (IT) % NCG, t0_ = ((IT) / NCG) * 8, T0_ = t0_ & (SEQ - 1); const bf16_t* rp_ = proj + (size_t)(t0_ - T0_) * LDP + C_XBC + 8 * cg_; \
    _Pragma("unroll") for (int j_ = 0; j_ < 11; ++j_) { const int T_ = T0_ - 3 + j_; R[j_] = (T_ >= 0) ? *(const u32x4*)(rp_ + (size_t)T_ * LDP) : (u32x4){0u, 0u, 0u, 0u}; } } while (0)
  u32x4 ra[11], rb[11];
  int it = gtid;
  { const int i0 = it < NITEM ? it : NITEM - 1; CONV_LOADROWS(ra, i0); }
#pragma unroll 1
  for (; it < NITEM; it += 2 * nthr) {
    const int it2 = it + nthr, i2 = it2 < NITEM ? it2 : NITEM - 1, it3 = it2 + nthr, i3 = it3 < NITEM ? it3 : NITEM - 1;
    CONV_LOADROWS(rb, i2);
    conv_rows(ra, conv_w, conv_b, xbcc, (it / NCG) * 8, 8 * (it % NCG), true);
    CONV_LOADROWS(ra, i3);
    conv_rows(rb, conv_w, conv_b, xbcc, (i2 / NCG) * 8, 8 * (i2 % NCG), it2 < NITEM);
  }
#undef CONV_LOADROWS
}

__device__ __forceinline__ void ssd_unit(const int tid, const int b, const int h, const bf16_t* __restrict__ proj, const bf16_t* __restrict__ xbcc, const float* __restrict__ dtraw,
                                         const float* __restrict__ dt_bias, const float* __restrict__ a_log, const float* __restrict__ d_skip,
                                         bf16_t* __restrict__ mixb, LAS char* lds) {
  const int wid = __builtin_amdgcn_readfirstlane(tid >> 6), lane = tid & 63, r32 = lane & 31, hi = lane >> 5;
  const int ph = wid & 1, rb = wid < 4 ? 3 - (wid >> 1) : (wid >> 1) - 2;
  LAS char* IC = lds + IMG_C; LAS char* IB = lds + IMG_B; LAS char* IX = lds + IMG_X; LAS char* IS = lds + IMG_S;
  LAS float* Tdt = (LAS float*)(lds + TBL); LAS float* Tacs = Tdt + 2048;
  const int grp = h >> 3;
  const float a = -__expf(a_log[h]), dtb = dt_bias[h], Dh = d_skip[h];
  __syncthreads();
  { const u32x4 z = {0u, 0u, 0u, 0u}; *(LAS u32x4*)(IS + tid * 32) = z; *(LAS u32x4*)(IS + tid * 32 + 16) = z; }
#pragma unroll 1
  for (int cc = 0; cc < 2; ++cc) {
    const int t0 = (wid * 2 + cc) * 128 + 2 * lane;
    const float d0 = softplus_f(dtraw[(size_t)(b * SEQ + t0) * 32 + h] + dtb), d1 = softplus_f(dtraw[(size_t)(b * SEQ + t0 + 1) * 32 + h] + dtb);
    const float v0 = d0 * a, ps = v0 + d1 * a;
    float sc = ps;
#pragma unroll
    for (int o = 1; o < 64; o <<= 1) { const float n = __shfl_up(sc, o); if (lane >= o) sc += n; }
    const float a0 = (sc - ps) + v0, a1 = sc, tot = __shfl(sc, 63);
    Tdt[t0] = d0; Tdt[t0 + 1] = d1; Tacs[t0] = a0; Tacs[t0 + 1] = a1;
  }
  f32x16 S = {};
  const unsigned xr = ((r32 & 3) << 2) | ((r32 >> 2) & 3);
#define RROW(k) (256u * r32 + 16u * ((2u * (k) + hi) ^ xr))
#pragma unroll 1
  for (int c = 0; c < 16; ++c) {
    int tq_ = tid; asm volatile("" : "+v"(tq_));
    const bf16_t* xsrc = xbcc + (size_t)(b * SEQ + c * 128) * CONVD;
    u32x4 rx[2], rB[4], rC[4];
#pragma unroll
    for (int i = 0; i < 2; ++i) rx[i] = *(const u32x4*)(xsrc + (size_t)((tq_ >> 3) + 64 * i) * CONVD + h * 64 + 8 * (tq_ & 7));
#pragma unroll
    for (int i = 0; i < 4; ++i) { rB[i] = *(const u32x4*)(xsrc + (size_t)((tq_ >> 4) + 32 * i) * CONVD + 2048 + grp * 128 + 8 * (tq_ & 15));
      rC[i] = *(const u32x4*)(xsrc + (size_t)((tq_ >> 4) + 32 * i) * CONVD + 2560 + grp * 128 + 8 * (tq_ & 15)); }
    __syncthreads();
    if (c > 0) {
      int lq_ = lane; asm volatile("" : "+v"(lq_)); const int r32 = lq_ & 31, hi = lq_ >> 5;
#pragma unroll
      for (int r = 0; r < 16; ++r) *(LAS bf16_t*)(IS + elem_addr(32 * ph + crow(r, hi), 32 * rb + r32)) = (bf16_t)(cvt_pk_bf16(S[r], 0.f) & 0xffffu);
    }
    {
      const float ace = Tacs[c * 128 + 127];
#pragma unroll
      for (int i = 0; i < 2; ++i) { const unsigned tk = (unsigned)(tq_ >> 3) + 64u * i, trow = tk & 31, xo = ((trow & 3) << 2) | ((trow >> 2) & 3), rowb = IMG_X + (tk >> 5) * 8192u + 256u * trow, cch = tq_ & 7;
        *(LAS u32x4*)(lds + rowb + 16u * (cch ^ xo)) = rx[i];
        const float w2 = Tdt[c * 128 + tk] * __expf(ace - Tacs[c * 128 + tk]);
        u32x4 v; v.x = cvt_pk_bf16(bflo(rx[i].x) * w2, bfhi(rx[i].x) * w2); v.y = cvt_pk_bf16(bflo(rx[i].y) * w2, bfhi(rx[i].y) * w2); v.z = cvt_pk_bf16(bflo(rx[i].z) * w2, bfhi(rx[i].z) * w2); v.w = cvt_pk_bf16(bflo(rx[i].w) * w2, bfhi(rx[i].w) * w2);
        *(LAS u32x4*)(lds + rowb + 16u * ((8u + cch) ^ xo)) = v; }
#pragma unroll
      for (int i = 0; i < 4; ++i) { const unsigned tk = (unsigned)(tq_ >> 4) + 32u * i, trow = tk & 31, xo = ((trow & 3) << 2) | ((trow >> 2) & 3), ro = (tk >> 5) * 8192u + 256u * trow + 16u * ((unsigned)(tq_ & 15) ^ xo);
        *(LAS u32x4*)(lds + IMG_B + ro) = rB[i]; *(LAS u32x4*)(lds + IMG_C + ro) = rC[i]; }
    }
    __syncthreads();
    int lq_ = lane; asm volatile("" : "+v"(lq_));
    const int lane = lq_, r32 = lane & 31, hi = lane >> 5; const unsigned xr = ((r32 & 3) << 2) | ((r32 >> 2) & 3);
    const LAS float* acs = Tacs + c * 128; const LAS float* dts = Tdt + c * 128;
    f32x16 Y = {};
    const float acl = acs[32 * rb + r32];
#pragma unroll 1
    for (int st = 0; st <= rb; ++st) {
      f32x16 Dm = {};
#pragma unroll
      for (int k = 0; k < 8; ++k) { const bf16x8 af = *(const LAS bf16x8*)(IB + st * 8192 + RROW(k)), bq = *(const LAS bf16x8*)(IC + rb * 8192 + RROW(k));
        Dm = __builtin_amdgcn_mfma_f32_32x32x16_bf16(af, bq, Dm, 0, 0, 0); }
#pragma unroll
      for (int q4 = 0; q4 < 4; ++q4) { const f32x4 as4 = *(const LAS f32x4*)(acs + 32 * st + 8 * q4 + 4 * hi), dt4 = *(const LAS f32x4*)(dts + 32 * st + 8 * q4 + 4 * hi);
#pragma unroll
        for (int e = 0; e < 4; ++e) { const int r = 4 * q4 + e; const bool dead = (st == rb) && (8 * q4 + 4 * hi + e > r32);
          const float f = dead ? 0.f : __expf(acl - as4[e]) * dt4[e]; Dm[r] *= f; } }
      bf16x8 pa0, pa1;
#define PK4(P, BASE, OUT) do { unsigned a0_ = cvt_pk_bf16(P[BASE + 0], P[BASE + 1]), a1_ = cvt_pk_bf16(P[BASE + 2], P[BASE + 3]);   \
    unsigned b0_ = cvt_pk_bf16(P[BASE + 4], P[BASE + 5]), b1_ = cvt_pk_bf16(P[BASE + 6], P[BASE + 7]);                              \
    auto r0_ = __builtin_amdgcn_permlane32_swap(a0_, b0_, false, false); auto r1_ = __builtin_amdgcn_permlane32_swap(a1_, b1_, false, false); \
    u32x4 w_ = {r0_[0], r1_[0], r0_[1], r1_[1]}; OUT = *reinterpret_cast<bf16x8*>(&w_); } while (0)
      PK4(Dm, 0, pa0); PK4(Dm, 8, pa1);
#undef PK4
      Y = __builtin_amdgcn_mfma_f32_32x32x16_bf16(pa0, tr_frag(IX + st * 8192, tr_read_addr(lane, ph, 0, 0), tr_read_addr(lane, ph, 0, 1)), Y, 0, 0, 0);
      Y = __builtin_amdgcn_mfma_f32_32x32x16_bf16(pa1, tr_frag(IX + st * 8192, tr_read_addr(lane, ph, 1, 0), tr_read_addr(lane, ph, 1, 1)), Y, 0, 0, 0);
    }
    {
      f32x16 CS = {};
#pragma unroll
      for (int k = 0; k < 8; ++k) { const bf16x8 af = *(const LAS bf16x8*)(IC + rb * 8192 + RROW(k)), bq = *(const LAS bf16x8*)(IS + ph * 8192 + RROW(k));
        CS = __builtin_amdgcn_mfma_f32_32x32x16_bf16(af, bq, CS, 0, 0, 0); }
#pragma unroll
      for (int q4 = 0; q4 < 4; ++q4) { const f32x4 as4 = *(const LAS f32x4*)(acs + 32 * rb + 8 * q4 + 4 * hi);
#pragma unroll
        for (int e = 0; e < 4; ++e) Y[4 * q4 + e] += CS[4 * q4 + e] * __expf(as4[e]); }
    }
    {
      const float dec = __expf(acs[127]);
#pragma unroll
      for (int r = 0; r < 16; ++r) S[r] *= dec;
#pragma unroll
      for (int st = 0; st < 4; ++st)
#pragma unroll
        for (int ks = 0; ks < 2; ++ks) {
          const bf16x8 af = tr_frag(IX + st * 8192, tr_read_addr(lane, 2 + ph, ks, 0), tr_read_addr(lane, 2 + ph, ks, 1));
          const bf16x8 bq = tr_frag(IB + st * 8192, tr_read_addr(lane, rb, ks, 0), tr_read_addr(lane, rb, ks, 1));
          S = __builtin_amdgcn_mfma_f32_32x32x16_bf16(af, bq, S, 0, 0, 0);
        }
    }
    {
      const int p = 32 * ph + r32;
#pragma unroll
      for (int r = 0; r < 16; ++r) {
        const int l = 32 * rb + crow(r, hi); const size_t tok = (size_t)(b * SEQ + c * 128 + l);
        const float xv = bf2f(*(const LAS bf16_t*)(IX + elem_addr(l, p)));
        const float yg = Y[r] + xv * Dh;
        mixb[tok * MIXW + AW + h * 64 + p] = (bf16_t)(cvt_pk_bf16(yg, 0.f) & 0xffffu);
      }
    }
  }
#undef RROW
  __syncthreads();
}
}
constexpr int RING_OFF = 0, RING_BYTES = 131072;
constexpr int TAB_OFF = RING_BYTES;
constexpr int RSL_OFF = TAB_OFF + 8192;
constexpr int MOE_OFF = RSL_OFF + 1024;
constexpr int LDSCTL_OFF = MOE_OFF + 512;
constexpr int MISC_OFF = LDSCTL_OFF + 320;
constexpr int LDS_BYTES = 147456;
static_assert(MISC_OFF + 128 <= LDS_BYTES, "LDS map");
constexpr int NWAVES = 8;

struct Args { const float* in[27]; float* out; unsigned char* ws; float rf[16]; int ph_lo, ph_hi, li, pad; };

struct Frame {
    LAS unsigned char* lds;
    volatile LAS unsigned* MISC;
    int tid, lane, wave, vcu, G;
};

__device__ __forceinline__ void row_to_bf16_rs(const float* xrow, bf16_t* orow, float* rs_out, int lane) {
    const f32x4* xr = (const f32x4*)xrow + lane;
    f32x4 v[8]; float s = 0.f;
#pragma unroll
    for (int j = 0; j < 8; ++j) { v[j] = xr[64 * j]; s += (v[j].x * v[j].x + v[j].y * v[j].y) + (v[j].z * v[j].z + v[j].w * v[j].w); }
    s = wave_sum(s);
    if (lane == 0) *rs_out = rsqrtf(s * (1.f / DM) + EPS);
    u32x2* o8 = (u32x2*)orow + lane;
#pragma unroll
    for (int j = 0; j < 8; ++j) { u32x2 w; w.x = cvt_pk_bf16(v[j].x, v[j].y); w.y = cvt_pk_bf16(v[j].z, v[j].w); o8[64 * j] = w; }
}
struct P0Item { const float* W; const float* sc; bf16_t* dst; int ldw, k0, dK, kd, f8; };
__device__ __forceinline__ void p0_item_load(const P0Item& I, f32x4 (&v)[8], f32x4 (&sv)[2], int lane) {
#pragma unroll
    for (int j = 0; j < 8; ++j) v[j] = __builtin_nontemporal_load((const f32x4*)(I.W + (size_t)(I.k0 + 8 * j + (lane >> 3)) * I.ldw + 4 * (lane & 7)));
    if (I.sc) { sv[0] = *(const f32x4*)(I.sc + I.k0 + 8 * (lane & 7)); sv[1] = *(const f32x4*)(I.sc + I.k0 + 8 * (lane & 7) + 4); }
    else { sv[0] = (f32x4){1.f, 1.f, 1.f, 1.f}; sv[1] = sv[0]; }
}
__device__ __forceinline__ void p0_item_store(const P0Item& I, const f32x4 (&v)[8], const f32x4 (&sv)[2], LAS float* scr, int lane, bool live) {
#pragma unroll
    for (int j = 0; j < 8; ++j) *(LAS f32x4*)(scr + (8 * j + (lane >> 3)) * 36 + 4 * (lane & 7)) = v[j];
    LDS_WAIT(); asm volatile("" ::: "memory");
    const int c = lane & 7;
#pragma unroll
    for (int j = 0; j < 4; ++j) { const int n = (lane >> 3) + 8 * j; const LAS float* s = scr + (8 * c) * 36 + n;
        u32x4 o; o.x = cvt_pk_bf16(s[0 * 36] * sv[0][0], s[1 * 36] * sv[0][1]); o.y = cvt_pk_bf16(s[2 * 36] * sv[0][2], s[3 * 36] * sv[0][3]);
        o.z = cvt_pk_bf16(s[4 * 36] * sv[1][0], s[5 * 36] * sv[1][1]); o.w = cvt_pk_bf16(s[6 * 36] * sv[1][2], s[7 * 36] * sv[1][3]);
        if (I.f8) { u32x2 q; q.x = pk4_fp8(256.f * s[0 * 36] * sv[0][0], 256.f * s[1 * 36] * sv[0][1], 256.f * s[2 * 36] * sv[0][2], 256.f * s[3 * 36] * sv[0][3]);
            q.y = pk4_fp8(256.f * s[4 * 36] * sv[1][0], 256.f * s[5 * 36] * sv[1][1], 256.f * s[6 * 36] * sv[1][2], 256.f * s[7 * 36] * sv[1][3]);
            if (live) __builtin_nontemporal_store(q, (u32x2*)((unsigned char*)I.dst + (size_t)n * I.dK + I.kd + 8 * c)); }
        else if (live) __builtin_nontemporal_store(o, (u32x4*)(I.dst + (size_t)n * I.dK + I.kd + 8 * c)); }
    LDS_WAIT(); asm volatile("" ::: "memory");
}
template <class Dec> __device__ __forceinline__ void p0_items(const Dec& D, const int first, const int stride, const int nitems, LAS float* scr, const int lane) {
#pragma unroll 1
    for (int base = first; base < nitems; base += 4 * stride) {
        P0Item I0, I1, I2, I3; f32x4 v0[8], v1[8], v2[8], v3[8]; f32x4 s0[2], s1[2], s2[2], s3[2];
        const int i1 = base + stride, i2 = base + 2 * stride, i3 = base + 3 * stride;
        const bool h1 = i1 < nitems, h2 = i2 < nitems, h3 = i3 < nitems;
        D(base, I0); D(h1 ? i1 : 0, I1); D(h2 ? i2 : 0, I2); D(h3 ? i3 : 0, I3);
        p0_item_load(I0, v0, s0, lane); p0_item_load(I1, v1, s1, lane); p0_item_load(I2, v2, s2, lane); p0_item_load(I3, v3, s3, lane);
        p0_item_store(I0, v0, s0, scr, lane, true); p0_item_store(I1, v1, s1, scr, lane, h1); p0_item_store(I2, v2, s2, scr, lane, h2); p0_item_store(I3, v3, s3, scr, lane, h3);
    }
}
struct DecIn {
    const float* w_in; const float* nmw; bf16_t* dst;
    __device__ __forceinline__ bool operator()(int r, P0Item& I) const {
        if (r >= 32 * 257) return false;
        const int kb = r / 257, nb = r - kb * 257; I.W = w_in + 32 * nb; I.ldw = INW; I.k0 = 64 * kb; I.sc = nmw; I.dst = dst + (size_t)(32 * nb) * DM; I.dK = DM; I.kd = I.k0; I.f8 = 0; return true;
    }
};
struct DecRest {
    const Args* a; unsigned char* ws;
    __device__ __forceinline__ bool operator()(int r, P0Item& I) const {
        constexpr int I_OUT = 48 * 64, I_CQ = 32 * 16, I_CO = 8 * 64, I_GU = 32 * 32 * 32, I_DN = 32 * 16 * 64;
        const float* const* in = a->in;
        if (r < I_OUT) { const int kb = r / 64, nb = r % 64; I.W = in[11] + 32 * nb; I.ldw = DM; I.k0 = 64 * kb; I.sc = (kb < 16) ? in[9] : (in[10] - AW); I.dst = (bf16_t*)(ws + WS_WOUT_T) + (size_t)(32 * nb) * MIXW; I.dK = MIXW; I.kd = I.k0; I.f8 = 0; return true; } r -= I_OUT;
        if (r < 3 * I_CQ) { const int m = r / I_CQ, q = r - m * I_CQ, kb = q / 16, nb = q % 16; I.W = in[14 + m] + 32 * nb; I.ldw = CW; I.k0 = 64 * kb; I.sc = m == 0 ? in[12] : in[13];
            I.dst = (m == 0 ? (bf16_t*)(ws + WS_WCQ_T) : (bf16_t*)(ws + WS_WCKV_T) + (size_t)(m - 1) * CW * DM) + (size_t)(32 * nb) * DM; I.dK = DM; I.kd = I.k0; I.f8 = 0; return true; } r -= 3 * I_CQ;
        if (r < I_CO) { const int kb = r / 64, nb = r % 64; I.W = in[17] + 32 * nb; I.ldw = DM; I.k0 = 64 * kb; I.sc = nullptr; I.dst = (bf16_t*)(ws + WS_WCO_T) + (size_t)(32 * nb) * CW; I.dK = CW; I.kd = I.k0; I.f8 = 0; return true; } r -= I_CO;
        if (r < 2 * I_GU) { const int up = r >= I_GU; if (up) r -= I_GU; const int e = r >> 10, kb = (r >> 5) & 31, nb = r & 31, n0 = 32 * nb;
            I.W = in[up ? 24 : 23] + (size_t)e * DM * DE + n0; I.ldw = DE; I.k0 = 64 * kb; I.sc = in[18]; I.dst = (bf16_t*)(ws + WS_WGU_T + (size_t)e * 2048 * DM + ((size_t)(((n0 >> 7) * 16 + (kb >> 1)) * 256 + up * 128 + (n0 & 127))) * 128 + (kb & 1) * 64); I.dK = 128; I.kd = 0; I.f8 = 1; return true; } r -= 2 * I_GU;
        if (r < I_DN) { const int e = r >> 10, kb = (r >> 6) & 15, nb = r & 63; I.W = in[25] + (size_t)e * DE * DM + 32 * nb; I.ldw = DM; I.k0 = 64 * kb; I.sc = nullptr; I.dst = (bf16_t*)(ws + WS_WD_T + (size_t)e * 2048 * DE + ((size_t)((((32 * nb) >> 8) * 8 + (kb >> 1)) * 256 + ((32 * nb) & 255))) * 128 + (kb & 1) * 64); I.dK = 128; I.kd = 0; I.f8 = 1; return true; }
        return false;
    }
};
__device__ __forceinline__ void p0a_prologue(Frame& F, const Args& args) {
    LAS float* scr = (LAS float*)(F.lds + RING_OFF + F.wave * 16384);
    const int gw = F.vcu * NWAVES + F.wave, NGW = F.G * NWAVES, lane = F.lane;
    GAS unsigned char* wsg_ = (GAS unsigned char*)args.ws; asm volatile("" : "+s"(wsg_)); unsigned char* ws = (unsigned char*)wsg_;
    { DecIn D{args.in[3], args.in[2], (bf16_t*)(ws + WS_WIN_T)}; p0_items(D, gw, NGW, 32 * 257, scr, lane); }
    { u32x4* z = (u32x4*)((bf16_t*)(ws + WS_WIN_T) + (size_t)INW * DM); const int n16 = (LDP - INW) * DM * 2 / 16;
      for (int i = (F.vcu * NWAVES * 64) + F.tid; i < n16; i += F.G * NWAVES * 64) z[i] = (u32x4){0u, 0u, 0u, 0u}; }
    { float* km = (float*)(ws + WS_KMEAN); for (int i = (F.vcu * NWAVES * 64) + F.tid; i < BATCH * NB * 1024; i += F.G * NWAVES * 64) km[i] = 0.f; }
    { float* tab = (float*)(ws + WS_ROPE);
      for (int i = (F.vcu * NWAVES * 64) + F.tid; i < SEQ * 16; i += F.G * NWAVES * 64) { const int pos = i >> 4, f = i & 15;
        const float ang = (float)pos * args.rf[f]; double r = (double)ang * 0.15915494309189533577; r -= rint(r); const float th = (float)(r * 6.283185307179586477);
        tab[pos * 32 + f] = cosf(th); tab[pos * 32 + 16 + f] = sinf(th); } }
    for (int m = gw; m < M; m += NGW) row_to_bf16_rs(args.in[0] + (size_t)m * DM, (bf16_t*)(ws + WS_XB) + (size_t)m * DM, (float*)(ws + WS_RSX) + m, lane);
}
__device__ __forceinline__ void p0b_share(Frame& F, const Args& args) {
    LAS float* scr = (LAS float*)(F.lds + RING_OFF + F.wave * 16384);
    const int gw = F.vcu * NWAVES + F.wave, NGW = F.G * NWAVES, lane = F.lane;
    GAS unsigned char* wsg_ = (GAS unsigned char*)args.ws; asm volatile("" : "+s"(wsg_)); unsigned char* ws = (unsigned char*)wsg_;
    { DecRest D{&args, ws}; p0_items(D, gw, NGW, 48 * 64 + 3 * 32 * 16 + 8 * 64 + 2 * 32 * 32 * 32 + 32 * 16 * 64, scr, lane); }
    { bf16_t* wh = (bf16_t*)(ws + WS_WR); bf16_t* wl = wh + 48 * DM; const float* nfw = args.in[18];
      for (int i = (F.vcu * NWAVES * 64) + F.tid; i < 48 * DM; i += F.G * NWAVES * 64) { const int n = i >> 11, k = i & (DM - 1);
        const float v = n < NG ? args.in[19][k * NG + n] * nfw[k] : (n < 36 ? args.in[21][k * NE + (n - NG)] * nfw[k] : 0.f);
        const unsigned hb = cvt_pk_bf16(v, 0.f) & 0xffffu; wh[i] = (bf16_t)hb; wl[i] = (bf16_t)(cvt_pk_bf16(v - __uint_as_float(hb << 16), 0.f) & 0xffffu); } }
    for (int m = gw; m < MROWS; m += NGW) row_to_bf16_rs(args.in[1] + (size_t)m * DM, (bf16_t*)(ws + WS_MEMB) + (size_t)m * DM, (float*)(ws + WS_RSMEM) + m, lane);
}

struct SchedG1 {
    const char* A; const char* Bt; int G, c, i0, i1;
    __device__ __forceinline__ bool next(int i, gm::Unit& u) const {
        i += i0; if (i >= i1) return false;
        const int L = i * G + c; if (L >= 64 * 32) return false;
        int pm, pn; gm::tile_of(L, 64, 32, pm, pn);
        u.pm = pm; u.pn = pn; u.kind = 0; u.ti = 0; u.a = A + (size_t)pm * 256 * DM * 2; u.b = Bt + (size_t)pn * 256 * DM * 2; return true;
    }
};
struct EpiG1 {
    bf16_t* proj; float* dtraw; const float* rsx; const float* ropetab; float* kmean;
    __device__ __forceinline__ void operator()(const f32x4 (&acc)[2][2][4][2], const gm::Unit& u, int wr, int wc, int fr, int fq) const {
        const int row0 = u.pm * 256 + wr * 64 + fr;
        const bool rope = (u.pn < 8) && (wc == 0), dtt = (u.pn == 32), ktile = (u.pn >= 4) && (u.pn < 8);
        const float sgn = (fq < 2) ? -1.f : 1.f;
        f32x4 ks[2][2] = {{{0.f, 0.f, 0.f, 0.f}, {0.f, 0.f, 0.f, 0.f}}, {{0.f, 0.f, 0.f, 0.f}, {0.f, 0.f, 0.f, 0.f}}};
#pragma unroll
        for (int ai = 0; ai < 2; ++ai)
#pragma unroll
            for (int m = 0; m < 4; ++m) {
                const int row = row0 + ai * 128 + m * 16; const float rs = rsx[row];
                f32x4 c0 = {1.f, 1.f, 1.f, 1.f}, c1 = c0, s0 = {0.f, 0.f, 0.f, 0.f}, s1 = s0;
                if (rope) { const float* rt = ropetab + (row & (SEQ - 1)) * 32 + 8 * (fq & 1); c0 = *(const f32x4*)rt; c1 = *(const f32x4*)(rt + 4); s0 = *(const f32x4*)(rt + 16); s1 = *(const f32x4*)(rt + 20); }
#pragma unroll
                for (int bj = 0; bj < 2; ++bj) {
                    f32x4 v0 = acc[ai][bj][m][0] * rs, v1 = acc[ai][bj][m][1] * rs;
                    if (rope) {
                        f32x4 p0, p1;
#pragma unroll
                        for (int e = 0; e < 4; ++e) { p0[e] = __shfl_xor(v0[e], 32); p1[e] = __shfl_xor(v1[e], 32); }
                        v0 = v0 * c0 + (p0 * s0) * sgn; v1 = v1 * c1 + (p1 * s1) * sgn;
                    }
                    ks[bj][0] += v0; ks[bj][1] += v1;
                    if (!dtt) { u32x4 w; w.x = cvt_pk_bf16(v0[0], v0[1]); w.y = cvt_pk_bf16(v0[2], v0[3]); w.z = cvt_pk_bf16(v1[0], v1[1]); w.w = cvt_pk_bf16(v1[2], v1[3]);
                        *(u32x4*)(proj + (size_t)row * LDP + u.pn * 256 + bj * 128 + wc * 32 + 8 * fq) = w; }
                    else if (bj == 0 && wc == 0) { float* d = dtraw + (size_t)row * 32 + 8 * fq; *(f32x4*)d = v0; *(f32x4*)(d + 4) = v1; }
                }
                asm volatile("" ::: "memory");
            }
        if (ktile) {
#pragma unroll
            for (int bj = 0; bj < 2; ++bj)
#pragma unroll
                for (int n = 0; n < 2; ++n)
#pragma unroll
                    for (int e = 0; e < 4; ++e) { float s = ks[bj][n][e]; s += __shfl_xor(s, 1); s += __shfl_xor(s, 2); s += __shfl_xor(s, 4); s += __shfl_xor(s, 8);
                        if (fr == 0) atomicAdd(kmean + (size_t)u.pm * 1024 + (u.pn - 4) * 256 + bj * 128 + wc * 32 + 8 * fq + 4 * n + e, s * (1.f / MB)); }
        }
    }
};

struct SchedTiles {
    const char* A; const char* Bt; int nM, nN, K, G, c;
    __device__ __forceinline__ bool next(int i, gm::Unit& u) const {
        const int L = i * G + c; if (L >= nM * nN) return false;
        int pm, pn; gm::tile_of(L, nM, nN, pm, pn);
        u.pm = pm; u.pn = pn; u.kind = 0; u.ti = 0; u.a = A + (size_t)pm * 256 * K * 2; u.b = Bt + (size_t)pn * 256 * K * 2; return true;
    }
};
template <bool Q8> struct EpiRes {
    const float* base; float* outf; bf16_t* hb; float* ss;
    __device__ __forceinline__ void operator()(const f32x4 (&acc)[2][2][4][2], const gm::Unit& u, int wr, int wc, int fr, int fq) const {
        const int row0 = u.pm * 256 + wr * 64 + fr, colb = u.pn * 256 + wc * 32 + 8 * fq;
        f32x4 nb[2][2];
#pragma unroll
        for (int bj = 0; bj < 2; ++bj) { const size_t o = (size_t)row0 * DM + colb + bj * 128; nb[bj][0] = *(const f32x4*)(base + o); nb[bj][1] = *(const f32x4*)(base + o + 4); }
#pragma unroll
        for (int g = 0; g < 8; ++g) {
            const int row = row0 + (g >> 2) * 128 + (g & 3) * 16; float q = 0.f;
            f32x4 cb[2][2];
#pragma unroll
            for (int bj = 0; bj < 2; ++bj) { cb[bj][0] = nb[bj][0]; cb[bj][1] = nb[bj][1]; }
            if (g + 1 < 8) { const int rn = row0 + ((g + 1) >> 2) * 128 + ((g + 1) & 3) * 16;
#pragma unroll
                for (int bj = 0; bj < 2; ++bj) { const size_t o = (size_t)rn * DM + colb + bj * 128; nb[bj][0] = *(const f32x4*)(base + o); nb[bj][1] = *(const f32x4*)(base + o + 4); } }
            asm volatile("" ::: "memory");
#pragma unroll
            for (int bj = 0; bj < 2; ++bj) {
                const size_t o = (size_t)row * DM + colb + bj * 128;
                const f32x4 v0 = acc[g >> 2][bj][g & 3][0] + cb[bj][0], v1 = acc[g >> 2][bj][g & 3][1] + cb[bj][1];
                *(f32x4*)(outf + o) = v0; *(f32x4*)(outf + o + 4) = v1;
                if constexpr (Q8) { u32x2 w8; w8.x = pk4_fp8(v0[0], v0[1], v0[2], v0[3]); w8.y = pk4_fp8(v1[0], v1[1], v1[2], v1[3]); *(u32x2*)((unsigned char*)hb + o) = w8; }
                else { u32x4 w; w.x = cvt_pk_bf16(v0[0], v0[1]); w.y = cvt_pk_bf16(v0[2], v0[3]); w.z = cvt_pk_bf16(v1[0], v1[1]); w.w = cvt_pk_bf16(v1[2], v1[3]); *(u32x4*)(hb + o) = w; }
                q += (v0[0] * v0[0] + v0[1] * v0[1]) + (v0[2] * v0[2] + v0[3] * v0[3]) + (v1[0] * v1[0] + v1[1] * v1[1]) + (v1[2] * v1[2] + v1[3] * v1[3]);
            }
            if (ss) { q += __shfl_xor(q, 16); q += __shfl_xor(q, 32); if (fq == 0) ss[(size_t)row * 32 + u.pn * 4 + wc] = q; }
        }
    }
};
struct SchedQKV {
    const char* A0; const char* B0; const char* A1; const char* B1; int G, c;
    __device__ __forceinline__ bool next(int i, gm::Unit& u) const {
        const int L = i * G + c; int pm, pn;
        if (L < 128) { gm::tile_of(L, 64, 2, pm, pn); u.kind = 0; u.a = A0 + (size_t)pm * 256 * DM * 2; u.b = B0 + (size_t)pn * 256 * DM * 2; }
        else if (L < 160) { gm::tile_of(L - 128, 8, 4, pm, pn); u.kind = 1; u.a = A1 + (size_t)pm * 256 * DM * 2; u.b = B1 + (size_t)pn * 256 * DM * 2; }
        else return false;
        u.pm = pm; u.pn = pn; u.ti = 0; return true;
    }
};
struct EpiScale {
    bf16_t* O0; bf16_t* O1; int ld0, ld1; const LAS float* rsl;
    __device__ __forceinline__ void operator()(const f32x4 (&acc)[2][2][4][2], const gm::Unit& u, int wr, int wc, int fr, int fq) const {
        bf16_t* O = u.kind ? O1 : O0; const int ld = u.kind ? ld1 : ld0;
#pragma unroll
        for (int ai = 0; ai < 2; ++ai)
#pragma unroll
            for (int m = 0; m < 4; ++m) {
                const int r = ai * 128 + wr * 64 + m * 16 + fr; const float rs = rsl[r];
#pragma unroll
                for (int bj = 0; bj < 2; ++bj) {
                    const f32x4 v0 = acc[ai][bj][m][0] * rs, v1 = acc[ai][bj][m][1] * rs;
                    u32x4 w; w.x = cvt_pk_bf16(v0[0], v0[1]); w.y = cvt_pk_bf16(v0[2], v0[3]); w.z = cvt_pk_bf16(v1[0], v1[1]); w.w = cvt_pk_bf16(v1[2], v1[3]);
                    *(u32x4*)(O + (size_t)(u.pm * 256 + r) * ld + u.pn * 256 + bj * 128 + wc * 32 + 8 * fq) = w;
                }
            }
    }
};

__device__ __forceinline__ void moe_tables(LAS int* mt, const int* cnt_g, int tid) {
    if (tid < 32) mt[tid] = cnt_g[tid];
    LDS_WAIT(); __syncthreads();
    if (tid == 0) { int p = 0, o = 0; for (int e = 0; e < NE; ++e) { mt[32 + e] = p; mt[65 + e] = o; const int c = mt[e]; p += 8 * ((c + 255) >> 8); o += c; } mt[32 + NE] = p; mt[65 + NE] = o; }
    LDS_WAIT(); __syncthreads();
}
__device__ __forceinline__ void moe_unit_list(LAS int* ul, const LAS int* mt, int G, int c, int tid) {
    if (tid < 8) {
        const int L = tid * G + c; int v = 0, e = 0, pn = 0, mtile = 0;
        if (L < mt[32 + NE]) {
            for (int k = 1; k < NE; ++k) if (L >= mt[32 + k]) e = k;
            const int rem = L - mt[32 + e], te = (mt[e] + 255) >> 8; pn = rem / te; mtile = rem - pn * te; v = 1;
        }
        ul[4 * tid] = e; ul[4 * tid + 1] = pn; ul[4 * tid + 2] = mtile; ul[4 * tid + 3] = v;
    }
    LDS_WAIT(); __syncthreads();
}
template <bool GU> struct SchedMoEL {
    const LAS int* ul; const char* A; const char* Bt;
    __device__ __forceinline__ bool next(int i, gm::Unit& u) const {
        if (i >= 8 || __builtin_amdgcn_readfirstlane(ul[4 * i + 3]) == 0) return false;
        const int e = __builtin_amdgcn_readfirstlane(ul[4 * i]), pn = __builtin_amdgcn_readfirstlane(ul[4 * i + 1]);
        u.pm = __builtin_amdgcn_readfirstlane(ul[4 * i + 2]); u.pn = pn; u.kind = e; u.ti = i; u.a = A;
        u.b = Bt + ((size_t)e * 2048 + pn * 256) * (GU ? DM : DE);
        return true;
    }
};
struct EpiGU {
    bf16_t* Hact; const float* rs2; const LAS int* mt; const LAS int* tab;
    __device__ __forceinline__ void operator()(const f32x4 (&acc)[2][2][4][2], const gm::Unit& u, int wr, int wc, int fr, int fq) const {
        const int e = u.kind, valid = mt[e] - u.pm * 256, slot0 = mt[65 + e] + u.pm * 256;
        float rsv[8];
#pragma unroll
        for (int g = 0; g < 8; ++g) rsv[g] = rs2[tab[u.ti * 256 + (g >> 2) * 128 + wr * 64 + (g & 3) * 16 + fr]];
#pragma unroll
        for (int ai = 0; ai < 2; ++ai)
#pragma unroll
            for (int m = 0; m < 4; ++m) {
                const int r = ai * 128 + wr * 64 + m * 16 + fr;
                if (r < valid) {
                    const float rs = rsv[ai * 4 + m] * (1.f / 256.f);
                    const f32x4 g0 = acc[ai][0][m][0] * rs, g1 = acc[ai][0][m][1] * rs, u0 = acc[ai][1][m][0] * rs, u1 = acc[ai][1][m][1] * rs;
                    float o[8];
#pragma unroll
                    for (int j = 0; j < 4; ++j) { o[j] = g0[j] * __builtin_amdgcn_rcpf(1.f + __expf(-g0[j])) * u0[j]; o[4 + j] = g1[j] * __builtin_amdgcn_rcpf(1.f + __expf(-g1[j])) * u1[j]; }
                    u32x2 w; w.x = pk4_fp8(16.f * o[0], 16.f * o[1], 16.f * o[2], 16.f * o[3]); w.y = pk4_fp8(16.f * o[4], 16.f * o[5], 16.f * o[6], 16.f * o[7]);
                    *(u32x2*)((unsigned char*)Hact + (size_t)(slot0 + r) * DE + u.pn * 128 + wc * 32 + 8 * fq) = w;
                }
            }
    }
};
struct EpiDown {
    bf16_t* Y; const LAS int* mt;
    __device__ __forceinline__ void operator()(const f32x4 (&acc)[2][2][4][2], const gm::Unit& u, int wr, int wc, int fr, int fq) const {
        const int e = u.kind, valid = mt[e] - u.pm * 256, slot0 = mt[65 + e] + u.pm * 256;
#pragma unroll
        for (int ai = 0; ai < 2; ++ai)
#pragma unroll
            for (int m = 0; m < 4; ++m) {
                const int r = ai * 128 + wr * 64 + m * 16 + fr;
                if (r < valid) {
#pragma unroll
                    for (int bj = 0; bj < 2; ++bj) { const f32x4 v0 = acc[ai][bj][m][0] * (1.f / 4096.f), v1 = acc[ai][bj][m][1] * (1.f / 4096.f);
                        u32x4 w; w.x = cvt_pk_bf16(v0[0], v0[1]); w.y = cvt_pk_bf16(v0[2], v0[3]); w.z = cvt_pk_bf16(v1[0], v1[1]); w.w = cvt_pk_bf16(v1[2], v1[3]);
                        *(u32x4*)(Y + (size_t)(slot0 + r) * DM + u.pn * 256 + bj * 128 + wc * 32 + 8 * fq) = w; }
                }
            }
    }
};
__device__ __forceinline__ void final_rows(Frame& F, float* hio, const bf16_t* Y, const int* tok_e, const int* tok_pos, const float* tok_w, const float* fw, const LAS int* mt) {
    const int gw = F.vcu * NWAVES + F.wave, NGW = F.G * NWAVES, lane = F.lane;
    for (int t = gw; t < M; t += NGW) {
        const int e1 = tok_e[2 * t], e2 = tok_e[2 * t + 1];
        const size_t s1 = (size_t)(mt[65 + e1] + tok_pos[2 * t]), s2 = (size_t)(mt[65 + e2] + tok_pos[2 * t + 1]);
        const float w1 = tok_w[2 * t], w2 = tok_w[2 * t + 1];
        f32x4* hr = (f32x4*)(hio + (size_t)t * DM) + 2 * lane;
        const u32x4* y1 = (const u32x4*)(Y + s1 * DM) + lane; const u32x4* y2 = (const u32x4*)(Y + s2 * DM) + lane;
        float v[4][8]; float ss = 0.f;
#pragma unroll
        for (int j = 0; j < 4; ++j) {
            const f32x4 a0 = hr[128 * j], a1 = hr[128 * j + 1]; const u32x4 p = y1[64 * j], q = y2[64 * j];
            const float pa[8] = {bflo(p.x), bfhi(p.x), bflo(p.y), bfhi(p.y), bflo(p.z), bfhi(p.z), bflo(p.w), bfhi(p.w)};
            const float qa[8] = {bflo(q.x), bfhi(q.x), bflo(q.y), bfhi(q.y), bflo(q.z), bfhi(q.z), bflo(q.w), bfhi(q.w)};
            const float ha[8] = {a0[0], a0[1], a0[2], a0[3], a1[0], a1[1], a1[2], a1[3]};
#pragma unroll
            for (int k = 0; k < 8; ++k) { v[j][k] = ha[k] + (w1 * pa[k] + w2 * qa[k]); ss += v[j][k] * v[j][k]; }
        }
        ss = wave_sum(ss);
        const float rs = rsqrtf(ss * (1.f / DM) + EPS);
#pragma unroll
        for (int j = 0; j < 4; ++j) {
            const f32x4 g0 = *((const f32x4*)fw + 2 * lane + 128 * j), g1 = *((const f32x4*)fw + 2 * lane + 128 * j + 1);
            hr[128 * j] = (f32x4){v[j][0] * rs * g0[0], v[j][1] * rs * g0[1], v[j][2] * rs * g0[2], v[j][3] * rs * g0[3]};
            hr[128 * j + 1] = (f32x4){v[j][4] * rs * g1[0], v[j][5] * rs * g1[1], v[j][6] * rs * g1[2], v[j][7] * rs * g1[3]};
        }
    }
}

__device__ __forceinline__ void router_rows(Frame& F, const float* h2, const bf16_t* wrh, const float* b_rg, const float* b_re, float* rs2, int* cnt, int* list, int* tok_e, int* tok_pos, float* tok_w) {
    const int lane = F.lane, tid = F.tid, w = F.wave, ti = lane & 15, kg = lane >> 4;
    LAS float* part = (LAS float*)(F.lds + RING_OFF);
    LAS float* sqp = part + 8 * 16 * 48;
    LAS float* lgt = sqp + 8 * 16;
    const bf16_t* wrl = wrh + 48 * DM;
    for (int g = F.vcu; g < M / 16; g += F.G) {
        const float* hr = h2 + (size_t)(g * 16 + ti) * DM + w * 256 + 8 * kg;
        f32x4 acc[3] = {{0.f, 0.f, 0.f, 0.f}, {0.f, 0.f, 0.f, 0.f}, {0.f, 0.f, 0.f, 0.f}}; float sq = 0.f;
#pragma unroll 2
        for (int s = 0; s < 8; ++s) {
            const f32x4 x0 = *(const f32x4*)(hr + 32 * s), x1 = *(const f32x4*)(hr + 32 * s + 4);
            bf16x8 bh[3], bl[3];
#pragma unroll
            for (int nt = 0; nt < 3; ++nt) { const size_t o = (size_t)(16 * nt + ti) * DM + w * 256 + 32 * s + 8 * kg; bh[nt] = *(const bf16x8*)(wrh + o); bl[nt] = *(const bf16x8*)(wrl + o); }
            sq += (x0[0] * x0[0] + x0[1] * x0[1]) + (x0[2] * x0[2] + x0[3] * x0[3]) + (x1[0] * x1[0] + x1[1] * x1[1]) + (x1[2] * x1[2] + x1[3] * x1[3]);
            u32x4 hw, lw;
            hw.x = cvt_pk_bf16(x0[0], x0[1]); hw.y = cvt_pk_bf16(x0[2], x0[3]); hw.z = cvt_pk_bf16(x1[0], x1[1]); hw.w = cvt_pk_bf16(x1[2], x1[3]);
            lw.x = cvt_pk_bf16(x0[0] - bflo(hw.x), x0[1] - bfhi(hw.x)); lw.y = cvt_pk_bf16(x0[2] - bflo(hw.y), x0[3] - bfhi(hw.y));
            lw.z = cvt_pk_bf16(x1[0] - bflo(hw.z), x1[1] - bfhi(hw.z)); lw.w = cvt_pk_bf16(x1[2] - bflo(hw.w), x1[3] - bfhi(hw.w));
            const bf16x8 ah = *reinterpret_cast<const bf16x8*>(&hw), al = *reinterpret_cast<const bf16x8*>(&lw);
#pragma unroll
            for (int nt = 0; nt < 3; ++nt) { acc[nt] = __builtin_amdgcn_mfma_f32_16x16x32_bf16(ah, bh[nt], acc[nt], 0, 0, 0); acc[nt] = __builtin_amdgcn_mfma_f32_16x16x32_bf16(ah, bl[nt], acc[nt], 0, 0, 0);
                acc[nt] = __builtin_amdgcn_mfma_f32_16x16x32_bf16(al, bh[nt], acc[nt], 0, 0, 0); }
        }
        sq += __shfl_xor(sq, 16); sq += __shfl_xor(sq, 32);
        __syncthreads();
#pragma unroll
        for (int nt = 0; nt < 3; ++nt)
#pragma unroll
            for (int r = 0; r < 4; ++r) part[(w * 16 + 4 * kg + r) * 48 + 16 * nt + ti] = acc[nt][r];
        if (kg == 0) sqp[w * 16 + ti] = sq;
        __syncthreads();
        for (int i = tid; i < 16 * 48 + 16; i += NWAVES * 64) { float s = 0.f;
            if (i < 16 * 48) {
#pragma unroll
                for (int ww = 0; ww < 8; ++ww) s += part[ww * 16 * 48 + i]; }
            else {
#pragma unroll
                for (int ww = 0; ww < 8; ++ww) s += sqp[ww * 16 + (i - 16 * 48)]; }
            lgt[i] = s; }
        __syncthreads();
        if (tid < 16) {
            const int tt = g * 16 + tid; const LAS float* lg = lgt + tid * 48;
            const float rs = rsqrtf(lgt[16 * 48 + tid] * (1.f / DM) + EPS);
            float gm_ = -INFINITY; int gi = 0; float gv[4];
#pragma unroll
            for (int i = 0; i < 4; ++i) { gv[i] = lg[i] * rs + b_rg[i]; if (gv[i] > gm_) { gm_ = gv[i]; gi = i; } }
            float gs = 0.f;
#pragma unroll
            for (int i = 0; i < 4; ++i) gs += __expf(gv[i] - gm_);
            const float gwt = 1.f / gs;
            float e1 = -INFINITY, e2 = -INFINITY; int i1 = 0, i2 = 0;
#pragma unroll
            for (int i = 0; i < 8; ++i) { const float vv = lg[4 + gi * 8 + i] * rs + b_re[gi * 8 + i]; if (vv > e1) { e2 = e1; i2 = i1; e1 = vv; i1 = i; } else if (vv > e2) { e2 = vv; i2 = i; } }
            const float p2 = 1.f / (1.f + __expf(e1 - e2)), p1 = 1.f - p2;
            const int ea = gi * 8 + i1, eb = gi * 8 + i2;
            const int pa = atomicAdd(&cnt[ea], 1), pb = atomicAdd(&cnt[eb], 1);
            list[ea * M + pa] = tt; list[eb * M + pb] = tt;
            tok_e[tt * 2] = ea; tok_e[tt * 2 + 1] = eb; tok_pos[tt * 2] = pa; tok_pos[tt * 2 + 1] = pb; tok_w[tt * 2] = gwt * p1; tok_w[tt * 2 + 1] = gwt * p2; rs2[tt] = rs;
        }
    }
    __syncthreads();
}

__device__ __forceinline__ void dt_rows(Frame& F, const bf16_t* xb, const bf16_t* wdt, const float* rsx, float* dtraw) {
    const int lane = F.lane, tid = F.tid, w = F.wave, ti = lane & 15, kg = lane >> 4;
    LAS float* part = (LAS float*)(F.lds + RING_OFF);
    for (int g = F.vcu; g < M / 16; g += F.G) {
        const bf16_t* ar = xb + (size_t)(g * 16 + ti) * DM + w * 256 + 8 * kg;
        f32x4 acc[2] = {{0.f, 0.f, 0.f, 0.f}, {0.f, 0.f, 0.f, 0.f}};
        bf16x8 af[8], b0[8], b1[8];
#pragma unroll
        for (int s = 0; s < 8; ++s) { af[s] = *(const bf16x8*)(ar + 32 * s); b0[s] = *(const bf16x8*)(wdt + (size_t)ti * DM + w * 256 + 32 * s + 8 * kg); b1[s] = *(const bf16x8*)(wdt + (size_t)(16 + ti) * DM + w * 256 + 32 * s + 8 * kg); }
#pragma unroll
        for (int s = 0; s < 8; ++s) { acc[0] = __builtin_amdgcn_mfma_f32_16x16x32_bf16(af[s], b0[s], acc[0], 0, 0, 0); acc[1] = __builtin_amdgcn_mfma_f32_16x16x32_bf16(af[s], b1[s], acc[1], 0, 0, 0); }
        __syncthreads();
#pragma unroll
        for (int nt = 0; nt < 2; ++nt)
#pragma unroll
            for (int r = 0; r < 4; ++r) part[(w * 16 + 4 * kg + r) * 32 + 16 * nt + ti] = acc[nt][r];
        __syncthreads();
        { float s = 0.f;
#pragma unroll
          for (int ww = 0; ww < 8; ++ww) s += part[ww * 512 + tid];
          const int tok = g * 16 + (tid >> 5); dtraw[(size_t)tok * 32 + (tid & 31)] = s * rsx[tok]; }
    }
    __syncthreads();
}

__device__ __forceinline__ void gnorm_rows(Frame& F, bf16_t* mixb, const bf16_t* proj) {
    const int gw = F.vcu * NWAVES + F.wave, NGW = F.G * NWAVES, lane = F.lane;
#pragma unroll 2
    for (int tok = gw; tok < M; tok += NGW) {
        u32x4* p = (u32x4*)(mixb + (size_t)tok * MIXW + AW) + lane; const u32x4* zp = (const u32x4*)(proj + (size_t)tok * LDP + C_Z) + lane;
        u32x4 w[4], zw[4]; float v[4][8]; float q[4];
#pragma unroll
        for (int g = 0; g < 4; ++g) { w[g] = p[64 * g]; zw[g] = zp[64 * g]; }
#pragma unroll
        for (int g = 0; g < 4; ++g) { float z[8] = {bflo(zw[g].x), bfhi(zw[g].x), bflo(zw[g].y), bfhi(zw[g].y), bflo(zw[g].z), bfhi(zw[g].z), bflo(zw[g].w), bfhi(zw[g].w)};
#pragma unroll
            for (int e = 0; e < 8; ++e) z[e] = z[e] * __builtin_amdgcn_rcpf(1.f + __expf(-z[e]));
            v[g][0] = bflo(w[g].x) * z[0]; v[g][1] = bfhi(w[g].x) * z[1]; v[g][2] = bflo(w[g].y) * z[2]; v[g][3] = bfhi(w[g].y) * z[3]; v[g][4] = bflo(w[g].z) * z[4]; v[g][5] = bfhi(w[g].z) * z[5]; v[g][6] = bflo(w[g].w) * z[6]; v[g][7] = bfhi(w[g].w) * z[7];
            q[g] = (v[g][0] * v[g][0] + v[g][1] * v[g][1]) + (v[g][2] * v[g][2] + v[g][3] * v[g][3]) + (v[g][4] * v[g][4] + v[g][5] * v[g][5]) + (v[g][6] * v[g][6] + v[g][7] * v[g][7]); }
#pragma unroll
        for (int o = 1; o < 64; o <<= 1) {
#pragma unroll
            for (int g = 0; g < 4; ++g) q[g] += __shfl_xor(q[g], o); }
#pragma unroll
        for (int g = 0; g < 4; ++g) { const float rs = rsqrtf(q[g] * (1.f / 512.f) + EPS); u32x4 o;
            o.x = cvt_pk_bf16(v[g][0] * rs, v[g][1] * rs); o.y = cvt_pk_bf16(v[g][2] * rs, v[g][3] * rs); o.z = cvt_pk_bf16(v[g][4] * rs, v[g][5] * rs); o.w = cvt_pk_bf16(v[g][6] * rs, v[g][7] * rs);
            p[64 * g] = o; }
    }
}

#ifndef REP_P0
#define REP_P0 1
#endif
#ifndef REP_P0B
#define REP_P0B 1
#endif
#ifndef REP_G1
#define REP_G1 1
#endif
#ifndef REP_SSD
#define REP_SSD 1
#endif
#ifndef REP_MOE
#define REP_MOE 1
#endif
#ifndef REP_ATT
#define REP_ATT 1
#endif
#ifndef REP_G2
#define REP_G2 1
#endif
__global__ void __launch_bounds__(NWAVES * 64, 2) fwd(Args args) {
    extern __shared__ __attribute__((aligned(16))) unsigned char lds_raw[];
    Frame F;
    F.lds = (LAS unsigned char*)lds_raw;
    F.MISC = (volatile LAS unsigned*)(F.lds + MISC_OFF);
    F.tid = threadIdx.x; F.lane = F.tid & 63; F.wave = __builtin_amdgcn_readfirstlane(F.tid >> 6);
    F.G = gridDim.x; { const int bx = blockIdx.x; F.vcu = (F.G % 8 == 0) ? (bx % 8) * (F.G / 8) + bx / 8 : bx; }
    for (int u = F.tid; u < (LDS_BYTES - LDSCTL_OFF) / 4; u += NWAVES * 64) ((LAS unsigned*)(F.lds + LDSCTL_OFF))[u] = 0u;
    __syncthreads();
    (void)xcd_barrier_post((unsigned*)(args.ws + WS_CTL) + CW_BAR + args.li * XCD_BAR_WORDS, F.MISC + 8);
#define GRID_BAR() do { GAS unsigned char* wb_ = (GAS unsigned char*)args.ws; asm volatile("" : "+s"(wb_)); XcdBarrier b_; \
        b_.bar = (unsigned*)((unsigned char*)wb_ + WS_CTL) + CW_BAR + args.li * XCD_BAR_WORDS; b_.x = xb_xcc_id(); b_.st = F.MISC + 8; xcd_barrier(b_, F.wave * 64 + lane_id_now()); } while (0)
    const int lo = args.ph_lo, hi = args.ph_hi;
#define IN(k) (lo <= (k) && (k) < hi)
#define BOTH(k) (IN(k) && IN((k) + 1))
#define PHASE_WS() F.lane = lane_id_now(); F.tid = F.wave * 64 + F.lane; GAS unsigned char* wsg_ = (GAS unsigned char*)args.ws; asm volatile("" : "+s"(wsg_)); unsigned char* ws = (unsigned char*)wsg_
    if (IN(0)) { F.lane = lane_id_now(); F.tid = F.wave * 64 + F.lane;
p0a_prologue(F, args); if constexpr (REP_P0 > 1) p0a_prologue(F, args); if (BOTH(0)) GRID_BAR(); }
    if (IN(1)) {
        PHASE_WS();
        const int rsplit = (F.vcu >> 5) & 7;
        EpiG1 E{(bf16_t*)(ws + WS_PROJ), (float*)(ws + WS_DTRAW), (const float*)(ws + WS_RSX), (const float*)(ws + WS_ROPE), (float*)(ws + WS_KMEAN)};
        { SchedG1 S{(const char*)(ws + WS_XB), (const char*)(ws + WS_WIN_T), F.G, (int)blockIdx.x, 0, rsplit};
          gm::gemm_phase<EpiG1, SchedG1, false>(F.tid, F.lds + RING_OFF, (const LAS int*)(F.lds + TAB_OFF), DM, S, E); }
        __syncthreads();
        p0b_share(F, args);
        if constexpr (REP_P0B > 1) { __syncthreads(); p0b_share(F, args); }
        __syncthreads();
        { F.lane = lane_id_now(); F.tid = F.wave * 64 + F.lane;
          SchedG1 S{(const char*)(ws + WS_XB), (const char*)(ws + WS_WIN_T), F.G, (int)blockIdx.x, rsplit, 1 << 20};
          gm::gemm_phase<EpiG1, SchedG1, false>(F.tid, F.lds + RING_OFF, (const LAS int*)(F.lds + TAB_OFF), DM, S, E); }
        if (BOTH(1)) GRID_BAR();
    }
    if (IN(2)) {
        PHASE_WS();
        dt_rows(F, (const bf16_t*)(ws + WS_XB), (const bf16_t*)(ws + WS_WIN_T) + (size_t)C_DT * DM, (const float*)(ws + WS_RSX), (float*)(ws + WS_DTRAW));
        sd::conv_prepass(F.vcu * NWAVES * 64 + F.tid, F.G * NWAVES * 64, (const bf16_t*)(ws + WS_PROJ), args.in[4], args.in[5], (bf16_t*)(ws + WS_XBCC));
        if (BOTH(2)) GRID_BAR();
    }
    if (IN(3)) {
        PHASE_WS();
        for (int L = F.vcu; L < BATCH * SH; L += F.G)
            sd::ssd_unit(F.tid, L / SH, L % SH, (const bf16_t*)(ws + WS_PROJ), (const bf16_t*)(ws + WS_XBCC), (const float*)(ws + WS_DTRAW), args.in[6], args.in[7], args.in[8],
                         (bf16_t*)(ws + WS_MIXB), (LAS char*)(F.lds + RING_OFF));
        if constexpr (REP_SSD > 1) {
        for (int L = F.vcu; L < BATCH * SH; L += F.G)
            sd::ssd_unit(F.tid, L / SH, L % SH, (const bf16_t*)(ws + WS_PROJ), (const bf16_t*)(ws + WS_XBCC), (const float*)(ws + WS_DTRAW), args.in[6], args.in[7], args.in[8],
                         (bf16_t*)(ws + WS_MIXB), (LAS char*)(F.lds + RING_OFF));
        }
        if (BOTH(3)) GRID_BAR();
    }
    if (IN(4)) {
        PHASE_WS();
        for (int L = F.vcu; L < BATCH * AH * 4; L += F.G) {
            const int b = L >> 5, h = (L >> 2) & 7, pi = L & 3;
            const bf16_t* pb = (const bf16_t*)(ws + WS_PROJ) + (size_t)b * SEQ * LDP + h * HD;
#pragma unroll 1
            for (int k = 0; k < 2; ++k) { const int jb = k ? pi : 7 - pi;
                at::attn_unit<true>(F.tid, pb + (size_t)jb * MB * LDP + C_Q, pb + C_K, (bf16_t*)(ws + WS_MIXB) + (size_t)(b * SEQ + jb * MB) * MIXW + h * HD,
                                    4 * (jb + 1), jb, (const float*)(ws + WS_KMEAN) + (size_t)b * NB * 1024 + h * HD, (LAS char*)(F.lds + RING_OFF)); }
        }
        if constexpr (REP_ATT > 1) {
        for (int L = F.vcu; L < BATCH * AH * 4; L += F.G) {
            const int b = L >> 5, h = (L >> 2) & 7, pi = L & 3;
            const bf16_t* pb = (const bf16_t*)(ws + WS_PROJ) + (size_t)b * SEQ * LDP + h * HD;
#pragma unroll 1
            for (int k = 0; k < 2; ++k) { const int jb = k ? pi : 7 - pi;
                at::attn_unit<true>(F.tid, pb + (size_t)jb * MB * LDP + C_Q, pb + C_K, (bf16_t*)(ws + WS_MIXB) + (size_t)(b * SEQ + jb * MB) * MIXW + h * HD,
                                    4 * (jb + 1), jb, (const float*)(ws + WS_KMEAN) + (size_t)b * NB * 1024 + h * HD, (LAS char*)(F.lds + RING_OFF)); }
        }
        }
        __syncthreads();
        gnorm_rows(F, (bf16_t*)(ws + WS_MIXB), (const bf16_t*)(ws + WS_PROJ));
        if (BOTH(4)) GRID_BAR();
    }
    if (IN(5)) {
        PHASE_WS();
        SchedTiles S{(const char*)(ws + WS_MIXB), (const char*)(ws + WS_WOUT_T), 64, 8, MIXW, F.G, (int)blockIdx.x};
        EpiRes<false> E{args.in[0], args.out, (bf16_t*)(ws + WS_XB), (float*)(ws + WS_SS)};
        gm::gemm_phase<EpiRes<false>, SchedTiles, false>(F.tid, F.lds + RING_OFF, (const LAS int*)(F.lds + TAB_OFF), MIXW, S, E);
        if constexpr (REP_G2 > 1) { __syncthreads(); gm::gemm_phase<EpiRes<false>, SchedTiles, false>(F.tid, F.lds + RING_OFF, (const LAS int*)(F.lds + TAB_OFF), MIXW, S, E); }
        if (BOTH(5)) GRID_BAR();
    }
    if (IN(6)) {
        PHASE_WS();
        SchedQKV S{(const char*)(ws + WS_XB), (const char*)(ws + WS_WCQ_T), (const char*)(ws + WS_MEMB), (const char*)(ws + WS_WCKV_T), F.G, (int)blockIdx.x};
        gm::Unit u0; LAS float* rsl = (LAS float*)(F.lds + RSL_OFF);
        if (S.next(0, u0) && F.tid < 256) {
            const int row = u0.pm * 256 + F.tid;
            if (u0.kind == 0) { const f32x4* p = (const f32x4*)((const float*)(ws + WS_SS) + (size_t)row * 32); float q = 0.f;
#pragma unroll
                for (int j = 0; j < 8; ++j) { const f32x4 v = p[j]; q += (v[0] + v[1]) + (v[2] + v[3]); }
                rsl[F.tid] = rsqrtf(q * (1.f / DM) + EPS); }
            else rsl[F.tid] = ((const float*)(ws + WS_RSMEM))[row];
        }
        VM_WAIT(); LDS_WAIT(); __syncthreads();
        EpiScale E{(bf16_t*)(ws + WS_QC), (bf16_t*)(ws + WS_KVC), CW, 2 * CW, rsl};
        gm::gemm_phase<EpiScale, SchedQKV, false>(F.tid, F.lds + RING_OFF, (const LAS int*)(F.lds + TAB_OFF), DM, S, E);
        if (BOTH(6)) GRID_BAR();
    }
    if (IN(7)) {
        PHASE_WS();
        for (int L = F.vcu; L < BATCH * CH * 8; L += F.G) {
            const int b = L >> 5, h = (L >> 3) & 3, qt = L & 7;
            const bf16_t* kb_ = (const bf16_t*)(ws + WS_KVC) + (size_t)b * MEM * (2 * CW) + h * CHD;
            at::attn_unit<false>(F.tid, (const bf16_t*)(ws + WS_QC) + (size_t)(b * SEQ + qt * 256) * CW + h * CHD, kb_,
                                 (bf16_t*)(ws + WS_OC) + (size_t)(b * SEQ + qt * 256) * CW + h * CHD, 4, 0, nullptr, (LAS char*)(F.lds + RING_OFF));
        }
        __syncthreads();
        if (BOTH(7)) GRID_BAR();
    }
    if (IN(8)) {
        PHASE_WS();
        SchedTiles S{(const char*)(ws + WS_OC), (const char*)(ws + WS_WCO_T), 64, 8, CW, F.G, (int)blockIdx.x};
        EpiRes<true> E{args.out, args.out, (bf16_t*)(ws + WS_XB), nullptr};
        gm::gemm_phase<EpiRes<true>, SchedTiles, false>(F.tid, F.lds + RING_OFF, (const LAS int*)(F.lds + TAB_OFF), CW, S, E);
        if (BOTH(8)) GRID_BAR();
    }
    if (IN(9)) {
        PHASE_WS();
        int* tok_e = (int*)(ws + WS_TOK);
        router_rows(F, args.out, (const bf16_t*)(ws + WS_WR), args.in[20], args.in[22], (float*)(ws + WS_RS2), (int*)(ws + WS_CTL) + CW_CNT, (int*)(ws + WS_LIST), tok_e, tok_e + 2 * M, (float*)(tok_e + 4 * M));
        if (BOTH(9)) GRID_BAR();
    }
    if (IN(10)) {
        PHASE_WS();
        LAS int* mt = (LAS int*)(F.lds + MOE_OFF); LAS int* tab = (LAS int*)(F.lds + TAB_OFF); LAS int* ul = mt + 100;
        moe_tables(mt, (const int*)(ws + WS_CTL) + CW_CNT, F.tid);
        moe_unit_list(ul, mt, F.G, F.vcu, F.tid);
        SchedMoEL<true> SL{ul, (const char*)(ws + WS_XB), (const char*)(ws + WS_WGU_T)};
        { const int* list = (const int*)(ws + WS_LIST); gm::Unit u;
          for (int i = 0; i < 8 && SL.next(i, u); ++i) if (F.tid < 256) { const int rg = u.pm * 256 + F.tid; tab[i * 256 + F.tid] = list[u.kind * M + (rg < mt[u.kind] ? rg : 0)]; } }
        VM_WAIT(); LDS_WAIT(); __syncthreads();
        EpiGU E{(bf16_t*)(ws + WS_HACT), (const float*)(ws + WS_RS2), mt, tab};
        gm::gemm_phase<EpiGU, SchedMoEL<true>, true, true, true>(F.tid, F.lds + RING_OFF, tab, DM / 2, SL, E);
        if constexpr (REP_MOE > 1) { __syncthreads(); gm::gemm_phase<EpiGU, SchedMoEL<true>, true, true, true>(F.tid, F.lds + RING_OFF, tab, DM / 2, SL, E); }
        if (BOTH(10)) GRID_BAR();
    }
    if (IN(11)) {
        PHASE_WS();
        LAS int* mt = (LAS int*)(F.lds + MOE_OFF);
        moe_tables(mt, (const int*)(ws + WS_CTL) + CW_CNT, F.tid);
        LAS int* tab = (LAS int*)(F.lds + TAB_OFF); LAS int* ul = mt + 100;
        moe_unit_list(ul, mt, F.G, F.vcu, F.tid);
        SchedMoEL<false> SL{ul, (const char*)(ws + WS_HACT), (const char*)(ws + WS_WD_T)};
        { gm::Unit u;
          for (int i = 0; i < 8 && SL.next(i, u); ++i) if (F.tid < 256) tab[i * 256 + F.tid] = mt[65 + u.kind] + u.pm * 256 + F.tid; }
        LDS_WAIT(); __syncthreads();
        EpiDown E{(bf16_t*)(ws + WS_Y), mt};
        gm::gemm_phase<EpiDown, SchedMoEL<false>, true, true, true>(F.tid, F.lds + RING_OFF, tab, DE / 2, SL, E);
        if constexpr (REP_MOE > 1) { __syncthreads(); gm::gemm_phase<EpiDown, SchedMoEL<false>, true, true, true>(F.tid, F.lds + RING_OFF, tab, DE / 2, SL, E); }
        if (BOTH(11)) GRID_BAR();
    }
    if (IN(12)) {
        PHASE_WS();
        LAS int* mt = (LAS int*)(F.lds + MOE_OFF);
        moe_tables(mt, (const int*)(ws + WS_CTL) + CW_CNT, F.tid);
        const int* tok_e = (const int*)(ws + WS_TOK);
        final_rows(F, args.out, (const bf16_t*)(ws + WS_Y), tok_e, tok_e + 2 * M, (const float*)(tok_e + 4 * M), args.in[26], mt);
    }
#undef IN
#undef BOTH
}
extern "C" void kernel_launch(void* const* d_in, const int* in_sizes, int n_in, void* d_out, int out_size, void* d_ws, size_t ws_size, hipStream_t stream) {
  static int grid = 0;
  static float rfv[16];
  if (grid == 0) {
    int dev = 0, cus = 0;
    if (hipGetDevice(&dev) != hipSuccess || hipDeviceGetAttribute(&cus, hipDeviceAttributeMultiprocessorCount, dev) != hipSuccess) { fprintf(stderr, "kernel_launch: device query failed\n"); grid = -1; return; }
    if (hipFuncSetAttribute((const void*)fwd, hipFuncAttributeMaxDynamicSharedMemorySize, LDS_BYTES) != hipSuccess) { fprintf(stderr, "kernel_launch: hipFuncSetAttribute failed\n"); grid = -1; return; }
    int per_cu = 0;
    if (hipOccupancyMaxActiveBlocksPerMultiprocessor(&per_cu, (const void*)fwd, NWAVES * 64, LDS_BYTES) != hipSuccess || per_cu < 1) fprintf(stderr, "kernel_launch: occupancy query says %d\n", per_cu);
    (void)hipGetLastError();
    for (int i = 0; i < 16; ++i) rfv[i] = (float)pow(500000.0, -(double)i / 16.0);
    grid = cus;
  }
  if (grid < 0) return;
  float* out = (float*)d_out;
  unsigned char* ws = (unsigned char*)d_ws;
  (void)hipMemsetAsync(ws + WS_CTL, 0, CTL_ZERO_BYTES, stream);
  Args a{};
  for (int i = 0; i < 27; ++i) a.in[i] = (const float*)d_in[i];
  a.out = out; a.ws = ws; for (int i = 0; i < 16; ++i) a.rf[i] = rfv[i];
  a.ph_lo = 0; a.ph_hi = 13; a.li = 0;
  hipLaunchKernelGGL(fwd, dim3(grid), dim3(NWAVES * 64), LDS_BYTES, stream, a);
}
```

```cpp
#include <hip/hip_runtime.h>
#include <stdint.h>
#include <math.h>
#include <cstdio>

constexpr int DM = 2048, BATCH = 8, SEQ = 2048, M = BATCH * SEQ, MEM = 256, MROWS = BATCH * MEM;
constexpr float EPS = 1e-6f;
constexpr int AH = 8, HD = 128, AW = 1024;
constexpr int MB = 256, NB = SEQ / MB;
constexpr int SW = 2048, SH = 32, SG = 4, SCONV = 4, CONVD = 3072;
constexpr int MIXW = 3072, INW = 8224, LDP = 8448;
constexpr int C_Q = 0, C_K = 1024, C_V = 2048, C_Z = 3072, C_XBC = 5120, C_DT = 8192;
constexpr int CH = 4, CHD = 128, CW = 512;
constexpr int NG = 4, EPG = 8, NE = 32, DE = 1024;

#define LAS __attribute__((address_space(3)))
#define GAS __attribute__((address_space(1)))
typedef unsigned short bf16_t;
typedef short bf16x8 __attribute__((ext_vector_type(8)));
typedef float f32x4 __attribute__((ext_vector_type(4)));
typedef float f32x2 __attribute__((ext_vector_type(2)));
typedef unsigned u32x4 __attribute__((ext_vector_type(4)));
typedef unsigned u32x2 __attribute__((ext_vector_type(2)));
typedef int i32x4 __attribute__((ext_vector_type(4)));
typedef int i32x8 __attribute__((ext_vector_type(8)));
typedef short s16x16 __attribute__((ext_vector_type(16)));
#define LDS_WAIT() asm volatile("s_waitcnt lgkmcnt(0)" ::: "memory")
#define VM_WAIT() asm volatile("s_waitcnt vmcnt(0)" ::: "memory")

__device__ __forceinline__ unsigned cvt_pk_bf16(float lo, float hi) { unsigned r; asm volatile("v_cvt_pk_bf16_f32 %0, %1, %2" : "=v"(r) : "v"(lo), "v"(hi)); return r; }
__device__ __forceinline__ unsigned pk4_fp8(float a, float b, float c, float d) {
  a = fminf(fmaxf(a, -448.f), 448.f); b = fminf(fmaxf(b, -448.f), 448.f); c = fminf(fmaxf(c, -448.f), 448.f); d = fminf(fmaxf(d, -448.f), 448.f);
  int w = 0; w = __builtin_amdgcn_cvt_pk_fp8_f32(a, b, w, false); w = __builtin_amdgcn_cvt_pk_fp8_f32(c, d, w, true); return (unsigned)w; }
__device__ __forceinline__ float bf2f(bf16_t b) { return __uint_as_float(((unsigned)b) << 16); }
__device__ __forceinline__ float bflo(unsigned w) { return __uint_as_float(w << 16); }
__device__ __forceinline__ float bfhi(unsigned w) { return __uint_as_float(w & 0xffff0000u); }
__device__ __forceinline__ void ld8bf(const bf16_t* p, float (&o)[8]) { const u32x4 w = *(const u32x4*)p; o[0] = bflo(w.x); o[1] = bfhi(w.x); o[2] = bflo(w.y); o[3] = bfhi(w.y); o[4] = bflo(w.z); o[5] = bfhi(w.z); o[6] = bflo(w.w); o[7] = bfhi(w.w); }
__device__ __forceinline__ float wave_sum(float v) {
#pragma unroll
  for (int o = 1; o < 64; o <<= 1) v += __shfl_xor(v, o);
  return v;
}
__device__ __forceinline__ float wave_max(float v) {
#pragma unroll
  for (int o = 1; o < 64; o <<= 1) v = fmaxf(v, __shfl_xor(v, o));
  return v;
}
__device__ __forceinline__ int lane_id_now() { int l; asm volatile("v_mbcnt_lo_u32_b32 %0, -1, 0\n\tv_mbcnt_hi_u32_b32 %0, -1, %0" : "=v"(l)); return l; }
__device__ __forceinline__ float silu_f(float x) { return x / (1.f + __expf(-x)); }

constexpr size_t MiB = 1u << 20;
constexpr size_t WS_CTL = 0, CTL_ZERO_BYTES = 1 * MiB;
constexpr int CW_BAR = 4096;
constexpr int CW_CNT = 65536;
constexpr size_t WS_WIN_T = 1 * MiB;
constexpr size_t WS_WOUT_T = 34 * MiB;
constexpr size_t WS_WCQ_T = 46 * MiB;
constexpr size_t WS_WCKV_T = 48 * MiB;
constexpr size_t WS_WCO_T = 52 * MiB;
constexpr size_t WS_WR = 54 * MiB;
constexpr size_t WS_SMALL = 55 * MiB;
constexpr size_t WS_ROPE = WS_SMALL, WS_RSX = WS_SMALL + 256 * 1024, WS_RSMEM = WS_RSX + 64 * 1024, WS_RS2 = WS_RSMEM + 64 * 1024, WS_KMEAN = WS_RS2 + 64 * 1024;
constexpr size_t WS_DTRAW = 56 * MiB;
constexpr size_t WS_SS = 58 * MiB;
constexpr size_t WS_MEMB = 62 * MiB;
constexpr size_t WS_XB = 70 * MiB;
constexpr size_t WS_PROJ = 134 * MiB;
constexpr size_t WS_MIXB = 398 * MiB;
constexpr size_t WS_H2B = WS_MIXB, WS_H2Q = WS_MIXB + 64 * MiB;
constexpr size_t WS_QC = 494 * MiB, WS_OC = 510 * MiB;
constexpr size_t WS_KVC = 526 * MiB;
constexpr size_t WS_WGU_T = 530 * MiB;
constexpr size_t WS_WD_T = 786 * MiB;
constexpr size_t WS_LIST = 914 * MiB;
constexpr size_t WS_TOK = 916 * MiB;
constexpr size_t WS_HACT = WS_PROJ;
constexpr size_t WS_Y = WS_PROJ + 66 * MiB;
constexpr size_t WS_XBCC = 918 * MiB;
constexpr size_t WS_AFTER = 1014 * MiB;
#define XB_TMO      128
#define XB_XCNT(j)  (256  + 64 * (j))
#define XB_XSUB(j)  (1280 + 64 * (j))
#define XB_XGEN(j)  (2304 + 64 * (j))
#define XB_TOP      3328
#define XB_TOPGEN   3392
#define XCD_BAR_WORDS 3456
#define XB_SPIN_CAP (1u << 18)

__device__ __forceinline__ unsigned xb_ld(unsigned* p)              { return __hip_atomic_load(p, __ATOMIC_RELAXED, __HIP_MEMORY_SCOPE_AGENT); }
__device__ __forceinline__ unsigned xb_add(unsigned* p, unsigned v) { return __hip_atomic_fetch_add(p, v, __ATOMIC_RELAXED, __HIP_MEMORY_SCOPE_AGENT); }
__device__ __forceinline__ unsigned xb_xcc_id() { return (unsigned)__builtin_amdgcn_s_getreg((3 << 11) | 20) & 0xFu; }
#define XB_SPIN(cond, bar) do { unsigned _sp = 0; while (cond) { __builtin_amdgcn_s_sleep(1); \
    if ((++_sp & 255u) == 0u) { if (xb_ld(&(bar)[XB_TMO])) break; if (_sp > XB_SPIN_CAP) { atomicAdd(&(bar)[XB_TMO], 1u); break; } } } } while (0)

struct XcdBarrier {
    unsigned* bar; unsigned x;
    volatile LAS unsigned* st;
};

__device__ __forceinline__ XcdBarrier xcd_barrier_post(unsigned* bar, volatile LAS unsigned* st) {
    XcdBarrier b; b.bar = bar; b.x = xb_xcc_id(); b.st = st;
    if (threadIdx.x == 0) (void)xb_add(&bar[XB_XCNT(b.x)], 1u);
    return b;
}
__device__ __forceinline__ void xcd_barrier_complete(unsigned* bar, unsigned x, unsigned& nloc, unsigned& nx) {
    const unsigned G = gridDim.x * gridDim.y * gridDim.z;
    unsigned sum, cnt, mine, sp = 0u;
    for (;;) {
        sum = 0u; cnt = 0u; mine = 0u;
#pragma unroll
        for (unsigned j = 0; j < 16; ++j) { const unsigned c = xb_ld(&bar[XB_XCNT(j)]); sum += c; cnt += (c > 0u) ? 1u : 0u; mine = (j == x) ? c : mine; }
        if (sum == G) break;
        __builtin_amdgcn_s_sleep(1);
        if ((++sp & 255u) == 0u) { if (xb_ld(&bar[XB_TMO])) break; if (sp > XB_SPIN_CAP) { atomicAdd(&bar[XB_TMO], 1u); break; } }
    }
    nloc = mine > 0u ? mine : 1u; nx = cnt > 0u ? cnt : 1u;
}

__device__ __forceinline__ void xcd_barrier(const XcdBarrier& b, const int xb_tid) {
    asm volatile("s_waitcnt vmcnt(0)" ::: "memory");
    __syncthreads();
    if (xb_tid == 0) {
        unsigned* bar = b.bar;
        __builtin_amdgcn_s_waitcnt(0);
        unsigned nloc = b.st[0], nx = b.st[1];
        if (nloc == 0u) { xcd_barrier_complete(bar, b.x, nloc, nx); b.st[0] = nloc; b.st[1] = nx; }
        const unsigned old = xb_add(&bar[XB_XSUB(b.x)], 1u);
        const unsigned gen = old / nloc;
        if (old + 1u == (gen + 1u) * nloc) {
            __builtin_amdgcn_fence(__ATOMIC_RELEASE, "agent");
            asm volatile("s_waitcnt vmcnt(0)" ::: "memory");
            const unsigned og = xb_add(&bar[XB_TOP], 1u);
            const unsigned tg = og / nx;
            if (og + 1u == (tg + 1u) * nx) xb_add(&bar[XB_TOPGEN], 1u);
            else XB_SPIN(xb_ld(&bar[XB_TOPGEN]) == tg, bar);
            __builtin_amdgcn_fence(__ATOMIC_ACQUIRE, "agent");
            xb_add(&bar[XB_XGEN(b.x)], 1u);
            asm volatile("s_waitcnt vmcnt(0)" ::: "memory");
        } else {
            XB_SPIN(xb_ld(&bar[XB_XGEN(b.x)]) == gen, bar);
            __builtin_amdgcn_fence(__ATOMIC_ACQUIRE, "agent");
            asm volatile("s_waitcnt vmcnt(0)" ::: "memory");
        }
    }
    __syncthreads();
}

namespace gm {
constexpr int BM = 256, BK = 64, HALF = 128, HTB = HALF * BK * 2, STAGE_BYTES = 8 * HTB, NXCD = 8, WGM = 8;
__host__ __device__ __forceinline__ int lds_byte(int r, int c) { const int st = (r >> 4) * 2 + (c >> 5), rr = r & 15, cc = c & 31, ob = rr * 64 + cc * 2; return st * 1024 + (ob ^ (((ob >> 9) & 1) << 5)); }
__host__ __device__ __forceinline__ void stage_rc(int b, int& R, int& C) { const int st = b / 1024, sb = b % 1024, swz = sb ^ (((sb >> 9) & 1) << 5); R = (st >> 1) * 16 + swz / 64; C = (st & 1) * 32 + (swz % 64) / 2; }
__host__ __device__ __forceinline__ int perm32(int rho) { const int n = rho >> 4, i = rho & 15; return 8 * (i >> 2) + 4 * n + (i & 3); }

struct Unit { const char* a; const char* b; int pm, pn, kind, ti; };

__device__ __forceinline__ void tile_of(int L, int nM, int nN, int& pm, int& pn) {
    const int nwg = nM * nN; int wgid = L;
    { const int q = nwg / NXCD, r = nwg % NXCD, xcd = wgid % NXCD, off = wgid / NXCD; wgid = (xcd < r ? xcd * (q + 1) : r * (q + 1) + (xcd - r) * q) + off; }
    const int nig = WGM * nN, gid = wgid / nig, fm = gid * WGM, gsz = (nM - fm) < WGM ? (nM - fm) : WGM;
    pm = fm + ((wgid % nig) % gsz); pn = (wgid % nig) / gsz;
}

template <class Epi, class Sched, bool GATHER, bool BTILED = false, bool F8 = false>
__device__ __forceinline__ void gemm_phase(const int tid, LAS unsigned char* lds, const LAS int* tab, const int K, const Sched& S, const Epi& E) {
    const int wid = __builtin_amdgcn_readfirstlane(tid >> 6), lane = tid & 63, wr = wid >> 2, wc = wid & 3, fr = lane & 15, fq = lane >> 4;
    const int nt = K / BK;
    unsigned voffA0[2], voffA1[2], voffB[2];
    const size_t kstep = (size_t)(BK * 2);
    const size_t hstep = (size_t)HALF * K * 2;
    const size_t kstepB = BTILED ? (size_t)(BM * BK * 2) : kstep, hstepB = BTILED ? (size_t)(HALF * BK * 2) : hstep;
#pragma unroll
    for (int i = 0; i < 2; ++i) { int R, C; stage_rc(tid * 16 + i * 8192, R, C); const int Rb = (R & ~31) + perm32(R & 31);
        voffB[i] = BTILED ? (unsigned)(Rb * BK + C) * 2u : (unsigned)(Rb * K + C) * 2u; voffA0[i] = (unsigned)(R * K + C) * 2u; voffA1[i] = 0u; }
#define GM_SETVOFF(u) do { if constexpr (GATHER) { _Pragma("unroll") for (int _i = 0; _i < 2; ++_i) { int R_, C_; stage_rc(tid * 16 + _i * 8192, R_, C_); \
        const int r0_ = tab[(u).ti * 256 + R_], r1_ = tab[(u).ti * 256 + 128 + R_]; voffA0[_i] = (unsigned)(r0_ * K + C_) * 2u; voffA1[_i] = (unsigned)(r1_ * K + C_) * 2u; } } } while (0)
    const unsigned ldsw = (unsigned)wid * 1024u;
    const int aoff = lds_byte(wr * 64 + fr, fq * 8), boff = lds_byte(wc * 32 + fr, fq * 8);
#define PG8_SA(b, h) (((b) * 2 + (h)) * HTB)
#define PG8_SB(b, h) ((4 + (b) * 2 + (h)) * HTB)
#define PG8_STAGE(bufoff, gbase, voff) do { _Pragma("unroll") for (int _i = 0; _i < 2; ++_i) \
        __builtin_amdgcn_global_load_lds((const unsigned*)((const char*)(gbase) + (voff)[_i]), (LAS unsigned*)(lds + (bufoff) + ldsw + _i * 8192), 16, 0, 0); } while (0)
#define PG8_LDA8(dst, b, h) do { _Pragma("unroll") for (int m = 0; m < 4; ++m) { const bf16x8 lo_ = *(const LAS bf16x8*)(lds + PG8_SA(b, h) + aoff + m * 2048), hi_ = *(const LAS bf16x8*)(lds + PG8_SA(b, h) + aoff + m * 2048 + 1024); \
        dst[m] = __builtin_shufflevector(__builtin_bit_cast(i32x4, lo_), __builtin_bit_cast(i32x4, hi_), 0, 1, 2, 3, 4, 5, 6, 7); } } while (0)
#define PG8_LDB8(dst, b, h) do { _Pragma("unroll") for (int n = 0; n < 2; ++n) { const bf16x8 lo_ = *(const LAS bf16x8*)(lds + PG8_SB(b, h) + boff + n * 2048), hi_ = *(const LAS bf16x8*)(lds + PG8_SB(b, h) + boff + n * 2048 + 1024); \
        dst[n] = __builtin_shufflevector(__builtin_bit_cast(i32x4, lo_), __builtin_bit_cast(i32x4, hi_), 0, 1, 2, 3, 4, 5, 6, 7); } } while (0)
#define PG8_MMA8(ai, bj, At, Bt) do { __builtin_amdgcn_s_setprio(1); _Pragma("unroll") for (int m = 0; m < 4; ++m) _Pragma("unroll") for (int n = 0; n < 2; ++n) \
        acc[ai][bj][m][n] = __builtin_amdgcn_mfma_scale_f32_16x16x128_f8f6f4(Bt[n], At[m], acc[ai][bj][m][n], 0, 0, 0, 0, 0, 0); __builtin_amdgcn_s_setprio(0); } while (0)
#define PG8_LDA(dst, b, h) do { _Pragma("unroll") for (int m = 0; m < 4; ++m) _Pragma("unroll") for (int k = 0; k < 2; ++k) dst[m][k] = *(const LAS bf16x8*)(lds + PG8_SA(b, h) + aoff + m * 2048 + k * 1024); } while (0)
#define PG8_LDB(dst, b, h) do { _Pragma("unroll") for (int n = 0; n < 2; ++n) _Pragma("unroll") for (int k = 0; k < 2; ++k) dst[n][k] = *(const LAS bf16x8*)(lds + PG8_SB(b, h) + boff + n * 2048 + k * 1024); } while (0)
#define PG8_MMA(ai, bj, At, Bt) do { __builtin_amdgcn_s_setprio(1); _Pragma("unroll") for (int m = 0; m < 4; ++m) _Pragma("unroll") for (int n = 0; n < 2; ++n) _Pragma("unroll") for (int k = 0; k < 2; ++k) \
        acc[ai][bj][m][n] = __builtin_amdgcn_mfma_f32_16x16x32_bf16(Bt[n][k], At[m][k], acc[ai][bj][m][n], 0, 0, 0); __builtin_amdgcn_s_setprio(0); } while (0)
#define GM_STAGE_A1(bufoff, gbase) do { if constexpr (GATHER) { PG8_STAGE(bufoff, gbase, voffA1); } else { PG8_STAGE(bufoff, (gbase) + hstep, voffA0); } } while (0)
#define PG8_WAIT_V(n) asm volatile("s_waitcnt vmcnt(" #n ")" ::: "memory")
#define PG8_WAIT_L(n) asm volatile("s_waitcnt lgkmcnt(" #n ")" ::: "memory")
#define PG8_BAR __builtin_amdgcn_s_barrier()
#define PG8_SCHED __builtin_amdgcn_sched_barrier(0)
    Unit cur, nxt; int ui = 0;
    if (!S.next(0, cur)) return;
    GM_SETVOFF(cur);
    f32x4 acc[2][2][4][2];
#pragma unroll
    for (int a = 0; a < 2; ++a)
#pragma unroll
        for (int b = 0; b < 2; ++b)
#pragma unroll
            for (int m = 0; m < 4; ++m)
#pragma unroll
                for (int n = 0; n < 2; ++n) acc[a][b][m][n] = (f32x4){0.f, 0.f, 0.f, 0.f};
    bf16x8 At[4][2], B0[2][2], B1[2][2]; i32x8 At8[4], B08[2], B18[2];
    const char* cA = cur.a; const char* cB = cur.b;
    PG8_STAGE(PG8_SB(0, 0), cB, voffB); PG8_STAGE(PG8_SB(0, 1), cB + hstepB, voffB); PG8_STAGE(PG8_SA(0, 0), cA, voffA0); GM_STAGE_A1(PG8_SA(0, 1), cA);
    if (wr == 1) PG8_BAR;
    PG8_WAIT_V(2); PG8_BAR;
    PG8_STAGE(PG8_SB(1, 0), cB + kstepB, voffB); PG8_STAGE(PG8_SA(1, 0), cA + kstep, voffA0); PG8_STAGE(PG8_SB(1, 1), cB + hstepB + kstepB, voffB);
    PG8_WAIT_V(6); PG8_BAR;
    for (;;) {
        const bool has_next = S.next(ui + 1, nxt);
        const char* nA = has_next ? nxt.a : cA; const char* nB = has_next ? nxt.b : cB;
#pragma unroll 1
        for (int t = 0; t < nt; t += 2) {
            const bool last = (t == nt - 2);
            const char* a1 = cA + (size_t)(t + 1) * kstep;
            const char* a2 = last ? nA : cA + (size_t)(t + 2) * kstep; const char* b2 = last ? nB : cB + (size_t)(t + 2) * kstepB;
            const char* a3 = a2 + kstep; const char* b3 = b2 + kstepB;
            if constexpr (F8) {
            PG8_LDB8(B08, 0, 0); PG8_LDB8(B18, 0, 1); PG8_SCHED; PG8_LDA8(At8, 0, 0); GM_STAGE_A1(PG8_SA(1, 1), a1);
            PG8_WAIT_V(8); PG8_WAIT_L(0); PG8_BAR; PG8_MMA8(0, 0, At8, B08); PG8_MMA8(0, 1, At8, B18); PG8_BAR; PG8_SCHED;
            if constexpr (GATHER) { if (last && has_next) { GM_SETVOFF(nxt); } }
            PG8_LDA8(At8, 0, 1); PG8_STAGE(PG8_SB(0, 0), b2, voffB); PG8_STAGE(PG8_SB(0, 1), b2 + hstepB, voffB); PG8_STAGE(PG8_SA(0, 0), a2, voffA0);
            PG8_WAIT_V(8); PG8_WAIT_L(0); PG8_BAR; PG8_MMA8(1, 0, At8, B08); PG8_MMA8(1, 1, At8, B18); PG8_BAR; PG8_SCHED;
            PG8_LDB8(B08, 1, 0); PG8_LDB8(B18, 1, 1); PG8_SCHED; PG8_LDA8(At8, 1, 0); GM_STAGE_A1(PG8_SA(0, 1), a2);
            PG8_WAIT_V(8); PG8_WAIT_L(0); PG8_BAR; PG8_MMA8(0, 0, At8, B08); PG8_MMA8(0, 1, At8, B18); PG8_BAR; PG8_SCHED;
            PG8_LDA8(At8, 1, 1); PG8_STAGE(PG8_SB(1, 0), b3, voffB); PG8_STAGE(PG8_SB(1, 1), b3 + hstepB, voffB); PG8_STAGE(PG8_SA(1, 0), a3, voffA0);
            PG8_WAIT_V(8); PG8_WAIT_L(0); PG8_BAR; PG8_MMA8(1, 0, At8, B08); PG8_MMA8(1, 1, At8, B18); PG8_BAR; PG8_SCHED;
            } else {
            PG8_LDB(B0, 0, 0); PG8_LDB(B1, 0, 1); PG8_SCHED; PG8_LDA(At, 0, 0); GM_STAGE_A1(PG8_SA(1, 1), a1);
            PG8_WAIT_V(8); PG8_WAIT_L(0); PG8_BAR; PG8_MMA(0, 0, At, B0); PG8_MMA(0, 1, At, B1); PG8_BAR; PG8_SCHED;
            if constexpr (GATHER) { if (last && has_next) { GM_SETVOFF(nxt); } }
            PG8_LDA(At, 0, 1); PG8_STAGE(PG8_SB(0, 0), b2, voffB); PG8_STAGE(PG8_SB(0, 1), b2 + hstepB, voffB); PG8_STAGE(PG8_SA(0, 0), a2, voffA0);
            PG8_WAIT_V(8); PG8_WAIT_L(0); PG8_BAR; PG8_MMA(1, 0, At, B0); PG8_MMA(1, 1, At, B1); PG8_BAR; PG8_SCHED;
            PG8_LDB(B0, 1, 0); PG8_LDB(B1, 1, 1); PG8_SCHED; PG8_LDA(At, 1, 0); GM_STAGE_A1(PG8_SA(0, 1), a2);
            PG8_WAIT_V(8); PG8_WAIT_L(0); PG8_BAR; PG8_MMA(0, 0, At, B0); PG8_MMA(0, 1, At, B1); PG8_BAR; PG8_SCHED;
            PG8_LDA(At, 1, 1); PG8_STAGE(PG8_SB(1, 0), b3, voffB); PG8_STAGE(PG8_SB(1, 1), b3 + hstepB, voffB); PG8_STAGE(PG8_SA(1, 0), a3, voffA0);
            PG8_WAIT_V(8); PG8_WAIT_L(0); PG8_BAR; PG8_MMA(1, 0, At, B0); PG8_MMA(1, 1, At, B1); PG8_BAR; PG8_SCHED;
            }
        }
        if (wr == 0) PG8_BAR;
        { int fr_ = fr, fq_ = fq; asm volatile("" : "+v"(fr_), "+v"(fq_));
          E(acc, cur, wr, wc, fr_, fq_); }
        if (!has_next) break;
#pragma unroll
        for (int a = 0; a < 2; ++a)
#pragma unroll
            for (int b = 0; b < 2; ++b)
#pragma unroll
                for (int m = 0; m < 4; ++m)
#pragma unroll
                    for (int n = 0; n < 2; ++n) acc[a][b][m][n] = (f32x4){0.f, 0.f, 0.f, 0.f};
        cur = nxt; cA = nA; cB = nB; ++ui;
        if (wr == 1) PG8_BAR;
    }
    PG8_WAIT_V(0);
    PG8_BAR;
#undef GM_SETVOFF
#undef GM_STAGE_A1
#undef PG8_SA
#undef PG8_SB
#undef PG8_STAGE
#undef PG8_LDA
#undef PG8_LDA8
#undef PG8_LDB8
#undef PG8_MMA8
#undef PG8_LDB
#undef PG8_MMA
#undef PG8_WAIT_V
#undef PG8_WAIT_L
#undef PG8_BAR
#undef PG8_SCHED
}
}
namespace at {
using f32x16 = __attribute__((ext_vector_type(16))) float;
using s16x4 = __attribute__((ext_vector_type(4))) short;
constexpr int D = 128, NW = 8, QBLK = 32, KVBLK = 64;
constexpr float SCALE = 0.088388347648318440f;
constexpr float THR = 8.f;
constexpr int SHM_V = KVBLK * D * 2, SHM_K = KVBLK * D * 2, VR_OFF = 2 * SHM_K, WS_OFF = VR_OFF + 3 * SHM_V, SHM_ATTN = WS_OFF + NW * 64 * 4;
constexpr int KM_OFF = SHM_ATTN;
constexpr int QL_OFF = KM_OFF + 4096, QPARK = 7;
static_assert(QL_OFF + QPARK * 8192 <= 146944, "attention LDS map");
#define KSWZ(row, colB) ((row) * 256 + ((colB) ^ (((row) & 7) << 4)))
#define SBAR() __builtin_amdgcn_sched_barrier(0)
__device__ __forceinline__ int crow(int r, int hi) { return (r & 3) + 8 * (r >> 2) + 4 * hi; }

__device__ __forceinline__ void partialSM(f32x16& p0, f32x16& p1, float& m_reg, float& mn, float& alpha, bool dead) {
  constexpr float C = SCALE * 1.4426950408889634f;
  float pmax = p0[0];
#pragma unroll
  for (int r = 1; r < 16; ++r) pmax = fmaxf(pmax, p0[r]);
#pragma unroll
  for (int r = 0; r < 16; ++r) pmax = fmaxf(pmax, p1[r]);
  { auto rr = __builtin_amdgcn_permlane32_swap(__float_as_uint(pmax), __float_as_uint(pmax), false, false);
    pmax = fmaxf(__uint_as_float(rr[0]), __uint_as_float(rr[1])); }
  if (dead) pmax = -1e30f;
  if (__builtin_expect(__all(pmax - m_reg <= THR / SCALE), 1)) { mn = m_reg; alpha = 1.f; }
  else { mn = fmaxf(m_reg, pmax); alpha = __builtin_amdgcn_exp2f((m_reg - mn) * C); m_reg = mn; }
  const float mnC = dead ? -INFINITY : -mn * C;
#pragma unroll
  for (int r = 0; r < 16; ++r) p0[r] = fmaf(p0[r], C, mnC);
#pragma unroll
  for (int r = 0; r < 16; ++r) p1[r] = fmaf(p1[r], C, mnC);
#pragma unroll
  for (int r = 0; r < 16; ++r) p0[r] = __builtin_amdgcn_exp2f(p0[r]);
}
__device__ __forceinline__ void finishSM(f32x16& p0, f32x16& p1, float alpha, float& l_reg, bf16x8& pa0, bf16x8& pa1, bf16x8& pa2, bf16x8& pa3) {
#pragma unroll
  for (int r = 0; r < 16; ++r) p1[r] = __builtin_amdgcn_exp2f(p1[r]);
  float ps = 0;
#pragma unroll
  for (int r = 0; r < 16; ++r) ps += p0[r];
#pragma unroll
  for (int r = 0; r < 16; ++r) ps += p1[r];
  { auto rr = __builtin_amdgcn_permlane32_swap(__float_as_uint(ps), __float_as_uint(ps), false, false);
    ps = __uint_as_float(rr[0]) + __uint_as_float(rr[1]); }
  l_reg = l_reg * alpha + ps;
#define PK4(P, BASE, OUT) do { unsigned a0 = cvt_pk_bf16(P[BASE + 0], P[BASE + 1]), a1 = cvt_pk_bf16(P[BASE + 2], P[BASE + 3]);   \
    unsigned b0 = cvt_pk_bf16(P[BASE + 4], P[BASE + 5]), b1 = cvt_pk_bf16(P[BASE + 6], P[BASE + 7]);                              \
    auto r0 = __builtin_amdgcn_permlane32_swap(a0, b0, false, false); auto r1 = __builtin_amdgcn_permlane32_swap(a1, b1, false, false); \
    u32x4 w = {r0[0], r1[0], r0[1], r1[1]}; OUT = *reinterpret_cast<bf16x8*>(&w); } while (0)
  PK4(p0, 0, pa0); PK4(p0, 8, pa1); PK4(p1, 0, pa2); PK4(p1, 8, pa3);
#undef PK4
}
template <bool QLDS>
__device__ __forceinline__ void qkt(f32x16& p0, f32x16& p1, const LAS char* Ks, const bf16x8* qr, const LAS char* ql, int r32, int hi) {
  p0 = f32x16{}; p1 = f32x16{};
#pragma unroll
  for (int d0 = 0; d0 < 8; ++d0) { int cb = (d0 * 16 + hi * 8) * 2;
    bf16x8 b0 = *(const LAS bf16x8*)(Ks + KSWZ(r32, cb));
    bf16x8 b1 = *(const LAS bf16x8*)(Ks + KSWZ(32 + r32, cb));
    bf16x8 q; if (QLDS && d0 >= 8 - QPARK) q = *(const LAS bf16x8*)(ql + (d0 - (8 - QPARK)) * 8192); else q = qr[d0];
    p0 = __builtin_amdgcn_mfma_f32_32x32x16_bf16(b0, q, p0, 0, 0, 0);
    p1 = __builtin_amdgcn_mfma_f32_32x32x16_bf16(b1, q, p1, 0, 0, 0); }
}
__device__ __forceinline__ int v_st(int k, int c) { const int kk = (k & ~0xC) | ((k & 4) << 1) | ((k & 8) >> 1); return ((kk >> 3) * 4 + (c >> 5)) * 512 + ((kk & 7) * 32 + (c & 31)) * 2; }
__device__ __forceinline__ int v_rd_base(int lane) { return ((lane & 3) << 3) | (((lane >> 2) & 3) << 6) | (((lane >> 4) & 1) << 5) | (((lane >> 5) & 1) << 8); }
constexpr int v_rd_off(int d0, int ks, int half) { return d0 * 512 + ks * 4096 + half * 2048; }
template <int OFF> __device__ __forceinline__ s16x4 tr_read(int vb) {
  s16x4 r; asm volatile("ds_read_b64_tr_b16 %0, %1 offset:%2" : "=&v"(r) : "v"(vb), "i"(OFF) : "memory"); return r;
}
template <int D0> __device__ __forceinline__ void pv_one(f32x16& od, int vb, bf16x8 pa0, bf16x8 pa1, bf16x8 pa2, bf16x8 pa3) {
  const s16x4 l0 = tr_read<v_rd_off(D0, 0, 0)>(vb), h0 = tr_read<v_rd_off(D0, 0, 1)>(vb), l1 = tr_read<v_rd_off(D0, 1, 0)>(vb), h1 = tr_read<v_rd_off(D0, 1, 1)>(vb);
  const s16x4 l2 = tr_read<v_rd_off(D0, 2, 0)>(vb), h2 = tr_read<v_rd_off(D0, 2, 1)>(vb), l3 = tr_read<v_rd_off(D0, 3, 0)>(vb), h3 = tr_read<v_rd_off(D0, 3, 1)>(vb);
  asm volatile("s_waitcnt lgkmcnt(0)" ::: "memory"); SBAR();
#define PK(L, H) (bf16x8){L[0], L[1], L[2], L[3], H[0], H[1], H[2], H[3]}
  od = __builtin_amdgcn_mfma_f32_32x32x16_bf16(pa0, PK(l0, h0), od, 0, 0, 0);
  od = __builtin_amdgcn_mfma_f32_32x32x16_bf16(pa1, PK(l1, h1), od, 0, 0, 0);
  od = __builtin_amdgcn_mfma_f32_32x32x16_bf16(pa2, PK(l2, h2), od, 0, 0, 0);
  od = __builtin_amdgcn_mfma_f32_32x32x16_bf16(pa3, PK(l3, h3), od, 0, 0, 0);
#undef PK
}
__device__ __forceinline__ void pv_d0(f32x16* o, int vb, bf16x8 pa0, bf16x8 pa1, bf16x8 pa2, bf16x8 pa3) {
  pv_one<0>(o[0], vb, pa0, pa1, pa2, pa3); pv_one<1>(o[1], vb, pa0, pa1, pa2, pa3); pv_one<2>(o[2], vb, pa0, pa1, pa2, pa3); pv_one<3>(o[3], vb, pa0, pa1, pa2, pa3);
}

template <bool MOBA>
__device__ __forceinline__ void attn_unit(const int tid, const bf16_t* __restrict__ Qb, const bf16_t* __restrict__ Kh, bf16_t* __restrict__ Ob, int NT, int jb, const float* __restrict__ kmean_bh, LAS char* lds) {
  constexpr int ldq = MOBA ? LDP : CW, ldk = MOBA ? LDP : 2 * CW, ldo = MOBA ? MIXW : CW, VOFF = MOBA ? (C_V - C_K) : CW;
  const bf16_t* __restrict__ Vh = Kh + VOFF;
  const int wid = __builtin_amdgcn_readfirstlane(tid >> 6), lane = tid & 63, r32 = lane & 31, hi = lane >> 5;
  LAS float* wsf = (LAS float*)(lds + WS_OFF) + wid * 64; LAS float* li_l = wsf; LAS float* al_l = wsf + 32;
  float m_reg = -1e30f, l_reg = 0; f32x16 o[4] = {}; bf16x8 qr[8];
  const bf16_t* Qw = Qb + (long)(wid * QBLK + r32) * ldq + hi * 8;
#pragma unroll
  for (int d0 = 0; d0 < 8; ++d0) qr[d0] = *reinterpret_cast<const bf16x8*>(Qw + d0 * 16);
  unsigned selmask = 0;
  if constexpr (MOBA) {
    LAS float* kml = (LAS float*)(lds + KM_OFF);
    __syncthreads();
    for (int i = tid; i < 8 * 128; i += NW * 64) kml[i] = kmean_bh[(i >> 7) * 1024 + (i & 127)];
    __syncthreads();
    float gate[8];
#pragma unroll
    for (int kb = 0; kb < 8; ++kb) {
      float g = 0.f;
      if (kb < jb) {
#pragma unroll
        for (int d0 = 0; d0 < 8; ++d0) { const f32x4 k0 = *(const LAS f32x4*)(kml + kb * 128 + d0 * 16 + hi * 8), k1 = *(const LAS f32x4*)(kml + kb * 128 + d0 * 16 + hi * 8 + 4);
          const u32x4 qw = *reinterpret_cast<const u32x4*>(&qr[d0]);
          g += bflo(qw.x) * k0[0] + bfhi(qw.x) * k0[1] + bflo(qw.y) * k0[2] + bfhi(qw.y) * k0[3] + bflo(qw.z) * k1[0] + bfhi(qw.z) * k1[1] + bflo(qw.w) * k1[2] + bfhi(qw.w) * k1[3]; }
        g += __shfl_xor(g, 32);
      }
      gate[kb] = g;
    }
#pragma unroll
    for (int r = 0; r < 3; ++r) { float best = -INFINITY; int bi = -1;
#pragma unroll
      for (int kb = 0; kb < 8; ++kb) { const bool ok = (kb < jb) && !((selmask >> kb) & 1u) && (gate[kb] > best || bi < 0); if (ok) { best = gate[kb]; bi = kb; } }
      if (bi >= 0) selmask |= 1u << bi; }
  }
  const LAS char* ql = lds + QL_OFF + tid * 16;
  if constexpr (MOBA) {
#pragma unroll
    for (int d0 = 8 - QPARK; d0 < 8; ++d0) *(LAS bf16x8*)(lds + QL_OFF + tid * 16 + (d0 - (8 - QPARK)) * 8192) = qr[d0];
  }
  const int rowb = wid * QBLK + r32;
#define MASK(P0, P1, T, DEAD) do { DEAD = false; if constexpr (MOBA) { const int kb_ = (T) >> 2; \
    if (kb_ < jb) { DEAD = !((selmask >> kb_) & 1u); } \
    else { const int lim_ = rowb - 64 * ((T) - 4 * jb); \
      if (!__all(lim_ >= 63)) { const int lh_ = lim_ - 4 * hi;     \
        _Pragma("unroll") for (int r_ = 0; r_ < 16; ++r_) { if ((r_ & 3) + 8 * (r_ >> 2) > lh_) P0[r_] = -INFINITY; if (32 + (r_ & 3) + 8 * (r_ >> 2) > lh_) P1[r_] = -INFINITY; } } } } } while (0)
#define KVDMA(KSLOT, VSLOT, K0) do { int ln_ = lane; asm volatile("" : "+v"(ln_));     \
    _Pragma("unroll") for (int i_ = 0; i_ < 2; ++i_) { const int q_ = 64 * (2 * wid + i_) + ln_; \
      const int row_ = q_ >> 4, cch_ = (q_ & 15) ^ (row_ & 7), ko_ = row_ * ldk + 8 * cch_; \
      const int kk_ = 8 * (q_ >> 7) + ((q_ >> 2) & 7), k_ = (kk_ & ~0xC) | ((kk_ & 4) << 1) | ((kk_ & 8) >> 1), vo_ = k_ * ldk + 32 * ((q_ >> 5) & 3) + 8 * (q_ & 3); \
      __builtin_amdgcn_global_load_lds((const unsigned*)(Kh + (long)(K0) * ldk + ko_), (LAS unsigned*)(lds + (KSLOT) + (2 * wid + i_) * 1024), 16, 0, 0); \
      __builtin_amdgcn_global_load_lds((const unsigned*)(Vh + (long)(K0) * ldk + vo_), (LAS unsigned*)(lds + VR_OFF + (VSLOT) + (2 * wid + i_) * 1024), 16, 0, 0); } } while (0)
#define RESC(a) do { if (__any((a) < 1.f)) { if (hi == 0) al_l[r32] = (a); asm volatile("s_waitcnt lgkmcnt(0)" ::: "memory"); \
    _Pragma("unroll") for (int d = 0; d < 4; ++d) _Pragma("unroll") for (int r = 0; r < 16; ++r) o[d][r] *= al_l[crow(r, hi)]; } } while (0)
  const int vrb = (int)(size_t)lds + VR_OFF + v_rd_base(lane);
  f32x16 pA0, pA1, pB0, pB1; float mnA, mnB, alA, alB; bf16x8 pa0, pa1, pa2, pa3; bool deadA, deadB;
  if constexpr (!MOBA) __syncthreads();
  int sc = 0, sn = SHM_V, sf = 2 * SHM_V;
  const int ntw = MOBA ? (4 * jb + (wid >> 1) + 1 < NT ? 4 * jb + (wid >> 1) + 1 : NT) : NT;
  KVDMA(0, sc, 0); KVDMA(SHM_K, sn, KVBLK); __syncthreads();
  qkt<MOBA>(pA0, pA1, lds, qr, ql, r32, hi); MASK(pA0, pA1, 0, deadA); partialSM(pA0, pA1, m_reg, mnA, alA, deadA);
  __syncthreads();
  for (int j = 0; j < NT; j += 2) {
    if (j + 2 < NT) KVDMA(0, sf, (j + 2) * KVBLK);
    if (j + 1 < ntw) { SBAR(); qkt<MOBA>(pB0, pB1, lds + SHM_K, qr, ql, r32, hi); }
    if (j < ntw) { finishSM(pA0, pA1, alA, l_reg, pa0, pa1, pa2, pa3); SBAR();
      pv_d0(o, vrb + sc, pa0, pa1, pa2, pa3); }
    if (j + 1 < ntw) { MASK(pB0, pB1, j + 1, deadB); partialSM(pB0, pB1, m_reg, mnB, alB, deadB); RESC(alB); }
    __syncthreads();
    { const int t_ = sc; sc = sn; sn = sf; sf = t_; }
    if (j + 2 < NT) {
      if (j + 3 < NT) KVDMA(SHM_K, sf, (j + 3) * KVBLK);
      if (j + 2 < ntw) { SBAR(); qkt<MOBA>(pA0, pA1, lds, qr, ql, r32, hi); }
      if (j + 1 < ntw) { finishSM(pB0, pB1, alB, l_reg, pa0, pa1, pa2, pa3); SBAR();
        pv_d0(o, vrb + sc, pa0, pa1, pa2, pa3); }
      if (j + 2 < ntw) { MASK(pA0, pA1, j + 2, deadA); partialSM(pA0, pA1, m_reg, mnA, alA, deadA); RESC(alA); }
      __syncthreads();
      { const int t_ = sc; sc = sn; sn = sf; sf = t_; }
    }
  }
  if (NT - 1 < ntw) { finishSM(pB0, pB1, alB, l_reg, pa0, pa1, pa2, pa3); SBAR();
    pv_d0(o, vrb + sc, pa0, pa1, pa2, pa3); }
  if (hi == 0) li_l[r32] = l_reg; asm volatile("s_waitcnt lgkmcnt(0)" ::: "memory");
  float rli[16];
#pragma unroll
  for (int r = 0; r < 16; ++r) rli[r] = __builtin_amdgcn_rcpf(li_l[crow(r, hi)]);
  if constexpr (MOBA) {
#pragma unroll
    for (int r = 0; r < 16; ++r) {
      float q = 0.f;
#pragma unroll
      for (int d0 = 0; d0 < 4; ++d0) { const float v = o[d0][r] * rli[r]; q += v * v; }
      q += __shfl_xor(q, 1); q += __shfl_xor(q, 2); q += __shfl_xor(q, 4); q += __shfl_xor(q, 8); q += __shfl_xor(q, 16);
      rli[r] *= rsqrtf(q * (1.f / 128.f) + EPS);
    }
  }
  bf16_t* Ow = Ob + (long)(wid * QBLK) * ldo;
#pragma unroll
  for (int r = 0; r < 16; ++r) { const int orow = crow(r, hi);
#pragma unroll
    for (int d0 = 0; d0 < 4; ++d0) Ow[(long)orow * ldo + d0 * 32 + r32] = (bf16_t)(cvt_pk_bf16(o[d0][r] * rli[r], 0.f) & 0xffffu); }
#undef MASK
#undef KVDMA
#undef RESC
}
#undef KSWZ
#undef SBAR
}
namespace sd {
using f32x16 = __attribute__((ext_vector_type(16))) float;
typedef short v4i16_t __attribute__((ext_vector_type(4)));
constexpr int IMG_C = 0, IMG_B = 32768, IMG_X = 65536, IMG_S = 98304, TBL = 114688, CWL = 131072;
__device__ __forceinline__ unsigned off_b(unsigned row, unsigned ch) { return 256u * row + 16u * (ch ^ (((row & 3) << 2) | ((row >> 2) & 3))); }
__device__ __forceinline__ unsigned row_read_addr(unsigned lane, unsigned s) { return off_b(lane & 31, 2 * s + (lane >> 5)); }
__device__ __forceinline__ unsigned tr_read_addr(unsigned lane, unsigned c, unsigned ks, unsigned t) {
  const unsigned h = lane >> 5, blk = (lane >> 4) & 1, q = (lane & 15) >> 2, p = lane & 3;
  return off_b(16 * ks + 8 * h + 4 * t + q, 4 * c + 2 * blk + (p >> 1)) + 8 * (p & 1);
}
__device__ __forceinline__ unsigned elem_addr(unsigned row, unsigned col) { return (row >> 5) * 8192u + off_b(row & 31, col >> 3) + (col & 7) * 2u; }
__device__ __forceinline__ bf16x8 tr_frag(const LAS char* img, unsigned a0, unsigned a1) {
  const v4i16_t l = __builtin_amdgcn_ds_read_tr16_b64_v4i16((LAS v4i16_t*)(img + a0)), h = __builtin_amdgcn_ds_read_tr16_b64_v4i16((LAS v4i16_t*)(img + a1));
  return (bf16x8){l[0], l[1], l[2], l[3], h[0], h[1], h[2], h[3]};
}
__device__ __forceinline__ int crow(int r, int hi) { return (r & 3) + 8 * (r >> 2) + 4 * hi; }
__device__ __forceinline__ bf16_t f2bf_native(float v) { return __builtin_bit_cast(bf16_t, (__bf16)v); }
__device__ __forceinline__ unsigned pk2bf_native(float lo, float hi) { typedef __bf16 bf2_t __attribute__((ext_vector_type(2))); typedef float fl2_t __attribute__((ext_vector_type(2))); return __builtin_bit_cast(unsigned, __builtin_convertvector((fl2_t){lo, hi}, bf2_t)); }
__device__ __forceinline__ float softplus_f(float r) { return fmaxf(r, 0.f) + log1pf(__expf(-fabsf(r))); }

__device__ __forceinline__ void conv_rows(const u32x4 (&raw)[11], const float* __restrict__ conv_w, const float* __restrict__ conv_b, bf16_t* __restrict__ xbcc, const int tok0, const int ch, const bool live) {
  f32x4 w[5][2];
#pragma unroll
  for (int tp = 0; tp < 4; ++tp) { w[tp][0] = *(const f32x4*)(conv_w + tp * CONVD + ch); w[tp][1] = *(const f32x4*)(conv_w + tp * CONVD + ch + 4); }
  w[4][0] = *(const f32x4*)(conv_b + ch); w[4][1] = *(const f32x4*)(conv_b + ch + 4);
  float ac[4][8];
#pragma unroll
  for (int j = 0; j < 11; ++j) {
    const u32x4 rw = raw[j];
    const float x[8] = {bflo(rw.x), bfhi(rw.x), bflo(rw.y), bfhi(rw.y), bflo(rw.z), bfhi(rw.z), bflo(rw.w), bfhi(rw.w)};
#pragma unroll
    for (int tp = 0; tp < 4; ++tp) {
      const int i = j - tp;
      if (i >= 0 && i < 8) { const int sl = i & 3;
#pragma unroll
        for (int e = 0; e < 8; ++e) ac[sl][e] = __builtin_fmaf(w[tp][e >> 2][e & 3], x[e], tp == 0 ? w[4][e >> 2][e & 3] : ac[sl][e]); }
    }
    if (j >= 3) {
      const int sl = (j - 3) & 3; float o8[8];
#pragma unroll
      for (int e = 0; e < 8; ++e) o8[e] = ac[sl][e] * __builtin_amdgcn_rcpf(1.f + __expf(-ac[sl][e]));
      u32x4 o; o.x = cvt_pk_bf16(o8[0], o8[1]); o.y = cvt_pk_bf16(o8[2], o8[3]); o.z = cvt_pk_bf16(o8[4], o8[5]); o.w = cvt_pk_bf16(o8[6], o8[7]);
      if (live) *(u32x4*)(xbcc + (size_t)(tok0 + j - 3) * CONVD + ch) = o;
    }
  }
}
__device__ __forceinline__ void conv_prepass(const int gtid, const int nthr, const bf16_t* __restrict__ proj, const float* __restrict__ conv_w, const float* __restrict__ conv_b, bf16_t* __restrict__ xbcc) {
  constexpr int NCG = 1024 / 8, NITEM = NCG * (M / 8);
#define CONV_LOADROWS(R, IT) do { const int cg_ = (IT) % NCG, t0_ = ((IT) / NCG) * 8, T0_ = t0_ & (SEQ - 1); const bf16_t* rp_ = proj + (size_t)(t0_ - T0_) * LDP + C_XBC + 2048 + 8 * cg_; \
    _Pragma("unroll") for (int j_ = 0; j_ < 11; ++j_) { const int T_ = T0_ - 3 + j_; R[j_] = (T_ >= 0) ? __builtin_nontemporal_load((const u32x4*)(rp_ + (size_t)T_ * LDP)) : (u32x4){0u, 0u, 0u, 0u}; } } while (0)
  u32x4 ra[11], rb[11];
  int it = gtid;
  { const int i0 = it < NITEM ? it : NITEM - 1; CONV_LOADROWS(ra, i0); }
#pragma unroll 1
  for (; it < NITEM; it += 2 * nthr) {
    const int it2 = it + nthr, i2 = it2 < NITEM ? it2 : NITEM - 1, it3 = it2 + nthr, i3 = it3 < NITEM ? it3 : NITEM - 1;
    CONV_LOADROWS(rb, i2);
    conv_rows(ra, conv_w, conv_b, xbcc, (it / NCG) * 8, 2048 + 8 * (it % NCG), true);
    CONV_LOADROWS(ra, i3);
    conv_rows(rb, conv_w, conv_b, xbcc, (i2 / NCG) * 8, 2048 + 8 * (i2 % NCG), it2 < NITEM);
  }
#undef CONV_LOADROWS
}

__device__ __forceinline__ void ssd_unit(const int tid, const int b, const int h, const bf16_t* __restrict__ proj, const bf16_t* __restrict__ xbcc, const float* __restrict__ conv_w, const float* __restrict__ conv_b, const float* __restrict__ dtraw,
                                         const float* __restrict__ dt_bias, const float* __restrict__ a_log, const float* __restrict__ d_skip,
                                         bf16_t* __restrict__ mixb, LAS char* lds) {
  const int wid = __builtin_amdgcn_readfirstlane(tid >> 6), lane = tid & 63, r32 = lane & 31, hi = lane >> 5;
  const int ph = wid & 1, rb = wid < 4 ? 3 - (wid >> 1) : (wid >> 1) - 2;
  LAS char* IC = lds + IMG_C; LAS char* IB = lds + IMG_B; LAS char* IX = lds + IMG_X; LAS char* IS = lds + IMG_S;
  LAS float* Tdt = (LAS float*)(lds + TBL); LAS float* Tacs = Tdt + 2048; LAS float* Tec = (LAS float*)(lds + CWL + 2048); LAS float* Tel = Tec + 128;
  const int grp = h >> 3;
  const float a = -__expf(a_log[h]), dtb = dt_bias[h], Dh = d_skip[h];
  __syncthreads();
  { const u32x4 z = {0u, 0u, 0u, 0u}; *(LAS u32x4*)(IS + tid * 32) = z; *(LAS u32x4*)(IS + tid * 32 + 16) = z; }
#pragma unroll 1
  for (int cc = 0; cc < 2; ++cc) {
    const int t0 = (wid * 2 + cc) * 128 + 2 * lane;
    const float d0 = softplus_f(dtraw[(size_t)(b * SEQ + t0) * 32 + h] + dtb), d1 = softplus_f(dtraw[(size_t)(b * SEQ + t0 + 1) * 32 + h] + dtb);
    const float v0 = d0 * a, ps = v0 + d1 * a;
    float sc = ps;
#pragma unroll
    for (int o = 1; o < 64; o <<= 1) { const float n = __shfl_up(sc, o); if (lane >= o) sc += n; }
    const float a0 = (sc - ps) + v0, a1 = sc, tot = __shfl(sc, 63);
    Tdt[t0] = d0; Tdt[t0 + 1] = d1; Tacs[t0] = a0; Tacs[t0 + 1] = a1;
  }
  { const int ci = tid & 63, tp = tid >> 6; if (tid < 320) ((LAS float*)(lds + CWL))[tid] = tp < 4 ? conv_w[tp * CONVD + h * 64 + ci] : conv_b[h * 64 + ci]; }
  const unsigned xr = ((r32 & 3) << 2) | ((r32 >> 2) & 3);
#define RROW(k) (256u * r32 + 16u * ((2u * (k) + hi) ^ xr))
#define SSD_LOAD(cn) do { int tl_ = tid; asm volatile("" : "+v"(tl_)); const bf16_t* xraw_ = proj + (size_t)(b * SEQ) * LDP + C_XBC + h * 64 + 8 * (tl_ & 7);                       \
    _Pragma("unroll") for (int j_ = 0; j_ < 5; ++j_) { const int T_ = (cn) * 128 + 2 * (tl_ >> 3) - 3 + j_; rx[j_] = (T_ >= 0) ? *(const u32x4*)(xraw_ + (size_t)T_ * LDP) : (u32x4){0u, 0u, 0u, 0u}; } \
    const bf16_t* xs_ = xbcc + (size_t)(b * SEQ + (cn) * 128) * CONVD;                                                                                                            \
    _Pragma("unroll") for (int i_ = 0; i_ < 4; ++i_) { rB[i_] = *(const u32x4*)(xs_ + (size_t)((tl_ >> 4) + 32 * i_) * CONVD + 2048 + grp * 128 + 8 * (tl_ & 15));               \
      rC[i_] = *(const u32x4*)(xs_ + (size_t)((tl_ >> 4) + 32 * i_) * CONVD + 2560 + grp * 128 + 8 * (tl_ & 15)); } } while (0)
#define SSD_BUILD(cn) do { int tq_ = tid; asm volatile("" : "+v"(tq_));                                                                                                           \
    const float ace_ = Tacs[(cn) * 128 + 127]; const LAS float* cwl_ = (const LAS float*)(lds + CWL) + 8 * (tq_ & 7);                                                              \
    if (tq_ < 128) { Tec[tq_] = Tdt[(cn) * 128 + tq_] * __expf(Tacs[(cn) * 128 + (tq_ | 31)] - Tacs[(cn) * 128 + tq_]); Tel[tq_] = __expf(Tacs[(cn) * 128 + tq_]); }        \
    _Pragma("unroll") for (int i_ = 0; i_ < 2; ++i_) { const unsigned tk_ = 2u * (unsigned)(tq_ >> 3) + i_, trow_ = tk_ & 31, xo_ = ((trow_ & 3) << 2) | ((trow_ >> 2) & 3),      \
        rowb_ = IMG_X + (tk_ >> 5) * 8192u + 256u * trow_, cch_ = tq_ & 7;                                                                                                       \
      float o8_[8];                                                                                                                                                              \
      _Pragma("unroll") for (int hh_ = 0; hh_ < 2; ++hh_) { f32x4 acc_ = *(const LAS f32x4*)(cwl_ + 256 + 4 * hh_);                                                               \
        _Pragma("unroll") for (int tp_ = 0; tp_ < 4; ++tp_) { const f32x4 w_ = *(const LAS f32x4*)(cwl_ + 64 * tp_ + 4 * hh_); const u32x4 rw_ = rx[i_ + tp_];                    \
          const unsigned q0_ = hh_ ? rw_.z : rw_.x, q1_ = hh_ ? rw_.w : rw_.y;                                                                                                   \
          acc_[0] = __builtin_fmaf(w_[0], bflo(q0_), acc_[0]); acc_[1] = __builtin_fmaf(w_[1], bfhi(q0_), acc_[1]);                                                                \
          acc_[2] = __builtin_fmaf(w_[2], bflo(q1_), acc_[2]); acc_[3] = __builtin_fmaf(w_[3], bfhi(q1_), acc_[3]); }                                                              \
        _Pragma("unroll") for (int e_ = 0; e_ < 4; ++e_) o8_[4 * hh_ + e_] = acc_[e_] * __builtin_amdgcn_rcpf(1.f + __expf(-acc_[e_])); }                                         \
      u32x4 o_; o_.x = cvt_pk_bf16(o8_[0], o8_[1]); o_.y = cvt_pk_bf16(o8_[2], o8_[3]); o_.z = cvt_pk_bf16(o8_[4], o8_[5]); o_.w = cvt_pk_bf16(o8_[6], o8_[7]);                   \
      *(LAS u32x4*)(lds + rowb_ + 16u * (cch_ ^ xo_)) = o_;                                                                                                                      \
      const float w2_ = Tdt[(cn) * 128 + tk_] * __expf(ace_ - Tacs[(cn) * 128 + tk_]);                                                                                           \
      u32x4 v_; v_.x = cvt_pk_bf16(o8_[0] * w2_, o8_[1] * w2_); v_.y = cvt_pk_bf16(o8_[2] * w2_, o8_[3] * w2_); v_.z = cvt_pk_bf16(o8_[4] * w2_, o8_[5] * w2_);                   \
      v_.w = cvt_pk_bf16(o8_[6] * w2_, o8_[7] * w2_);                                                                                                                            \
      *(LAS u32x4*)(lds + rowb_ + 16u * ((8u + cch_) ^ xo_)) = v_; }                                                                                                             \
    _Pragma("unroll") for (int i_ = 0; i_ < 4; ++i_) { const unsigned tk_ = (unsigned)(tq_ >> 4) + 32u * i_, trow_ = tk_ & 31, xo_ = ((trow_ & 3) << 2) | ((trow_ >> 2) & 3),    \
        ro_ = (tk_ >> 5) * 8192u + 256u * trow_ + 16u * ((unsigned)(tq_ & 15) ^ xo_);                                                                                            \
      *(LAS u32x4*)(lds + IMG_B + ro_) = rB[i_]; *(LAS u32x4*)(lds + IMG_C + ro_) = rC[i_]; } } while (0)
#define SSD_BAR() asm volatile("s_waitcnt lgkmcnt(0)\n\ts_barrier" ::: "memory")
  u32x4 rx[5], rB[4], rC[4];
  SSD_LOAD(0);
  __syncthreads();
  SSD_BUILD(0);
  __syncthreads();
  f32x16 S = {};
#pragma unroll 1
  for (int c = 0; c < 16; ++c) {
    { const int cn = c < 15 ? c + 1 : 15; SSD_LOAD(cn); }
    int lq_ = lane; asm volatile("" : "+v"(lq_));
    const int lane = lq_, r32 = lane & 31, hi = lane >> 5; const unsigned xr = ((r32 & 3) << 2) | ((r32 >> 2) & 3);
    const LAS float* acs = Tacs + c * 128; const LAS float* dts = Tdt + c * 128;
    f32x16 Y = {};
    const float acl = acs[32 * rb + r32];
#define SSD_GT(ST) f32x16 Dm = {};                                                                                                                      \
      _Pragma("unroll") for (int k = 0; k < 8; ++k) { const bf16x8 af = *(const LAS bf16x8*)(IB + (ST) * 8192 + RROW(k)), bq = *(const LAS bf16x8*)(IC + rb * 8192 + RROW(k)); \
        Dm = __builtin_amdgcn_mfma_f32_32x32x16_bf16(af, bq, Dm, 0, 0, 0); }
#define PK4(P, BASE, OUT) do { unsigned a0_ = cvt_pk_bf16(P[BASE + 0], P[BASE + 1]), a1_ = cvt_pk_bf16(P[BASE + 2], P[BASE + 3]);   \
    unsigned b0_ = cvt_pk_bf16(P[BASE + 4], P[BASE + 5]), b1_ = cvt_pk_bf16(P[BASE + 6], P[BASE + 7]);                              \
    auto r0_ = __builtin_amdgcn_permlane32_swap(a0_, b0_, false, false); auto r1_ = __builtin_amdgcn_permlane32_swap(a1_, b1_, false, false); \
    u32x4 w_ = {r0_[0], r1_[0], r0_[1], r1_[1]}; OUT = *reinterpret_cast<bf16x8*>(&w_); } while (0)
#define SSD_PX(ST) do { bf16x8 pa0, pa1; PK4(Dm, 0, pa0); PK4(Dm, 8, pa1);                                                                               \
      Y = __builtin_amdgcn_mfma_f32_32x32x16_bf16(pa0, tr_frag(IX + (ST) * 8192, tr_read_addr(lane, ph, 0, 0), tr_read_addr(lane, ph, 0, 1)), Y, 0, 0, 0); \
      Y = __builtin_amdgcn_mfma_f32_32x32x16_bf16(pa1, tr_frag(IX + (ST) * 8192, tr_read_addr(lane, ph, 1, 0), tr_read_addr(lane, ph, 1, 1)), Y, 0, 0, 0); } while (0)
#pragma unroll 1
    for (int st = 0; st < rb; ++st) {
      SSD_GT(st)
      const float mrow = __expf(acl - acs[32 * st + 31]);
#pragma unroll
      for (int q4 = 0; q4 < 4; ++q4) { const f32x4 ec4 = *(const LAS f32x4*)(Tec + 32 * st + 8 * q4 + 4 * hi);
#pragma unroll
        for (int e = 0; e < 4; ++e) Dm[4 * q4 + e] *= mrow * ec4[e]; }
      SSD_PX(st);
    }
    {
      SSD_GT(rb)
      if (__all(acs[32 * rb] - acs[32 * rb + 31] < 60.f)) {
        const float mrow = __expf(acl - acs[32 * rb + 31]);
#pragma unroll
        for (int q4 = 0; q4 < 4; ++q4) { const f32x4 ec4 = *(const LAS f32x4*)(Tec + 32 * rb + 8 * q4 + 4 * hi);
#pragma unroll
          for (int e = 0; e < 4; ++e) { const int r = 4 * q4 + e, sidx = 8 * q4 + 4 * hi + e;
            const float f = sidx > r32 ? 0.f : mrow * ec4[e]; Dm[r] = __builtin_fmaf(Dm[r], f, sidx == r32 ? Dh : 0.f); } }
      } else {
#pragma unroll
        for (int q4 = 0; q4 < 4; ++q4) { const f32x4 as4 = *(const LAS f32x4*)(acs + 32 * rb + 8 * q4 + 4 * hi), dt4 = *(const LAS f32x4*)(dts + 32 * rb + 8 * q4 + 4 * hi);
#pragma unroll
          for (int e = 0; e < 4; ++e) { const int r = 4 * q4 + e, sidx = 8 * q4 + 4 * hi + e;
            const float f = sidx > r32 ? 0.f : __expf(acl - as4[e]) * dt4[e]; Dm[r] = __builtin_fmaf(Dm[r], f, sidx == r32 ? Dh : 0.f); } }
      }
      SSD_PX(rb);
    }
#undef SSD_GT
#undef SSD_PX
#undef PK4
    {
      f32x16 CS = {};
#pragma unroll
      for (int k = 0; k < 8; ++k) { const bf16x8 af = *(const LAS bf16x8*)(IC + rb * 8192 + RROW(k)), bq = *(const LAS bf16x8*)(IS + ph * 8192 + RROW(k));
        CS = __builtin_amdgcn_mfma_f32_32x32x16_bf16(af, bq, CS, 0, 0, 0); }
#pragma unroll
      for (int q4 = 0; q4 < 4; ++q4) { const f32x4 el4 = *(const LAS f32x4*)(Tel + 32 * rb + 8 * q4 + 4 * hi);
#pragma unroll
        for (int e = 0; e < 4; ++e) Y[4 * q4 + e] += CS[4 * q4 + e] * el4[e]; }
    }
    {
      const float dec = __expf(acs[127]);
#pragma unroll
      for (int r = 0; r < 16; ++r) S[r] *= dec;
#pragma unroll
      for (int st = 0; st < 4; ++st)
#pragma unroll
        for (int ks = 0; ks < 2; ++ks) {
          const bf16x8 af = tr_frag(IX + st * 8192, tr_read_addr(lane, 2 + ph, ks, 0), tr_read_addr(lane, 2 + ph, ks, 1));
          const bf16x8 bq = tr_frag(IB + st * 8192, tr_read_addr(lane, rb, ks, 0), tr_read_addr(lane, rb, ks, 1));
          S = __builtin_amdgcn_mfma_f32_32x32x16_bf16(bq, af, S, 0, 0, 0);
        }
    }
    {
      bf16_t* yp = mixb + (size_t)(b * SEQ + c * 128 + 32 * rb + 4 * hi) * MIXW + AW + h * 64 + 32 * ph + r32;
#pragma unroll
      for (int r = 0; r < 16; ++r) yp[((r & 3) + 8 * (r >> 2)) * MIXW] = f2bf_native(Y[r]);
    }
    SSD_BAR();
    {
      int lq2_ = lane; asm volatile("" : "+v"(lq2_)); const int r32 = lq2_ & 31, hi = lq2_ >> 5;
#pragma unroll
      for (int q = 0; q < 4; ++q) { u32x2 w; w.x = pk2bf_native(S[4 * q], S[4 * q + 1]); w.y = pk2bf_native(S[4 * q + 2], S[4 * q + 3]);
        *(LAS u32x2*)(IS + elem_addr(32 * ph + r32, 32 * rb + 8 * q + 4 * hi)) = w; }
    }
    { const int cn = c < 15 ? c + 1 : 15; SSD_BUILD(cn); }
    SSD_BAR();
  }
#undef RROW
#undef SSD_LOAD
#undef SSD_BUILD
#undef SSD_BAR
  __syncthreads();
}
}
constexpr int RING_OFF = 0, RING_BYTES = 131072;
constexpr int TAB_OFF = RING_BYTES;
constexpr int RSL_OFF = TAB_OFF + 8192;
constexpr int MOE_OFF = RSL_OFF + 1024;
constexpr int LDSCTL_OFF = 147456 - 512;
constexpr int MISC_OFF = LDSCTL_OFF + 320;
constexpr int LDS_BYTES = 147456;
static_assert(MISC_OFF + 128 <= LDS_BYTES, "LDS map");
constexpr int NWAVES = 8;

struct Args { const float* in[27]; float* out; unsigned char* ws; float rf[16]; int ph_lo, ph_hi, li, pad; };

struct Frame {
    LAS unsigned char* lds;
    volatile LAS unsigned* MISC;
    int tid, lane, wave, vcu, G;
};

__device__ __forceinline__ void row_to_bf16_rs(const float* xrow, bf16_t* orow, float* rs_out, int lane) {
    const f32x4* xr = (const f32x4*)xrow + lane;
    f32x4 v[8]; float s = 0.f;
#pragma unroll
    for (int j = 0; j < 8; ++j) { v[j] = __builtin_nontemporal_load(xr + 64 * j); s += (v[j].x * v[j].x + v[j].y * v[j].y) + (v[j].z * v[j].z + v[j].w * v[j].w); }
    s = wave_sum(s);
    if (lane == 0) *rs_out = rsqrtf(s * (1.f / DM) + EPS);
    u32x2* o8 = (u32x2*)orow + lane;
#pragma unroll
    for (int j = 0; j < 8; ++j) { u32x2 w; w.x = cvt_pk_bf16(v[j].x, v[j].y); w.y = cvt_pk_bf16(v[j].z, v[j].w); o8[64 * j] = w; }
}
struct P0Item { const float* W; const float* sc; bf16_t* dst; int ldw, k0, dK, kd, f8; };
__device__ __forceinline__ void p0_item_load(const P0Item& I, f32x4 (&v)[8], f32x4 (&sv)[2], int lane) {
#pragma unroll
    for (int i = 0; i < 8; ++i) v[i] = __builtin_nontemporal_load((const f32x4*)(I.W + (size_t)(I.k0 + 8 * (lane >> 3) + i) * I.ldw + 4 * (lane & 7)));
    if (I.sc) { sv[0] = *(const f32x4*)(I.sc + I.k0 + 8 * (lane >> 3)); sv[1] = *(const f32x4*)(I.sc + I.k0 + 8 * (lane >> 3) + 4); }
    else { sv[0] = (f32x4){1.f, 1.f, 1.f, 1.f}; sv[1] = sv[0]; }
}
__device__ __forceinline__ void p0_item_store(const P0Item& I, const f32x4 (&v)[8], const f32x4 (&sv)[2], LAS float* scr, int lane, bool live) {
    (void)scr;
#pragma unroll
    for (int t = 0; t < 4; ++t) {
        const float x0 = v[0][t] * sv[0][0], x1 = v[1][t] * sv[0][1], x2 = v[2][t] * sv[0][2], x3 = v[3][t] * sv[0][3], x4 = v[4][t] * sv[1][0], x5 = v[5][t] * sv[1][1], x6 = v[6][t] * sv[1][2], x7 = v[7][t] * sv[1][3];
        const size_t ro = (size_t)(4 * (lane & 7) + t) * I.dK + I.kd + 8 * (lane >> 3);
        if (I.f8) { u32x2 q; q.x = pk4_fp8(256.f * x0, 256.f * x1, 256.f * x2, 256.f * x3); q.y = pk4_fp8(256.f * x4, 256.f * x5, 256.f * x6, 256.f * x7);
            if (live) __builtin_nontemporal_store(q, (u32x2*)((unsigned char*)I.dst + ro)); }
        else { u32x4 o; o.x = cvt_pk_bf16(x0, x1); o.y = cvt_pk_bf16(x2, x3); o.z = cvt_pk_bf16(x4, x5); o.w = cvt_pk_bf16(x6, x7);
            if (live) __builtin_nontemporal_store(o, (u32x4*)(I.dst + ro)); }
    }
}
template <class Dec> __device__ __forceinline__ void p0_items(const Dec& D, const int first, const int stride, const int nitems, LAS float* scr, const int lane) {
#pragma unroll 1
    for (int base = first; base < nitems; base += 4 * stride) {
        P0Item I0, I1, I2, I3; f32x4 v0[8], v1[8], v2[8], v3[8]; f32x4 s0[2], s1[2], s2[2], s3[2];
        const int i1 = base + stride, i2 = base + 2 * stride, i3 = base + 3 * stride;
        const bool h1 = i1 < nitems, h2 = i2 < nitems, h3 = i3 < nitems;
        D(base, I0); D(h1 ? i1 : 0, I1); D(h2 ? i2 : 0, I2); D(h3 ? i3 : 0, I3);
        p0_item_load(I0, v0, s0, lane); p0_item_load(I1, v1, s1, lane); p0_item_load(I2, v2, s2, lane); p0_item_load(I3, v3, s3, lane);
        p0_item_store(I0, v0, s0, scr, lane, true); p0_item_store(I1, v1, s1, scr, lane, h1); p0_item_store(I2, v2, s2, scr, lane, h2); p0_item_store(I3, v3, s3, scr, lane, h3);
    }
}
struct DecIn {
    const float* w_in; const float* nmw; bf16_t* dst;
    __device__ __forceinline__ bool operator()(int r, P0Item& I) const {
        if (r >= 32 * 257) return false;
        const int kb = r / 257, nb = r - kb * 257; I.W = w_in + 32 * nb; I.ldw = INW; I.k0 = 64 * kb; I.sc = nmw; I.dst = dst + (size_t)(32 * nb) * DM; I.dK = DM; I.kd = I.k0; I.f8 = 0; return true;
    }
};
struct DecRest {
    const Args* a; unsigned char* ws;
    __device__ __forceinline__ bool operator()(int r, P0Item& I) const {
        constexpr int I_OUT = 48 * 64, I_CQ = 32 * 16, I_CO = 8 * 64, I_GU = 32 * 32 * 32, I_DN = 32 * 16 * 64;
        const float* const* in = a->in;
        if (r < I_OUT) { const int kb = r / 64, nb = r % 64; I.W = in[11] + 32 * nb; I.ldw = DM; I.k0 = 64 * kb; I.sc = (kb < 16) ? in[9] : (in[10] - AW); I.dst = (bf16_t*)(ws + WS_WOUT_T) + (size_t)(32 * nb) * MIXW; I.dK = MIXW; I.kd = I.k0; I.f8 = 0; return true; } r -= I_OUT;
        if (r < 3 * I_CQ) { const int m = r / I_CQ, q = r - m * I_CQ, kb = q / 16, nb = q % 16; I.W = in[14 + m] + 32 * nb; I.ldw = CW; I.k0 = 64 * kb; I.sc = m == 0 ? in[12] : in[13];
            I.dst = (m == 0 ? (bf16_t*)(ws + WS_WCQ_T) : (bf16_t*)(ws + WS_WCKV_T) + (size_t)(m - 1) * CW * DM) + (size_t)(32 * nb) * DM; I.dK = DM; I.kd = I.k0; I.f8 = 0; return true; } r -= 3 * I_CQ;
        if (r < I_CO) { const int kb = r / 64, nb = r % 64; I.W = in[17] + 32 * nb; I.ldw = DM; I.k0 = 64 * kb; I.sc = nullptr; I.dst = (bf16_t*)(ws + WS_WCO_T) + (size_t)(32 * nb) * CW; I.dK = CW; I.kd = I.k0; I.f8 = 0; return true; } r -= I_CO;
        if (r < 2 * I_GU) { const int up = r >= I_GU; if (up) r -= I_GU; const int e = r >> 10, kb = (r >> 5) & 31, nb = r & 31, n0 = 32 * nb;
            I.W = in[up ? 24 : 23] + (size_t)e * DM * DE + n0; I.ldw = DE; I.k0 = 64 * kb; I.sc = in[18]; I.dst = (bf16_t*)(ws + WS_WGU_T + (size_t)e * 2048 * DM + ((size_t)(((n0 >> 7) * 16 + (kb >> 1)) * 256 + up * 128 + (n0 & 127))) * 128 + (kb & 1) * 64); I.dK = 128; I.kd = 0; I.f8 = 1; return true; } r -= 2 * I_GU;
        if (r < I_DN) { const int e = r >> 10, kb = (r >> 6) & 15, nb = r & 63; I.W = in[25] + (size_t)e * DE * DM + 32 * nb; I.ldw = DM; I.k0 = 64 * kb; I.sc = nullptr; I.dst = (bf16_t*)(ws + WS_WD_T + (size_t)e * 2048 * DE + ((size_t)((((32 * nb) >> 8) * 8 + (kb >> 1)) * 256 + ((32 * nb) & 255))) * 128 + (kb & 1) * 64); I.dK = 128; I.kd = 0; I.f8 = 1; return true; }
        return false;
    }
};
__device__ __forceinline__ void p0a_prologue(Frame& F, const Args& args) {
    LAS float* scr = (LAS float*)(F.lds + RING_OFF + F.wave * 16384);
    const int gw = F.vcu * NWAVES + F.wave, NGW = F.G * NWAVES, lane = F.lane;
    GAS unsigned char* wsg_ = (GAS unsigned char*)args.ws; asm volatile("" : "+s"(wsg_)); unsigned char* ws = (unsigned char*)wsg_;
    { DecIn D{args.in[3], args.in[2], (bf16_t*)(ws + WS_WIN_T)}; p0_items(D, gw, NGW, 32 * 257, scr, lane); }
    { u32x4* z = (u32x4*)((bf16_t*)(ws + WS_WIN_T) + (size_t)INW * DM); const int n16 = (LDP - INW) * DM * 2 / 16;
      for (int i = (F.vcu * NWAVES * 64) + F.tid; i < n16; i += F.G * NWAVES * 64) z[i] = (u32x4){0u, 0u, 0u, 0u}; }
    { float* km = (float*)(ws + WS_KMEAN); for (int i = (F.vcu * NWAVES * 64) + F.tid; i < BATCH * NB * 1024; i += F.G * NWAVES * 64) km[i] = 0.f; }
    { float* tab = (float*)(ws + WS_ROPE);
      for (int i = (F.vcu * NWAVES * 64) + F.tid; i < SEQ * 16; i += F.G * NWAVES * 64) { const int pos = i >> 4, f = i & 15;
        const float ang = (float)pos * args.rf[f]; double r = (double)ang * 0.15915494309189533577; r -= rint(r); const float th = (float)(r * 6.283185307179586477);
        tab[pos * 32 + f] = cosf(th); tab[pos * 32 + 16 + f] = sinf(th); } }
    for (int m = gw; m < M; m += NGW) row_to_bf16_rs(args.in[0] + (size_t)m * DM, (bf16_t*)(ws + WS_XB) + (size_t)m * DM, (float*)(ws + WS_RSX) + m, lane);
}
constexpr int P0B_ITEMS = 48 * 64 + 3 * 32 * 16 + 8 * 64 + 2 * 32 * 32 * 32 + 32 * 16 * 64, QKV_UNITS = 160, P0_DEFER_PER_WAVE = 8;
__device__ __forceinline__ int p0_deferred(int G) { return G > QKV_UNITS ? (G - QKV_UNITS) * NWAVES * P0_DEFER_PER_WAVE : 0; }
__device__ __forceinline__ void p0b_share(Frame& F, const Args& args) {
    LAS float* scr = (LAS float*)(F.lds + RING_OFF + F.wave * 16384);
    const int gw = F.vcu * NWAVES + F.wave, NGW = F.G * NWAVES, lane = F.lane;
    GAS unsigned char* wsg_ = (GAS unsigned char*)args.ws; asm volatile("" : "+s"(wsg_)); unsigned char* ws = (unsigned char*)wsg_;
    { DecRest D{&args, ws}; p0_items(D, gw, NGW, P0B_ITEMS - p0_deferred(F.G), scr, lane); }
    { bf16_t* wh = (bf16_t*)(ws + WS_WR); bf16_t* wl = wh + 48 * DM; const float* nfw = args.in[18];
      for (int i = (F.vcu * NWAVES * 64) + F.tid; i < 48 * DM; i += F.G * NWAVES * 64) { const int n = i >> 11, k = i & (DM - 1);
        const float v = n < NG ? args.in[19][k * NG + n] * nfw[k] : (n < 36 ? args.in[21][k * NE + (n - NG)] * nfw[k] : 0.f);
        const unsigned hb = cvt_pk_bf16(v, 0.f) & 0xffffu; wh[i] = (bf16_t)hb; wl[i] = (bf16_t)(cvt_pk_bf16(v - __uint_as_float(hb << 16), 0.f) & 0xffffu); } }
    for (int m = gw; m < MROWS; m += NGW) row_to_bf16_rs(args.in[1] + (size_t)m * DM, (bf16_t*)(ws + WS_MEMB) + (size_t)m * DM, (float*)(ws + WS_RSMEM) + m, lane);
}

struct SchedG1 {
    const char* A; const char* Bt; int G, c, i0, i1;
    __device__ __forceinline__ bool next(int i, gm::Unit& u) const {
        i += i0; if (i >= i1) return false;
        const int L = i * G + c; if (L >= 64 * 32) return false;
        int pm, pn; gm::tile_of(L, 64, 32, pm, pn);
        u.pm = pm; u.pn = pn; u.kind = 0; u.ti = 0; u.a = A + (size_t)pm * 256 * DM * 2; u.b = Bt + (size_t)pn * 256 * DM * 2; return true;
    }
};
struct EpiG1 {
    bf16_t* proj; float* dtraw; const float* rsx; const float* ropetab; float* kmean;
    template <bool ROPE> __device__ __forceinline__ void rows(const f32x4 (&acc)[2][2][4][2], const gm::Unit& u, const int wc, const int fr, const int fq, const int row0, const float (&rs8)[8], f32x4 (&ks)[2][2]) const {
        const float sgn = (fq < 2) ? -1.f : 1.f;
        f32x4 nc0, nc1, ns0, ns1;
        if constexpr (ROPE) { const float* rt = ropetab + (row0 & (SEQ - 1)) * 32 + 8 * (fq & 1); nc0 = *(const f32x4*)rt; nc1 = *(const f32x4*)(rt + 4); ns0 = *(const f32x4*)(rt + 16); ns1 = *(const f32x4*)(rt + 20); }
#pragma unroll
        for (int g = 0; g < 8; ++g) {
            const int ai = g >> 2, m = g & 3, row = row0 + ai * 128 + m * 16; const float rs = rs8[g];
            f32x4 c0, c1, s0, s1;
            if constexpr (ROPE) { c0 = nc0; c1 = nc1; s0 = ns0; s1 = ns1;
                if (g + 1 < 8) { const int rn = row0 + ((g + 1) >> 2) * 128 + ((g + 1) & 3) * 16; const float* rt = ropetab + (rn & (SEQ - 1)) * 32 + 8 * (fq & 1);
                    nc0 = *(const f32x4*)rt; nc1 = *(const f32x4*)(rt + 4); ns0 = *(const f32x4*)(rt + 16); ns1 = *(const f32x4*)(rt + 20); } }
#pragma unroll
            for (int bj = 0; bj < 2; ++bj) {
                f32x4 v0 = acc[ai][bj][m][0] * rs, v1 = acc[ai][bj][m][1] * rs;
                if constexpr (ROPE) {
                    f32x4 p0, p1;
#pragma unroll
                    for (int e = 0; e < 4; ++e) { p0[e] = __shfl_xor(v0[e], 32); p1[e] = __shfl_xor(v1[e], 32); }
                    v0 = v0 * c0 + (p0 * s0) * sgn; v1 = v1 * c1 + (p1 * s1) * sgn;
                }
                ks[bj][0] += v0; ks[bj][1] += v1;
                u32x4 w; w.x = cvt_pk_bf16(v0[0], v0[1]); w.y = cvt_pk_bf16(v0[2], v0[3]); w.z = cvt_pk_bf16(v1[0], v1[1]); w.w = cvt_pk_bf16(v1[2], v1[3]);
                *(u32x4*)(proj + (size_t)row * LDP + u.pn * 256 + bj * 128 + wc * 32 + 8 * fq) = w;
            }
            asm volatile("" ::: "memory");
        }
    }
    __device__ __forceinline__ void operator()(const f32x4 (&acc)[2][2][4][2], const gm::Unit& u, int wr, int wc, int fr, int fq) const {
        const int row0 = u.pm * 256 + wr * 64 + fr;
        const bool rope = (u.pn < 8) && (wc == 0), ktile = (u.pn >= 4) && (u.pn < 8);
        f32x4 ks[2][2] = {{{0.f, 0.f, 0.f, 0.f}, {0.f, 0.f, 0.f, 0.f}}, {{0.f, 0.f, 0.f, 0.f}, {0.f, 0.f, 0.f, 0.f}}};
        float rs8[8];
#pragma unroll
        for (int g = 0; g < 8; ++g) rs8[g] = rsx[row0 + (g >> 2) * 128 + (g & 3) * 16];
#pragma unroll
        for (int g = 0; g < 8; ++g) asm volatile("" : "+v"(rs8[g]));
        if (rope) rows<true>(acc, u, wc, fr, fq, row0, rs8, ks); else rows<false>(acc, u, wc, fr, fq, row0, rs8, ks);
        if (ktile) {
#pragma unroll
            for (int bj = 0; bj < 2; ++bj)
#pragma unroll
                for (int n = 0; n < 2; ++n)
#pragma unroll
                    for (int e = 0; e < 4; ++e) { float s = ks[bj][n][e]; s += __shfl_xor(s, 1); s += __shfl_xor(s, 2); s += __shfl_xor(s, 4); s += __shfl_xor(s, 8);
                        if (fr == 0) atomicAdd(kmean + (size_t)u.pm * 1024 + (u.pn - 4) * 256 + bj * 128 + wc * 32 + 8 * fq + 4 * n + e, s * (1.f / MB)); }
        }
    }
};
struct SchedTiles {
    const char* A; const char* Bt; int nM, nN, K, G, c;
    __device__ __forceinline__ bool next(int i, gm::Unit& u) const {
        const int L = i * G + c; if (L >= nM * nN) return false;
        int pm, pn; gm::tile_of(L, nM, nN, pm, pn);
        u.pm = pm; u.pn = pn; u.kind = 0; u.ti = 0; u.a = A + (size_t)pm * 256 * K * 2; u.b = Bt + (size_t)pn * 256 * K * 2; return true;
    }
};
template <bool GO> struct EpiRes {
    const bf16_t* base; bf16_t* hb; unsigned char* q8; float* ss;
    __device__ __forceinline__ void operator()(const f32x4 (&acc)[2][2][4][2], const gm::Unit& u, int wr, int wc, int fr, int fq) const {
        const int row0 = u.pm * 256 + wr * 64 + fr, colb = u.pn * 256 + wc * 32 + 8 * fq;
        u32x4 nh[2];
#pragma unroll
        for (int bj = 0; bj < 2; ++bj) nh[bj] = __builtin_nontemporal_load((const u32x4*)(base + (size_t)row0 * DM + colb + bj * 128));
#pragma unroll
        for (int g = 0; g < 8; ++g) {
            const int row = row0 + (g >> 2) * 128 + (g & 3) * 16; float q = 0.f;
            f32x4 cb[2][2];
#pragma unroll
            for (int bj = 0; bj < 2; ++bj) { cb[bj][0] = (f32x4){bflo(nh[bj].x), bfhi(nh[bj].x), bflo(nh[bj].y), bfhi(nh[bj].y)}; cb[bj][1] = (f32x4){bflo(nh[bj].z), bfhi(nh[bj].z), bflo(nh[bj].w), bfhi(nh[bj].w)}; }
            if (g + 1 < 8) { const int rn = row0 + ((g + 1) >> 2) * 128 + ((g + 1) & 3) * 16;
#pragma unroll
                for (int bj = 0; bj < 2; ++bj) nh[bj] = __builtin_nontemporal_load((const u32x4*)(base + (size_t)rn * DM + colb + bj * 128)); }
            asm volatile("" ::: "memory");
#pragma unroll
            for (int bj = 0; bj < 2; ++bj) {
                const size_t o = (size_t)row * DM + colb + bj * 128;
                const f32x4 v0 = acc[g >> 2][bj][g & 3][0] + cb[bj][0], v1 = acc[g >> 2][bj][g & 3][1] + cb[bj][1];
                { u32x4 w; w.x = cvt_pk_bf16(v0[0], v0[1]); w.y = cvt_pk_bf16(v0[2], v0[3]); w.z = cvt_pk_bf16(v1[0], v1[1]); w.w = cvt_pk_bf16(v1[2], v1[3]); *(u32x4*)(hb + o) = w; }
                if constexpr (GO) { u32x2 w8; w8.x = pk4_fp8(v0[0], v0[1], v0[2], v0[3]); w8.y = pk4_fp8(v1[0], v1[1], v1[2], v1[3]); *(u32x2*)(q8 + o) = w8; }
                else q += (v0[0] * v0[0] + v0[1] * v0[1]) + (v0[2] * v0[2] + v0[3] * v0[3]) + (v1[0] * v1[0] + v1[1] * v1[1]) + (v1[2] * v1[2] + v1[3] * v1[3]);
            }
            if constexpr (!GO) { q += __shfl_xor(q, 16); q += __shfl_xor(q, 32); if (fq == 0) ss[(size_t)row * 32 + u.pn * 4 + wc] = q; }
        }
    }
};
struct SchedQKV {
    const char* A0; const char* B0; const char* A1; const char* B1; int G, c;
    __device__ __forceinline__ bool next(int i, gm::Unit& u) const {
        const int L = i * G + c; int pm, pn;
        if (L < 128) { gm::tile_of(L, 64, 2, pm, pn); u.kind = 0; u.a = A0 + (size_t)pm * 256 * DM * 2; u.b = B0 + (size_t)pn * 256 * DM * 2; }
        else if (L < 160) { gm::tile_of(L - 128, 8, 4, pm, pn); u.kind = 1; u.a = A1 + (size_t)pm * 256 * DM * 2; u.b = B1 + (size_t)pn * 256 * DM * 2; }
        else return false;
        u.pm = pm; u.pn = pn; u.ti = 0; return true;
    }
};
struct EpiScale {
    bf16_t* O0; bf16_t* O1; int ld0, ld1; const LAS float* rsl;
    __device__ __forceinline__ void operator()(const f32x4 (&acc)[2][2][4][2], const gm::Unit& u, int wr, int wc, int fr, int fq) const {
        bf16_t* O = u.kind ? O1 : O0; const int ld = u.kind ? ld1 : ld0;
#pragma unroll
        for (int ai = 0; ai < 2; ++ai)
#pragma unroll
            for (int m = 0; m < 4; ++m) {
                const int r = ai * 128 + wr * 64 + m * 16 + fr; const float rs = rsl[r];
#pragma unroll
                for (int bj = 0; bj < 2; ++bj) {
                    const f32x4 v0 = acc[ai][bj][m][0] * rs, v1 = acc[ai][bj][m][1] * rs;
                    u32x4 w; w.x = cvt_pk_bf16(v0[0], v0[1]); w.y = cvt_pk_bf16(v0[2], v0[3]); w.z = cvt_pk_bf16(v1[0], v1[1]); w.w = cvt_pk_bf16(v1[2], v1[3]);
                    *(u32x4*)(O + (size_t)(u.pm * 256 + r) * ld + u.pn * 256 + bj * 128 + wc * 32 + 8 * fq) = w;
                }
            }
    }
};

__device__ __forceinline__ void moe_tables(LAS int* mt, const int* cnt_g, int tid) {
    if (tid < 64) {
        const int lane = tid, c = lane < NE ? cnt_g[lane] : 0, u8 = 8 * ((c + 255) >> 8);
        int pu = u8, po = c;
#pragma unroll
        for (int o = 1; o < 32; o <<= 1) { const int a_ = __shfl_up(pu, o), b_ = __shfl_up(po, o); if (lane >= o) { pu += a_; po += b_; } }
        if (lane < NE) { mt[lane] = c; mt[32 + lane] = pu - u8; mt[65 + lane] = po - c; }
        if (lane == NE - 1) { mt[32 + NE] = pu; mt[65 + NE] = po; }
    }
    LDS_WAIT(); __syncthreads();
}
__device__ __forceinline__ void moe_unit_list(LAS int* ul, const LAS int* mt, int G, int c, int tid) {
    if (tid < 8) {
        const int L = tid * G + c; int v = 0, e = 0, pn = 0, mtile = 0;
        if (L < mt[32 + NE]) {
            for (int k = 1; k < NE; ++k) if (L >= mt[32 + k]) e = k;
            const int rem = L - mt[32 + e], te = (mt[e] + 255) >> 8; pn = rem / te; mtile = rem - pn * te; v = 1;
        }
        ul[4 * tid] = e; ul[4 * tid + 1] = pn; ul[4 * tid + 2] = mtile; ul[4 * tid + 3] = v;
    }
    LDS_WAIT(); __syncthreads();
}
template <bool GU> struct SchedMoEL {
    const LAS int* ul; const char* A; const char* Bt;
    __device__ __forceinline__ bool next(int i, gm::Unit& u) const {
        if (i >= 8 || __builtin_amdgcn_readfirstlane(ul[4 * i + 3]) == 0) return false;
        const int e = __builtin_amdgcn_readfirstlane(ul[4 * i]), pn = __builtin_amdgcn_readfirstlane(ul[4 * i + 1]);
        u.pm = __builtin_amdgcn_readfirstlane(ul[4 * i + 2]); u.pn = pn; u.kind = e; u.ti = i; u.a = A;
        u.b = Bt + ((size_t)e * 2048 + pn * 256) * (GU ? DM : DE);
        return true;
    }
};
struct EpiGU {
    bf16_t* Hact; const float* rs2; const LAS int* mt; const LAS int* tab;
    __device__ __forceinline__ void operator()(const f32x4 (&acc)[2][2][4][2], const gm::Unit& u, int wr, int wc, int fr, int fq) const {
        const int e = u.kind, valid = mt[e] - u.pm * 256, slot0 = mt[65 + e] + u.pm * 256;
        float rsv[8];
#pragma unroll
        for (int g = 0; g < 8; ++g) rsv[g] = rs2[tab[u.ti * 256 + (g >> 2) * 128 + wr * 64 + (g & 3) * 16 + fr]];
#pragma unroll
        for (int g = 0; g < 8; ++g) asm volatile("" : "+v"(rsv[g]));
#pragma unroll
        for (int ai = 0; ai < 2; ++ai)
#pragma unroll
            for (int m = 0; m < 4; ++m) {
                const int r = ai * 128 + wr * 64 + m * 16 + fr;
                if (r < valid) {
                    const float rs = rsv[ai * 4 + m] * (1.f / 256.f);
                    const f32x4 g0 = acc[ai][0][m][0] * rs, g1 = acc[ai][0][m][1] * rs, u0 = acc[ai][1][m][0] * rs, u1 = acc[ai][1][m][1] * rs;
                    float o[8];
#pragma unroll
                    for (int j = 0; j < 4; ++j) { o[j] = g0[j] * __builtin_amdgcn_rcpf(1.f + __expf(-g0[j])) * u0[j]; o[4 + j] = g1[j] * __builtin_amdgcn_rcpf(1.f + __expf(-g1[j])) * u1[j]; }
                    u32x2 w; w.x = pk4_fp8(16.f * o[0], 16.f * o[1], 16.f * o[2], 16.f * o[3]); w.y = pk4_fp8(16.f * o[4], 16.f * o[5], 16.f * o[6], 16.f * o[7]);
                    *(u32x2*)((unsigned char*)Hact + (size_t)(slot0 + r) * DE + u.pn * 128 + wc * 32 + 8 * fq) = w;
                }
            }
    }
};
struct EpiDown {
    unsigned char* Y; const LAS int* mt;
    __device__ __forceinline__ void operator()(const f32x4 (&acc)[2][2][4][2], const gm::Unit& u, int wr, int wc, int fr, int fq) const {
        const int e = u.kind, valid = mt[e] - u.pm * 256, slot0 = mt[65 + e] + u.pm * 256;
#pragma unroll
        for (int ai = 0; ai < 2; ++ai)
#pragma unroll
            for (int m = 0; m < 4; ++m) {
                const int r = ai * 128 + wr * 64 + m * 16 + fr;
                if (r < valid) {
#pragma unroll
                    for (int bj = 0; bj < 2; ++bj) { const f32x4 v0 = acc[ai][bj][m][0] * (1.f / 256.f), v1 = acc[ai][bj][m][1] * (1.f / 256.f);
                        u32x2 w; w.x = pk4_fp8(v0[0], v0[1], v0[2], v0[3]); w.y = pk4_fp8(v1[0], v1[1], v1[2], v1[3]);
                        *(u32x2*)(Y + (size_t)(slot0 + r) * DM + u.pn * 256 + bj * 128 + wc * 32 + 8 * fq) = w; }
                }
            }
    }
};
__device__ __forceinline__ void final_rows(Frame& F, const bf16_t* h2b, float* outp, const unsigned char* Y, const int* tok_e, const int* tok_pos, const float* tok_w, const float* fw, const LAS int* mt) {
    const int gw = F.vcu * NWAVES + F.wave, NGW = F.G * NWAVES, lane = F.lane;
#pragma unroll 2
    for (int t = gw; t < M; t += NGW) {
        const int e1 = tok_e[2 * t], e2 = tok_e[2 * t + 1];
        const size_t s1 = (size_t)(mt[65 + e1] + tok_pos[2 * t]), s2 = (size_t)(mt[65 + e2] + tok_pos[2 * t + 1]);
        const float w1 = tok_w[2 * t] * (1.f / 16.f), w2 = tok_w[2 * t + 1] * (1.f / 16.f);
        f32x4* hr = (f32x4*)(outp + (size_t)t * DM) + 2 * lane;
        const u32x4* hb = (const u32x4*)(h2b + (size_t)t * DM) + lane;
        const u32x2* y1 = (const u32x2*)(Y + s1 * DM) + lane; const u32x2* y2 = (const u32x2*)(Y + s2 * DM) + lane;
        float v[4][8]; float ss = 0.f;
#pragma unroll
        for (int j = 0; j < 4; ++j) {
            const u32x4 a = __builtin_nontemporal_load(hb + 64 * j); const u32x2 p = __builtin_nontemporal_load(y1 + 64 * j), q = __builtin_nontemporal_load(y2 + 64 * j);
            float pa[8], qa[8];
            { const f32x2 t0 = __builtin_amdgcn_cvt_pk_f32_fp8((int)p.x, false), t1 = __builtin_amdgcn_cvt_pk_f32_fp8((int)p.x, true), t2 = __builtin_amdgcn_cvt_pk_f32_fp8((int)p.y, false), t3 = __builtin_amdgcn_cvt_pk_f32_fp8((int)p.y, true);
              pa[0] = t0[0]; pa[1] = t0[1]; pa[2] = t1[0]; pa[3] = t1[1]; pa[4] = t2[0]; pa[5] = t2[1]; pa[6] = t3[0]; pa[7] = t3[1]; }
            { const f32x2 t0 = __builtin_amdgcn_cvt_pk_f32_fp8((int)q.x, false), t1 = __builtin_amdgcn_cvt_pk_f32_fp8((int)q.x, true), t2 = __builtin_amdgcn_cvt_pk_f32_fp8((int)q.y, false), t3 = __builtin_amdgcn_cvt_pk_f32_fp8((int)q.y, true);
              qa[0] = t0[0]; qa[1] = t0[1]; qa[2] = t1[0]; qa[3] = t1[1]; qa[4] = t2[0]; qa[5] = t2[1]; qa[6] = t3[0]; qa[7] = t3[1]; }
            const float ha[8] = {bflo(a.x), bfhi(a.x), bflo(a.y), bfhi(a.y), bflo(a.z), bfhi(a.z), bflo(a.w), bfhi(a.w)};
#pragma unroll
            for (int k = 0; k < 8; ++k) { v[j][k] = ha[k] + (w1 * pa[k] + w2 * qa[k]); ss += v[j][k] * v[j][k]; }
        }
        ss = wave_sum(ss);
        const float rs = rsqrtf(ss * (1.f / DM) + EPS);
#pragma unroll
        for (int j = 0; j < 4; ++j) {
            const f32x4 g0 = *((const f32x4*)fw + 2 * lane + 128 * j), g1 = *((const f32x4*)fw + 2 * lane + 128 * j + 1);
            __builtin_nontemporal_store((f32x4){v[j][0] * rs * g0[0], v[j][1] * rs * g0[1], v[j][2] * rs * g0[2], v[j][3] * rs * g0[3]}, hr + 128 * j);
            __builtin_nontemporal_store((f32x4){v[j][4] * rs * g1[0], v[j][5] * rs * g1[1], v[j][6] * rs * g1[2], v[j][7] * rs * g1[3]}, hr + 128 * j + 1);
        }
    }
}

__device__ __forceinline__ void router_rows(Frame& F, const bf16_t* h2, const bf16_t* wrh, const float* b_rg, const float* b_re, float* rs2, int* cnt, int* list, int* tok_e, int* tok_pos, float* tok_w) {
    const int lane = F.lane, tid = F.tid, w = F.wave, ti = lane & 15, kg = lane >> 4;
    LAS float* part = (LAS float*)(F.lds + RING_OFF);
    LAS float* sqp = part + 8 * 64 * 48;
    LAS float* lgt = sqp + 8 * 64;
    const bf16_t* wrl = wrh + 48 * DM;
    for (int g = F.vcu; g < M / 64; g += F.G) {
        const bf16_t* hr = h2 + (size_t)(g * 64 + ti) * DM + w * 256 + 8 * kg;
        f32x4 acc[4][3]; float sq[4];
#pragma unroll
        for (int sb = 0; sb < 4; ++sb) { sq[sb] = 0.f;
#pragma unroll
            for (int nt = 0; nt < 3; ++nt) acc[sb][nt] = (f32x4){0.f, 0.f, 0.f, 0.f}; }
#pragma unroll 2
        for (int s = 0; s < 8; ++s) {
            bf16x8 bh[3], bl[3]; u32x4 xw[4];
#pragma unroll
            for (int nt = 0; nt < 3; ++nt) { const size_t o = (size_t)(16 * nt + ti) * DM + w * 256 + 32 * s + 8 * kg; bh[nt] = *(const bf16x8*)(wrh + o); bl[nt] = *(const bf16x8*)(wrl + o); }
#pragma unroll
            for (int sb = 0; sb < 4; ++sb) xw[sb] = *(const u32x4*)(hr + (size_t)(16 * sb) * DM + 32 * s);
#pragma unroll
            for (int sb = 0; sb < 4; ++sb) {
                { const float x0 = bflo(xw[sb].x), x1 = bfhi(xw[sb].x), x2 = bflo(xw[sb].y), x3 = bfhi(xw[sb].y), x4 = bflo(xw[sb].z), x5 = bfhi(xw[sb].z), x6 = bflo(xw[sb].w), x7 = bfhi(xw[sb].w);
                  sq[sb] += (x0 * x0 + x1 * x1) + (x2 * x2 + x3 * x3) + (x4 * x4 + x5 * x5) + (x6 * x6 + x7 * x7); }
                const bf16x8 ah = *reinterpret_cast<const bf16x8*>(&xw[sb]);
#pragma unroll
                for (int nt = 0; nt < 3; ++nt) { acc[sb][nt] = __builtin_amdgcn_mfma_f32_16x16x32_bf16(ah, bh[nt], acc[sb][nt], 0, 0, 0); acc[sb][nt] = __builtin_amdgcn_mfma_f32_16x16x32_bf16(ah, bl[nt], acc[sb][nt], 0, 0, 0); }
            }
        }
#pragma unroll
        for (int sb = 0; sb < 4; ++sb) { sq[sb] += __shfl_xor(sq[sb], 16); sq[sb] += __shfl_xor(sq[sb], 32); }
        __syncthreads();
#pragma unroll
        for (int sb = 0; sb < 4; ++sb) {
#pragma unroll
            for (int nt = 0; nt < 3; ++nt)
#pragma unroll
                for (int r = 0; r < 4; ++r) part[(w * 64 + 16 * sb + 4 * kg + r) * 48 + 16 * nt + ti] = acc[sb][nt][r];
            if (kg == 0) sqp[w * 64 + 16 * sb + ti] = sq[sb]; }
        __syncthreads();
        for (int i = tid; i < 64 * 48 + 64; i += NWAVES * 64) { float s = 0.f;
            if (i < 64 * 48) {
#pragma unroll
                for (int ww = 0; ww < 8; ++ww) s += part[ww * 64 * 48 + i]; }
            else {
#pragma unroll
                for (int ww = 0; ww < 8; ++ww) s += sqp[ww * 64 + (i - 64 * 48)]; }
            lgt[i] = s; }
        __syncthreads();
        if (tid < 64) {
            const int tt = g * 64 + tid; const LAS float* lg = lgt + tid * 48;
            const float rs = rsqrtf(lgt[64 * 48 + tid] * (1.f / DM) + EPS);
            float gm_ = -INFINITY; int gi = 0; float gv[4];
#pragma unroll
            for (int i = 0; i < 4; ++i) { gv[i] = lg[i] * rs + b_rg[i]; if (gv[i] > gm_) { gm_ = gv[i]; gi = i; } }
            float gs = 0.f;
#pragma unroll
            for (int i = 0; i < 4; ++i) gs += __expf(gv[i] - gm_);
            const float gwt = 1.f / gs;
            float e1 = -INFINITY, e2 = -INFINITY; int i1 = 0, i2 = 0;
#pragma unroll
            for (int i = 0; i < 8; ++i) { const float vv = lg[4 + gi * 8 + i] * rs + b_re[gi * 8 + i]; if (vv > e1) { e2 = e1; i2 = i1; e1 = vv; i1 = i; } else if (vv > e2) { e2 = vv; i2 = i; } }
            const float p2 = 1.f / (1.f + __expf(e1 - e2)), p1 = 1.f - p2;
            const int ea = gi * 8 + i1, eb = gi * 8 + i2;
            const int pa = atomicAdd(&cnt[ea], 1), pb = atomicAdd(&cnt[eb], 1);
            list[ea * M + pa] = tt; list[eb * M + pb] = tt;
            tok_e[tt * 2] = ea; tok_e[tt * 2 + 1] = eb; tok_pos[tt * 2] = pa; tok_pos[tt * 2 + 1] = pb; tok_w[tt * 2] = gwt * p1; tok_w[tt * 2 + 1] = gwt * p2; rs2[tt] = rs;
        }
    }
    __syncthreads();
}

__device__ __forceinline__ void dt_rows(Frame& F, const bf16_t* xb, const bf16_t* wdt, const float* rsx, float* dtraw) {
    const int lane = F.lane, tid = F.tid, w = F.wave, ti = lane & 15, kg = lane >> 4;
    LAS float* part = (LAS float*)(F.lds + RING_OFF);
    for (int g = F.vcu; g < M / 64; g += F.G) {
        const bf16_t* ar = xb + (size_t)(g * 64 + ti) * DM + w * 256 + 8 * kg;
        f32x4 acc[4][2];
#pragma unroll
        for (int sb = 0; sb < 4; ++sb) { acc[sb][0] = (f32x4){0.f, 0.f, 0.f, 0.f}; acc[sb][1] = acc[sb][0]; }
#pragma unroll 4
        for (int s = 0; s < 8; ++s) {
            const bf16x8 b0 = *(const bf16x8*)(wdt + (size_t)ti * DM + w * 256 + 32 * s + 8 * kg), b1 = *(const bf16x8*)(wdt + (size_t)(16 + ti) * DM + w * 256 + 32 * s + 8 * kg);
            bf16x8 af[4];
#pragma unroll
            for (int sb = 0; sb < 4; ++sb) af[sb] = *(const bf16x8*)(ar + (size_t)(16 * sb) * DM + 32 * s);
#pragma unroll
            for (int sb = 0; sb < 4; ++sb) { acc[sb][0] = __builtin_amdgcn_mfma_f32_16x16x32_bf16(af[sb], b0, acc[sb][0], 0, 0, 0); acc[sb][1] = __builtin_amdgcn_mfma_f32_16x16x32_bf16(af[sb], b1, acc[sb][1], 0, 0, 0); }
        }
        __syncthreads();
#pragma unroll
        for (int sb = 0; sb < 4; ++sb)
#pragma unroll
            for (int nt = 0; nt < 2; ++nt)
#pragma unroll
                for (int r = 0; r < 4; ++r) part[(w * 64 + 16 * sb + 4 * kg + r) * 32 + 16 * nt + ti] = acc[sb][nt][r];
        __syncthreads();
#pragma unroll
        for (int j = 0; j < 4; ++j) { const int i = tid + 512 * j; float s = 0.f;
#pragma unroll
          for (int ww = 0; ww < 8; ++ww) s += part[ww * 2048 + i];
          const int tok = g * 64 + (i >> 5); dtraw[(size_t)tok * 32 + (i & 31)] = s * rsx[tok]; }
    }
    __syncthreads();
}

__device__ __forceinline__ void gnorm_rows(Frame& F, bf16_t* mixb, const bf16_t* proj) {
    const int gw = F.vcu * NWAVES + F.wave, NGW = F.G * NWAVES, lane = F.lane;
#pragma unroll 2
    for (int tok = gw; tok < M; tok += NGW) {
        u32x4* p = (u32x4*)(mixb + (size_t)tok * MIXW + AW) + lane; const u32x4* zp = (const u32x4*)(proj + (size_t)tok * LDP + C_Z) + lane;
        u32x4 w[4], zw[4]; float v[4][8]; float q[4];
#pragma unroll
        for (int g = 0; g < 4; ++g) { w[g] = __builtin_nontemporal_load(p + 64 * g); zw[g] = __builtin_nontemporal_load(zp + 64 * g); }
#pragma unroll
        for (int g = 0; g < 4; ++g) { float z[8] = {bflo(zw[g].x), bfhi(zw[g].x), bflo(zw[g].y), bfhi(zw[g].y), bflo(zw[g].z), bfhi(zw[g].z), bflo(zw[g].w), bfhi(zw[g].w)};
#pragma unroll
            for (int e = 0; e < 8; ++e) z[e] = z[e] * __builtin_amdgcn_rcpf(1.f + __expf(-z[e]));
            v[g][0] = bflo(w[g].x) * z[0]; v[g][1] = bfhi(w[g].x) * z[1]; v[g][2] = bflo(w[g].y) * z[2]; v[g][3] = bfhi(w[g].y) * z[3]; v[g][4] = bflo(w[g].z) * z[4]; v[g][5] = bfhi(w[g].z) * z[5]; v[g][6] = bflo(w[g].w) * z[6]; v[g][7] = bfhi(w[g].w) * z[7];
            q[g] = (v[g][0] * v[g][0] + v[g][1] * v[g][1]) + (v[g][2] * v[g][2] + v[g][3] * v[g][3]) + (v[g][4] * v[g][4] + v[g][5] * v[g][5]) + (v[g][6] * v[g][6] + v[g][7] * v[g][7]); }
#pragma unroll
        for (int o = 1; o < 64; o <<= 1) {
#pragma unroll
            for (int g = 0; g < 4; ++g) q[g] += __shfl_xor(q[g], o); }
#pragma unroll
        for (int g = 0; g < 4; ++g) { const float rs = rsqrtf(q[g] * (1.f / 512.f) + EPS); u32x4 o;
            o.x = cvt_pk_bf16(v[g][0] * rs, v[g][1] * rs); o.y = cvt_pk_bf16(v[g][2] * rs, v[g][3] * rs); o.z = cvt_pk_bf16(v[g][4] * rs, v[g][5] * rs); o.w = cvt_pk_bf16(v[g][6] * rs, v[g][7] * rs);
            p[64 * g] = o; }
    }
}

#ifndef REP_P0
#define REP_P0 1
#endif
#ifndef REP_P0B
#define REP_P0B 1
#endif
#ifndef REP_G1
#define REP_G1 1
#endif
#ifndef REP_SSD
#define REP_SSD 1
#endif
#ifndef REP_MOE
#define REP_MOE 1
#endif
#ifndef REP_ATT
#define REP_ATT 1
#endif
#ifndef REP_G2
#define REP_G2 1
#endif
__global__ void __launch_bounds__(NWAVES * 64, 2) fwd(Args args) {
    extern __shared__ __attribute__((aligned(16))) unsigned char lds_raw[];
    Frame F;
    F.lds = (LAS unsigned char*)lds_raw;
    F.MISC = (volatile LAS unsigned*)(F.lds + MISC_OFF);
    F.tid = threadIdx.x; F.lane = F.tid & 63; F.wave = __builtin_amdgcn_readfirstlane(F.tid >> 6);
    F.G = gridDim.x; { const int bx = blockIdx.x; F.vcu = (F.G % 8 == 0) ? (bx % 8) * (F.G / 8) + bx / 8 : bx; }
    for (int u = F.tid; u < (LDS_BYTES - LDSCTL_OFF) / 4; u += NWAVES * 64) ((LAS unsigned*)(F.lds + LDSCTL_OFF))[u] = 0u;
    __syncthreads();
    (void)xcd_barrier_post((unsigned*)(args.ws + WS_CTL) + CW_BAR + args.li * XCD_BAR_WORDS, F.MISC + 8);
#define GRID_BAR() do { GAS unsigned char* wb_ = (GAS unsigned char*)args.ws; asm volatile("" : "+s"(wb_)); XcdBarrier b_; \
        b_.bar = (unsigned*)((unsigned char*)wb_ + WS_CTL) + CW_BAR + args.li * XCD_BAR_WORDS; b_.x = xb_xcc_id(); b_.st = F.MISC + 8; xcd_barrier(b_, F.wave * 64 + lane_id_now()); } while (0)
    const int lo = args.ph_lo, hi = args.ph_hi;
#define IN(k) (lo <= (k) && (k) < hi)
#define BOTH(k) (IN(k) && IN((k) + 1))
#define PHASE_WS() F.lane = lane_id_now(); F.tid = F.wave * 64 + F.lane; GAS unsigned char* wsg_ = (GAS unsigned char*)args.ws; asm volatile("" : "+s"(wsg_)); unsigned char* ws = (unsigned char*)wsg_
    if (IN(0)) { F.lane = lane_id_now(); F.tid = F.wave * 64 + F.lane;
p0a_prologue(F, args); if constexpr (REP_P0 > 1) p0a_prologue(F, args); if (BOTH(0)) GRID_BAR(); }
    if (IN(1)) {
        PHASE_WS();
        const int rsplit = (F.vcu >> 5) & 7;
        EpiG1 E{(bf16_t*)(ws + WS_PROJ), (float*)(ws + WS_DTRAW), (const float*)(ws + WS_RSX), (const float*)(ws + WS_ROPE), (float*)(ws + WS_KMEAN)};
        { SchedG1 S{(const char*)(ws + WS_XB), (const char*)(ws + WS_WIN_T), F.G, (int)blockIdx.x, 0, rsplit};
          gm::gemm_phase<EpiG1, SchedG1, false>(F.tid, F.lds + RING_OFF, (const LAS int*)(F.lds + TAB_OFF), DM, S, E); }
        __syncthreads();
        p0b_share(F, args);
        if constexpr (REP_P0B > 1) { __syncthreads(); p0b_share(F, args); }
        __syncthreads();
        { F.lane = lane_id_now(); F.tid = F.wave * 64 + F.lane;
          SchedG1 S{(const char*)(ws + WS_XB), (const char*)(ws + WS_WIN_T), F.G, (int)blockIdx.x, rsplit, 1 << 20};
          gm::gemm_phase<EpiG1, SchedG1, false>(F.tid, F.lds + RING_OFF, (const LAS int*)(F.lds + TAB_OFF), DM, S, E); }
        if (BOTH(1)) GRID_BAR();
    }
    if (IN(2)) {
        PHASE_WS();
        dt_rows(F, (const bf16_t*)(ws + WS_XB), (const bf16_t*)(ws + WS_WIN_T) + (size_t)C_DT * DM, (const float*)(ws + WS_RSX), (float*)(ws + WS_DTRAW));
        sd::conv_prepass(F.vcu * NWAVES * 64 + F.tid, F.G * NWAVES * 64, (const bf16_t*)(ws + WS_PROJ), args.in[4], args.in[5], (bf16_t*)(ws + WS_XBCC));
        if (BOTH(2)) GRID_BAR();
    }
    if (IN(3)) {
        PHASE_WS();
        for (int L = F.vcu; L < BATCH * SH; L += F.G)
            sd::ssd_unit(F.tid, L / SH, L % SH, (const bf16_t*)(ws + WS_PROJ), (const bf16_t*)(ws + WS_XBCC), args.in[4], args.in[5], (const float*)(ws + WS_DTRAW), args.in[6], args.in[7], args.in[8],
                         (bf16_t*)(ws + WS_MIXB), (LAS char*)(F.lds + RING_OFF));
        if constexpr (REP_SSD > 1) {
        for (int L = F.vcu; L < BATCH * SH; L += F.G)
            sd::ssd_unit(F.tid, L / SH, L % SH, (const bf16_t*)(ws + WS_PROJ), (const bf16_t*)(ws + WS_XBCC), args.in[4], args.in[5], (const float*)(ws + WS_DTRAW), args.in[6], args.in[7], args.in[8],
                         (bf16_t*)(ws + WS_MIXB), (LAS char*)(F.lds + RING_OFF));
        }
        if (BOTH(3)) GRID_BAR();
    }
    if (IN(4)) {
        PHASE_WS();
        for (int L = F.vcu; L < BATCH * AH * 4; L += F.G) {
            const int b = L >> 5, h = (L >> 2) & 7, pi = L & 3;
            const bf16_t* pb = (const bf16_t*)(ws + WS_PROJ) + (size_t)b * SEQ * LDP + h * HD;
#pragma unroll 1
            for (int k = 0; k < 2; ++k) { const int jb = k ? pi : 7 - pi;
                at::attn_unit<true>(F.tid, pb + (size_t)jb * MB * LDP + C_Q, pb + C_K, (bf16_t*)(ws + WS_MIXB) + (size_t)(b * SEQ + jb * MB) * MIXW + h * HD,
                                    4 * (jb + 1), jb, (const float*)(ws + WS_KMEAN) + (size_t)b * NB * 1024 + h * HD, (LAS char*)(F.lds + RING_OFF)); }
        }
        if constexpr (REP_ATT > 1) {
        for (int L = F.vcu; L < BATCH * AH * 4; L += F.G) {
            const int b = L >> 5, h = (L >> 2) & 7, pi = L & 3;
            const bf16_t* pb = (const bf16_t*)(ws + WS_PROJ) + (size_t)b * SEQ * LDP + h * HD;
#pragma unroll 1
            for (int k = 0; k < 2; ++k) { const int jb = k ? pi : 7 - pi;
                at::attn_unit<true>(F.tid, pb + (size_t)jb * MB * LDP + C_Q, pb + C_K, (bf16_t*)(ws + WS_MIXB) + (size_t)(b * SEQ + jb * MB) * MIXW + h * HD,
                                    4 * (jb + 1), jb, (const float*)(ws + WS_KMEAN) + (size_t)b * NB * 1024 + h * HD, (LAS char*)(F.lds + RING_OFF)); }
        }
        }
        __syncthreads();
        gnorm_rows(F, (bf16_t*)(ws + WS_MIXB), (const bf16_t*)(ws + WS_PROJ));
        if (BOTH(4)) GRID_BAR();
    }
    if (IN(5)) {
        PHASE_WS();
        SchedTiles S{(const char*)(ws + WS_MIXB), (const char*)(ws + WS_WOUT_T), 64, 8, MIXW, F.G, (int)blockIdx.x};
        EpiRes<false> E{(const bf16_t*)(ws + WS_XB), (bf16_t*)(ws + WS_XB), nullptr, (float*)(ws + WS_SS)};
        gm::gemm_phase<EpiRes<false>, SchedTiles, false>(F.tid, F.lds + RING_OFF, (const LAS int*)(F.lds + TAB_OFF), MIXW, S, E);
        if constexpr (REP_G2 > 1) { __syncthreads(); gm::gemm_phase<EpiRes<false>, SchedTiles, false>(F.tid, F.lds + RING_OFF, (const LAS int*)(F.lds + TAB_OFF), MIXW, S, E); }
        if (BOTH(5)) GRID_BAR();
    }
    if (IN(6)) {
        PHASE_WS();
        SchedQKV S{(const char*)(ws + WS_XB), (const char*)(ws + WS_WCQ_T), (const char*)(ws + WS_MEMB), (const char*)(ws + WS_WCKV_T), F.G, (int)blockIdx.x};
        gm::Unit u0; LAS float* rsl = (LAS float*)(F.lds + RSL_OFF);
        if (S.next(0, u0) && F.tid < 256) {
            const int row = u0.pm * 256 + F.tid;
            if (u0.kind == 0) { const f32x4* p = (const f32x4*)((const float*)(ws + WS_SS) + (size_t)row * 32); float q = 0.f;
#pragma unroll
                for (int j = 0; j < 8; ++j) { const f32x4 v = p[j]; q += (v[0] + v[1]) + (v[2] + v[3]); }
                rsl[F.tid] = rsqrtf(q * (1.f / DM) + EPS); }
            else rsl[F.tid] = ((const float*)(ws + WS_RSMEM))[row];
        }
        VM_WAIT(); LDS_WAIT(); __syncthreads();
        EpiScale E{(bf16_t*)(ws + WS_QC), (bf16_t*)(ws + WS_KVC), CW, 2 * CW, rsl};
        gm::gemm_phase<EpiScale, SchedQKV, false>(F.tid, F.lds + RING_OFF, (const LAS int*)(F.lds + TAB_OFF), DM, S, E);
        if ((int)blockIdx.x >= QKV_UNITS) {
            const int nd = p0_deferred(F.G); DecRest D{&args, ws};
            p0_items(D, P0B_ITEMS - nd + ((int)blockIdx.x - QKV_UNITS) * NWAVES + F.wave, (F.G - QKV_UNITS) * NWAVES, P0B_ITEMS, (LAS float*)(F.lds + RING_OFF), F.lane);
        }
        if (BOTH(6)) GRID_BAR();
    }
    if (IN(7)) {
        PHASE_WS();
        for (int L = F.vcu; L < BATCH * CH * 8; L += F.G) {
            const int b = L >> 5, h = (L >> 3) & 3, qt = L & 7;
            const bf16_t* kb_ = (const bf16_t*)(ws + WS_KVC) + (size_t)b * MEM * (2 * CW) + h * CHD;
            at::attn_unit<false>(F.tid, (const bf16_t*)(ws + WS_QC) + (size_t)(b * SEQ + qt * 256) * CW + h * CHD, kb_,
                                 (bf16_t*)(ws + WS_OC) + (size_t)(b * SEQ + qt * 256) * CW + h * CHD, 4, 0, nullptr, (LAS char*)(F.lds + RING_OFF));
        }
        __syncthreads();
        if (BOTH(7)) GRID_BAR();
    }
    if (IN(8)) {
        PHASE_WS();
        SchedTiles S{(const char*)(ws + WS_OC), (const char*)(ws + WS_WCO_T), 64, 8, CW, F.G, (int)blockIdx.x};
        EpiRes<true> E{(const bf16_t*)(ws + WS_XB), (bf16_t*)(ws + WS_H2B), ws + WS_H2Q, nullptr};
        gm::gemm_phase<EpiRes<true>, SchedTiles, false>(F.tid, F.lds + RING_OFF, (const LAS int*)(F.lds + TAB_OFF), CW, S, E);
        if (BOTH(8)) GRID_BAR();
    }
    if (IN(9)) {
        PHASE_WS();
        int* tok_e = (int*)(ws + WS_TOK);
        router_rows(F, (const bf16_t*)(ws + WS_H2B), (const bf16_t*)(ws + WS_WR), args.in[20], args.in[22], (float*)(ws + WS_RS2), (int*)(ws + WS_CTL) + CW_CNT, (int*)(ws + WS_LIST), tok_e, tok_e + 2 * M, (float*)(tok_e + 4 * M));
        if (BOTH(9)) GRID_BAR();
    }
    if (IN(10)) {
        PHASE_WS();
        LAS int* mt = (LAS int*)(F.lds + MOE_OFF); LAS int* tab = (LAS int*)(F.lds + TAB_OFF); LAS int* ul = mt + 100;
        moe_tables(mt, (const int*)(ws + WS_CTL) + CW_CNT, F.tid);
        moe_unit_list(ul, mt, F.G, F.vcu, F.tid);
        SchedMoEL<true> SL{ul, (const char*)(ws + WS_H2Q), (const char*)(ws + WS_WGU_T)};
        { const int* list = (const int*)(ws + WS_LIST); gm::Unit u;
          for (int i = 0; i < 8 && SL.next(i, u); ++i) if (F.tid < 256) { const int rg = u.pm * 256 + F.tid; tab[i * 256 + F.tid] = list[u.kind * M + (rg < mt[u.kind] ? rg : 0)]; } }
        VM_WAIT(); LDS_WAIT(); __syncthreads();
        EpiGU E{(bf16_t*)(ws + WS_HACT), (const float*)(ws + WS_RS2), mt, tab};
        gm::gemm_phase<EpiGU, SchedMoEL<true>, true, true, true>(F.tid, F.lds + RING_OFF, tab, DM / 2, SL, E);
        if constexpr (REP_MOE > 1) { __syncthreads(); gm::gemm_phase<EpiGU, SchedMoEL<true>, true, true, true>(F.tid, F.lds + RING_OFF, tab, DM / 2, SL, E); }
        if (BOTH(10)) GRID_BAR();
    }
    if (IN(11)) {
        PHASE_WS();
        LAS int* mt = (LAS int*)(F.lds + MOE_OFF);
        moe_tables(mt, (const int*)(ws + WS_CTL) + CW_CNT, F.tid);
        LAS int* tab = (LAS int*)(F.lds + TAB_OFF); LAS int* ul = mt + 100;
        moe_unit_list(ul, mt, F.G, F.vcu, F.tid);
        SchedMoEL<false> SL{ul, (const char*)(ws + WS_HACT), (const char*)(ws + WS_WD_T)};
        { gm::Unit u;
          for (int i = 0; i < 8 && SL.next(i, u); ++i) if (F.tid < 256) tab[i * 256 + F.tid] = mt[65 + u.kind] + u.pm * 256 + F.tid; }
        LDS_WAIT(); __syncthreads();
        EpiDown E{ws + WS_Y, mt};
        gm::gemm_phase<EpiDown, SchedMoEL<false>, true, true, true>(F.tid, F.lds + RING_OFF, tab, DE / 2, SL, E);
        if constexpr (REP_MOE > 1) { __syncthreads(); gm::gemm_phase<EpiDown, SchedMoEL<false>, true, true, true>(F.tid, F.lds + RING_OFF, tab, DE / 2, SL, E); }
        if (BOTH(11)) GRID_BAR();
    }
    if (IN(12)) {
        PHASE_WS();
        LAS int* mt = (LAS int*)(F.lds + MOE_OFF);
        moe_tables(mt, (const int*)(ws + WS_CTL) + CW_CNT, F.tid);
        const int* tok_e = (const int*)(ws + WS_TOK);
        final_rows(F, (const bf16_t*)(ws + WS_H2B), args.out, ws + WS_Y, tok_e, tok_e + 2 * M, (const float*)(tok_e + 4 * M), args.in[26], mt);
    }
#undef IN
#undef BOTH
}
extern "C" void kernel_launch(void* const* d_in, const int* in_sizes, int n_in, void* d_out, int out_size, void* d_ws, size_t ws_size, hipStream_t stream) {
  static int grid = 0;
  static float rfv[16];
  if (grid == 0) {
    int dev = 0, cus = 0;
    if (hipGetDevice(&dev) != hipSuccess || hipDeviceGetAttribute(&cus, hipDeviceAttributeMultiprocessorCount, dev) != hipSuccess) { fprintf(stderr, "kernel_launch: device query failed\n"); grid = -1; return; }
    if (hipFuncSetAttribute((const void*)fwd, hipFuncAttributeMaxDynamicSharedMemorySize, LDS_BYTES) != hipSuccess) { fprintf(stderr, "kernel_launch: hipFuncSetAttribute failed\n"); grid = -1; return; }
    int per_cu = 0;
    if (hipOccupancyMaxActiveBlocksPerMultiprocessor(&per_cu, (const void*)fwd, NWAVES * 64, LDS_BYTES) != hipSuccess || per_cu < 1) fprintf(stderr, "kernel_launch: occupancy query says %d\n", per_cu);
    (void)hipGetLastError();
    for (int i = 0; i < 16; ++i) rfv[i] = (float)pow(500000.0, -(double)i / 16.0);
    grid = cus;
  }
  if (grid < 0) return;
  float* out = (float*)d_out;
  unsigned char* ws = (unsigned char*)d_ws;
  (void)hipMemsetAsync(ws + WS_CTL, 0, CTL_ZERO_BYTES, stream);
  Args a{};
  for (int i = 0; i < 27; ++i) a.in[i] = (const float*)d_in[i];
  a.out = out; a.ws = ws; for (int i = 0; i < 16; ++i) a.rf[i] = rfv[i];
  a.ph_lo = 0; a.ph_hi = 13; a.li = 0;
  hipLaunchKernelGGL(fwd, dim3(grid), dim3(NWAVES * 64), LDS_BYTES, stream, a);
}
```

```cpp
#include <hip/hip_runtime.h>
#include <stdint.h>
#include <math.h>
#include <cstdio>

constexpr int DM = 2048, BATCH = 8, SEQ = 2048, M = BATCH * SEQ, MEM = 256, MROWS = BATCH * MEM;
constexpr float EPS = 1e-6f;
constexpr int AH = 8, HD = 128, AW = 1024;
constexpr int MB = 256, NB = SEQ / MB;
constexpr int SW = 2048, SH = 32, SG = 4, SCONV = 4, CONVD = 3072;
constexpr int MIXW = 3072, INW = 8224, LDP = 8448;
constexpr int C_Q = 0, C_K = 1024, C_V = 2048, C_Z = 3072, C_XBC = 5120, C_DT = 8192;
constexpr int CH = 4, CHD = 128, CW = 512;
constexpr int NG = 4, EPG = 8, NE = 32, DE = 1024;

#define LAS __attribute__((address_space(3)))
#define GAS __attribute__((address_space(1)))
typedef unsigned short bf16_t;
typedef short bf16x8 __attribute__((ext_vector_type(8)));
typedef float f32x4 __attribute__((ext_vector_type(4)));
typedef float f32x2 __attribute__((ext_vector_type(2)));
typedef unsigned u32x4 __attribute__((ext_vector_type(4)));
typedef unsigned u32x2 __attribute__((ext_vector_type(2)));
typedef int i32x4 __attribute__((ext_vector_type(4)));
typedef int i32x8 __attribute__((ext_vector_type(8)));
typedef short s16x16 __attribute__((ext_vector_type(16)));
#define LDS_WAIT() asm volatile("s_waitcnt lgkmcnt(0)" ::: "memory")
#define VM_WAIT() asm volatile("s_waitcnt vmcnt(0)" ::: "memory")

__device__ __forceinline__ unsigned cvt_pk_bf16(float lo, float hi) { unsigned r; asm volatile("v_cvt_pk_bf16_f32 %0, %1, %2" : "=v"(r) : "v"(lo), "v"(hi)); return r; }
__device__ __forceinline__ unsigned pk4_fp8(float a, float b, float c, float d) {
  a = fminf(fmaxf(a, -448.f), 448.f); b = fminf(fmaxf(b, -448.f), 448.f); c = fminf(fmaxf(c, -448.f), 448.f); d = fminf(fmaxf(d, -448.f), 448.f);
  int w = 0; w = __builtin_amdgcn_cvt_pk_fp8_f32(a, b, w, false); w = __builtin_amdgcn_cvt_pk_fp8_f32(c, d, w, true); return (unsigned)w; }
__device__ __forceinline__ float bf2f(bf16_t b) { return __uint_as_float(((unsigned)b) << 16); }
__device__ __forceinline__ float bflo(unsigned w) { return __uint_as_float(w << 16); }
__device__ __forceinline__ float bfhi(unsigned w) { return __uint_as_float(w & 0xffff0000u); }
__device__ __forceinline__ void ld8bf(const bf16_t* p, float (&o)[8]) { const u32x4 w = *(const u32x4*)p; o[0] = bflo(w.x); o[1] = bfhi(w.x); o[2] = bflo(w.y); o[3] = bfhi(w.y); o[4] = bflo(w.z); o[5] = bfhi(w.z); o[6] = bflo(w.w); o[7] = bfhi(w.w); }
__device__ __forceinline__ float wave_sum(float v) {
#pragma unroll
  for (int o = 1; o < 64; o <<= 1) v += __shfl_xor(v, o);
  return v;
}
__device__ __forceinline__ float wave_max(float v) {
#pragma unroll
  for (int o = 1; o < 64; o <<= 1) v = fmaxf(v, __shfl_xor(v, o));
  return v;
}
__device__ __forceinline__ int lane_id_now() { int l; asm volatile("v_mbcnt_lo_u32_b32 %0, -1, 0\n\tv_mbcnt_hi_u32_b32 %0, -1, %0" : "=v"(l)); return l; }
__device__ __forceinline__ float silu_f(float x) { return x / (1.f + __expf(-x)); }

constexpr size_t MiB = 1u << 20;
constexpr size_t WS_CTL = 0, CTL_ZERO_BYTES = 1 * MiB;
constexpr int CW_BAR = 4096;
constexpr int CW_CNT = 65536;
constexpr size_t WS_WIN_T = 1 * MiB;
constexpr size_t WS_WOUT_T = 34 * MiB;
constexpr size_t WS_WCQ_T = 46 * MiB;
constexpr size_t WS_WCKV_T = 48 * MiB;
constexpr size_t WS_WCO_T = 52 * MiB;
constexpr size_t WS_WR = 54 * MiB;
constexpr size_t WS_SMALL = 55 * MiB;
constexpr size_t WS_ROPE = WS_SMALL, WS_RSX = WS_SMALL + 256 * 1024, WS_RSMEM = WS_RSX + 64 * 1024, WS_RS2 = WS_RSMEM + 64 * 1024, WS_KMEAN = WS_RS2 + 64 * 1024;
constexpr size_t WS_DTRAW = 56 * MiB;
constexpr size_t WS_SS = 58 * MiB;
constexpr size_t WS_MEMB = 62 * MiB;
constexpr size_t WS_XB = 70 * MiB;
constexpr size_t WS_PROJ = 134 * MiB;
constexpr size_t WS_MIXB = 398 * MiB;
constexpr size_t WS_H2B = WS_MIXB, WS_H2Q = WS_MIXB + 64 * MiB;
constexpr size_t WS_SSQ = 494 * MiB;
constexpr size_t WS_QC = 494 * MiB, WS_OC = 510 * MiB;
constexpr size_t WS_KVC = 526 * MiB;
constexpr size_t WS_WGU_T = 530 * MiB;
constexpr size_t WS_WD_T = 786 * MiB;
constexpr size_t WS_LIST = 914 * MiB;
constexpr size_t WS_TOK = 916 * MiB;
constexpr size_t WS_HACT = WS_PROJ;
constexpr size_t WS_Y = WS_PROJ + 66 * MiB;
constexpr size_t WS_XBCC = 918 * MiB;
constexpr size_t WS_AFTER = 1014 * MiB;
#define XB_TMO      128
#define XB_XCNT(j)  (256  + 64 * (j))
#define XB_XSUB(j)  (1280 + 64 * (j))
#define XB_XGEN(j)  (2304 + 64 * (j))
#define XB_TOP      3328
#define XB_TOPGEN   3392
#define XCD_BAR_WORDS 3456
#define XB_SPIN_CAP (1u << 18)

__device__ __forceinline__ unsigned xb_ld(unsigned* p)              { return __hip_atomic_load(p, __ATOMIC_RELAXED, __HIP_MEMORY_SCOPE_AGENT); }
__device__ __forceinline__ unsigned xb_add(unsigned* p, unsigned v) { return __hip_atomic_fetch_add(p, v, __ATOMIC_RELAXED, __HIP_MEMORY_SCOPE_AGENT); }
__device__ __forceinline__ unsigned xb_xcc_id() { return (unsigned)__builtin_amdgcn_s_getreg((3 << 11) | 20) & 0xFu; }
#define XB_SPIN(cond, bar) do { unsigned _sp = 0; while (cond) { __builtin_amdgcn_s_sleep(1); \
    if ((++_sp & 255u) == 0u) { if (xb_ld(&(bar)[XB_TMO])) break; if (_sp > XB_SPIN_CAP) { atomicAdd(&(bar)[XB_TMO], 1u); break; } } } } while (0)

struct XcdBarrier {
    unsigned* bar; unsigned x;
    volatile LAS unsigned* st;
};

__device__ __forceinline__ XcdBarrier xcd_barrier_post(unsigned* bar, volatile LAS unsigned* st) {
    XcdBarrier b; b.bar = bar; b.x = xb_xcc_id(); b.st = st;
    if (threadIdx.x == 0) (void)xb_add(&bar[XB_XCNT(b.x)], 1u);
    return b;
}
__device__ __forceinline__ void xcd_barrier_complete(unsigned* bar, unsigned x, unsigned& nloc, unsigned& nx) {
    const unsigned G = gridDim.x * gridDim.y * gridDim.z;
    unsigned sum, cnt, mine, sp = 0u;
    for (;;) {
        sum = 0u; cnt = 0u; mine = 0u;
#pragma unroll
        for (unsigned j = 0; j < 16; ++j) { const unsigned c = xb_ld(&bar[XB_XCNT(j)]); sum += c; cnt += (c > 0u) ? 1u : 0u; mine = (j == x) ? c : mine; }
        if (sum == G) break;
        __builtin_amdgcn_s_sleep(1);
        if ((++sp & 255u) == 0u) { if (xb_ld(&bar[XB_TMO])) break; if (sp > XB_SPIN_CAP) { atomicAdd(&bar[XB_TMO], 1u); break; } }
    }
    nloc = mine > 0u ? mine : 1u; nx = cnt > 0u ? cnt : 1u;
}

__device__ __forceinline__ void xcd_barrier(const XcdBarrier& b, const int xb_tid) {
    asm volatile("s_waitcnt vmcnt(0)" ::: "memory");
    __syncthreads();
    if (xb_tid == 0) {
        unsigned* bar = b.bar;
        __builtin_amdgcn_s_waitcnt(0);
        unsigned nloc = b.st[0], nx = b.st[1];
        if (nloc == 0u) { xcd_barrier_complete(bar, b.x, nloc, nx); b.st[0] = nloc; b.st[1] = nx; }
        const unsigned old = xb_add(&bar[XB_XSUB(b.x)], 1u);
        const unsigned gen = old / nloc;
        if (old + 1u == (gen + 1u) * nloc) {
            __builtin_amdgcn_fence(__ATOMIC_RELEASE, "agent");
            asm volatile("s_waitcnt vmcnt(0)" ::: "memory");
            const unsigned og = xb_add(&bar[XB_TOP], 1u);
            const unsigned tg = og / nx;
            if (og + 1u == (tg + 1u) * nx) xb_add(&bar[XB_TOPGEN], 1u);
            else XB_SPIN(xb_ld(&bar[XB_TOPGEN]) == tg, bar);
            __builtin_amdgcn_fence(__ATOMIC_ACQUIRE, "agent");
            xb_add(&bar[XB_XGEN(b.x)], 1u);
            asm volatile("s_waitcnt vmcnt(0)" ::: "memory");
        } else {
            XB_SPIN(xb_ld(&bar[XB_XGEN(b.x)]) == gen, bar);
            __builtin_amdgcn_fence(__ATOMIC_ACQUIRE, "agent");
            asm volatile("s_waitcnt vmcnt(0)" ::: "memory");
        }
    }
    __syncthreads();
}

namespace gm {
constexpr int BM = 256, BK = 64, HALF = 128, HTB = HALF * BK * 2, STAGE_BYTES = 8 * HTB, NXCD = 8, WGM = 8;
__host__ __device__ __forceinline__ int lds_byte(int r, int c) { const int st = (r >> 4) * 2 + (c >> 5), rr = r & 15, cc = c & 31, ob = rr * 64 + cc * 2; return st * 1024 + (ob ^ (((ob >> 9) & 1) << 5)); }
__host__ __device__ __forceinline__ void stage_rc(int b, int& R, int& C) { const int st = b / 1024, sb = b % 1024, swz = sb ^ (((sb >> 9) & 1) << 5); R = (st >> 1) * 16 + swz / 64; C = (st & 1) * 32 + (swz % 64) / 2; }
__host__ __device__ __forceinline__ int perm32(int rho) { const int n = rho >> 4, i = rho & 15; return 8 * (i >> 2) + 4 * n + (i & 3); }

struct Unit { const char* a; const char* b; int pm, pn, kind, ti; };

__device__ __forceinline__ void tile_of(int L, int nM, int nN, int& pm, int& pn) {
    const int nwg = nM * nN; int wgid = L;
    { const int q = nwg / NXCD, r = nwg % NXCD, xcd = wgid % NXCD, off = wgid / NXCD; wgid = (xcd < r ? xcd * (q + 1) : r * (q + 1) + (xcd - r) * q) + off; }
    const int nig = WGM * nN, gid = wgid / nig, fm = gid * WGM, gsz = (nM - fm) < WGM ? (nM - fm) : WGM;
    pm = fm + ((wgid % nig) % gsz); pn = (wgid % nig) / gsz;
}

template <class T, class = void> struct epi_mid_t { static constexpr bool value = false; };
template <class T> struct epi_mid_t<T, decltype((void)T::MID)> { static constexpr bool value = T::MID; };
template <class Epi, class Sched, bool GATHER, bool BTILED = false, bool F8 = false>
__device__ __forceinline__ void gemm_phase(const int tid, LAS unsigned char* lds, const LAS int* tab, const int K, const Sched& S, const Epi& E) {
    const int wid = __builtin_amdgcn_readfirstlane(tid >> 6), lane = tid & 63, wr = wid >> 2, wc = wid & 3, fr = lane & 15, fq = lane >> 4;
    const int nt = K / BK;
    unsigned voffA0[2], voffA1[2], voffB[2];
    const size_t kstep = (size_t)(BK * 2);
    const size_t hstep = (size_t)HALF * K * 2;
    const size_t kstepB = BTILED ? (size_t)(BM * BK * 2) : kstep, hstepB = BTILED ? (size_t)(HALF * BK * 2) : hstep;
#pragma unroll
    for (int i = 0; i < 2; ++i) { int R, C; stage_rc(tid * 16 + i * 8192, R, C); const int Rb = (R & ~31) + perm32(R & 31);
        voffB[i] = BTILED ? (unsigned)(Rb * BK + C) * 2u : (unsigned)(Rb * K + C) * 2u; voffA0[i] = (unsigned)(R * K + C) * 2u; voffA1[i] = 0u; }
#define GM_SETVOFF(u) do { if constexpr (GATHER) { _Pragma("unroll") for (int _i = 0; _i < 2; ++_i) { int R_, C_; stage_rc(tid * 16 + _i * 8192, R_, C_); \
        const int r0_ = tab[(u).ti * 256 + R_], r1_ = tab[(u).ti * 256 + 128 + R_]; voffA0[_i] = (unsigned)(r0_ * K + C_) * 2u; voffA1[_i] = (unsigned)(r1_ * K + C_) * 2u; } } } while (0)
    const unsigned ldsw = (unsigned)wid * 1024u;
    const int aoff = lds_byte(wr * 64 + fr, fq * 8), boff = lds_byte(wc * 32 + fr, fq * 8);
#define PG8_SA(b, h) (((b) * 2 + (h)) * HTB)
#define PG8_SB(b, h) ((4 + (b) * 2 + (h)) * HTB)
#define PG8_STAGE(bufoff, gbase, voff) do { _Pragma("unroll") for (int _i = 0; _i < 2; ++_i) \
        __builtin_amdgcn_global_load_lds((const unsigned*)((const char*)(gbase) + (voff)[_i]), (LAS unsigned*)(lds + (bufoff) + ldsw + _i * 8192), 16, 0, 0); } while (0)
#define PG8_LDA8(dst, b, h) do { _Pragma("unroll") for (int m = 0; m < 4; ++m) { const bf16x8 lo_ = *(const LAS bf16x8*)(lds + PG8_SA(b, h) + aoff + m * 2048), hi_ = *(const LAS bf16x8*)(lds + PG8_SA(b, h) + aoff + m * 2048 + 1024); \
        dst[m] = __builtin_shufflevector(__builtin_bit_cast(i32x4, lo_), __builtin_bit_cast(i32x4, hi_), 0, 1, 2, 3, 4, 5, 6, 7); } } while (0)
#define PG8_LDB8(dst, b, h) do { _Pragma("unroll") for (int n = 0; n < 2; ++n) { const bf16x8 lo_ = *(const LAS bf16x8*)(lds + PG8_SB(b, h) + boff + n * 2048), hi_ = *(const LAS bf16x8*)(lds + PG8_SB(b, h) + boff + n * 2048 + 1024); \
        dst[n] = __builtin_shufflevector(__builtin_bit_cast(i32x4, lo_), __builtin_bit_cast(i32x4, hi_), 0, 1, 2, 3, 4, 5, 6, 7); } } while (0)
#define PG8_MMA8(ai, bj, At, Bt) do { __builtin_amdgcn_s_setprio(1); _Pragma("unroll") for (int m = 0; m < 4; ++m) _Pragma("unroll") for (int n = 0; n < 2; ++n) \
        acc[ai][bj][m][n] = __builtin_amdgcn_mfma_scale_f32_16x16x128_f8f6f4(Bt[n], At[m], acc[ai][bj][m][n], 0, 0, 0, 0, 0, 0); __builtin_amdgcn_s_setprio(0); } while (0)
#define PG8_LDA(dst, b, h) do { _Pragma("unroll") for (int m = 0; m < 4; ++m) _Pragma("unroll") for (int k = 0; k < 2; ++k) dst[m][k] = *(const LAS bf16x8*)(lds + PG8_SA(b, h) + aoff + m * 2048 + k * 1024); } while (0)
#define PG8_LDB(dst, b, h) do { _Pragma("unroll") for (int n = 0; n < 2; ++n) _Pragma("unroll") for (int k = 0; k < 2; ++k) dst[n][k] = *(const LAS bf16x8*)(lds + PG8_SB(b, h) + boff + n * 2048 + k * 1024); } while (0)
#define PG8_MMA(ai, bj, At, Bt) do { __builtin_amdgcn_s_setprio(1); _Pragma("unroll") for (int m = 0; m < 4; ++m) _Pragma("unroll") for (int n = 0; n < 2; ++n) _Pragma("unroll") for (int k = 0; k < 2; ++k) \
        acc[ai][bj][m][n] = __builtin_amdgcn_mfma_f32_16x16x32_bf16(Bt[n][k], At[m][k], acc[ai][bj][m][n], 0, 0, 0); __builtin_amdgcn_s_setprio(0); } while (0)
#define GM_STAGE_A1(bufoff, gbase) do { if constexpr (GATHER) { PG8_STAGE(bufoff, gbase, voffA1); } else { PG8_STAGE(bufoff, (gbase) + hstep, voffA0); } } while (0)
#define PG8_WAIT_V(n) asm volatile("s_waitcnt vmcnt(" #n ")" ::: "memory")
#define PG8_WAIT_L(n) asm volatile("s_waitcnt lgkmcnt(" #n ")" ::: "memory")
#define PG8_BAR __builtin_amdgcn_s_barrier()
#define PG8_SCHED __builtin_amdgcn_sched_barrier(0)
    Unit cur, nxt; int ui = 0;
    if (!S.next(0, cur)) return;
    GM_SETVOFF(cur);
    f32x4 acc[2][2][4][2];
#pragma unroll
    for (int a = 0; a < 2; ++a)
#pragma unroll
        for (int b = 0; b < 2; ++b)
#pragma unroll
            for (int m = 0; m < 4; ++m)
#pragma unroll
                for (int n = 0; n < 2; ++n) acc[a][b][m][n] = (f32x4){0.f, 0.f, 0.f, 0.f};
    bf16x8 At[4][2], B0[2][2], B1[2][2]; i32x8 At8[4], B08[2], B18[2];
    const char* cA = cur.a; const char* cB = cur.b;
    PG8_STAGE(PG8_SB(0, 0), cB, voffB); PG8_STAGE(PG8_SB(0, 1), cB + hstepB, voffB); PG8_STAGE(PG8_SA(0, 0), cA, voffA0); GM_STAGE_A1(PG8_SA(0, 1), cA);
    if (wr == 1) PG8_BAR;
    PG8_WAIT_V(2); PG8_BAR;
    PG8_STAGE(PG8_SB(1, 0), cB + kstepB, voffB); PG8_STAGE(PG8_SA(1, 0), cA + kstep, voffA0); PG8_STAGE(PG8_SB(1, 1), cB + hstepB + kstepB, voffB);
    PG8_WAIT_V(6); PG8_BAR;
    for (;;) {
        const bool has_next = S.next(ui + 1, nxt);
        const char* nA = has_next ? nxt.a : cA; const char* nB = has_next ? nxt.b : cB;
#pragma unroll 1
        for (int t = 0; t < nt; t += 2) {
            if constexpr (epi_mid_t<Epi>::value) E.mid(acc, cur, t, wr, fr);
            const bool last = (t == nt - 2);
            const char* a1 = cA + (size_t)(t + 1) * kstep;
            const char* a2 = last ? nA : cA + (size_t)(t + 2) * kstep; const char* b2 = last ? nB : cB + (size_t)(t + 2) * kstepB;
            const char* a3 = a2 + kstep; const char* b3 = b2 + kstepB;
            if constexpr (F8) {
            PG8_LDB8(B08, 0, 0); PG8_LDB8(B18, 0, 1); PG8_SCHED; PG8_LDA8(At8, 0, 0); GM_STAGE_A1(PG8_SA(1, 1), a1);
            PG8_WAIT_V(8); PG8_WAIT_L(0); PG8_BAR; PG8_MMA8(0, 0, At8, B08); PG8_MMA8(0, 1, At8, B18); PG8_BAR; PG8_SCHED;
            if constexpr (GATHER) { if (last && has_next) { GM_SETVOFF(nxt); } }
            PG8_LDA8(At8, 0, 1); PG8_STAGE(PG8_SB(0, 0), b2, voffB); PG8_STAGE(PG8_SB(0, 1), b2 + hstepB, voffB); PG8_STAGE(PG8_SA(0, 0), a2, voffA0);
            PG8_WAIT_V(8); PG8_WAIT_L(0); PG8_BAR; PG8_MMA8(1, 0, At8, B08); PG8_MMA8(1, 1, At8, B18); PG8_BAR; PG8_SCHED;
            PG8_LDB8(B08, 1, 0); PG8_LDB8(B18, 1, 1); PG8_SCHED; PG8_LDA8(At8, 1, 0); GM_STAGE_A1(PG8_SA(0, 1), a2);
            PG8_WAIT_V(8); PG8_WAIT_L(0); PG8_BAR; PG8_MMA8(0, 0, At8, B08); PG8_MMA8(0, 1, At8, B18); PG8_BAR; PG8_SCHED;
            PG8_LDA8(At8, 1, 1); PG8_STAGE(PG8_SB(1, 0), b3, voffB); PG8_STAGE(PG8_SB(1, 1), b3 + hstepB, voffB); PG8_STAGE(PG8_SA(1, 0), a3, voffA0);
            PG8_WAIT_V(8); PG8_WAIT_L(0); PG8_BAR; PG8_MMA8(1, 0, At8, B08); PG8_MMA8(1, 1, At8, B18); PG8_BAR; PG8_SCHED;
            } else {
            PG8_LDB(B0, 0, 0); PG8_LDB(B1, 0, 1); PG8_SCHED; PG8_LDA(At, 0, 0); GM_STAGE_A1(PG8_SA(1, 1), a1);
            PG8_WAIT_V(8); PG8_WAIT_L(0); PG8_BAR; PG8_MMA(0, 0, At, B0); PG8_MMA(0, 1, At, B1); PG8_BAR; PG8_SCHED;
            if constexpr (GATHER) { if (last && has_next) { GM_SETVOFF(nxt); } }
            PG8_LDA(At, 0, 1); PG8_STAGE(PG8_SB(0, 0), b2, voffB); PG8_STAGE(PG8_SB(0, 1), b2 + hstepB, voffB); PG8_STAGE(PG8_SA(0, 0), a2, voffA0);
            PG8_WAIT_V(8); PG8_WAIT_L(0); PG8_BAR; PG8_MMA(1, 0, At, B0); PG8_MMA(1, 1, At, B1); PG8_BAR; PG8_SCHED;
            PG8_LDB(B0, 1, 0); PG8_LDB(B1, 1, 1); PG8_SCHED; PG8_LDA(At, 1, 0); GM_STAGE_A1(PG8_SA(0, 1), a2);
            PG8_WAIT_V(8); PG8_WAIT_L(0); PG8_BAR; PG8_MMA(0, 0, At, B0); PG8_MMA(0, 1, At, B1); PG8_BAR; PG8_SCHED;
            PG8_LDA(At, 1, 1); PG8_STAGE(PG8_SB(1, 0), b3, voffB); PG8_STAGE(PG8_SB(1, 1), b3 + hstepB, voffB); PG8_STAGE(PG8_SA(1, 0), a3, voffA0);
            PG8_WAIT_V(8); PG8_WAIT_L(0); PG8_BAR; PG8_MMA(1, 0, At, B0); PG8_MMA(1, 1, At, B1); PG8_BAR; PG8_SCHED;
            }
        }
        if (wr == 0) PG8_BAR;
        { int fr_ = fr, fq_ = fq; asm volatile("" : "+v"(fr_), "+v"(fq_));
          E(acc, cur, wr, wc, fr_, fq_); }
        if (!has_next) break;
#pragma unroll
        for (int a = 0; a < 2; ++a)
#pragma unroll
            for (int b = 0; b < 2; ++b)
#pragma unroll
                for (int m = 0; m < 4; ++m)
#pragma unroll
                    for (int n = 0; n < 2; ++n) acc[a][b][m][n] = (f32x4){0.f, 0.f, 0.f, 0.f};
        cur = nxt; cA = nA; cB = nB; ++ui;
        if (wr == 1) PG8_BAR;
    }
    PG8_WAIT_V(0);
    PG8_BAR;
#undef GM_SETVOFF
#undef GM_STAGE_A1
#undef PG8_SA
#undef PG8_SB
#undef PG8_STAGE
#undef PG8_LDA
#undef PG8_LDA8
#undef PG8_LDB8
#undef PG8_MMA8
#undef PG8_LDB
#undef PG8_MMA
#undef PG8_WAIT_V
#undef PG8_WAIT_L
#undef PG8_BAR
#undef PG8_SCHED
}
}
namespace at {
using f32x16 = __attribute__((ext_vector_type(16))) float;
using s16x4 = __attribute__((ext_vector_type(4))) short;
constexpr int D = 128, NW = 8, QBLK = 32, KVBLK = 64;
constexpr float SCALE = 0.088388347648318440f;
constexpr float THR = 8.f;
constexpr int SHM_V = KVBLK * D * 2, SHM_K = KVBLK * D * 2, VR_OFF = 2 * SHM_K, WS_OFF = VR_OFF + 3 * SHM_V, SHM_ATTN = WS_OFF + NW * 64 * 4;
constexpr int KM_OFF = SHM_ATTN;
constexpr int QL_OFF = KM_OFF + 4096, QPARK = 7;
static_assert(QL_OFF + QPARK * 8192 <= 146944, "attention LDS map");
#define KSWZ(row, colB) ((row) * 256 + ((colB) ^ (((row) & 7) << 4)))
#define SBAR() __builtin_amdgcn_sched_barrier(0)
__device__ __forceinline__ int crow(int r, int hi) { return (r & 3) + 8 * (r >> 2) + 4 * hi; }

__device__ __forceinline__ void partialSM(f32x16& p0, f32x16& p1, float& m_reg, float& mn, float& alpha, bool dead) {
  constexpr float C = SCALE * 1.4426950408889634f;
  float pmax = p0[0];
#pragma unroll
  for (int r = 1; r < 16; ++r) pmax = fmaxf(pmax, p0[r]);
#pragma unroll
  for (int r = 0; r < 16; ++r) pmax = fmaxf(pmax, p1[r]);
  { auto rr = __builtin_amdgcn_permlane32_swap(__float_as_uint(pmax), __float_as_uint(pmax), false, false);
    pmax = fmaxf(__uint_as_float(rr[0]), __uint_as_float(rr[1])); }
  if (dead) pmax = -1e30f;
  if (__builtin_expect(__all(pmax - m_reg <= THR / SCALE), 1)) { mn = m_reg; alpha = 1.f; }
  else { mn = fmaxf(m_reg, pmax); alpha = __builtin_amdgcn_exp2f((m_reg - mn) * C); m_reg = mn; }
  const float mnC = dead ? -INFINITY : -mn * C;
#pragma unroll
  for (int r = 0; r < 16; ++r) p0[r] = fmaf(p0[r], C, mnC);
#pragma unroll
  for (int r = 0; r < 16; ++r) p1[r] = fmaf(p1[r], C, mnC);
#pragma unroll
  for (int r = 0; r < 16; ++r) p0[r] = __builtin_amdgcn_exp2f(p0[r]);
}
__device__ __forceinline__ void finishSM(f32x16& p0, f32x16& p1, float alpha, float& l_reg, bf16x8& pa0, bf16x8& pa1, bf16x8& pa2, bf16x8& pa3) {
#pragma unroll
  for (int r = 0; r < 16; ++r) p1[r] = __builtin_amdgcn_exp2f(p1[r]);
  float ps = 0;
#pragma unroll
  for (int r = 0; r < 16; ++r) ps += p0[r];
#pragma unroll
  for (int r = 0; r < 16; ++r) ps += p1[r];
  { auto rr = __builtin_amdgcn_permlane32_swap(__float_as_uint(ps), __float_as_uint(ps), false, false);
    ps = __uint_as_float(rr[0]) + __uint_as_float(rr[1]); }
  l_reg = l_reg * alpha + ps;
#define PK4(P, BASE, OUT) do { unsigned a0 = cvt_pk_bf16(P[BASE + 0], P[BASE + 1]), a1 = cvt_pk_bf16(P[BASE + 2], P[BASE + 3]);   \
    unsigned b0 = cvt_pk_bf16(P[BASE + 4], P[BASE + 5]), b1 = cvt_pk_bf16(P[BASE + 6], P[BASE + 7]);                              \
    auto r0 = __builtin_amdgcn_permlane32_swap(a0, b0, false, false); auto r1 = __builtin_amdgcn_permlane32_swap(a1, b1, false, false); \
    u32x4 w = {r0[0], r1[0], r0[1], r1[1]}; OUT = *reinterpret_cast<bf16x8*>(&w); } while (0)
  PK4(p0, 0, pa0); PK4(p0, 8, pa1); PK4(p1, 0, pa2); PK4(p1, 8, pa3);
#undef PK4
}
template <bool QLDS>
__device__ __forceinline__ void qkt(f32x16& p0, f32x16& p1, const LAS char* Ks, const bf16x8* qr, const LAS char* ql, int r32, int hi) {
  p0 = f32x16{}; p1 = f32x16{};
#pragma unroll
  for (int d0 = 0; d0 < 8; ++d0) { int cb = (d0 * 16 + hi * 8) * 2;
    bf16x8 b0 = *(const LAS bf16x8*)(Ks + KSWZ(r32, cb));
    bf16x8 b1 = *(const LAS bf16x8*)(Ks + KSWZ(32 + r32, cb));
    bf16x8 q; if (QLDS && d0 >= 8 - QPARK) q = *(const LAS bf16x8*)(ql + (d0 - (8 - QPARK)) * 8192); else q = qr[d0];
    p0 = __builtin_amdgcn_mfma_f32_32x32x16_bf16(b0, q, p0, 0, 0, 0);
    p1 = __builtin_amdgcn_mfma_f32_32x32x16_bf16(b1, q, p1, 0, 0, 0); }
}
__device__ __forceinline__ int v_st(int k, int c) { const int kk = (k & ~0xC) | ((k & 4) << 1) | ((k & 8) >> 1); return ((kk >> 3) * 4 + (c >> 5)) * 512 + ((kk & 7) * 32 + (c & 31)) * 2; }
__device__ __forceinline__ int v_rd_base(int lane) { return ((lane & 3) << 3) | (((lane >> 2) & 3) << 6) | (((lane >> 4) & 1) << 5) | (((lane >> 5) & 1) << 8); }
constexpr int v_rd_off(int d0, int ks, int half) { return d0 * 512 + ks * 4096 + half * 2048; }
template <int OFF> __device__ __forceinline__ s16x4 tr_read(int vb) {
  s16x4 r; asm volatile("ds_read_b64_tr_b16 %0, %1 offset:%2" : "=&v"(r) : "v"(vb), "i"(OFF) : "memory"); return r;
}
template <int D0> __device__ __forceinline__ void pv_one(f32x16& od, int vb, bf16x8 pa0, bf16x8 pa1, bf16x8 pa2, bf16x8 pa3) {
  const s16x4 l0 = tr_read<v_rd_off(D0, 0, 0)>(vb), h0 = tr_read<v_rd_off(D0, 0, 1)>(vb), l1 = tr_read<v_rd_off(D0, 1, 0)>(vb), h1 = tr_read<v_rd_off(D0, 1, 1)>(vb);
  const s16x4 l2 = tr_read<v_rd_off(D0, 2, 0)>(vb), h2 = tr_read<v_rd_off(D0, 2, 1)>(vb), l3 = tr_read<v_rd_off(D0, 3, 0)>(vb), h3 = tr_read<v_rd_off(D0, 3, 1)>(vb);
  asm volatile("s_waitcnt lgkmcnt(0)" ::: "memory"); SBAR();
#define PK(L, H) (bf16x8){L[0], L[1], L[2], L[3], H[0], H[1], H[2], H[3]}
  od = __builtin_amdgcn_mfma_f32_32x32x16_bf16(pa0, PK(l0, h0), od, 0, 0, 0);
  od = __builtin_amdgcn_mfma_f32_32x32x16_bf16(pa1, PK(l1, h1), od, 0, 0, 0);
  od = __builtin_amdgcn_mfma_f32_32x32x16_bf16(pa2, PK(l2, h2), od, 0, 0, 0);
  od = __builtin_amdgcn_mfma_f32_32x32x16_bf16(pa3, PK(l3, h3), od, 0, 0, 0);
#undef PK
}
__device__ __forceinline__ void pv_d0(f32x16* o, int vb, bf16x8 pa0, bf16x8 pa1, bf16x8 pa2, bf16x8 pa3) {
  pv_one<0>(o[0], vb, pa0, pa1, pa2, pa3); pv_one<1>(o[1], vb, pa0, pa1, pa2, pa3); pv_one<2>(o[2], vb, pa0, pa1, pa2, pa3); pv_one<3>(o[3], vb, pa0, pa1, pa2, pa3);
}

template <bool MOBA>
__device__ __forceinline__ void attn_unit(const int tid, const bf16_t* __restrict__ Qb, const bf16_t* __restrict__ Kh, bf16_t* __restrict__ Ob, int NT, int jb, const float* __restrict__ kmean_bh, LAS char* lds) {
  constexpr int ldq = MOBA ? LDP : CW, ldk = MOBA ? LDP : 2 * CW, ldo = MOBA ? MIXW : CW, VOFF = MOBA ? (C_V - C_K) : CW;
  const bf16_t* __restrict__ Vh = Kh + VOFF;
  const int wid = __builtin_amdgcn_readfirstlane(tid >> 6), lane = tid & 63, r32 = lane & 31, hi = lane >> 5;
  LAS float* wsf = (LAS float*)(lds + WS_OFF) + wid * 64; LAS float* li_l = wsf; LAS float* al_l = wsf + 32;
  float m_reg = -1e30f, l_reg = 0; f32x16 o[4] = {}; bf16x8 qr[8];
  const bf16_t* Qw = Qb + (long)(wid * QBLK + r32) * ldq + hi * 8;
#pragma unroll
  for (int d0 = 0; d0 < 8; ++d0) qr[d0] = *reinterpret_cast<const bf16x8*>(Qw + d0 * 16);
  unsigned selmask = 0;
  if constexpr (MOBA) {
    LAS float* kml = (LAS float*)(lds + KM_OFF);
    __syncthreads();
    for (int i = tid; i < 8 * 128; i += NW * 64) kml[i] = kmean_bh[(i >> 7) * 1024 + (i & 127)];
    __syncthreads();
    float gate[8];
#pragma unroll
    for (int kb = 0; kb < 8; ++kb) {
      float g = 0.f;
      if (kb < jb) {
#pragma unroll
        for (int d0 = 0; d0 < 8; ++d0) { const f32x4 k0 = *(const LAS f32x4*)(kml + kb * 128 + d0 * 16 + hi * 8), k1 = *(const LAS f32x4*)(kml + kb * 128 + d0 * 16 + hi * 8 + 4);
          const u32x4 qw = *reinterpret_cast<const u32x4*>(&qr[d0]);
          g += bflo(qw.x) * k0[0] + bfhi(qw.x) * k0[1] + bflo(qw.y) * k0[2] + bfhi(qw.y) * k0[3] + bflo(qw.z) * k1[0] + bfhi(qw.z) * k1[1] + bflo(qw.w) * k1[2] + bfhi(qw.w) * k1[3]; }
        g += __shfl_xor(g, 32);
      }
      gate[kb] = g;
    }
#pragma unroll
    for (int r = 0; r < 3; ++r) { float best = -INFINITY; int bi = -1;
#pragma unroll
      for (int kb = 0; kb < 8; ++kb) { const bool ok = (kb < jb) && !((selmask >> kb) & 1u) && (gate[kb] > best || bi < 0); if (ok) { best = gate[kb]; bi = kb; } }
      if (bi >= 0) selmask |= 1u << bi; }
  }
  const LAS char* ql = lds + QL_OFF + tid * 16;
  if constexpr (MOBA) {
#pragma unroll
    for (int d0 = 8 - QPARK; d0 < 8; ++d0) *(LAS bf16x8*)(lds + QL_OFF + tid * 16 + (d0 - (8 - QPARK)) * 8192) = qr[d0];
  }
  const int rowb = wid * QBLK + r32;
#define MASK(P0, P1, T, DEAD) do { DEAD = false; if constexpr (MOBA) { const int kb_ = (T) >> 2; \
    if (kb_ < jb) { DEAD = !((selmask >> kb_) & 1u); } \
    else { const int lim_ = rowb - 64 * ((T) - 4 * jb); \
      if (!__all(lim_ >= 63)) { const int lh_ = lim_ - 4 * hi;     \
        _Pragma("unroll") for (int r_ = 0; r_ < 16; ++r_) { if ((r_ & 3) + 8 * (r_ >> 2) > lh_) P0[r_] = -INFINITY; if (32 + (r_ & 3) + 8 * (r_ >> 2) > lh_) P1[r_] = -INFINITY; } } } } } while (0)
#define KVDMA(KSLOT, VSLOT, K0) do { int ln_ = lane; asm volatile("" : "+v"(ln_));     \
    _Pragma("unroll") for (int i_ = 0; i_ < 2; ++i_) { const int q_ = 64 * (2 * wid + i_) + ln_; \
      const int row_ = q_ >> 4, cch_ = (q_ & 15) ^ (row_ & 7), ko_ = row_ * ldk + 8 * cch_; \
      const int kk_ = 8 * (q_ >> 7) + ((q_ >> 2) & 7), k_ = (kk_ & ~0xC) | ((kk_ & 4) << 1) | ((kk_ & 8) >> 1), vo_ = k_ * ldk + 32 * ((q_ >> 5) & 3) + 8 * (q_ & 3); \
      __builtin_amdgcn_global_load_lds((const unsigned*)(Kh + (long)(K0) * ldk + ko_), (LAS unsigned*)(lds + (KSLOT) + (2 * wid + i_) * 1024), 16, 0, 0); \
      __builtin_amdgcn_global_load_lds((const unsigned*)(Vh + (long)(K0) * ldk + vo_), (LAS unsigned*)(lds + VR_OFF + (VSLOT) + (2 * wid + i_) * 1024), 16, 0, 0); } } while (0)
#define RESC(a) do { if (__any((a) < 1.f)) { if (hi == 0) al_l[r32] = (a); asm volatile("s_waitcnt lgkmcnt(0)" ::: "memory"); \
    _Pragma("unroll") for (int d = 0; d < 4; ++d) _Pragma("unroll") for (int r = 0; r < 16; ++r) o[d][r] *= al_l[crow(r, hi)]; } } while (0)
  const int vrb = (int)(size_t)lds + VR_OFF + v_rd_base(lane);
  f32x16 pA0, pA1, pB0, pB1; float mnA, mnB, alA, alB; bf16x8 pa0, pa1, pa2, pa3; bool deadA, deadB;
  if constexpr (!MOBA) __syncthreads();
  int sc = 0, sn = SHM_V, sf = 2 * SHM_V;
  const int ntw = MOBA ? (4 * jb + (wid >> 1) + 1 < NT ? 4 * jb + (wid >> 1) + 1 : NT) : NT;
  KVDMA(0, sc, 0); KVDMA(SHM_K, sn, KVBLK); __syncthreads();
  qkt<MOBA>(pA0, pA1, lds, qr, ql, r32, hi); MASK(pA0, pA1, 0, deadA); partialSM(pA0, pA1, m_reg, mnA, alA, deadA);
  __syncthreads();
  for (int j = 0; j < NT; j += 2) {
    if (j + 2 < NT) KVDMA(0, sf, (j + 2) * KVBLK);
    if (j + 1 < ntw) { SBAR(); qkt<MOBA>(pB0, pB1, lds + SHM_K, qr, ql, r32, hi); }
    if (j < ntw) { finishSM(pA0, pA1, alA, l_reg, pa0, pa1, pa2, pa3); SBAR();
      pv_d0(o, vrb + sc, pa0, pa1, pa2, pa3); }
    if (j + 1 < ntw) { MASK(pB0, pB1, j + 1, deadB); partialSM(pB0, pB1, m_reg, mnB, alB, deadB); RESC(alB); }
    __syncthreads();
    { const int t_ = sc; sc = sn; sn = sf; sf = t_; }
    if (j + 2 < NT) {
      if (j + 3 < NT) KVDMA(SHM_K, sf, (j + 3) * KVBLK);
      if (j + 2 < ntw) { SBAR(); qkt<MOBA>(pA0, pA1, lds, qr, ql, r32, hi); }
      if (j + 1 < ntw) { finishSM(pB0, pB1, alB, l_reg, pa0, pa1, pa2, pa3); SBAR();
        pv_d0(o, vrb + sc, pa0, pa1, pa2, pa3); }
      if (j + 2 < ntw) { MASK(pA0, pA1, j + 2, deadA); partialSM(pA0, pA1, m_reg, mnA, alA, deadA); RESC(alA); }
      __syncthreads();
      { const int t_ = sc; sc = sn; sn = sf; sf = t_; }
    }
  }
  if (NT - 1 < ntw) { finishSM(pB0, pB1, alB, l_reg, pa0, pa1, pa2, pa3); SBAR();
    pv_d0(o, vrb + sc, pa0, pa1, pa2, pa3); }
  if (hi == 0) li_l[r32] = l_reg; asm volatile("s_waitcnt lgkmcnt(0)" ::: "memory");
  float rli[16];
#pragma unroll
  for (int r = 0; r < 16; ++r) rli[r] = __builtin_amdgcn_rcpf(li_l[crow(r, hi)]);
  if constexpr (MOBA) {
#pragma unroll
    for (int r = 0; r < 16; ++r) {
      float q = 0.f;
#pragma unroll
      for (int d0 = 0; d0 < 4; ++d0) { const float v = o[d0][r] * rli[r]; q += v * v; }
      q += __shfl_xor(q, 1); q += __shfl_xor(q, 2); q += __shfl_xor(q, 4); q += __shfl_xor(q, 8); q += __shfl_xor(q, 16);
      rli[r] *= rsqrtf(q * (1.f / 128.f) + EPS);
    }
  }
  bf16_t* Ow = Ob + (long)(wid * QBLK) * ldo;
#pragma unroll
  for (int r = 0; r < 16; ++r) { const int orow = crow(r, hi);
#pragma unroll
    for (int d0 = 0; d0 < 4; ++d0) Ow[(long)orow * ldo + d0 * 32 + r32] = (bf16_t)(cvt_pk_bf16(o[d0][r] * rli[r], 0.f) & 0xffffu); }
#undef MASK
#undef KVDMA
#undef RESC
}
#undef KSWZ
#undef SBAR
}
namespace sd {
using f32x16 = __attribute__((ext_vector_type(16))) float;
typedef short v4i16_t __attribute__((ext_vector_type(4)));
constexpr int IMG_C = 0, IMG_B = 32768, IMG_X = 65536, IMG_S = 98304, TBL = 114688, CWL = 131072;
__device__ __forceinline__ unsigned off_b(unsigned row, unsigned ch) { return 256u * row + 16u * (ch ^ (((row & 3) << 2) | ((row >> 2) & 3))); }
__device__ __forceinline__ unsigned row_read_addr(unsigned lane, unsigned s) { return off_b(lane & 31, 2 * s + (lane >> 5)); }
__device__ __forceinline__ unsigned tr_read_addr(unsigned lane, unsigned c, unsigned ks, unsigned t) {
  const unsigned h = lane >> 5, blk = (lane >> 4) & 1, q = (lane & 15) >> 2, p = lane & 3;
  return off_b(16 * ks + 8 * h + 4 * t + q, 4 * c + 2 * blk + (p >> 1)) + 8 * (p & 1);
}
__device__ __forceinline__ unsigned elem_addr(unsigned row, unsigned col) { return (row >> 5) * 8192u + off_b(row & 31, col >> 3) + (col & 7) * 2u; }
__device__ __forceinline__ bf16x8 tr_frag(const LAS char* img, unsigned a0, unsigned a1) {
  const v4i16_t l = __builtin_amdgcn_ds_read_tr16_b64_v4i16((LAS v4i16_t*)(img + a0)), h = __builtin_amdgcn_ds_read_tr16_b64_v4i16((LAS v4i16_t*)(img + a1));
  return (bf16x8){l[0], l[1], l[2], l[3], h[0], h[1], h[2], h[3]};
}
__device__ __forceinline__ int crow(int r, int hi) { return (r & 3) + 8 * (r >> 2) + 4 * hi; }
__device__ __forceinline__ bf16_t f2bf_native(float v) { return __builtin_bit_cast(bf16_t, (__bf16)v); }
__device__ __forceinline__ unsigned pk2bf_native(float lo, float hi) { typedef __bf16 bf2_t __attribute__((ext_vector_type(2))); typedef float fl2_t __attribute__((ext_vector_type(2))); return __builtin_bit_cast(unsigned, __builtin_convertvector((fl2_t){lo, hi}, bf2_t)); }
__device__ __forceinline__ float softplus_f(float r) { return fmaxf(r, 0.f) + log1pf(__expf(-fabsf(r))); }

__device__ __forceinline__ void conv_rows(const u32x4 (&raw)[11], const float* __restrict__ conv_w, const float* __restrict__ conv_b, bf16_t* __restrict__ xbcc, const int tok0, const int ch, const bool live) {
  f32x4 w[5][2];
#pragma unroll
  for (int tp = 0; tp < 4; ++tp) { w[tp][0] = *(const f32x4*)(conv_w + tp * CONVD + ch); w[tp][1] = *(const f32x4*)(conv_w + tp * CONVD + ch + 4); }
  w[4][0] = *(const f32x4*)(conv_b + ch); w[4][1] = *(const f32x4*)(conv_b + ch + 4);
  float ac[4][8];
#pragma unroll
  for (int j = 0; j < 11; ++j) {
    const u32x4 rw = raw[j];
    const float x[8] = {bflo(rw.x), bfhi(rw.x), bflo(rw.y), bfhi(rw.y), bflo(rw.z), bfhi(rw.z), bflo(rw.w), bfhi(rw.w)};
#pragma unroll
    for (int tp = 0; tp < 4; ++tp) {
      const int i = j - tp;
      if (i >= 0 && i < 8) { const int sl = i & 3;
#pragma unroll
        for (int e = 0; e < 8; ++e) ac[sl][e] = __builtin_fmaf(w[tp][e >> 2][e & 3], x[e], tp == 0 ? w[4][e >> 2][e & 3] : ac[sl][e]); }
    }
    if (j >= 3) {
      const int sl = (j - 3) & 3; float o8[8];
#pragma unroll
      for (int e = 0; e < 8; ++e) o8[e] = ac[sl][e] * __builtin_amdgcn_rcpf(1.f + __expf(-ac[sl][e]));
      u32x4 o; o.x = cvt_pk_bf16(o8[0], o8[1]); o.y = cvt_pk_bf16(o8[2], o8[3]); o.z = cvt_pk_bf16(o8[4], o8[5]); o.w = cvt_pk_bf16(o8[6], o8[7]);
      if (live) *(u32x4*)(xbcc + (size_t)(tok0 + j - 3) * CONVD + ch) = o;
    }
  }
}
__device__ __forceinline__ void conv_prepass(const int gtid, const int nthr, const bf16_t* __restrict__ proj, const float* __restrict__ conv_w, const float* __restrict__ conv_b, bf16_t* __restrict__ xbcc) {
  constexpr int NCG = 1024 / 8, NITEM = NCG * (M / 8);
#define CONV_LOADROWS(R, IT) do { const int cg_ = (IT) % NCG, t0_ = ((IT) / NCG) * 8, T0_ = t0_ & (SEQ - 1); const bf16_t* rp_ = proj + (size_t)(t0_ - T0_) * LDP + C_XBC + 2048 + 8 * cg_; \
    _Pragma("unroll") for (int j_ = 0; j_ < 11; ++j_) { const int T_ = T0_ - 3 + j_; R[j_] = (T_ >= 0) ? *(const u32x4*)(rp_ + (size_t)T_ * LDP) : (u32x4){0u, 0u, 0u, 0u}; } } while (0)
  u32x4 ra[11], rb[11];
  int it = gtid;
  { const int i0 = it < NITEM ? it : NITEM - 1; CONV_LOADROWS(ra, i0); }
#pragma unroll 1
  for (; it < NITEM; it += 2 * nthr) {
    const int it2 = it + nthr, i2 = it2 < NITEM ? it2 : NITEM - 1, it3 = it2 + nthr, i3 = it3 < NITEM ? it3 : NITEM - 1;
    CONV_LOADROWS(rb, i2);
    conv_rows(ra, conv_w, conv_b, xbcc, (it / NCG) * 8, 2048 + 8 * (it % NCG), true);
    CONV_LOADROWS(ra, i3);
    conv_rows(rb, conv_w, conv_b, xbcc, (i2 / NCG) * 8, 2048 + 8 * (i2 % NCG), it2 < NITEM);
  }
#undef CONV_LOADROWS
}

__device__ __forceinline__ void ssd_unit(const int tid, const int b, const int h, const bf16_t* __restrict__ proj, const bf16_t* __restrict__ xbcc, const float* __restrict__ conv_w, const float* __restrict__ conv_b, const float* __restrict__ dtraw,
                                         const float* __restrict__ dt_bias, const float* __restrict__ a_log, const float* __restrict__ d_skip,
                                         bf16_t* __restrict__ mixb, float* __restrict__ ssq, LAS char* lds) {
  const int wid = __builtin_amdgcn_readfirstlane(tid >> 6), lane = tid & 63, r32 = lane & 31, hi = lane >> 5;
  const int ph = wid & 1, rb = wid < 4 ? 3 - (wid >> 1) : (wid >> 1) - 2;
  LAS char* IC = lds + IMG_C; LAS char* IB = lds + IMG_B; LAS char* IX = lds + IMG_X; LAS char* IS = lds + IMG_S;
  LAS float* Tdt = (LAS float*)(lds + TBL); LAS float* Tacs = Tdt + 2048; LAS float* Tec = (LAS float*)(lds + CWL + 2048); LAS float* Tel = Tec + 128;
  const int grp = h >> 3;
  const float a = -__expf(a_log[h]), dtb = dt_bias[h], Dh = d_skip[h];
  __syncthreads();
  { const u32x4 z = {0u, 0u, 0u, 0u}; *(LAS u32x4*)(IS + tid * 32) = z; *(LAS u32x4*)(IS + tid * 32 + 16) = z; }
#pragma unroll 1
  for (int cc = 0; cc < 2; ++cc) {
    const int t0 = (wid * 2 + cc) * 128 + 2 * lane;
    const float d0 = softplus_f(dtraw[(size_t)(b * SEQ + t0) * 32 + h] + dtb), d1 = softplus_f(dtraw[(size_t)(b * SEQ + t0 + 1) * 32 + h] + dtb);
    const float v0 = d0 * a, ps = v0 + d1 * a;
    float sc = ps;
#pragma unroll
    for (int o = 1; o < 64; o <<= 1) { const float n = __shfl_up(sc, o); if (lane >= o) sc += n; }
    const float a0 = (sc - ps) + v0, a1 = sc, tot = __shfl(sc, 63);
    Tdt[t0] = d0; Tdt[t0 + 1] = d1; Tacs[t0] = a0; Tacs[t0 + 1] = a1;
  }
  { const int ci = tid & 63, tp = tid >> 6; if (tid < 320) ((LAS float*)(lds + CWL))[tid] = tp < 4 ? conv_w[tp * CONVD + h * 64 + ci] : conv_b[h * 64 + ci]; }
  const unsigned xr = ((r32 & 3) << 2) | ((r32 >> 2) & 3);
#define RROW(k) (256u * r32 + 16u * ((2u * (k) + hi) ^ xr))
#define SSD_LOAD(cn) do { int tl_ = tid; asm volatile("" : "+v"(tl_)); const bf16_t* xraw_ = proj + (size_t)(b * SEQ) * LDP + C_XBC + h * 64 + 8 * (tl_ & 7);                       \
    _Pragma("unroll") for (int j_ = 0; j_ < 5; ++j_) { const int T_ = (cn) * 128 + 2 * (tl_ >> 3) - 3 + j_; rx[j_] = (T_ >= 0) ? *(const u32x4*)(xraw_ + (size_t)T_ * LDP) : (u32x4){0u, 0u, 0u, 0u}; } \
    const bf16_t* xs_ = xbcc + (size_t)(b * SEQ + (cn) * 128) * CONVD;                                                                                                            \
    _Pragma("unroll") for (int i_ = 0; i_ < 4; ++i_) { rB[i_] = *(const u32x4*)(xs_ + (size_t)((tl_ >> 4) + 32 * i_) * CONVD + 2048 + grp * 128 + 8 * (tl_ & 15));               \
      rC[i_] = *(const u32x4*)(xs_ + (size_t)((tl_ >> 4) + 32 * i_) * CONVD + 2560 + grp * 128 + 8 * (tl_ & 15)); } } while (0)
#define SSD_BUILD(cn) do { int tq_ = tid; asm volatile("" : "+v"(tq_));                                                                                                           \
    const float ace_ = Tacs[(cn) * 128 + 127]; const LAS float* cwl_ = (const LAS float*)(lds + CWL) + 8 * (tq_ & 7);                                                              \
    if (tq_ < 128) { Tec[tq_] = Tdt[(cn) * 128 + tq_] * __expf(Tacs[(cn) * 128 + (tq_ | 31)] - Tacs[(cn) * 128 + tq_]); Tel[tq_] = __expf(Tacs[(cn) * 128 + tq_]); }        \
    _Pragma("unroll") for (int i_ = 0; i_ < 2; ++i_) { const unsigned tk_ = 2u * (unsigned)(tq_ >> 3) + i_, trow_ = tk_ & 31, xo_ = ((trow_ & 3) << 2) | ((trow_ >> 2) & 3),      \
        rowb_ = IMG_X + (tk_ >> 5) * 8192u + 256u * trow_, cch_ = tq_ & 7;                                                                                                       \
      float o8_[8];                                                                                                                                                              \
      _Pragma("unroll") for (int hh_ = 0; hh_ < 2; ++hh_) { f32x4 acc_ = *(const LAS f32x4*)(cwl_ + 256 + 4 * hh_);                                                               \
        _Pragma("unroll") for (int tp_ = 0; tp_ < 4; ++tp_) { const f32x4 w_ = *(const LAS f32x4*)(cwl_ + 64 * tp_ + 4 * hh_); const u32x4 rw_ = rx[i_ + tp_];                    \
          const unsigned q0_ = hh_ ? rw_.z : rw_.x, q1_ = hh_ ? rw_.w : rw_.y;                                                                                                   \
          acc_[0] = __builtin_fmaf(w_[0], bflo(q0_), acc_[0]); acc_[1] = __builtin_fmaf(w_[1], bfhi(q0_), acc_[1]);                                                                \
          acc_[2] = __builtin_fmaf(w_[2], bflo(q1_), acc_[2]); acc_[3] = __builtin_fmaf(w_[3], bfhi(q1_), acc_[3]); }                                                              \
        _Pragma("unroll") for (int e_ = 0; e_ < 4; ++e_) o8_[4 * hh_ + e_] = acc_[e_] * __builtin_amdgcn_rcpf(1.f + __expf(-acc_[e_])); }                                         \
      u32x4 o_; o_.x = cvt_pk_bf16(o8_[0], o8_[1]); o_.y = cvt_pk_bf16(o8_[2], o8_[3]); o_.z = cvt_pk_bf16(o8_[4], o8_[5]); o_.w = cvt_pk_bf16(o8_[6], o8_[7]);                   \
      *(LAS u32x4*)(lds + rowb_ + 16u * (cch_ ^ xo_)) = o_;                                                                                                                      \
      const float w2_ = Tdt[(cn) * 128 + tk_] * __expf(ace_ - Tacs[(cn) * 128 + tk_]);                                                                                           \
      u32x4 v_; v_.x = cvt_pk_bf16(o8_[0] * w2_, o8_[1] * w2_); v_.y = cvt_pk_bf16(o8_[2] * w2_, o8_[3] * w2_); v_.z = cvt_pk_bf16(o8_[4] * w2_, o8_[5] * w2_);                   \
      v_.w = cvt_pk_bf16(o8_[6] * w2_, o8_[7] * w2_);                                                                                                                            \
      *(LAS u32x4*)(lds + rowb_ + 16u * ((8u + cch_) ^ xo_)) = v_; }                                                                                                             \
    _Pragma("unroll") for (int i_ = 0; i_ < 4; ++i_) { const unsigned tk_ = (unsigned)(tq_ >> 4) + 32u * i_, trow_ = tk_ & 31, xo_ = ((trow_ & 3) << 2) | ((trow_ >> 2) & 3),    \
        ro_ = (tk_ >> 5) * 8192u + 256u * trow_ + 16u * ((unsigned)(tq_ & 15) ^ xo_);                                                                                            \
      *(LAS u32x4*)(lds + IMG_B + ro_) = rB[i_]; *(LAS u32x4*)(lds + IMG_C + ro_) = rC[i_]; } } while (0)
#define SSD_BAR() asm volatile("s_waitcnt lgkmcnt(0)\n\ts_barrier" ::: "memory")
  u32x4 rx[5], rB[4], rC[4];
  SSD_LOAD(0);
  __syncthreads();
  SSD_BUILD(0);
  __syncthreads();
  f32x16 S = {};
#pragma unroll 1
  for (int c = 0; c < 16; ++c) {
    { const int cn = c < 15 ? c + 1 : 15; SSD_LOAD(cn); }
    int lq_ = lane; asm volatile("" : "+v"(lq_));
    const int lane = lq_, r32 = lane & 31, hi = lane >> 5; const unsigned xr = ((r32 & 3) << 2) | ((r32 >> 2) & 3);
    const LAS float* acs = Tacs + c * 128; const LAS float* dts = Tdt + c * 128;
    f32x16 Y = {};
    const float acl = acs[32 * rb + r32];
#define SSD_GT(ST) f32x16 Dm = {};                                                                                                                      \
      _Pragma("unroll") for (int k = 0; k < 8; ++k) { const bf16x8 af = *(const LAS bf16x8*)(IB + (ST) * 8192 + RROW(k)), bq = *(const LAS bf16x8*)(IC + rb * 8192 + RROW(k)); \
        Dm = __builtin_amdgcn_mfma_f32_32x32x16_bf16(af, bq, Dm, 0, 0, 0); }
#define PK4(P, BASE, OUT) do { unsigned a0_ = cvt_pk_bf16(P[BASE + 0], P[BASE + 1]), a1_ = cvt_pk_bf16(P[BASE + 2], P[BASE + 3]);   \
    unsigned b0_ = cvt_pk_bf16(P[BASE + 4], P[BASE + 5]), b1_ = cvt_pk_bf16(P[BASE + 6], P[BASE + 7]);                              \
    auto r0_ = __builtin_amdgcn_permlane32_swap(a0_, b0_, false, false); auto r1_ = __builtin_amdgcn_permlane32_swap(a1_, b1_, false, false); \
    u32x4 w_ = {r0_[0], r1_[0], r0_[1], r1_[1]}; OUT = *reinterpret_cast<bf16x8*>(&w_); } while (0)
#define SSD_PX(ST) do { bf16x8 pa0, pa1; PK4(Dm, 0, pa0); PK4(Dm, 8, pa1);                                                                               \
      Y = __builtin_amdgcn_mfma_f32_32x32x16_bf16(pa0, tr_frag(IX + (ST) * 8192, tr_read_addr(lane, ph, 0, 0), tr_read_addr(lane, ph, 0, 1)), Y, 0, 0, 0); \
      Y = __builtin_amdgcn_mfma_f32_32x32x16_bf16(pa1, tr_frag(IX + (ST) * 8192, tr_read_addr(lane, ph, 1, 0), tr_read_addr(lane, ph, 1, 1)), Y, 0, 0, 0); } while (0)
#pragma unroll 1
    for (int st = 0; st < rb; ++st) {
      SSD_GT(st)
      const float mrow = __expf(acl - acs[32 * st + 31]);
#pragma unroll
      for (int q4 = 0; q4 < 4; ++q4) { const f32x4 ec4 = *(const LAS f32x4*)(Tec + 32 * st + 8 * q4 + 4 * hi);
#pragma unroll
        for (int e = 0; e < 4; ++e) Dm[4 * q4 + e] *= mrow * ec4[e]; }
      SSD_PX(st);
    }
    {
      SSD_GT(rb)
      if (__all(acs[32 * rb] - acs[32 * rb + 31] < 60.f)) {
        const float mrow = __expf(acl - acs[32 * rb + 31]);
#pragma unroll
        for (int q4 = 0; q4 < 4; ++q4) { const f32x4 ec4 = *(const LAS f32x4*)(Tec + 32 * rb + 8 * q4 + 4 * hi);
#pragma unroll
          for (int e = 0; e < 4; ++e) { const int r = 4 * q4 + e, sidx = 8 * q4 + 4 * hi + e;
            const float f = sidx > r32 ? 0.f : mrow * ec4[e]; Dm[r] = __builtin_fmaf(Dm[r], f, sidx == r32 ? Dh : 0.f); } }
      } else {
#pragma unroll
        for (int q4 = 0; q4 < 4; ++q4) { const f32x4 as4 = *(const LAS f32x4*)(acs + 32 * rb + 8 * q4 + 4 * hi), dt4 = *(const LAS f32x4*)(dts + 32 * rb + 8 * q4 + 4 * hi);
#pragma unroll
          for (int e = 0; e < 4; ++e) { const int r = 4 * q4 + e, sidx = 8 * q4 + 4 * hi + e;
            const float f = sidx > r32 ? 0.f : __expf(acl - as4[e]) * dt4[e]; Dm[r] = __builtin_fmaf(Dm[r], f, sidx == r32 ? Dh : 0.f); } }
      }
      SSD_PX(rb);
    }
#undef SSD_GT
#undef SSD_PX
#undef PK4
    bf16_t zr[16];
    { int lz_ = lane; asm volatile("" : "+v"(lz_)); const bf16_t* zp = proj + (size_t)(b * SEQ + c * 128 + 32 * rb + 4 * (lz_ >> 5)) * LDP + C_Z + h * 64 + 32 * ph + (lz_ & 31);
#pragma unroll
      for (int r = 0; r < 16; ++r) zr[r] = zp[(size_t)((r & 3) + 8 * (r >> 2)) * LDP]; }
    {
      f32x16 CS = {};
#pragma unroll
      for (int k = 0; k < 8; ++k) { const bf16x8 af = *(const LAS bf16x8*)(IC + rb * 8192 + RROW(k)), bq = *(const LAS bf16x8*)(IS + ph * 8192 + RROW(k));
        CS = __builtin_amdgcn_mfma_f32_32x32x16_bf16(af, bq, CS, 0, 0, 0); }
#pragma unroll
      for (int q4 = 0; q4 < 4; ++q4) { const f32x4 el4 = *(const LAS f32x4*)(Tel + 32 * rb + 8 * q4 + 4 * hi);
#pragma unroll
        for (int e = 0; e < 4; ++e) Y[4 * q4 + e] += CS[4 * q4 + e] * el4[e]; }
    }
    {
      const float dec = __expf(acs[127]);
#pragma unroll
      for (int r = 0; r < 16; ++r) S[r] *= dec;
#pragma unroll
      for (int st = 0; st < 4; ++st)
#pragma unroll
        for (int ks = 0; ks < 2; ++ks) {
          const bf16x8 af = tr_frag(IX + st * 8192, tr_read_addr(lane, 2 + ph, ks, 0), tr_read_addr(lane, 2 + ph, ks, 1));
          const bf16x8 bq = tr_frag(IB + st * 8192, tr_read_addr(lane, rb, ks, 0), tr_read_addr(lane, rb, ks, 1));
          S = __builtin_amdgcn_mfma_f32_32x32x16_bf16(bq, af, S, 0, 0, 0);
        }
    }
    {
      bf16_t* yp = mixb + (size_t)(b * SEQ + c * 128 + 32 * rb + 4 * hi) * MIXW + AW + h * 64 + 32 * ph + r32;
      float sq[16];
#pragma unroll
      for (int r = 0; r < 16; ++r) { const float yg = Y[r] * bf2f(zr[r]); yp[((r & 3) + 8 * (r >> 2)) * MIXW] = f2bf_native(yg); sq[r] = yg * yg; }
#pragma unroll
      for (int k = 0; k < 4; ++k) { const bool up = (r32 >> k) & 1;
#pragma unroll
        for (int i = 0; i < (8 >> k); ++i) { const float keep = up ? sq[2 * i + 1] : sq[2 * i], send = up ? sq[2 * i] : sq[2 * i + 1]; sq[i] = keep + __shfl_xor(send, 1 << k); } }
      sq[0] += __shfl_xor(sq[0], 16);
      if (r32 < 16) { const int rr = r32; ssq[(size_t)(b * SEQ + c * 128 + 32 * rb + (rr & 3) + 8 * (rr >> 2) + 4 * hi) * 64 + h * 2 + ph] = sq[0]; }
    }
    SSD_BAR();
    {
      int lq2_ = lane; asm volatile("" : "+v"(lq2_)); const int r32 = lq2_ & 31, hi = lq2_ >> 5;
#pragma unroll
      for (int q = 0; q < 4; ++q) { u32x2 w; w.x = pk2bf_native(S[4 * q], S[4 * q + 1]); w.y = pk2bf_native(S[4 * q + 2], S[4 * q + 3]);
        *(LAS u32x2*)(IS + elem_addr(32 * ph + r32, 32 * rb + 8 * q + 4 * hi)) = w; }
    }
    { const int cn = c < 15 ? c + 1 : 15; SSD_BUILD(cn); }
    SSD_BAR();
  }
#undef RROW
#undef SSD_LOAD
#undef SSD_BUILD
#undef SSD_BAR
  __syncthreads();
}
}
constexpr int RING_OFF = 0, RING_BYTES = 131072;
constexpr int TAB_OFF = RING_BYTES;
constexpr int RSL_OFF = TAB_OFF + 8192;
constexpr int MOE_OFF = RSL_OFF + 1024;
constexpr int LDSCTL_OFF = 147456 - 512;
constexpr int MISC_OFF = LDSCTL_OFF + 320;
constexpr int LDS_BYTES = 147456;
static_assert(MISC_OFF + 128 <= LDS_BYTES, "LDS map");
constexpr int NWAVES = 8;

struct Args { const float* in[27]; float* out; unsigned char* ws; float rf[16]; int ph_lo, ph_hi, li, pad; };

struct Frame {
    LAS unsigned char* lds;
    volatile LAS unsigned* MISC;
    int tid, lane, wave, vcu, G;
};

__device__ __forceinline__ void row_to_bf16_rs(const float* xrow, bf16_t* orow, float* rs_out, int lane) {
    const f32x4* xr = (const f32x4*)xrow + lane;
    f32x4 v[8]; float s = 0.f;
#pragma unroll
    for (int j = 0; j < 8; ++j) { v[j] = __builtin_nontemporal_load(xr + 64 * j); s += (v[j].x * v[j].x + v[j].y * v[j].y) + (v[j].z * v[j].z + v[j].w * v[j].w); }
    s = wave_sum(s);
    if (lane == 0) *rs_out = rsqrtf(s * (1.f / DM) + EPS);
    u32x2* o8 = (u32x2*)orow + lane;
#pragma unroll
    for (int j = 0; j < 8; ++j) { u32x2 w; w.x = cvt_pk_bf16(v[j].x, v[j].y); w.y = cvt_pk_bf16(v[j].z, v[j].w); o8[64 * j] = w; }
}
struct P0Item { const float* W; const float* sc; bf16_t* dst; int ldw, k0, dK, kd, f8; };
__device__ __forceinline__ void p0_item_load(const P0Item& I, f32x4 (&v)[8], f32x4 (&sv)[2], int lane) {
#pragma unroll
    for (int i = 0; i < 8; ++i) v[i] = __builtin_nontemporal_load((const f32x4*)(I.W + (size_t)(I.k0 + 8 * (lane >> 3) + i) * I.ldw + 4 * (lane & 7)));
    if (I.sc) { sv[0] = *(const f32x4*)(I.sc + I.k0 + 8 * (lane >> 3)); sv[1] = *(const f32x4*)(I.sc + I.k0 + 8 * (lane >> 3) + 4); }
    else { sv[0] = (f32x4){1.f, 1.f, 1.f, 1.f}; sv[1] = sv[0]; }
}
__device__ __forceinline__ void p0_item_store(const P0Item& I, const f32x4 (&v)[8], const f32x4 (&sv)[2], LAS float* scr, int lane, bool live) {
    (void)scr;
#pragma unroll
    for (int t = 0; t < 4; ++t) {
        const float x0 = v[0][t] * sv[0][0], x1 = v[1][t] * sv[0][1], x2 = v[2][t] * sv[0][2], x3 = v[3][t] * sv[0][3], x4 = v[4][t] * sv[1][0], x5 = v[5][t] * sv[1][1], x6 = v[6][t] * sv[1][2], x7 = v[7][t] * sv[1][3];
        const size_t ro = (size_t)(4 * (lane & 7) + t) * I.dK + I.kd + 8 * (lane >> 3);
        if (I.f8) { u32x2 q; q.x = pk4_fp8(256.f * x0, 256.f * x1, 256.f * x2, 256.f * x3); q.y = pk4_fp8(256.f * x4, 256.f * x5, 256.f * x6, 256.f * x7);
            if (live) __builtin_nontemporal_store(q, (u32x2*)((unsigned char*)I.dst + ro)); }
        else { u32x4 o; o.x = cvt_pk_bf16(x0, x1); o.y = cvt_pk_bf16(x2, x3); o.z = cvt_pk_bf16(x4, x5); o.w = cvt_pk_bf16(x6, x7);
            if (live) __builtin_nontemporal_store(o, (u32x4*)(I.dst + ro)); }
    }
}
template <class Dec> __device__ __forceinline__ void p0_items(const Dec& D, const int first, const int stride, const int nitems, LAS float* scr, const int lane) {
#pragma unroll 1
    for (int base = first; base < nitems; base += 4 * stride) {
        P0Item I0, I1, I2, I3; f32x4 v0[8], v1[8], v2[8], v3[8]; f32x4 s0[2], s1[2], s2[2], s3[2];
        const int i1 = base + stride, i2 = base + 2 * stride, i3 = base + 3 * stride;
        const bool h1 = i1 < nitems, h2 = i2 < nitems, h3 = i3 < nitems;
        D(base, I0); D(h1 ? i1 : 0, I1); D(h2 ? i2 : 0, I2); D(h3 ? i3 : 0, I3);
        p0_item_load(I0, v0, s0, lane); p0_item_load(I1, v1, s1, lane); p0_item_load(I2, v2, s2, lane); p0_item_load(I3, v3, s3, lane);
        p0_item_store(I0, v0, s0, scr, lane, true); p0_item_store(I1, v1, s1, scr, lane, h1); p0_item_store(I2, v2, s2, scr, lane, h2); p0_item_store(I3, v3, s3, scr, lane, h3);
    }
}
struct DecIn {
    const float* w_in; const float* nmw; bf16_t* dst;
    __device__ __forceinline__ bool operator()(int r, P0Item& I) const {
        if (r >= 32 * 257) return false;
        const int kb = r / 257, nb = r - kb * 257; I.W = w_in + 32 * nb; I.ldw = INW; I.k0 = 64 * kb; I.sc = nmw; I.dst = dst + (size_t)(32 * nb) * DM; I.dK = DM; I.kd = I.k0; I.f8 = 0; return true;
    }
};
struct DecRest {
    const Args* a; unsigned char* ws;
    __device__ __forceinline__ bool operator()(int r, P0Item& I) const {
        constexpr int I_OUT = 48 * 64, I_CQ = 32 * 16, I_CO = 8 * 64, I_GU = 32 * 32 * 32, I_DN = 32 * 16 * 64;
        const float* const* in = a->in;
        if (r < I_OUT) { const int kb = r / 64, nb = r % 64; I.W = in[11] + 32 * nb; I.ldw = DM; I.k0 = 64 * kb; I.sc = (kb < 16) ? in[9] : (in[10] - AW); I.dst = (bf16_t*)(ws + WS_WOUT_T) + (size_t)(32 * nb) * MIXW; I.dK = MIXW; I.kd = I.k0; I.f8 = 0; return true; } r -= I_OUT;
        if (r < 3 * I_CQ) { const int m = r / I_CQ, q = r - m * I_CQ, kb = q / 16, nb = q % 16; I.W = in[14 + m] + 32 * nb; I.ldw = CW; I.k0 = 64 * kb; I.sc = m == 0 ? in[12] : in[13];
            I.dst = (m == 0 ? (bf16_t*)(ws + WS_WCQ_T) : (bf16_t*)(ws + WS_WCKV_T) + (size_t)(m - 1) * CW * DM) + (size_t)(32 * nb) * DM; I.dK = DM; I.kd = I.k0; I.f8 = 0; return true; } r -= 3 * I_CQ;
        if (r < I_CO) { const int kb = r / 64, nb = r % 64; I.W = in[17] + 32 * nb; I.ldw = DM; I.k0 = 64 * kb; I.sc = nullptr; I.dst = (bf16_t*)(ws + WS_WCO_T) + (size_t)(32 * nb) * CW; I.dK = CW; I.kd = I.k0; I.f8 = 0; return true; } r -= I_CO;
        if (r < 2 * I_GU) { const int up = r >= I_GU; if (up) r -= I_GU; const int e = r >> 10, kb = (r >> 5) & 31, nb = r & 31, n0 = 32 * nb;
            I.W = in[up ? 24 : 23] + (size_t)e * DM * DE + n0; I.ldw = DE; I.k0 = 64 * kb; I.sc = in[18]; I.dst = (bf16_t*)(ws + WS_WGU_T + (size_t)e * 2048 * DM + ((size_t)(((n0 >> 7) * 16 + (kb >> 1)) * 256 + up * 128 + (n0 & 127))) * 128 + (kb & 1) * 64); I.dK = 128; I.kd = 0; I.f8 = 1; return true; } r -= 2 * I_GU;
        if (r < I_DN) { const int e = r >> 10, kb = (r >> 6) & 15, nb = r & 63; I.W = in[25] + (size_t)e * DE * DM + 32 * nb; I.ldw = DM; I.k0 = 64 * kb; I.sc = nullptr; I.dst = (bf16_t*)(ws + WS_WD_T + (size_t)e * 2048 * DE + ((size_t)((((32 * nb) >> 8) * 8 + (kb >> 1)) * 256 + ((32 * nb) & 255))) * 128 + (kb & 1) * 64); I.dK = 128; I.kd = 0; I.f8 = 1; return true; }
        return false;
    }
};
__device__ __forceinline__ void p0a_prologue(Frame& F, const Args& args) {
    LAS float* scr = (LAS float*)(F.lds + RING_OFF + F.wave * 16384);
    const int gw = F.vcu * NWAVES + F.wave, NGW = F.G * NWAVES, lane = F.lane;
    GAS unsigned char* wsg_ = (GAS unsigned char*)args.ws; asm volatile("" : "+s"(wsg_)); unsigned char* ws = (unsigned char*)wsg_;
    { DecIn D{args.in[3], args.in[2], (bf16_t*)(ws + WS_WIN_T)}; p0_items(D, gw, NGW, 32 * 257, scr, lane); }
    { u32x4* z = (u32x4*)((bf16_t*)(ws + WS_WIN_T) + (size_t)INW * DM); const int n16 = (LDP - INW) * DM * 2 / 16;
      for (int i = (F.vcu * NWAVES * 64) + F.tid; i < n16; i += F.G * NWAVES * 64) z[i] = (u32x4){0u, 0u, 0u, 0u}; }
    { float* km = (float*)(ws + WS_KMEAN); for (int i = (F.vcu * NWAVES * 64) + F.tid; i < BATCH * NB * 1024; i += F.G * NWAVES * 64) km[i] = 0.f; }
    { float* tab = (float*)(ws + WS_ROPE);
      for (int i = (F.vcu * NWAVES * 64) + F.tid; i < SEQ * 16; i += F.G * NWAVES * 64) { const int pos = i >> 4, f = i & 15;
        const float ang = (float)pos * args.rf[f]; double r = (double)ang * 0.15915494309189533577; r -= rint(r); const float th = (float)(r * 6.283185307179586477);
        tab[pos * 32 + f] = cosf(th); tab[pos * 32 + 16 + f] = sinf(th); } }
    for (int m = gw; m < M; m += NGW) row_to_bf16_rs(args.in[0] + (size_t)m * DM, (bf16_t*)(ws + WS_XB) + (size_t)m * DM, (float*)(ws + WS_RSX) + m, lane);
}
constexpr int P0B_ITEMS = 48 * 64 + 3 * 32 * 16 + 8 * 64 + 2 * 32 * 32 * 32 + 32 * 16 * 64, QKV_UNITS = 160, P0_DEFER_PER_WAVE = 8;
__device__ __forceinline__ int p0_deferred(int G) { return G > QKV_UNITS ? (G - QKV_UNITS) * NWAVES * P0_DEFER_PER_WAVE : 0; }
__device__ __forceinline__ void p0b_share(Frame& F, const Args& args) {
    LAS float* scr = (LAS float*)(F.lds + RING_OFF + F.wave * 16384);
    const int gw = F.vcu * NWAVES + F.wave, NGW = F.G * NWAVES, lane = F.lane;
    GAS unsigned char* wsg_ = (GAS unsigned char*)args.ws; asm volatile("" : "+s"(wsg_)); unsigned char* ws = (unsigned char*)wsg_;
    { DecRest D{&args, ws}; p0_items(D, gw, NGW, P0B_ITEMS - p0_deferred(F.G), scr, lane); }
    { bf16_t* wh = (bf16_t*)(ws + WS_WR); bf16_t* wl = wh + 48 * DM; const float* nfw = args.in[18];
      for (int i = (F.vcu * NWAVES * 64) + F.tid; i < 48 * DM; i += F.G * NWAVES * 64) { const int n = i >> 11, k = i & (DM - 1);
        const float v = n < NG ? args.in[19][k * NG + n] * nfw[k] : (n < 36 ? args.in[21][k * NE + (n - NG)] * nfw[k] : 0.f);
        const unsigned hb = cvt_pk_bf16(v, 0.f) & 0xffffu; wh[i] = (bf16_t)hb; wl[i] = (bf16_t)(cvt_pk_bf16(v - __uint_as_float(hb << 16), 0.f) & 0xffffu); } }
    for (int m = gw; m < MROWS; m += NGW) row_to_bf16_rs(args.in[1] + (size_t)m * DM, (bf16_t*)(ws + WS_MEMB) + (size_t)m * DM, (float*)(ws + WS_RSMEM) + m, lane);
}

struct SchedG1 {
    const char* A; const char* Bt; int G, c, i0, i1;
    __device__ __forceinline__ bool next(int i, gm::Unit& u) const {
        i += i0; if (i >= i1) return false;
        const int L = i * G + c; if (L >= 64 * 32) return false;
        int pm, pn; gm::tile_of(L, 64, 32, pm, pn);
        u.pm = pm; u.pn = pn; u.kind = 0; u.ti = 0; u.a = A + (size_t)pm * 256 * DM * 2; u.b = Bt + (size_t)pn * 256 * DM * 2; return true;
    }
};
struct EpiG1 {
    bf16_t* proj; float* dtraw; const float* rsx; const float* ropetab; float* kmean;
    template <bool ROPE, bool ZT> __device__ __forceinline__ void rows(const f32x4 (&acc)[2][2][4][2], const gm::Unit& u, const int wc, const int fr, const int fq, const int row0, const float (&rs8)[8], f32x4 (&ks)[2][2]) const {
        const float sgn = (fq < 2) ? -1.f : 1.f;
        f32x4 nc0, nc1, ns0, ns1;
        if constexpr (ROPE) { const float* rt = ropetab + (row0 & (SEQ - 1)) * 32 + 8 * (fq & 1); nc0 = *(const f32x4*)rt; nc1 = *(const f32x4*)(rt + 4); ns0 = *(const f32x4*)(rt + 16); ns1 = *(const f32x4*)(rt + 20); }
#pragma unroll
        for (int g = 0; g < 8; ++g) {
            const int ai = g >> 2, m = g & 3, row = row0 + ai * 128 + m * 16; const float rs = rs8[g];
            f32x4 c0, c1, s0, s1;
            if constexpr (ROPE) { c0 = nc0; c1 = nc1; s0 = ns0; s1 = ns1;
                if (g + 1 < 8) { const int rn = row0 + ((g + 1) >> 2) * 128 + ((g + 1) & 3) * 16; const float* rt = ropetab + (rn & (SEQ - 1)) * 32 + 8 * (fq & 1);
                    nc0 = *(const f32x4*)rt; nc1 = *(const f32x4*)(rt + 4); ns0 = *(const f32x4*)(rt + 16); ns1 = *(const f32x4*)(rt + 20); } }
#pragma unroll
            for (int bj = 0; bj < 2; ++bj) {
                f32x4 v0 = acc[ai][bj][m][0] * rs, v1 = acc[ai][bj][m][1] * rs;
                if constexpr (ROPE) {
                    f32x4 p0, p1;
#pragma unroll
                    for (int e = 0; e < 4; ++e) { p0[e] = __shfl_xor(v0[e], 32); p1[e] = __shfl_xor(v1[e], 32); }
                    v0 = v0 * c0 + (p0 * s0) * sgn; v1 = v1 * c1 + (p1 * s1) * sgn;
                }
                if constexpr (ZT) {
#pragma unroll
                    for (int e = 0; e < 4; ++e) { v0[e] = v0[e] * __builtin_amdgcn_rcpf(1.f + __expf(-v0[e])); v1[e] = v1[e] * __builtin_amdgcn_rcpf(1.f + __expf(-v1[e])); } }
                if constexpr (!ZT) { ks[bj][0] += v0; ks[bj][1] += v1; }
                u32x4 w; w.x = cvt_pk_bf16(v0[0], v0[1]); w.y = cvt_pk_bf16(v0[2], v0[3]); w.z = cvt_pk_bf16(v1[0], v1[1]); w.w = cvt_pk_bf16(v1[2], v1[3]);
                *(u32x4*)(proj + (size_t)row * LDP + u.pn * 256 + bj * 128 + wc * 32 + 8 * fq) = w;
            }
            asm volatile("" ::: "memory");
        }
    }
    __device__ __forceinline__ void operator()(const f32x4 (&acc)[2][2][4][2], const gm::Unit& u, int wr, int wc, int fr, int fq) const {
        const int row0 = u.pm * 256 + wr * 64 + fr;
        const bool rope = (u.pn < 8) && (wc == 0), ktile = (u.pn >= 4) && (u.pn < 8);
        f32x4 ks[2][2] = {{{0.f, 0.f, 0.f, 0.f}, {0.f, 0.f, 0.f, 0.f}}, {{0.f, 0.f, 0.f, 0.f}, {0.f, 0.f, 0.f, 0.f}}};
        float rs8[8];
#pragma unroll
        for (int g = 0; g < 8; ++g) rs8[g] = rsx[row0 + (g >> 2) * 128 + (g & 3) * 16];
#pragma unroll
        for (int g = 0; g < 8; ++g) asm volatile("" : "+v"(rs8[g]));
        const bool zt = (u.pn >= C_Z / 256) && (u.pn < C_XBC / 256);
        if (rope) rows<true, false>(acc, u, wc, fr, fq, row0, rs8, ks); else if (zt) rows<false, true>(acc, u, wc, fr, fq, row0, rs8, ks); else rows<false, false>(acc, u, wc, fr, fq, row0, rs8, ks);
        if (ktile) {
#pragma unroll
            for (int bj = 0; bj < 2; ++bj)
#pragma unroll
                for (int n = 0; n < 2; ++n)
#pragma unroll
                    for (int e = 0; e < 4; ++e) { float s = ks[bj][n][e]; s += __shfl_xor(s, 1); s += __shfl_xor(s, 2); s += __shfl_xor(s, 4); s += __shfl_xor(s, 8);
                        if (fr == 0) atomicAdd(kmean + (size_t)u.pm * 1024 + (u.pn - 4) * 256 + bj * 128 + wc * 32 + 8 * fq + 4 * n + e, s * (1.f / MB)); }
        }
    }
};
struct SchedTiles {
    const char* A; const char* Bt; int nM, nN, K, G, c, i0, i1;
    __device__ __forceinline__ bool next(int i, gm::Unit& u) const {
        i += i0; if (i >= i1) return false;
        const int L = i * G + c; if (L >= nM * nN) return false;
        int pm, pn; gm::tile_of(L, nM, nN, pm, pn);
        u.pm = pm; u.pn = pn; u.kind = 0; u.ti = i & 1; u.a = A + (size_t)pm * 256 * K * 2; u.b = Bt + (size_t)pn * 256 * K * 2; return true;
    }
};
template <bool GO> struct EpiRes {
    const bf16_t* base; bf16_t* hb; unsigned char* q8; float* ss;
    const LAS char* stab;
    static constexpr bool MID = !GO;
    __device__ __forceinline__ void mid(f32x4 (&acc)[2][2][4][2], const gm::Unit& u, const int t, const int wr, const int fr) const {
        if (t < 16 || (t & 7)) return;
        const int g = (t - 16) >> 3;
#pragma unroll
        for (int ai = 0; ai < 2; ++ai)
#pragma unroll
            for (int m = 0; m < 4; ++m) {
                const bf16x8 raw = *(const LAS bf16x8*)(stab + ((u.ti * 256) + ai * 128 + wr * 64 + m * 16 + fr) * 16);
                const f32x4 s4 = __builtin_bit_cast(f32x4, raw);
                const float sp = g == 0 ? 1.f : (g == 1 ? s4[0] : (g == 2 ? s4[1] : s4[2])), sc = g == 0 ? s4[0] : (g == 1 ? s4[1] : (g == 2 ? s4[2] : s4[3]));
                const float ratio = sp * __builtin_amdgcn_rcpf(sc);
#pragma unroll
                for (int bj = 0; bj < 2; ++bj)
#pragma unroll
                    for (int n = 0; n < 2; ++n) acc[ai][bj][m][n] *= ratio;
            }
    }
    __device__ __forceinline__ void operator()(const f32x4 (&acc)[2][2][4][2], const gm::Unit& u, int wr, int wc, int fr, int fq) const {
        const int row0 = u.pm * 256 + wr * 64 + fr, colb = u.pn * 256 + wc * 32 + 8 * fq;
        u32x4 nh[2];
#pragma unroll
        for (int bj = 0; bj < 2; ++bj) nh[bj] = *(const u32x4*)(base + (size_t)row0 * DM + colb + bj * 128);
#pragma unroll
        for (int g = 0; g < 8; ++g) {
            const int row = row0 + (g >> 2) * 128 + (g & 3) * 16; float q = 0.f;
            float sfin = 1.f;
            if constexpr (!GO) { const bf16x8 raw = *(const LAS bf16x8*)(stab + ((u.ti * 256) + (g >> 2) * 128 + wr * 64 + (g & 3) * 16 + fr) * 16); sfin = __builtin_bit_cast(f32x4, raw)[3]; }
            f32x4 cb[2][2];
#pragma unroll
            for (int bj = 0; bj < 2; ++bj) { cb[bj][0] = (f32x4){bflo(nh[bj].x), bfhi(nh[bj].x), bflo(nh[bj].y), bfhi(nh[bj].y)}; cb[bj][1] = (f32x4){bflo(nh[bj].z), bfhi(nh[bj].z), bflo(nh[bj].w), bfhi(nh[bj].w)}; }
            if (g + 1 < 8) { const int rn = row0 + ((g + 1) >> 2) * 128 + ((g + 1) & 3) * 16;
#pragma unroll
                for (int bj = 0; bj < 2; ++bj) nh[bj] = *(const u32x4*)(base + (size_t)rn * DM + colb + bj * 128); }
            asm volatile("" ::: "memory");
#pragma unroll
            for (int bj = 0; bj < 2; ++bj) {
                const size_t o = (size_t)row * DM + colb + bj * 128;
                const f32x4 v0 = acc[g >> 2][bj][g & 3][0] * sfin + cb[bj][0], v1 = acc[g >> 2][bj][g & 3][1] * sfin + cb[bj][1];
                { u32x4 w; w.x = cvt_pk_bf16(v0[0], v0[1]); w.y = cvt_pk_bf16(v0[2], v0[3]); w.z = cvt_pk_bf16(v1[0], v1[1]); w.w = cvt_pk_bf16(v1[2], v1[3]); *(u32x4*)(hb + o) = w; }
                if constexpr (GO) { u32x2 w8; w8.x = pk4_fp8(v0[0], v0[1], v0[2], v0[3]); w8.y = pk4_fp8(v1[0], v1[1], v1[2], v1[3]); *(u32x2*)(q8 + o) = w8; }
                else q += (v0[0] * v0[0] + v0[1] * v0[1]) + (v0[2] * v0[2] + v0[3] * v0[3]) + (v1[0] * v1[0] + v1[1] * v1[1]) + (v1[2] * v1[2] + v1[3] * v1[3]);
            }
            if constexpr (!GO) { q += __shfl_xor(q, 16); q += __shfl_xor(q, 32); if (fq == 0) ss[(size_t)row * 32 + u.pn * 4 + wc] = q; }
        }
    }
};
struct SchedQKV {
    const char* A0; const char* B0; const char* A1; const char* B1; int G, c;
    __device__ __forceinline__ bool next(int i, gm::Unit& u) const {
        const int L = i * G + c; int pm, pn;
        if (L < 128) { gm::tile_of(L, 64, 2, pm, pn); u.kind = 0; u.a = A0 + (size_t)pm * 256 * DM * 2; u.b = B0 + (size_t)pn * 256 * DM * 2; }
        else if (L < 160) { gm::tile_of(L - 128, 8, 4, pm, pn); u.kind = 1; u.a = A1 + (size_t)pm * 256 * DM * 2; u.b = B1 + (size_t)pn * 256 * DM * 2; }
        else return false;
        u.pm = pm; u.pn = pn; u.ti = 0; return true;
    }
};
struct EpiScale {
    bf16_t* O0; bf16_t* O1; int ld0, ld1; const LAS float* rsl;
    __device__ __forceinline__ void operator()(const f32x4 (&acc)[2][2][4][2], const gm::Unit& u, int wr, int wc, int fr, int fq) const {
        bf16_t* O = u.kind ? O1 : O0; const int ld = u.kind ? ld1 : ld0;
#pragma unroll
        for (int ai = 0; ai < 2; ++ai)
#pragma unroll
            for (int m = 0; m < 4; ++m) {
                const int r = ai * 128 + wr * 64 + m * 16 + fr; const float rs = rsl[r];
#pragma unroll
                for (int bj = 0; bj < 2; ++bj) {
                    const f32x4 v0 = acc[ai][bj][m][0] * rs, v1 = acc[ai][bj][m][1] * rs;
                    u32x4 w; w.x = cvt_pk_bf16(v0[0], v0[1]); w.y = cvt_pk_bf16(v0[2], v0[3]); w.z = cvt_pk_bf16(v1[0], v1[1]); w.w = cvt_pk_bf16(v1[2], v1[3]);
                    *(u32x4*)(O + (size_t)(u.pm * 256 + r) * ld + u.pn * 256 + bj * 128 + wc * 32 + 8 * fq) = w;
                }
            }
    }
};

__device__ __forceinline__ void moe_tables(LAS int* mt, const int* cnt_g, int tid) {
    if (tid < 64) {
        const int lane = tid, c = lane < NE ? cnt_g[lane] : 0, u8 = 8 * ((c + 255) >> 8);
        int pu = u8, po = c;
#pragma unroll
        for (int o = 1; o < 32; o <<= 1) { const int a_ = __shfl_up(pu, o), b_ = __shfl_up(po, o); if (lane >= o) { pu += a_; po += b_; } }
        if (lane < NE) { mt[lane] = c; mt[32 + lane] = pu - u8; mt[65 + lane] = po - c; }
        if (lane == NE - 1) { mt[32 + NE] = pu; mt[65 + NE] = po; }
    }
    LDS_WAIT(); __syncthreads();
}
__device__ __forceinline__ void moe_unit_list(LAS int* ul, const LAS int* mt, int G, int c, int tid) {
    if (tid < 8) {
        const int L = tid * G + c; int v = 0, e = 0, pn = 0, mtile = 0;
        if (L < mt[32 + NE]) {
            for (int k = 1; k < NE; ++k) if (L >= mt[32 + k]) e = k;
            const int rem = L - mt[32 + e], te = (mt[e] + 255) >> 8; pn = rem / te; mtile = rem - pn * te; v = 1;
        }
        ul[4 * tid] = e; ul[4 * tid + 1] = pn; ul[4 * tid + 2] = mtile; ul[4 * tid + 3] = v;
    }
    LDS_WAIT(); __syncthreads();
}
template <bool GU> struct SchedMoEL {
    const LAS int* ul; const char* A; const char* Bt;
    __device__ __forceinline__ bool next(int i, gm::Unit& u) const {
        if (i >= 8 || __builtin_amdgcn_readfirstlane(ul[4 * i + 3]) == 0) return false;
        const int e = __builtin_amdgcn_readfirstlane(ul[4 * i]), pn = __builtin_amdgcn_readfirstlane(ul[4 * i + 1]);
        u.pm = __builtin_amdgcn_readfirstlane(ul[4 * i + 2]); u.pn = pn; u.kind = e; u.ti = i; u.a = A;
        u.b = Bt + ((size_t)e * 2048 + pn * 256) * (GU ? DM : DE);
        return true;
    }
};
struct EpiGU {
    bf16_t* Hact; const float* rs2; const LAS int* mt; const LAS int* tab;
    __device__ __forceinline__ void operator()(const f32x4 (&acc)[2][2][4][2], const gm::Unit& u, int wr, int wc, int fr, int fq) const {
        const int e = u.kind, valid = mt[e] - u.pm * 256, slot0 = mt[65 + e] + u.pm * 256;
        float rsv[8];
#pragma unroll
        for (int g = 0; g < 8; ++g) rsv[g] = rs2[tab[u.ti * 256 + (g >> 2) * 128 + wr * 64 + (g & 3) * 16 + fr]];
#pragma unroll
        for (int g = 0; g < 8; ++g) asm volatile("" : "+v"(rsv[g]));
#pragma unroll
        for (int ai = 0; ai < 2; ++ai)
#pragma unroll
            for (int m = 0; m < 4; ++m) {
                const int r = ai * 128 + wr * 64 + m * 16 + fr;
                if (r < valid) {
                    const float rs = rsv[ai * 4 + m] * (1.f / 256.f);
                    const f32x4 g0 = acc[ai][0][m][0] * rs, g1 = acc[ai][0][m][1] * rs, u0 = acc[ai][1][m][0] * rs, u1 = acc[ai][1][m][1] * rs;
                    float o[8];
#pragma unroll
                    for (int j = 0; j < 4; ++j) { o[j] = g0[j] * __builtin_amdgcn_rcpf(1.f + __expf(-g0[j])) * u0[j]; o[4 + j] = g1[j] * __builtin_amdgcn_rcpf(1.f + __expf(-g1[j])) * u1[j]; }
                    u32x2 w; w.x = pk4_fp8(16.f * o[0], 16.f * o[1], 16.f * o[2], 16.f * o[3]); w.y = pk4_fp8(16.f * o[4], 16.f * o[5], 16.f * o[6], 16.f * o[7]);
                    *(u32x2*)((unsigned char*)Hact + (size_t)(slot0 + r) * DE + u.pn * 128 + wc * 32 + 8 * fq) = w;
                }
            }
    }
};
struct EpiDown {
    unsigned char* Y; const LAS int* mt;
    __device__ __forceinline__ void operator()(const f32x4 (&acc)[2][2][4][2], const gm::Unit& u, int wr, int wc, int fr, int fq) const {
        const int e = u.kind, valid = mt[e] - u.pm * 256, slot0 = mt[65 + e] + u.pm * 256;
#pragma unroll
        for (int ai = 0; ai < 2; ++ai)
#pragma unroll
            for (int m = 0; m < 4; ++m) {
                const int r = ai * 128 + wr * 64 + m * 16 + fr;
                if (r < valid) {
#pragma unroll
                    for (int bj = 0; bj < 2; ++bj) { const f32x4 v0 = acc[ai][bj][m][0] * (1.f / 256.f), v1 = acc[ai][bj][m][1] * (1.f / 256.f);
                        u32x2 w; w.x = pk4_fp8(v0[0], v0[1], v0[2], v0[3]); w.y = pk4_fp8(v1[0], v1[1], v1[2], v1[3]);
                        *(u32x2*)(Y + (size_t)(slot0 + r) * DM + u.pn * 256 + bj * 128 + wc * 32 + 8 * fq) = w; }
                }
            }
    }
};
__device__ __forceinline__ void final_rows(Frame& F, const bf16_t* h2b, float* outp, const unsigned char* Y, const int* tok_e, const int* tok_pos, const float* tok_w, const float* fw, const LAS int* mt) {
    const int gw = F.vcu * NWAVES + F.wave, NGW = F.G * NWAVES, lane = F.lane;
#pragma unroll 2
    for (int t = gw; t < M; t += NGW) {
        const int e1 = tok_e[2 * t], e2 = tok_e[2 * t + 1];
        const size_t s1 = (size_t)(mt[65 + e1] + tok_pos[2 * t]), s2 = (size_t)(mt[65 + e2] + tok_pos[2 * t + 1]);
        const float w1 = tok_w[2 * t] * (1.f / 16.f), w2 = tok_w[2 * t + 1] * (1.f / 16.f);
        f32x4* hr = (f32x4*)(outp + (size_t)t * DM) + 2 * lane;
        const u32x4* hb = (const u32x4*)(h2b + (size_t)t * DM) + lane;
        const u32x2* y1 = (const u32x2*)(Y + s1 * DM) + lane; const u32x2* y2 = (const u32x2*)(Y + s2 * DM) + lane;
        float v[4][8]; float ss = 0.f;
#pragma unroll
        for (int j = 0; j < 4; ++j) {
            const u32x4 a = __builtin_nontemporal_load(hb + 64 * j); const u32x2 p = __builtin_nontemporal_load(y1 + 64 * j), q = __builtin_nontemporal_load(y2 + 64 * j);
            float pa[8], qa[8];
            { const f32x2 t0 = __builtin_amdgcn_cvt_pk_f32_fp8((int)p.x, false), t1 = __builtin_amdgcn_cvt_pk_f32_fp8((int)p.x, true), t2 = __builtin_amdgcn_cvt_pk_f32_fp8((int)p.y, false), t3 = __builtin_amdgcn_cvt_pk_f32_fp8((int)p.y, true);
              pa[0] = t0[0]; pa[1] = t0[1]; pa[2] = t1[0]; pa[3] = t1[1]; pa[4] = t2[0]; pa[5] = t2[1]; pa[6] = t3[0]; pa[7] = t3[1]; }
            { const f32x2 t0 = __builtin_amdgcn_cvt_pk_f32_fp8((int)q.x, false), t1 = __builtin_amdgcn_cvt_pk_f32_fp8((int)q.x, true), t2 = __builtin_amdgcn_cvt_pk_f32_fp8((int)q.y, false), t3 = __builtin_amdgcn_cvt_pk_f32_fp8((int)q.y, true);
              qa[0] = t0[0]; qa[1] = t0[1]; qa[2] = t1[0]; qa[3] = t1[1]; qa[4] = t2[0]; qa[5] = t2[1]; qa[6] = t3[0]; qa[7] = t3[1]; }
            const float ha[8] = {bflo(a.x), bfhi(a.x), bflo(a.y), bfhi(a.y), bflo(a.z), bfhi(a.z), bflo(a.w), bfhi(a.w)};
#pragma unroll
            for (int k = 0; k < 8; ++k) { v[j][k] = ha[k] + (w1 * pa[k] + w2 * qa[k]); ss += v[j][k] * v[j][k]; }
        }
        ss = wave_sum(ss);
        const float rs = rsqrtf(ss * (1.f / DM) + EPS);
#pragma unroll
        for (int j = 0; j < 4; ++j) {
            const f32x4 g0 = *((const f32x4*)fw + 2 * lane + 128 * j), g1 = *((const f32x4*)fw + 2 * lane + 128 * j + 1);
            __builtin_nontemporal_store((f32x4){v[j][0] * rs * g0[0], v[j][1] * rs * g0[1], v[j][2] * rs * g0[2], v[j][3] * rs * g0[3]}, hr + 128 * j);
            __builtin_nontemporal_store((f32x4){v[j][4] * rs * g1[0], v[j][5] * rs * g1[1], v[j][6] * rs * g1[2], v[j][7] * rs * g1[3]}, hr + 128 * j + 1);
        }
    }
}

__device__ __forceinline__ void router_rows(Frame& F, const bf16_t* h2, const bf16_t* wrh, const float* b_rg, const float* b_re, float* rs2, int* cnt, int* list, int* tok_e, int* tok_pos, float* tok_w) {
    const int lane = F.lane, tid = F.tid, w = F.wave, ti = lane & 15, kg = lane >> 4;
    LAS float* part = (LAS float*)(F.lds + RING_OFF);
    LAS float* sqp = part + 8 * 64 * 48;
    LAS float* lgt = sqp + 8 * 64;
    const bf16_t* wrl = wrh + 48 * DM;
    for (int g = F.vcu; g < M / 64; g += F.G) {
        const bf16_t* hr = h2 + (size_t)(g * 64 + ti) * DM + w * 256 + 8 * kg;
        f32x4 acc[4][3]; float sq[4];
#pragma unroll
        for (int sb = 0; sb < 4; ++sb) { sq[sb] = 0.f;
#pragma unroll
            for (int nt = 0; nt < 3; ++nt) acc[sb][nt] = (f32x4){0.f, 0.f, 0.f, 0.f}; }
#pragma unroll 2
        for (int s = 0; s < 8; ++s) {
            bf16x8 bh[3], bl[3]; u32x4 xw[4];
#pragma unroll
            for (int nt = 0; nt < 3; ++nt) { const size_t o = (size_t)(16 * nt + ti) * DM + w * 256 + 32 * s + 8 * kg; bh[nt] = *(const bf16x8*)(wrh + o); bl[nt] = *(const bf16x8*)(wrl + o); }
#pragma unroll
            for (int sb = 0; sb < 4; ++sb) xw[sb] = *(const u32x4*)(hr + (size_t)(16 * sb) * DM + 32 * s);
#pragma unroll
            for (int sb = 0; sb < 4; ++sb) {
                { const float x0 = bflo(xw[sb].x), x1 = bfhi(xw[sb].x), x2 = bflo(xw[sb].y), x3 = bfhi(xw[sb].y), x4 = bflo(xw[sb].z), x5 = bfhi(xw[sb].z), x6 = bflo(xw[sb].w), x7 = bfhi(xw[sb].w);
                  sq[sb] += (x0 * x0 + x1 * x1) + (x2 * x2 + x3 * x3) + (x4 * x4 + x5 * x5) + (x6 * x6 + x7 * x7); }
                const bf16x8 ah = *reinterpret_cast<const bf16x8*>(&xw[sb]);
#pragma unroll
                for (int nt = 0; nt < 3; ++nt) { acc[sb][nt] = __builtin_amdgcn_mfma_f32_16x16x32_bf16(ah, bh[nt], acc[sb][nt], 0, 0, 0); acc[sb][nt] = __builtin_amdgcn_mfma_f32_16x16x32_bf16(ah, bl[nt], acc[sb][nt], 0, 0, 0); }
            }
        }
#pragma unroll
        for (int sb = 0; sb < 4; ++sb) { sq[sb] += __shfl_xor(sq[sb], 16); sq[sb] += __shfl_xor(sq[sb], 32); }
        __syncthreads();
#pragma unroll
        for (int sb = 0; sb < 4; ++sb) {
#pragma unroll
            for (int nt = 0; nt < 3; ++nt)
#pragma unroll
                for (int r = 0; r < 4; ++r) part[(w * 64 + 16 * sb + 4 * kg + r) * 48 + 16 * nt + ti] = acc[sb][nt][r];
            if (kg == 0) sqp[w * 64 + 16 * sb + ti] = sq[sb]; }
        __syncthreads();
        for (int i = tid; i < 64 * 48 + 64; i += NWAVES * 64) { float s = 0.f;
            if (i < 64 * 48) {
#pragma unroll
                for (int ww = 0; ww < 8; ++ww) s += part[ww * 64 * 48 + i]; }
            else {
#pragma unroll
                for (int ww = 0; ww < 8; ++ww) s += sqp[ww * 64 + (i - 64 * 48)]; }
            lgt[i] = s; }
        __syncthreads();
        if (tid < 64) {
            const int tt = g * 64 + tid; const LAS float* lg = lgt + tid * 48;
            const float rs = rsqrtf(lgt[64 * 48 + tid] * (1.f / DM) + EPS);
            float gm_ = -INFINITY; int gi = 0; float gv[4];
#pragma unroll
            for (int i = 0; i < 4; ++i) { gv[i] = lg[i] * rs + b_rg[i]; if (gv[i] > gm_) { gm_ = gv[i]; gi = i; } }
            float gs = 0.f;
#pragma unroll
            for (int i = 0; i < 4; ++i) gs += __expf(gv[i] - gm_);
            const float gwt = 1.f / gs;
            float e1 = -INFINITY, e2 = -INFINITY; int i1 = 0, i2 = 0;
#pragma unroll
            for (int i = 0; i < 8; ++i) { const float vv = lg[4 + gi * 8 + i] * rs + b_re[gi * 8 + i]; if (vv > e1) { e2 = e1; i2 = i1; e1 = vv; i1 = i; } else if (vv > e2) { e2 = vv; i2 = i; } }
            const float p2 = 1.f / (1.f + __expf(e1 - e2)), p1 = 1.f - p2;
            const int ea = gi * 8 + i1, eb = gi * 8 + i2;
            const int pa = atomicAdd(&cnt[ea], 1), pb = atomicAdd(&cnt[eb], 1);
            list[ea * M + pa] = tt; list[eb * M + pb] = tt;
            tok_e[tt * 2] = ea; tok_e[tt * 2 + 1] = eb; tok_pos[tt * 2] = pa; tok_pos[tt * 2 + 1] = pb; tok_w[tt * 2] = gwt * p1; tok_w[tt * 2 + 1] = gwt * p2; rs2[tt] = rs;
        }
    }
    __syncthreads();
}

__device__ __forceinline__ void dt_rows(Frame& F, const bf16_t* xb, const bf16_t* wdt, const float* rsx, float* dtraw) {
    const int lane = F.lane, tid = F.tid, w = F.wave, ti = lane & 15, kg = lane >> 4;
    LAS float* part = (LAS float*)(F.lds + RING_OFF);
    for (int g = F.vcu; g < M / 64; g += F.G) {
        const bf16_t* ar = xb + (size_t)(g * 64 + ti) * DM + w * 256 + 8 * kg;
        f32x4 acc[4][2];
#pragma unroll
        for (int sb = 0; sb < 4; ++sb) { acc[sb][0] = (f32x4){0.f, 0.f, 0.f, 0.f}; acc[sb][1] = acc[sb][0]; }
#pragma unroll 4
        for (int s = 0; s < 8; ++s) {
            const bf16x8 b0 = *(const bf16x8*)(wdt + (size_t)ti * DM + w * 256 + 32 * s + 8 * kg), b1 = *(const bf16x8*)(wdt + (size_t)(16 + ti) * DM + w * 256 + 32 * s + 8 * kg);
            bf16x8 af[4];
#pragma unroll
            for (int sb = 0; sb < 4; ++sb) af[sb] = *(const bf16x8*)(ar + (size_t)(16 * sb) * DM + 32 * s);
#pragma unroll
            for (int sb = 0; sb < 4; ++sb) { acc[sb][0] = __builtin_amdgcn_mfma_f32_16x16x32_bf16(af[sb], b0, acc[sb][0], 0, 0, 0); acc[sb][1] = __builtin_amdgcn_mfma_f32_16x16x32_bf16(af[sb], b1, acc[sb][1], 0, 0, 0); }
        }
        __syncthreads();
#pragma unroll
        for (int sb = 0; sb < 4; ++sb)
#pragma unroll
            for (int nt = 0; nt < 2; ++nt)
#pragma unroll
                for (int r = 0; r < 4; ++r) part[(w * 64 + 16 * sb + 4 * kg + r) * 32 + 16 * nt + ti] = acc[sb][nt][r];
        __syncthreads();
#pragma unroll
        for (int j = 0; j < 4; ++j) { const int i = tid + 512 * j; float s = 0.f;
#pragma unroll
          for (int ww = 0; ww < 8; ++ww) s += part[ww * 2048 + i];
          const int tok = g * 64 + (i >> 5); dtraw[(size_t)tok * 32 + (i & 31)] = s * rsx[tok]; }
    }
    __syncthreads();
}

__device__ __forceinline__ void gnorm_rows(Frame& F, bf16_t* mixb, const bf16_t* proj) {
    const int gw = F.vcu * NWAVES + F.wave, NGW = F.G * NWAVES, lane = F.lane;
#pragma unroll 2
    for (int tok = gw; tok < M; tok += NGW) {
        u32x4* p = (u32x4*)(mixb + (size_t)tok * MIXW + AW) + lane; const u32x4* zp = (const u32x4*)(proj + (size_t)tok * LDP + C_Z) + lane;
        u32x4 w[4], zw[4]; float v[4][8]; float q[4];
#pragma unroll
        for (int g = 0; g < 4; ++g) { w[g] = __builtin_nontemporal_load(p + 64 * g); zw[g] = __builtin_nontemporal_load(zp + 64 * g); }
#pragma unroll
        for (int g = 0; g < 4; ++g) { float z[8] = {bflo(zw[g].x), bfhi(zw[g].x), bflo(zw[g].y), bfhi(zw[g].y), bflo(zw[g].z), bfhi(zw[g].z), bflo(zw[g].w), bfhi(zw[g].w)};
#pragma unroll
            for (int e = 0; e < 8; ++e) z[e] = z[e] * __builtin_amdgcn_rcpf(1.f + __expf(-z[e]));
            v[g][0] = bflo(w[g].x) * z[0]; v[g][1] = bfhi(w[g].x) * z[1]; v[g][2] = bflo(w[g].y) * z[2]; v[g][3] = bfhi(w[g].y) * z[3]; v[g][4] = bflo(w[g].z) * z[4]; v[g][5] = bfhi(w[g].z) * z[5]; v[g][6] = bflo(w[g].w) * z[6]; v[g][7] = bfhi(w[g].w) * z[7];
            q[g] = (v[g][0] * v[g][0] + v[g][1] * v[g][1]) + (v[g][2] * v[g][2] + v[g][3] * v[g][3]) + (v[g][4] * v[g][4] + v[g][5] * v[g][5]) + (v[g][6] * v[g][6] + v[g][7] * v[g][7]); }
#pragma unroll
        for (int o = 1; o < 64; o <<= 1) {
#pragma unroll
            for (int g = 0; g < 4; ++g) q[g] += __shfl_xor(q[g], o); }
#pragma unroll
        for (int g = 0; g < 4; ++g) { const float rs = rsqrtf(q[g] * (1.f / 512.f) + EPS); u32x4 o;
            o.x = cvt_pk_bf16(v[g][0] * rs, v[g][1] * rs); o.y = cvt_pk_bf16(v[g][2] * rs, v[g][3] * rs); o.z = cvt_pk_bf16(v[g][4] * rs, v[g][5] * rs); o.w = cvt_pk_bf16(v[g][6] * rs, v[g][7] * rs);
            p[64 * g] = o; }
    }
}

#ifndef REP_P0
#define REP_P0 1
#endif
#ifndef REP_P0B
#define REP_P0B 1
#endif
#ifndef REP_G1
#define REP_G1 1
#endif
#ifndef REP_SSD
#define REP_SSD 1
#endif
#ifndef REP_MOE
#define REP_MOE 1
#endif
#ifndef REP_ATT
#define REP_ATT 1
#endif
#ifndef REP_G2
#define REP_G2 1
#endif
__global__ void __launch_bounds__(NWAVES * 64, 2) fwd(Args args) {
    extern __shared__ __attribute__((aligned(16))) unsigned char lds_raw[];
    Frame F;
    F.lds = (LAS unsigned char*)lds_raw;
    F.MISC = (volatile LAS unsigned*)(F.lds + MISC_OFF);
    F.tid = threadIdx.x; F.lane = F.tid & 63; F.wave = __builtin_amdgcn_readfirstlane(F.tid >> 6);
    F.G = gridDim.x; { const int bx = blockIdx.x; F.vcu = (F.G % 8 == 0) ? (bx % 8) * (F.G / 8) + bx / 8 : bx; }
    for (int u = F.tid; u < (LDS_BYTES - LDSCTL_OFF) / 4; u += NWAVES * 64) ((LAS unsigned*)(F.lds + LDSCTL_OFF))[u] = 0u;
    __syncthreads();
    (void)xcd_barrier_post((unsigned*)(args.ws + WS_CTL) + CW_BAR + args.li * XCD_BAR_WORDS, F.MISC + 8);
#define GRID_BAR() do { GAS unsigned char* wb_ = (GAS unsigned char*)args.ws; asm volatile("" : "+s"(wb_)); XcdBarrier b_; \
        b_.bar = (unsigned*)((unsigned char*)wb_ + WS_CTL) + CW_BAR + args.li * XCD_BAR_WORDS; b_.x = xb_xcc_id(); b_.st = F.MISC + 8; xcd_barrier(b_, F.wave * 64 + lane_id_now()); } while (0)
    const int lo = args.ph_lo, hi = args.ph_hi;
#define IN(k) (lo <= (k) && (k) < hi)
#define BOTH(k) (IN(k) && IN((k) + 1))
#define PHASE_WS() F.lane = lane_id_now(); F.tid = F.wave * 64 + F.lane; GAS unsigned char* wsg_ = (GAS unsigned char*)args.ws; asm volatile("" : "+s"(wsg_)); unsigned char* ws = (unsigned char*)wsg_
    if (IN(0)) { F.lane = lane_id_now(); F.tid = F.wave * 64 + F.lane;
p0a_prologue(F, args); if constexpr (REP_P0 > 1) p0a_prologue(F, args); if (BOTH(0)) GRID_BAR(); }
    if (IN(1)) {
        PHASE_WS();
        const int rsplit = (F.vcu >> 5) & 7;
        EpiG1 E{(bf16_t*)(ws + WS_PROJ), (float*)(ws + WS_DTRAW), (const float*)(ws + WS_RSX), (const float*)(ws + WS_ROPE), (float*)(ws + WS_KMEAN)};
        { SchedG1 S{(const char*)(ws + WS_XB), (const char*)(ws + WS_WIN_T), F.G, (int)blockIdx.x, 0, rsplit};
          gm::gemm_phase<EpiG1, SchedG1, false>(F.tid, F.lds + RING_OFF, (const LAS int*)(F.lds + TAB_OFF), DM, S, E); }
        __syncthreads();
        p0b_share(F, args);
        if constexpr (REP_P0B > 1) { __syncthreads(); p0b_share(F, args); }
        __syncthreads();
        { F.lane = lane_id_now(); F.tid = F.wave * 64 + F.lane;
          SchedG1 S{(const char*)(ws + WS_XB), (const char*)(ws + WS_WIN_T), F.G, (int)blockIdx.x, rsplit, 1 << 20};
          gm::gemm_phase<EpiG1, SchedG1, false>(F.tid, F.lds + RING_OFF, (const LAS int*)(F.lds + TAB_OFF), DM, S, E); }
        if (BOTH(1)) GRID_BAR();
    }
    if (IN(2)) {
        PHASE_WS();
        dt_rows(F, (const bf16_t*)(ws + WS_XB), (const bf16_t*)(ws + WS_WIN_T) + (size_t)C_DT * DM, (const float*)(ws + WS_RSX), (float*)(ws + WS_DTRAW));
        sd::conv_prepass(F.vcu * NWAVES * 64 + F.tid, F.G * NWAVES * 64, (const bf16_t*)(ws + WS_PROJ), args.in[4], args.in[5], (bf16_t*)(ws + WS_XBCC));
        if (BOTH(2)) GRID_BAR();
    }
    if (IN(3)) {
        PHASE_WS();
        for (int L = F.vcu; L < BATCH * SH; L += F.G)
            sd::ssd_unit(F.tid, L / SH, L % SH, (const bf16_t*)(ws + WS_PROJ), (const bf16_t*)(ws + WS_XBCC), args.in[4], args.in[5], (const float*)(ws + WS_DTRAW), args.in[6], args.in[7], args.in[8],
                         (bf16_t*)(ws + WS_MIXB), (float*)(ws + WS_SSQ), (LAS char*)(F.lds + RING_OFF));
        if constexpr (REP_SSD > 1) {
        for (int L = F.vcu; L < BATCH * SH; L += F.G)
            sd::ssd_unit(F.tid, L / SH, L % SH, (const bf16_t*)(ws + WS_PROJ), (const bf16_t*)(ws + WS_XBCC), args.in[4], args.in[5], (const float*)(ws + WS_DTRAW), args.in[6], args.in[7], args.in[8],
                         (bf16_t*)(ws + WS_MIXB), (float*)(ws + WS_SSQ), (LAS char*)(F.lds + RING_OFF));
        }
    }
    if (IN(4)) {
        PHASE_WS();
        for (int L = F.vcu; L < BATCH * AH * 4; L += F.G) {
            const int b = L >> 5, h = (L >> 2) & 7, pi = L & 3;
            const bf16_t* pb = (const bf16_t*)(ws + WS_PROJ) + (size_t)b * SEQ * LDP + h * HD;
#pragma unroll 1
            for (int k = 0; k < 2; ++k) { const int jb = k ? pi : 7 - pi;
                at::attn_unit<true>(F.tid, pb + (size_t)jb * MB * LDP + C_Q, pb + C_K, (bf16_t*)(ws + WS_MIXB) + (size_t)(b * SEQ + jb * MB) * MIXW + h * HD,
                                    4 * (jb + 1), jb, (const float*)(ws + WS_KMEAN) + (size_t)b * NB * 1024 + h * HD, (LAS char*)(F.lds + RING_OFF)); }
        }
        if constexpr (REP_ATT > 1) {
        for (int L = F.vcu; L < BATCH * AH * 4; L += F.G) {
            const int b = L >> 5, h = (L >> 2) & 7, pi = L & 3;
            const bf16_t* pb = (const bf16_t*)(ws + WS_PROJ) + (size_t)b * SEQ * LDP + h * HD;
#pragma unroll 1
            for (int k = 0; k < 2; ++k) { const int jb = k ? pi : 7 - pi;
                at::attn_unit<true>(F.tid, pb + (size_t)jb * MB * LDP + C_Q, pb + C_K, (bf16_t*)(ws + WS_MIXB) + (size_t)(b * SEQ + jb * MB) * MIXW + h * HD,
                                    4 * (jb + 1), jb, (const float*)(ws + WS_KMEAN) + (size_t)b * NB * 1024 + h * HD, (LAS char*)(F.lds + RING_OFF)); }
        }
        }
        __syncthreads();
        if (BOTH(4)) GRID_BAR();
    }
    if (IN(5)) {
        PHASE_WS();
        EpiRes<false> E{(const bf16_t*)(ws + WS_XB), (bf16_t*)(ws + WS_XB), nullptr, (float*)(ws + WS_SS), (const LAS char*)(F.lds + TAB_OFF)};
#pragma unroll 1
        for (int i0 = 0; ; i0 += 2) {
            SchedTiles S{(const char*)(ws + WS_MIXB), (const char*)(ws + WS_WOUT_T), 64, 8, MIXW, F.G, (int)blockIdx.x, i0, i0 + 2};
            gm::Unit u; if (!S.next(0, u)) break;
            __syncthreads();
            { const int slot = F.tid >> 8, r = F.tid & 255; gm::Unit uu; if (S.next(slot, uu)) {
                const f32x4* q = (const f32x4*)((const float*)(ws + WS_SSQ) + (size_t)(uu.pm * 256 + r) * 64); f32x4 s4;
#pragma unroll
                for (int g = 0; g < 4; ++g) { const f32x4 a = q[4 * g], b2 = q[4 * g + 1], c2 = q[4 * g + 2], d2 = q[4 * g + 3];
                    s4[g] = rsqrtf((((a[0] + a[1]) + (a[2] + a[3])) + ((b2[0] + b2[1]) + (b2[2] + b2[3])) + ((c2[0] + c2[1]) + (c2[2] + c2[3])) + ((d2[0] + d2[1]) + (d2[2] + d2[3]))) * (1.f / 512.f) + EPS); }
                *(LAS f32x4*)(F.lds + TAB_OFF + (slot * 256 + r) * 16) = s4; } }
            VM_WAIT(); LDS_WAIT(); __syncthreads();
            gm::gemm_phase<EpiRes<false>, SchedTiles, false>(F.tid, F.lds + RING_OFF, (const LAS int*)(F.lds + TAB_OFF), MIXW, S, E);
        }
        if (BOTH(5)) GRID_BAR();
    }
    if (IN(6)) {
        PHASE_WS();
        SchedQKV S{(const char*)(ws + WS_XB), (const char*)(ws + WS_WCQ_T), (const char*)(ws + WS_MEMB), (const char*)(ws + WS_WCKV_T), F.G, (int)blockIdx.x};
        gm::Unit u0; LAS float* rsl = (LAS float*)(F.lds + RSL_OFF);
        if (S.next(0, u0) && F.tid < 256) {
            const int row = u0.pm * 256 + F.tid;
            if (u0.kind == 0) { const f32x4* p = (const f32x4*)((const float*)(ws + WS_SS) + (size_t)row * 32); float q = 0.f;
#pragma unroll
                for (int j = 0; j < 8; ++j) { const f32x4 v = p[j]; q += (v[0] + v[1]) + (v[2] + v[3]); }
                rsl[F.tid] = rsqrtf(q * (1.f / DM) + EPS); }
            else rsl[F.tid] = ((const float*)(ws + WS_RSMEM))[row];
        }
        VM_WAIT(); LDS_WAIT(); __syncthreads();
        EpiScale E{(bf16_t*)(ws + WS_QC), (bf16_t*)(ws + WS_KVC), CW, 2 * CW, rsl};
        gm::gemm_phase<EpiScale, SchedQKV, false>(F.tid, F.lds + RING_OFF, (const LAS int*)(F.lds + TAB_OFF), DM, S, E);
        if ((int)blockIdx.x >= QKV_UNITS) {
            const int nd = p0_deferred(F.G); DecRest D{&args, ws};
            p0_items(D, P0B_ITEMS - nd + ((int)blockIdx.x - QKV_UNITS) * NWAVES + F.wave, (F.G - QKV_UNITS) * NWAVES, P0B_ITEMS, (LAS float*)(F.lds + RING_OFF), F.lane);
        }
        if (BOTH(6)) GRID_BAR();
    }
    if (IN(7)) {
        PHASE_WS();
        for (int L = F.vcu; L < BATCH * CH * 8; L += F.G) {
            const int b = L >> 5, h = (L >> 3) & 3, qt = L & 7;
            const bf16_t* kb_ = (const bf16_t*)(ws + WS_KVC) + (size_t)b * MEM * (2 * CW) + h * CHD;
            at::attn_unit<false>(F.tid, (const bf16_t*)(ws + WS_QC) + (size_t)(b * SEQ + qt * 256) * CW + h * CHD, kb_,
                                 (bf16_t*)(ws + WS_OC) + (size_t)(b * SEQ + qt * 256) * CW + h * CHD, 4, 0, nullptr, (LAS char*)(F.lds + RING_OFF));
        }
        __syncthreads();
        if (BOTH(7)) GRID_BAR();
    }
    if (IN(8)) {
        PHASE_WS();
        SchedTiles S{(const char*)(ws + WS_OC), (const char*)(ws + WS_WCO_T), 64, 8, CW, F.G, (int)blockIdx.x, 0, 1 << 20};
        EpiRes<true> E{(const bf16_t*)(ws + WS_XB), (bf16_t*)(ws + WS_H2B), ws + WS_H2Q, nullptr, nullptr};
        gm::gemm_phase<EpiRes<true>, SchedTiles, false>(F.tid, F.lds + RING_OFF, (const LAS int*)(F.lds + TAB_OFF), CW, S, E);
        if (BOTH(8)) GRID_BAR();
    }
    if (IN(9)) {
        PHASE_WS();
        int* tok_e = (int*)(ws + WS_TOK);
        router_rows(F, (const bf16_t*)(ws + WS_H2B), (const bf16_t*)(ws + WS_WR), args.in[20], args.in[22], (float*)(ws + WS_RS2), (int*)(ws + WS_CTL) + CW_CNT, (int*)(ws + WS_LIST), tok_e, tok_e + 2 * M, (float*)(tok_e + 4 * M));
        if (BOTH(9)) GRID_BAR();
    }
    if (IN(10)) {
        PHASE_WS();
        LAS int* mt = (LAS int*)(F.lds + MOE_OFF); LAS int* tab = (LAS int*)(F.lds + TAB_OFF); LAS int* ul = mt + 100;
        moe_tables(mt, (const int*)(ws + WS_CTL) + CW_CNT, F.tid);
        moe_unit_list(ul, mt, F.G, F.vcu, F.tid);
        SchedMoEL<true> SL{ul, (const char*)(ws + WS_H2Q), (const char*)(ws + WS_WGU_T)};
        { const int* list = (const int*)(ws + WS_LIST); gm::Unit u;
          for (int i = 0; i < 8 && SL.next(i, u); ++i) if (F.tid < 256) { const int rg = u.pm * 256 + F.tid; tab[i * 256 + F.tid] = list[u.kind * M + (rg < mt[u.kind] ? rg : 0)]; } }
        VM_WAIT(); LDS_WAIT(); __syncthreads();
        EpiGU E{(bf16_t*)(ws + WS_HACT), (const float*)(ws + WS_RS2), mt, tab};
        gm::gemm_phase<EpiGU, SchedMoEL<true>, true, true, true>(F.tid, F.lds + RING_OFF, tab, DM / 2, SL, E);
        if constexpr (REP_MOE > 1) { __syncthreads(); gm::gemm_phase<EpiGU, SchedMoEL<true>, true, true, true>(F.tid, F.lds + RING_OFF, tab, DM / 2, SL, E); }
        if (BOTH(10)) GRID_BAR();
    }
    if (IN(11)) {
        PHASE_WS();
        LAS int* mt = (LAS int*)(F.lds + MOE_OFF);
        moe_tables(mt, (const int*)(ws + WS_CTL) + CW_CNT, F.tid);
        LAS int* tab = (LAS int*)(F.lds + TAB_OFF); LAS int* ul = mt + 100;
        moe_unit_list(ul, mt, F.G, F.vcu, F.tid);
        SchedMoEL<false> SL{ul, (const char*)(ws + WS_HACT), (const char*)(ws + WS_WD_T)};
        { gm::Unit u;
          for (int i = 0; i < 8 && SL.next(i, u); ++i) if (F.tid < 256) tab[i * 256 + F.tid] = mt[65 + u.kind] + u.pm * 256 + F.tid; }
        LDS_WAIT(); __syncthreads();
        EpiDown E{ws + WS_Y, mt};
        gm::gemm_phase<EpiDown, SchedMoEL<false>, true, true, true>(F.tid, F.lds + RING_OFF, tab, DE / 2, SL, E);
        if constexpr (REP_MOE > 1) { __syncthreads(); gm::gemm_phase<EpiDown, SchedMoEL<false>, true, true, true>(F.tid, F.lds + RING_OFF, tab, DE / 2, SL, E); }
        if (BOTH(11)) GRID_BAR();
    }
    if (IN(12)) {
        PHASE_WS();
        LAS int* mt = (LAS int*)(F.lds + MOE_OFF);
        moe_tables(mt, (const int*)(ws + WS_CTL) + CW_CNT, F.tid);
        const int* tok_e = (const int*)(ws + WS_TOK);
        final_rows(F, (const bf16_t*)(ws + WS_H2B), args.out, ws + WS_Y, tok_e, tok_e + 2 * M, (const float*)(tok_e + 4 * M), args.in[26], mt);
    }
#undef IN
#undef BOTH
}
extern "C" void kernel_launch(void* const* d_in, const int* in_sizes, int n_in, void* d_out, int out_size, void* d_ws, size_t ws_size, hipStream_t stream) {
  static int grid = 0;
  static float rfv[16];
  if (grid == 0) {
    int dev = 0, cus = 0;
    if (hipGetDevice(&dev) != hipSuccess || hipDeviceGetAttribute(&cus, hipDeviceAttributeMultiprocessorCount, dev) != hipSuccess) { fprintf(stderr, "kernel_launch: device query failed\n"); grid = -1; return; }
    if (hipFuncSetAttribute((const void*)fwd, hipFuncAttributeMaxDynamicSharedMemorySize, LDS_BYTES) != hipSuccess) { fprintf(stderr, "kernel_launch: hipFuncSetAttribute failed\n"); grid = -1; return; }
    int per_cu = 0;
    if (hipOccupancyMaxActiveBlocksPerMultiprocessor(&per_cu, (const void*)fwd, NWAVES * 64, LDS_BYTES) != hipSuccess || per_cu < 1) fprintf(stderr, "kernel_launch: occupancy query says %d\n", per_cu);
    (void)hipGetLastError();
    for (int i = 0; i < 16; ++i) rfv[i] = (float)pow(500000.0, -(double)i / 16.0);
    grid = cus;
  }
  if (grid < 0) return;
  float* out = (float*)d_out;
  unsigned char* ws = (unsigned char*)d_ws;
  (void)hipMemsetAsync(ws + WS_CTL, 0, CTL_ZERO_BYTES, stream);
  Args a{};
  for (int i = 0; i < 27; ++i) a.in[i] = (const float*)d_in[i];
  a.out = out; a.ws = ws; for (int i = 0; i < 16; ++i) a.rf[i] = rfv[i];
  a.ph_lo = 0; a.ph_hi = 13; a.li = 0;
  hipLaunchKernelGGL(fwd, dim3(grid), dim3(NWAVES * 64), LDS_BYTES, stream, a);
}
```
